# Optimizing an MI355X kernel written in HIP

```python
import math
import jax, jax.numpy as jnp
from jax import lax
import numpy as np

D_MODEL = 1024
BATCH = 8
SEQ = 2048
DEPTH = 4
DEC_BATCH = 32
DEC_SEQ = 2048
PAST_LEN = 128

F32 = jnp.float32
GRID_W = 64
Q_BLOCK = 128
EPS = 1e-6
N_BRANCHES = 4
BRANCH_WIDTH = D_MODEL // 2
HEAD_DIM = 64
GQA_HEADS = BRANCH_WIDTH // HEAD_DIM
GQA_KV_HEADS = GQA_HEADS // 4
ROPE_THETA = 10000.0
S5_WIDTH = BRANCH_WIDTH
S5_GROUP = 16
S5_GROUPS = S5_WIDTH // S5_GROUP
S5_STATE = 64
DT_MIN = 1e-3
DT_MAX = 1e-1
DIFF_HEAD_DIM = HEAD_DIM
DIFF_V_DIM = 2 * DIFF_HEAD_DIM
DIFF_HEADS = BRANCH_WIDTH // DIFF_V_DIM
RET_K_DIM = HEAD_DIM
RET_V_DIM = 2 * RET_K_DIM
RET_HEADS = BRANCH_WIDTH // RET_V_DIM
RET_CHUNK = 128
REL_BUCKETS = 32
REL_MAX_DIST = 128
D_FF = -(-8 * D_MODEL // (3 * 256)) * 256
IN_SIZES = (GQA_HEADS * HEAD_DIM, GQA_KV_HEADS * HEAD_DIM, GQA_KV_HEADS * HEAD_DIM,
            S5_WIDTH,
            DIFF_HEADS * 2 * DIFF_HEAD_DIM, DIFF_HEADS * 2 * DIFF_HEAD_DIM, DIFF_HEADS * DIFF_V_DIM,
            RET_HEADS * RET_K_DIM, RET_HEADS * RET_K_DIM, RET_HEADS * RET_V_DIM, RET_HEADS * RET_V_DIM)
IN_WIDTH = sum(IN_SIZES)

kernel_name = 'hybrid_bidir_gated_branch_encoder'


def rms_norm(x, gain):
    xf = x.astype(F32)
    y = xf * lax.rsqrt(jnp.mean(xf * xf, axis=-1, keepdims=True) + EPS)
    return (y * gain.astype(F32)).astype(x.dtype)


def split_columns(u):
    points = []
    acc = 0
    for size in IN_SIZES[:-1]:
        acc += size
        points.append(acc)
    return jnp.split(u, points, axis=-1)


def apply_rotary(x, cos, sin):
    xf = x.astype(F32)
    x1, x2 = jnp.split(xf, 2, axis=-1)
    return jnp.concatenate([x1 * cos - x2 * sin, x2 * cos + x1 * sin], axis=-1).astype(x.dtype)


def axial_rotary(length):
    rows = length // GRID_W
    row = jnp.repeat(jnp.arange(rows, dtype=F32), GRID_W)
    col = jnp.tile(jnp.arange(GRID_W, dtype=F32), rows)
    n_freq = HEAD_DIM // 4
    inv = ROPE_THETA ** (-jnp.arange(n_freq, dtype=F32) / n_freq)
    ang = jnp.concatenate([row[:, None] * inv, col[:, None] * inv], axis=-1)
    return jnp.cos(ang)[:, None, :], jnp.sin(ang)[:, None, :]


def rotary_1d(length, dim):
    half = dim // 2
    inv = ROPE_THETA ** (-jnp.arange(half, dtype=F32) / half)
    ang = jnp.arange(length, dtype=F32)[:, None] * inv
    return jnp.cos(ang)[:, None, :], jnp.sin(ang)[:, None, :]


def gqa_axial_attention(q, k, v, q_gain, k_gain):
    B, L, _ = q.shape
    rep = GQA_HEADS // GQA_KV_HEADS
    cos, sin = axial_rotary(L)
    q = apply_rotary(rms_norm(q.reshape(B, L, GQA_HEADS, HEAD_DIM), q_gain), cos, sin)
    k = apply_rotary(rms_norm(k.reshape(B, L, GQA_KV_HEADS, HEAD_DIM), k_gain), cos, sin)
    v = v.reshape(B, L, GQA_KV_HEADS, HEAD_DIM)
    n_blocks = L // Q_BLOCK
    q_blocks = q.reshape(B, n_blocks, Q_BLOCK, GQA_KV_HEADS, rep, HEAD_DIM).transpose(1, 0, 2, 3, 4, 5)
    scale = HEAD_DIM ** -0.5

    def attend_block(qb):
        s = jnp.einsum('bqkgd,bskd->bkgqs', qb, k).astype(F32) * scale
        p = jax.nn.softmax(s, axis=-1).astype(v.dtype)
        return jnp.einsum('bkgqs,bskd->bqkgd', p, v)

    o = lax.map(attend_block, q_blocks)
    return o.transpose(1, 0, 2, 3, 4, 5).reshape(B, L, GQA_HEADS * HEAD_DIM)


def t5_bucket(rel):
    n = REL_BUCKETS // 2
    max_exact = n // 2
    base = (rel > 0).astype(jnp.int32) * n
    dist = jnp.abs(rel)
    log_ratio = jnp.log(jnp.maximum(dist, 1).astype(F32) / max_exact) / math.log(REL_MAX_DIST / max_exact)
    large = jnp.minimum(max_exact + (log_ratio * (n - max_exact)).astype(jnp.int32), n - 1)
    return base + jnp.where(dist < max_exact, dist, large)


def differential_attention(q, k, v, lam_vecs, subln_gain, rel_table, lambda_init):
    B, L, _ = q.shape
    H, d = DIFF_HEADS, DIFF_HEAD_DIM
    q = q.reshape(B, L, H, 2, d)
    k = k.reshape(B, L, H, 2, d)
    v = v.reshape(B, L, H, DIFF_V_DIM)
    lv = lam_vecs.astype(F32)
    lam = jnp.exp(jnp.sum(lv[0] * lv[1])) - jnp.exp(jnp.sum(lv[2] * lv[3])) + lambda_init
    n_blocks = L // Q_BLOCK
    q_blocks = q.reshape(B, n_blocks, Q_BLOCK, H, 2, d).transpose(1, 0, 2, 3, 4, 5)
    k_pos = jnp.arange(L, dtype=jnp.int32)
    scale = d ** -0.5

    def attend_block(args):
        qb, block_idx = args
        q_pos = block_idx * Q_BLOCK + jnp.arange(Q_BLOCK, dtype=jnp.int32)
        bias = rel_table[t5_bucket(k_pos[None, :] - q_pos[:, None])].astype(F32)
        bias = bias.transpose(2, 0, 1)[None, :, None]
        s = jnp.einsum('bqhmd,bshmd->bhmqs', qb, k).astype(F32) * scale + bias
        p = jax.nn.softmax(s, axis=-1)
        a = (p[:, :, 0] - lam * p[:, :, 1]).astype(v.dtype)
        return jnp.einsum('bhqs,bshv->bqhv', a, v)

    o = lax.map(attend_block, (q_blocks, jnp.arange(n_blocks, dtype=jnp.int32)))
    o = o.transpose(1, 0, 2, 3, 4).reshape(B, L, H, DIFF_V_DIM)
    o = rms_norm(o, subln_gain) * (1.0 - lambda_init)
    return o.reshape(B, L, H * DIFF_V_DIM)


def complex_linear_combine(e1, e2):
    ar1, ai1, br1, bi1 = e1
    ar2, ai2, br2, bi2 = e2
    ar2b, ai2b = ar2[:, None], ai2[:, None]
    return (ar1 * ar2 - ai1 * ai2, ar1 * ai2 + ai1 * ar2,
            ar2b * br1 - ai2b * bi1 + br2, ar2b * bi1 + ai2b * br1 + bi2)


def s5_direction(ug, a_re, a_im, log_dt, b_re, b_im, c_re, c_im, reverse):
    a_re, a_im = a_re.astype(F32), a_im.astype(F32)
    dt = jnp.exp(log_dt.astype(F32))[:, None]
    mag = jnp.exp(dt * a_re)
    ab_re = mag * jnp.cos(dt * a_im)
    ab_im = mag * jnp.sin(dt * a_im)
    den = a_re * a_re + a_im * a_im
    num_re = ab_re - 1.0
    f_re = (num_re * a_re + ab_im * a_im) / den
    f_im = (ab_im * a_re - num_re * a_im) / den
    b_re, b_im = b_re.astype(F32), b_im.astype(F32)
    bb_re = f_re[..., None] * b_re - f_im[..., None] * b_im
    bb_im = f_re[..., None] * b_im + f_im[..., None] * b_re
    u_re = jnp.einsum('blgc,gnc->lbgn', ug, bb_re)
    u_im = jnp.einsum('blgc,gnc->lbgn', ug, bb_im)
    shp = (ug.shape[1],) + ab_re.shape
    elems = (jnp.broadcast_to(ab_re, shp), jnp.broadcast_to(ab_im, shp), u_re, u_im)
    _, _, s_re, s_im = lax.associative_scan(complex_linear_combine, elems, reverse=reverse, axis=0)
    return (jnp.einsum('lbgn,gcn->blgc', s_re, c_re.astype(F32))
            - jnp.einsum('lbgn,gcn->blgc', s_im, c_im.astype(F32)))


def s5_mixer(u, a_re, a_im, log_dt, b_re, b_im, c_re, c_im, d_skip, w_glu, b_glu):
    B, L, _ = u.shape
    ug = u.astype(F32).reshape(B, L, S5_GROUPS, S5_GROUP)
    y = ug * d_skip.astype(F32).reshape(S5_GROUPS, S5_GROUP)
    for direction in range(2):
        y = y + s5_direction(ug, a_re[direction], a_im[direction], log_dt[direction],
                             b_re[direction], b_im[direction], c_re[direction], c_im[direction],
                             reverse=(direction == 1))
    y = jax.nn.gelu(y.reshape(B, L, S5_WIDTH))
    out = y * jax.nn.sigmoid(y @ w_glu.astype(F32) + b_glu.astype(F32))
    return out.astype(u.dtype)


def retention_mixer(q, k, v, g):
    B, L, _ = q.shape
    H, dk, dv, C = RET_HEADS, RET_K_DIM, RET_V_DIM, RET_CHUNK
    nc = L // C
    cos, sin = rotary_1d(L, dk)
    q = apply_rotary(q.reshape(B, L, H, dk).astype(F32), cos, sin) * dk ** -0.5
    k = apply_rotary(k.reshape(B, L, H, dk).astype(F32), cos, sin)
    v = v.reshape(B, L, H, dv).astype(F32)
    qc = q.reshape(B, nc, C, H, dk)
    kc = k.reshape(B, nc, C, H, dk)
    vc = v.reshape(B, nc, C, H, dv)
    log_gamma = jnp.log(1.0 - 2.0 ** (-5.0 - jnp.arange(H, dtype=F32)))
    pos = jnp.arange(C, dtype=F32)
    intra_decay = jnp.exp(jnp.abs(pos[:, None] - pos[None, :])[None] * log_gamma[:, None, None])
    scores = jnp.einsum('bnqhd,bnkhd->bnhqk', qc, kc) * intra_decay
    o = jnp.einsum('bnhqk,bnkhv->bnqhv', scores, vc)
    w_to_end = jnp.exp((C - 1 - pos)[:, None] * log_gamma)
    w_to_start = jnp.exp(pos[:, None] * log_gamma)
    kv_f = jnp.einsum('bnkhd,kh,bnkhv->nbhdv', kc, w_to_end, vc)
    kv_b = jnp.einsum('bnkhd,kh,bnkhv->nbhdv', kc, w_to_start, vc)
    chunk_decay = jnp.exp(C * log_gamma)[None, :, None, None]

    def carry_step(state, kv):
        return chunk_decay * state + kv, state

    init = jnp.zeros((B, H, dk, dv), F32)
    _, s_f = lax.scan(carry_step, init, kv_f)
    _, s_b = lax.scan(carry_step, init, kv_b, reverse=True)
    q_from_start = jnp.exp((pos + 1.0)[:, None] * log_gamma)
    q_from_end = jnp.exp((C - pos)[:, None] * log_gamma)
    o = (o + jnp.einsum('bnqhd,qh,nbhdv->bnqhv', qc, q_from_start, s_f)
         + jnp.einsum('bnqhd,qh,nbhdv->bnqhv', qc, q_from_end, s_b))
    o = o.reshape(B, L, H, dv)
    mu = jnp.mean(o, axis=-1, keepdims=True)
    var = jnp.mean(jnp.square(o - mu), axis=-1, keepdims=True)
    o = (o - mu) * lax.rsqrt(var + EPS)
    out = jax.nn.silu(g.astype(F32)).reshape(B, L, H, dv) * o
    return out.reshape(B, L, BRANCH_WIDTH).astype(g.dtype)


def hybrid_layer(x, layer, p):
    lambda_init = 0.8 - 0.6 * math.exp(-0.3 * layer)
    h = rms_norm(x, p['norm_mix'][layer])
    a_q, a_k, a_v, s5_u, c_q, c_k, c_v, r_q, r_k, r_v, r_g = split_columns(h @ p['w_in'][layer])
    branches = (
        gqa_axial_attention(a_q, a_k, a_v, p['q_gain'][layer], p['k_gain'][layer]),
        s5_mixer(s5_u, p['s5_a_re'][layer], p['s5_a_im'][layer], p['s5_log_dt'][layer],
                 p['s5_b_re'][layer], p['s5_b_im'][layer], p['s5_c_re'][layer], p['s5_c_im'][layer],
                 p['s5_d'][layer], p['s5_w_glu'][layer], p['s5_b_glu'][layer]),
        differential_attention(c_q, c_k, c_v, p['diff_lambda'][layer], p['diff_subln'][layer],
                               p['rel_bias_table'], lambda_init),
        retention_mixer(r_q, r_k, r_v, r_g),
    )
    merged = jnp.zeros_like(x)
    for b, out in enumerate(branches):
        gate = jax.nn.sigmoid(h @ p['w_gate'][layer, b])
        merged = merged + gate * (out @ p['w_branch'][layer, b])
    x = x + merged @ p['w_out'][layer]
    h = rms_norm(x, p['norm_ffn'][layer])
    ffn_gate, ffn_up = jnp.split(h @ p['w_ffn_in'][layer], 2, axis=-1)
    return x + (jax.nn.silu(ffn_gate) * ffn_up) @ p['w_ffn_out'][layer]


def encoder_trunk(x, p):
    for layer in range(DEPTH):
        x = hybrid_layer(x, layer, p)
    return rms_norm(x, p['norm_final'])


def setup_inputs(seed: int = 0) -> dict:
    key = jax.random.key(seed)
    ks = iter(jax.random.split(key, 32))

    def nrm(shape, scale):
        return jax.random.normal(next(ks), shape, F32) * scale

    s5_shape = (DEPTH, 2, S5_GROUPS, S5_STATE)
    return {
        'x_prompt': nrm((BATCH, SEQ, D_MODEL), 1.0),
        'x_sample': nrm((DEC_BATCH, DEC_SEQ, D_MODEL), 1.0),
        'norm_mix': 1.0 + nrm((DEPTH, D_MODEL), 0.02),
        'w_in': nrm((DEPTH, D_MODEL, IN_WIDTH), D_MODEL ** -0.5),
        'q_gain': 1.0 + nrm((DEPTH, HEAD_DIM), 0.02),
        'k_gain': 1.0 + nrm((DEPTH, HEAD_DIM), 0.02),
        's5_a_re': -0.5 + nrm(s5_shape, 0.01),
        's5_a_im': math.pi * jnp.arange(S5_STATE, dtype=F32) + nrm(s5_shape, 0.01),
        's5_log_dt': jax.random.uniform(next(ks), (DEPTH, 2, S5_GROUPS), F32,
                                        math.log(DT_MIN), math.log(DT_MAX)),
        's5_b_re': nrm((DEPTH, 2, S5_GROUPS, S5_STATE, S5_GROUP), (2 * S5_GROUP) ** -0.5),
        's5_b_im': nrm((DEPTH, 2, S5_GROUPS, S5_STATE, S5_GROUP), (2 * S5_GROUP) ** -0.5),
        's5_c_re': nrm((DEPTH, 2, S5_GROUPS, S5_GROUP, S5_STATE), (2 * S5_STATE) ** -0.5),
        's5_c_im': nrm((DEPTH, 2, S5_GROUPS, S5_GROUP, S5_STATE), (2 * S5_STATE) ** -0.5),
        's5_d': nrm((DEPTH, S5_WIDTH), 1.0),
        's5_w_glu': nrm((DEPTH, S5_WIDTH, S5_WIDTH), S5_WIDTH ** -0.5),
        's5_b_glu': nrm((DEPTH, S5_WIDTH), 0.01),
        'diff_lambda': nrm((DEPTH, 4, DIFF_HEAD_DIM), 0.1),
        'diff_subln': 1.0 + nrm((DEPTH, DIFF_V_DIM), 0.02),
        'rel_bias_table': nrm((REL_BUCKETS, DIFF_HEADS), 0.5),
        'w_gate': nrm((DEPTH, N_BRANCHES, D_MODEL, D_MODEL), D_MODEL ** -0.5),
        'w_branch': nrm((DEPTH, N_BRANCHES, BRANCH_WIDTH, D_MODEL), BRANCH_WIDTH ** -0.5),
        'w_out': nrm((DEPTH, D_MODEL, D_MODEL), D_MODEL ** -0.5),
        'norm_ffn': 1.0 + nrm((DEPTH, D_MODEL), 0.02),
        'w_ffn_in': nrm((DEPTH, D_MODEL, 2 * D_FF), D_MODEL ** -0.5),
        'w_ffn_out': nrm((DEPTH, D_FF, D_MODEL), D_FF ** -0.5),
        'norm_final': 1.0 + nrm((D_MODEL,), 0.02),
    }


def reference(x_prompt, x_sample, norm_mix, w_in, q_gain, k_gain, s5_a_re, s5_a_im, s5_log_dt,
              s5_b_re, s5_b_im, s5_c_re, s5_c_im, s5_d, s5_w_glu, s5_b_glu, diff_lambda, diff_subln,
              rel_bias_table, w_gate, w_branch, w_out, norm_ffn, w_ffn_in, w_ffn_out, norm_final):
    p = dict(norm_mix=norm_mix, w_in=w_in, q_gain=q_gain, k_gain=k_gain,
             s5_a_re=s5_a_re, s5_a_im=s5_a_im, s5_log_dt=s5_log_dt,
             s5_b_re=s5_b_re, s5_b_im=s5_b_im, s5_c_re=s5_c_re, s5_c_im=s5_c_im,
             s5_d=s5_d, s5_w_glu=s5_w_glu, s5_b_glu=s5_b_glu,
             diff_lambda=diff_lambda, diff_subln=diff_subln, rel_bias_table=rel_bias_table,
             w_gate=w_gate, w_branch=w_branch, w_out=w_out, norm_ffn=norm_ffn,
             w_ffn_in=w_ffn_in, w_ffn_out=w_ffn_out, norm_final=norm_final)
    y_prompt = encoder_trunk(x_prompt, p)
    y_sample = encoder_trunk(x_sample, p)
    return (y_prompt, y_sample)
```

```cpp
#include <hip/hip_runtime.h>
#include <hip/hip_cooperative_groups.h>
#include <cstdio>
#include <cstdint>
namespace cg = cooperative_groups;

#ifndef MULTI_LAUNCH
#define MULTI_LAUNCH 0
#endif

#define DI __device__ __forceinline__
typedef unsigned short bf16_t;
typedef __bf16 bf16v2 __attribute__((ext_vector_type(2)));
typedef float f32x2 __attribute__((ext_vector_type(2)));
typedef short bf16x8 __attribute__((ext_vector_type(8)));
typedef short s16x4 __attribute__((ext_vector_type(4)));
typedef float f32x4 __attribute__((ext_vector_type(4)));
typedef float f32x16 __attribute__((ext_vector_type(16)));
typedef unsigned u32x4 __attribute__((ext_vector_type(4)));
typedef unsigned u32x2 __attribute__((ext_vector_type(2)));

constexpr int DM = 1024, SL = 2048, NSEQ = 40, G = 8, NGRP = NSEQ / G, TG = G * SL;
constexpr int INW = 4352, NIN = INW + 4096, DFF = 2816;
constexpr float EPS = 1e-6f;
constexpr float LOG2E = 1.4426950408889634f;

constexpr size_t WING = 0;
constexpr size_t WB = 8650752;
constexpr size_t WO = WB + 2097152;
constexpr size_t WFI = WO + 1048576;
constexpr size_t WFO = WFI + 5767168;
constexpr size_t WGLU = WFO + 2883584;
constexpr size_t LW = WGLU + 262144;

constexpr size_t OFF_W = 0;
constexpr size_t OFF_TAB = OFF_W + 4 * LW * 2;
constexpr size_t OFF_COSA = OFF_TAB, OFF_SINA = OFF_TAB + 262144, OFF_COSD = OFF_TAB + 2 * 262144, OFF_SIND = OFF_TAB + 3 * 262144;
constexpr size_t OFF_BIAS = OFF_TAB + 1048576;
constexpr size_t OFF_LAM = OFF_BIAS + 65536;
constexpr size_t OFF_QCNT = OFF_LAM + 256;
constexpr size_t OFF_BAR = OFF_TAB + 1048576 + 131072;
constexpr size_t OFF_H = OFF_TAB + 2097152;
constexpr size_t OFF_U = OFF_H + (size_t)TG * 1024 * 2;
constexpr size_t OFF_GATE = OFF_U + (size_t)TG * INW * 2;
constexpr size_t OFF_VTA = OFF_GATE + (size_t)TG * 4096 * 2;
constexpr size_t OFF_VTC = OFF_VTA + (size_t)TG * 128 * 2;
constexpr size_t OFF_VTD = OFF_VTC + (size_t)TG * 512 * 2;
constexpr size_t OFF_O = OFF_VTD + (size_t)TG * 512 * 2;
constexpr size_t OFF_YF = OFF_O + (size_t)4 * TG * 512 * 2;
constexpr size_t OFF_YB = OFF_YF + (size_t)TG * 512 * 2;
constexpr size_t OFF_DT = OFF_YB + (size_t)TG * 512 * 2;
constexpr size_t OFF_RSS1 = OFF_DT + (size_t)2 * TG * 512 * 2;
constexpr size_t OFF_RSS2 = OFF_RSS1 + (size_t)TG * 32;
constexpr size_t WS_END = OFF_RSS2 + (size_t)TG * 32;
constexpr size_t OFF_M = OFF_U;
constexpr size_t OFF_F = OFF_U;

struct Params { const float* in[26]; float* out; char* ws; };

enum { I_XP = 0, I_XS, I_NMIX, I_WIN, I_QG, I_KG, I_SARE, I_SAIM, I_SLDT, I_SBRE, I_SBIM, I_SCRE, I_SCIM, I_SD, I_SWGLU, I_SBGLU,
       I_DLAM, I_DSUB, I_REL, I_WGATE, I_WBR, I_WOUT, I_NFFN, I_WFI, I_WFO, I_NFIN };

constexpr int LDS_BYTES = 71680;
constexpr int AROWB = 144;
constexpr int ROWB = 128;
constexpr int GT_BYTES = 128 * ROWB;

DI int bidx() { int b = blockIdx.x; asm volatile("" : "+s"(b)); return b; }
DI int gdim() { int g = gridDim.x; asm volatile("" : "+s"(g)); return g; }
DI int tidx() { int t = threadIdx.x; asm volatile("" : "+v"(t)); return t; }
DI unsigned pk2(float a, float b) { f32x2 v = {a, b}; bf16v2 r = __builtin_convertvector(v, bf16v2); return __builtin_bit_cast(unsigned, r); }
DI float bf2f(bf16_t v) { return __uint_as_float(((unsigned)v) << 16); }
DI float bflo(unsigned w) { return __uint_as_float(w << 16); }
DI float bfhi(unsigned w) { return __uint_as_float(w & 0xffff0000u); }
DI float sigmoidf_(float x) { return __builtin_amdgcn_rcpf(1.0f + __builtin_amdgcn_exp2f(-LOG2E * x)); }
DI float wave_sum(float v) { v += __shfl_xor(v, 32); v += __shfl_xor(v, 16); v += __shfl_xor(v, 8); v += __shfl_xor(v, 4); v += __shfl_xor(v, 2); v += __shfl_xor(v, 1); return v; }
DI float row_rstd(const float* rss, int row) { const f32x4 a = *(const f32x4*)(rss + (size_t)row * 8), b = *(const f32x4*)(rss + (size_t)row * 8 + 4); return rsqrtf((((a[0] + a[1]) + (a[2] + a[3])) + ((b[0] + b[1]) + (b[2] + b[3]))) * (1.0f / 1024.0f) + EPS); }
DI bf16_t* wts(const Params& p, int layer) { return (bf16_t*)(p.ws + OFF_W) + (size_t)layer * LW; }
#define MFMA16(a, b, c) __builtin_amdgcn_mfma_f32_16x16x32_bf16((a), (b), (c), 0, 0, 0)
#define MFMA32(a, b, c) __builtin_amdgcn_mfma_f32_32x32x16_bf16((a), (b), (c), 0, 0, 0)

template <bool SWAP, int BMAP>
DI void gemm_compute(const char* cur, int aoff, int boff, int sw, f32x4 (&acc)[4][4]) {
#pragma unroll
    for (int ks = 0; ks < 2; ++ks) {
        bf16x8 af[4], bfr[4];
        if (ks) asm volatile("" ::: "memory");
        const int so = sw ^ (ks * 64);
#pragma unroll
        for (int m = 0; m < 4; ++m) af[m] = *(const bf16x8*)(cur + aoff + m * 16 * ROWB + so);
#pragma unroll
        for (int n = 0; n < 4; ++n) bfr[n] = *(const bf16x8*)(cur + boff + (BMAP ? ((n >> 1) * 64 + (n & 1) * 16) : n * 16) * ROWB + so);
#pragma unroll
        for (int m = 0; m < 4; ++m)
#pragma unroll
            for (int n = 0; n < 4; ++n) acc[m][n] = SWAP ? MFMA16(bfr[n], af[m], acc[m][n]) : MFMA16(af[m], bfr[n], acc[m][n]);
    }
}
#define GLOAD(RA, RB, KT) { _Pragma("unroll") for (int i_ = 0; i_ < 4; ++i_) { \
    const char* ua_ = Ab + (size_t)(((32 * i_) * lda + (KT) * 64) * 2); const char* ub_ = Bb + (size_t)(((32 * i_) * ldb + (KT) * 64) * 2); \
    RA[i_] = *(const u32x4*)(ua_ + avoff); RB[i_] = *(const u32x4*)(ub_ + bvoff); } }
#define LSTORE(RA, RB, ST) { _Pragma("unroll") for (int i_ = 0; i_ < 4; ++i_) { *(u32x4*)(lds + (ST) * (2 * GT_BYTES) + soff + 32 * i_ * ROWB) = RA[i_]; *(u32x4*)(lds + (ST) * (2 * GT_BYTES) + GT_BYTES + soff + 32 * i_ * ROWB) = RB[i_]; } }
template <bool SWAP, int BMAP = 0, bool DEEP = true>
DI void gemm128(const bf16_t* __restrict__ A, int lda, const bf16_t* __restrict__ B, int ldb, int K, f32x4 (&acc)[4][4], char* lds) {
    const int tid = tidx(), lane = tid & 63, w = tid >> 6, wr = w >> 1, wc = w & 1;
    const int srow = tid >> 3, scol = tid & 7;
    const char* Ab = (const char*)A; const char* Bb = (const char*)B;
    const unsigned avoff = (unsigned)(srow * lda + scol * 8) * 2u, bvoff = (unsigned)(srow * ldb + scol * 8) * 2u;
    const int soff = srow * ROWB + ((scol ^ ((srow >> 1) & 7)) << 4);
    const int nk = K >> 6;
    const int aoff = (wr * 64 + (lane & 15)) * ROWB;
    const int boff = GT_BYTES + ((BMAP ? wc * 32 : wc * 64) + (lane & 15)) * ROWB;
    const int sw = ((lane >> 4) ^ ((lane & 15) >> 1)) << 4;
    u32x4 ra0[4], rb0[4];
    GLOAD(ra0, rb0, 0);
    LSTORE(ra0, rb0, 0);
    if (DEEP) {
        u32x4 ra1[4], rb1[4];
        GLOAD(ra1, rb1, 1);
        __syncthreads();
        for (int kt = 0; kt < nk; kt += 2) {
            { const int k2 = kt + 2 < nk ? kt + 2 : nk - 1; GLOAD(ra0, rb0, k2); }
            gemm_compute<SWAP, BMAP>(lds, aoff, boff, sw, acc);
            LSTORE(ra1, rb1, 1);
            __syncthreads();
            { const int k3 = kt + 3 < nk ? kt + 3 : nk - 1; GLOAD(ra1, rb1, k3); }
            gemm_compute<SWAP, BMAP>(lds + 2 * GT_BYTES, aoff, boff, sw, acc);
            LSTORE(ra0, rb0, 0);
            __syncthreads();
        }
    } else {
        __syncthreads();
        for (int kt = 0; kt < nk; ++kt) {
            const bool more = (kt + 1 < nk);
            if (more) GLOAD(ra0, rb0, kt + 1);
            gemm_compute<SWAP, BMAP>(lds + (kt & 1) * (2 * GT_BYTES), aoff, boff, sw, acc);
            if (more) { if (kt & 1) { LSTORE(ra0, rb0, 0); } else { LSTORE(ra0, rb0, 1); } }
            __syncthreads();
        }
    }
}

struct TileIter { int per, SM, SN, nSn, sbase, len, q, nslot; };
DI void ti_init(TileIter& it, int NTm, int NTn, int SM, int SN) {
    const int x = bidx() & 7;
    it.nslot = (gdim() - x + 7) >> 3; it.per = SM * SN; it.SM = SM; it.SN = SN; it.nSn = NTn / SN;
    const int nS = (NTm / SM) * it.nSn;
    it.sbase = x * (nS >> 3); it.len = (nS >> 3) * it.per; it.q = bidx() >> 3;
}
DI bool ti_next(TileIter& it, int& tm, int& tn) {
    if (it.q >= it.len) return false;
    const int j = it.q / it.per, w = it.q % it.per, S = it.sbase + j, sm = S / it.nSn, sn = S % it.nSn;
    tm = sm * it.SM + (w % it.SM); tn = sn * it.SN + (w / it.SM);
    it.q += it.nslot;
    return true;
}

struct GemmRegs { u32x4 a0[4], b0[4], a1[4], b1[4]; };
typedef const __attribute__((address_space(1))) char* gptr_t;
typedef const __attribute__((address_space(1))) u32x4* gvec_t;
DI gptr_t uptr(const void* q) {
    const size_t v = (size_t)q;
    const unsigned lo = __builtin_amdgcn_readfirstlane((unsigned)v), hi = __builtin_amdgcn_readfirstlane((unsigned)(v >> 32));
    return (gptr_t)(((size_t)hi << 32) | lo);
}
#define GLOADP(RA, RB, PA, PB, KT) { _Pragma("unroll") for (int i_ = 0; i_ < 4; ++i_) { \
    gptr_t ua_ = (PA) + (size_t)(((32 * i_) * lda + (KT) * 64) * 2); gptr_t ub_ = (PB) + (size_t)(((32 * i_) * ldb + (KT) * 64) * 2); \
    RA[i_] = *(gvec_t)(ua_ + avoff); RB[i_] = *(gvec_t)(ub_ + bvoff); } }
DI void gemm_prime(const bf16_t* A, int lda, const bf16_t* B, int ldb, GemmRegs& g) {
    const int tid = tidx(), srow = tid >> 3, scol = tid & 7;
    const unsigned avoff = (unsigned)(srow * lda + scol * 8) * 2u, bvoff = (unsigned)(srow * ldb + scol * 8) * 2u;
    gptr_t Ab = uptr(A); gptr_t Bb = uptr(B);
    GLOADP(g.a0, g.b0, Ab, Bb, 0);
    GLOADP(g.a1, g.b1, Ab, Bb, 1);
}
template <bool SWAP, int BMAP = 0>
DI void gemm_stream(const bf16_t* A, const bf16_t* B, const bf16_t* nA, const bf16_t* nB, int lda, int ldb, int K, GemmRegs& g, f32x4 (&acc)[4][4], char* lds) {
    const int tid = tidx(), lane = tid & 63, w = tid >> 6, wr = w >> 1, wc = w & 1;
    const int srow = tid >> 3, scol = tid & 7;
    const unsigned avoff = (unsigned)(srow * lda + scol * 8) * 2u, bvoff = (unsigned)(srow * ldb + scol * 8) * 2u;
    gptr_t Ab = uptr(A); gptr_t Bb = uptr(B); gptr_t nAb = uptr(nA); gptr_t nBb = uptr(nB);
    const int soff = srow * ROWB + ((scol ^ ((srow >> 1) & 7)) << 4);
    const int nk = K >> 6;
    const int aoff = (wr * 64 + (lane & 15)) * ROWB;
    const int boff = GT_BYTES + ((BMAP ? wc * 32 : wc * 64) + (lane & 15)) * ROWB;
    const int sw = ((lane >> 4) ^ ((lane & 15) >> 1)) << 4;
    LSTORE(g.a0, g.b0, 0);
    __syncthreads();
    for (int kt = 0; kt < nk; kt += 2) {
        const bool last = kt + 2 >= nk;
        gptr_t pa = last ? nAb : Ab; gptr_t pb = last ? nBb : Bb;
        const int k2 = last ? 0 : kt + 2, k3 = last ? 1 : kt + 3;
        GLOADP(g.a0, g.b0, pa, pb, k2);
        gemm_compute<SWAP, BMAP>(lds, aoff, boff, sw, acc);
        LSTORE(g.a1, g.b1, 1);
        __syncthreads();
        GLOADP(g.a1, g.b1, pa, pb, k3);
        gemm_compute<SWAP, BMAP>(lds + 2 * GT_BYTES, aoff, boff, sw, acc);
        if (!last) LSTORE(g.a0, g.b0, 0);
        __syncthreads();
    }
}

DI void zero_acc(f32x4 (&acc)[4][4]) {
#pragma unroll
    for (int m = 0; m < 4; ++m)
#pragma unroll
        for (int n = 0; n < 4; ++n) acc[m][n] = (f32x4){0.f, 0.f, 0.f, 0.f};
}


constexpr int OROW = 272;
constexpr int OROWF = 528;
DI void otile_put(char* lds, int row, int col, unsigned w0, unsigned w1) { u32x2 w; w[0] = w0; w[1] = w1; *(u32x2*)(lds + row * OROW + col * 2) = w; }
DI void otile_flush(char* lds, bf16_t* dst, int ld) {
    const int tid = tidx();
    __syncthreads();
#pragma unroll
    for (int i = 0; i < 8; ++i) {
        const int c = tid + 256 * i, row = c >> 4, ch = c & 15;
        const u32x4 v = *(const u32x4*)(lds + row * OROW + ch * 16);
        *(u32x4*)(dst + (size_t)row * ld + ch * 8) = v;
    }
    __syncthreads();
}

DI void conv_tile(const float* __restrict__ src, bf16_t* __restrict__ dst, int K, int N, int tk, int tn, int drow0, const float* kgain, float* tile) {
    const int tid = tidx(), ty = tid >> 4, tx = tid & 15;
#pragma unroll
    for (int i = 0; i < 4; ++i) {
        const int k = ty + 16 * i;
        f32x4 v = *(const f32x4*)(src + (size_t)(tk * 64 + k) * N + tn * 64 + tx * 4);
        if (kgain) v = v * kgain[tk * 64 + k];
        tile[k * 65 + tx * 4 + 0] = v[0]; tile[k * 65 + tx * 4 + 1] = v[1]; tile[k * 65 + tx * 4 + 2] = v[2]; tile[k * 65 + tx * 4 + 3] = v[3];
    }
    __syncthreads();
    const int n = tid >> 2, ks = (tid & 3) * 16;
    u32x4 w0, w1;
#pragma unroll
    for (int j = 0; j < 4; ++j) {
        w0[j] = pk2(tile[(ks + 2 * j) * 65 + n], tile[(ks + 2 * j + 1) * 65 + n]);
        w1[j] = pk2(tile[(ks + 8 + 2 * j) * 65 + n], tile[(ks + 8 + 2 * j + 1) * 65 + n]);
    }
    bf16_t* d = dst + (size_t)(drow0 + n) * K + tk * 64 + ks;
    *(u32x4*)d = w0; *(u32x4*)(d + 8) = w1;
    __syncthreads();
}

DI int t5_bucket(int rel) {
    const int base = rel > 0 ? 16 : 0;
    const int dist = rel < 0 ? -rel : rel;
    int b;
    if (dist < 8) b = dist;
    else {
        const float lr = logf((float)dist / 8.0f) / 2.772588722239781f;
        int lg = 8 + (int)(lr * 8.0f);
        b = lg < 15 ? lg : 15;
    }
    return base + b;
}

DI void phase_prologue(const Params& p, char* lds) {
    float* tile = (float*)lds;
    const int tid = tidx();
    for (int t = bidx(); t < 4 * 5056; t += gdim()) {
        const int layer = t / 5056; int q = t % 5056;
        bf16_t* wl = wts(p, layer);
        const float* src; bf16_t* dst; int K, N, nn; const float* kg = nullptr;
        if (q < 1088) { src = p.in[I_WIN] + (size_t)layer * 1024 * INW; dst = wl + WING; K = 1024; N = INW; kg = p.in[I_NMIX] + layer * DM; }
        else if ((q -= 1088) < 1024) { const int b = q >> 8; q &= 255; src = p.in[I_WGATE] + (size_t)(layer * 4 + b) * 1024 * 1024; dst = wl + WING + (size_t)(INW + b * 1024) * 1024; K = 1024; N = 1024; kg = p.in[I_NMIX] + layer * DM; }
        else if ((q -= 1024) < 512) { const int b = q >> 7; q &= 127; src = p.in[I_WBR] + (size_t)(layer * 4 + b) * 512 * 1024; dst = wl + WB + (size_t)b * 1024 * 512; K = 512; N = 1024; }
        else if ((q -= 512) < 256) { src = p.in[I_WOUT] + (size_t)layer * 1024 * 1024; dst = wl + WO; K = 1024; N = 1024; }
        else if ((q -= 256) < 1408) { src = p.in[I_WFI] + (size_t)layer * 1024 * 5632; dst = wl + WFI; K = 1024; N = 5632; kg = p.in[I_NFFN] + layer * DM; }
        else if ((q -= 1408) < 704) { src = p.in[I_WFO] + (size_t)layer * DFF * 1024; dst = wl + WFO; K = DFF; N = 1024; }
        else { q -= 704; src = p.in[I_SWGLU] + (size_t)layer * 512 * 512; dst = wl + WGLU; K = 512; N = 512; }
        nn = N >> 6;
        const int tk = q / nn, tn = q % nn;
        int drow0 = tn * 64;
        if (N == 5632) drow0 = tn < 44 ? tn * 128 : (tn - 44) * 128 + 64;
        conv_tile(src, dst, K, N, tk, tn, drow0, kg, tile);
    }
    const int gt = bidx() * 256 + tid, gn = gdim() * 256;
    float* cosA = (float*)(p.ws + OFF_COSA); float* sinA = (float*)(p.ws + OFF_SINA);
    float* cosD = (float*)(p.ws + OFF_COSD); float* sinD = (float*)(p.ws + OFF_SIND);
    for (int i = gt; i < SL * 32; i += gn) {
        const int t = i >> 5, j = i & 31;
        const float invA = exp2f(-(float)(j & 15) * (13.287712379549449f / 16.0f));
        const float angA = (j < 16 ? (float)(t >> 6) : (float)(t & 63)) * invA;
        cosA[i] = cosf(angA); sinA[i] = sinf(angA);
        const float invD = exp2f(-(float)j * (13.287712379549449f / 32.0f));
        const float angD = (float)t * invD;
        cosD[i] = cosf(angD); sinD[i] = sinf(angD);
    }
    float* bias = (float*)(p.ws + OFF_BIAS);
    for (int i = gt; i < 4 * 4096; i += gn) {
        const int h = i >> 12, r = i & 4095;
        float v = 0.f;
        if (r < 4095) v = p.in[I_REL][t5_bucket(r - 2047) * 4 + h] * LOG2E;
        bias[i] = v;
    }
    if (bidx() == 0) {
        if (tid < 4) {
            const float* lv = p.in[I_DLAM] + tid * 256;
            float s1 = 0.f, s2 = 0.f;
            for (int j = 0; j < 64; ++j) { s1 += lv[j] * lv[64 + j]; s2 += lv[128 + j] * lv[192 + j]; }
            const float li = 0.8f - 0.6f * expf(-0.3f * (float)tid);
            float* lam = (float*)(p.ws + OFF_LAM);
            lam[tid] = expf(s1) - expf(s2) + li; lam[4 + tid] = li;
        }
        if (tid < 64) ((int*)(p.ws + OFF_QCNT))[tid] = 0;
    }
}

DI const float* x_in_row(const Params& p, int grp, int row) {
    const int seq = grp * G + (row >> 11), t = row & 2047;
    return seq < 8 ? p.in[I_XP] + ((size_t)seq * SL + t) * DM : p.in[I_XS] + ((size_t)(seq - 8) * SL + t) * DM;
}
DI void phase_norm(const Params& p, int grp, const float* gain, int mode) {
    const int lane = tidx() & 63;
    const int gw = bidx() * 4 + (tidx() >> 6), nw = gdim() * 4;
    bf16_t* hb = (bf16_t*)(p.ws + OFF_H);
    float* rss = (float*)(p.ws + OFF_RSS1);
    f32x4 gv[4];
#pragma unroll
    for (int i = 0; i < 4; ++i) gv[i] = *(const f32x4*)(gain + lane * 4 + 256 * i);
    for (int row = gw; row < TG; row += nw) {
        float* xo = p.out + ((size_t)grp * TG + row) * DM;
        const float* x = mode == 0 ? x_in_row(p, grp, row) : xo;
        f32x4 v[4]; float ss = 0.f;
#pragma unroll
        for (int i = 0; i < 4; ++i) { v[i] = *(const f32x4*)(x + lane * 4 + 256 * i); ss += v[i][0] * v[i][0] + v[i][1] * v[i][1] + v[i][2] * v[i][2] + v[i][3] * v[i][3]; }
        ss = wave_sum(ss);
        if (mode == 0) {
            if (lane < 8) rss[(size_t)row * 8 + lane] = lane == 0 ? ss : 0.f;
#pragma unroll
            for (int i = 0; i < 4; ++i) { u32x2 w; w[0] = pk2(v[i][0], v[i][1]); w[1] = pk2(v[i][2], v[i][3]); *(u32x2*)(hb + (size_t)row * DM + lane * 4 + 256 * i) = w; }
        } else {
            const float rstd = rsqrtf(ss * (1.0f / 1024.0f) + EPS);
#pragma unroll
            for (int i = 0; i < 4; ++i) *(f32x4*)(xo + lane * 4 + 256 * i) = v[i] * rstd * gv[i];
        }
    }
}

DI void phase_in(const Params& p, int layer, char* lds, bool probe = false) {
    const bf16_t* hb = (const bf16_t*)(p.ws + OFF_H);
    const bf16_t* W = wts(p, layer) + WING;
    bf16_t* ub = (bf16_t*)(p.ws + OFF_U);
    bf16_t* gb = (bf16_t*)(p.ws + OFF_GATE);
    const float* rss = (const float*)(p.ws + OFF_RSS1);
    constexpr int NT = NIN / 128;
    const int lane = tidx() & 63, w = tidx() >> 6, wr = w >> 1, wc = w & 1, r16 = lane & 15, q4 = lane >> 4;
    TileIter it; ti_init(it, TG / 128, NT, 8, 6);
    int tm, tn;
    while (ti_next(it, tm, tn)) {
        const int c0 = tn * 128;
        const bool isV = (c0 == 640) || (c0 >= 2304 && c0 < 2816) || (c0 >= 3328 && c0 < 3840);
        f32x4 acc[4][4]; zero_acc(acc);
        const int cb = c0 + wc * 64;
        if (isV) {
            gemm128<false>(hb + (size_t)tm * 128 * DM, DM, W + (size_t)c0 * DM, DM, DM, acc, lds);
            bf16_t* vt; int cl, DV, NH;
            if (cb < 768) { vt = (bf16_t*)(p.ws + OFF_VTA); cl = cb - 640; DV = 64; NH = 2; }
            else if (cb < 2816) { vt = (bf16_t*)(p.ws + OFF_VTC); cl = cb - 2304; DV = 128; NH = 4; }
            else { vt = (bf16_t*)(p.ws + OFF_VTD); cl = cb - 3328; DV = 128; NH = 4; }
#pragma unroll
            for (int m = 0; m < 4; ++m) {
                const int row0 = tm * 128 + wr * 64 + m * 16 + q4 * 4, seq = row0 >> 11, t0 = row0 & 2047;
                f32x4 rs;
#pragma unroll
                for (int i = 0; i < 4; ++i) rs[i] = row_rstd(rss, row0 + i);
#pragma unroll
                for (int n = 0; n < 4; ++n) {
                    const int col = cl + n * 16 + r16, head = col / DV, d = col % DV;
                    u32x2 wv; wv[0] = pk2(acc[m][n][0] * rs[0], acc[m][n][1] * rs[1]); wv[1] = pk2(acc[m][n][2] * rs[2], acc[m][n][3] * rs[3]);
                    *(u32x2*)(vt + ((size_t)(seq * NH + head) * DV + d) * SL + t0) = wv;
                }
            }
        } else {
            gemm128<true>(hb + (size_t)tm * 128 * DM, DM, W + (size_t)c0 * DM, DM, DM, acc, lds);
            bool donorm = false, dosig = false; int rot = 0; float scale = 1.f; const float* gain = nullptr;
            bf16_t* dst = ub; int ld = INW, dcol = cb;
            if (cb < 512) { donorm = true; rot = 1; scale = 0.125f * LOG2E; gain = p.in[I_QG] + layer * 64; }
            else if (cb < 640) { donorm = true; rot = 1; gain = p.in[I_KG] + layer * 64; }
            else if (cb < 1280) { }
            else if (cb < 1792) { scale = 0.125f * LOG2E; }
            else if (cb < 2816) { }
            else if (cb < 3072) { rot = 2; scale = 0.125f; }
            else if (cb < 3328) { rot = 2; }
            else if (cb < INW) { }
            else { dosig = true; dst = gb; ld = 4096; dcol = cb - INW; }
            float gl[4][4];
            if (donorm) {
#pragma unroll
                for (int n = 0; n < 4; ++n) { const f32x4 g4 = *(const f32x4*)(gain + n * 16 + q4 * 4); gl[n][0] = g4[0]; gl[n][1] = g4[1]; gl[n][2] = g4[2]; gl[n][3] = g4[3]; }
            }
            const float* ct = (const float*)(p.ws + (rot == 2 ? OFF_COSD : OFF_COSA));
            const float* sn = (const float*)(p.ws + (rot == 2 ? OFF_SIND : OFF_SINA));
#pragma unroll
            for (int m = 0; m < 4; ++m) {
                asm volatile("" ::: "memory");
                const int row = tm * 128 + wr * 64 + m * 16 + r16, tpos = row & 2047;
                float v[4][4];
                const float rs = row_rstd(rss, row);
#pragma unroll
                for (int n = 0; n < 4; ++n)
#pragma unroll
                    for (int i = 0; i < 4; ++i) v[n][i] = acc[m][n][i] * rs;
                if (donorm) {
                    float ss = 0.f;
#pragma unroll
                    for (int n = 0; n < 4; ++n)
#pragma unroll
                        for (int i = 0; i < 4; ++i) ss += v[n][i] * v[n][i];
                    ss += __shfl_xor(ss, 16); ss += __shfl_xor(ss, 32);
                    const float rstd = rsqrtf(ss * (1.0f / 64.0f) + EPS);
#pragma unroll
                    for (int n = 0; n < 4; ++n)
#pragma unroll
                        for (int i = 0; i < 4; ++i) v[n][i] = v[n][i] * rstd * gl[n][i];
                }
                if (rot) {
#pragma unroll
                    for (int n = 0; n < 2; ++n) {
                        const f32x4 c4 = *(const f32x4*)(ct + tpos * 32 + n * 16 + q4 * 4), s4 = *(const f32x4*)(sn + tpos * 32 + n * 16 + q4 * 4);
#pragma unroll
                        for (int i = 0; i < 4; ++i) { const float x1 = v[n][i], x2 = v[n + 2][i]; v[n][i] = x1 * c4[i] - x2 * s4[i]; v[n + 2][i] = x2 * c4[i] + x1 * s4[i]; }
                    }
                }
#pragma unroll
                for (int n = 0; n < 4; ++n) {
                    float o0, o1, o2, o3;
                    if (dosig) { o0 = sigmoidf_(v[n][0]); o1 = sigmoidf_(v[n][1]); o2 = sigmoidf_(v[n][2]); o3 = sigmoidf_(v[n][3]); }
                    else { o0 = v[n][0] * scale; o1 = v[n][1] * scale; o2 = v[n][2] * scale; o3 = v[n][3] * scale; }
                    otile_put(lds, wr * 64 + m * 16 + r16, wc * 64 + n * 16 + q4 * 4, pk2(o0, o1), pk2(o2, o3));
                }
            }
            otile_flush(lds, dst + (size_t)(tm * 128) * ld + (dcol - wc * 64), ld);
        }
    }
}

template <int DV, int MODE>
DI void attn_task(const Params& p, int task, char* lds) {
    constexpr int NDT = DV / 32;
    constexpr int STG = 64 * AROWB + DV * AROWB;
    const int tid = tidx(), lane = tid & 63, wave = tid >> 6, r = lane & 31, h = lane >> 5;
    const bf16_t* ub = (const bf16_t*)(p.ws + OFF_U);
    const int qt = task & 15; const int rest = task >> 4;
    int seq, head, map = 0, qcol, kcol; const bf16_t* vt;
    if (MODE == 0) { head = rest & 7; seq = rest >> 3; qcol = head * 64; kcol = 512 + (head >> 2) * 64; vt = (const bf16_t*)(p.ws + OFF_VTA) + (size_t)(seq * 2 + (head >> 2)) * 64 * SL; }
    else if (MODE == 1) { map = rest & 1; head = (rest >> 1) & 3; seq = rest >> 3; qcol = 1280 + head * 128 + map * 64; kcol = 1792 + head * 128 + map * 64; vt = (const bf16_t*)(p.ws + OFF_VTC) + (size_t)(seq * 4 + head) * 128 * SL; }
    else { head = rest & 3; seq = rest >> 2; qcol = 2816 + head * 64; kcol = 3072 + head * 64; vt = (const bf16_t*)(p.ws + OFF_VTD) + (size_t)(seq * 4 + head) * 128 * SL; }
    const int qpos = qt * 128 + wave * 32 + r;
    const bf16_t* qptr = ub + ((size_t)seq * SL + qpos) * INW + qcol;
    bf16x8 qf[4];
#pragma unroll
    for (int s = 0; s < 4; ++s) qf[s] = *(const bf16x8*)(qptr + 16 * s + 8 * h);
    const bf16_t* kbase = ub + (size_t)seq * SL * INW + kcol;
    float* sBias = (float*)(lds + 2 * STG);
    if (MODE == 1) { const float* bl = (const float*)(p.ws + OFF_BIAS) + head * 4096; for (int i = tid; i < 4096; i += 256) sBias[i] = bl[i]; }
    float lgam = 0.f;
    if (MODE == 2) lgam = log2f(1.0f - exp2f(-5.0f - (float)head));
    f32x16 o[NDT];
#pragma unroll
    for (int d = 0; d < NDT; ++d)
#pragma unroll
        for (int i = 0; i < 16; ++i) o[d][i] = 0.f;
    float lsum = 0.f;
    const int srow = tid >> 3, sc = tid & 7;
    const bf16_t* kg = kbase + (size_t)srow * INW + sc * 8;
    const bf16_t* vg = vt + (size_t)srow * SL + sc * 8;
    u32x4 rk[2], rv[NDT];
#pragma unroll
    for (int i = 0; i < 2; ++i) rk[i] = *(const u32x4*)(kg + (size_t)(32 * i) * INW);
#pragma unroll
    for (int i = 0; i < NDT; ++i) rv[i] = *(const u32x4*)(vg + (size_t)(32 * i) * SL);
    const int soff = srow * AROWB + sc * 16;
#pragma unroll
    for (int i = 0; i < 2; ++i) *(u32x4*)(lds + soff + 32 * i * AROWB) = rk[i];
#pragma unroll
    for (int i = 0; i < NDT; ++i) *(u32x4*)(lds + 64 * AROWB + soff + 32 * i * AROWB) = rv[i];
    __syncthreads();
    for (int kt = 0; kt < SL / 64; ++kt) {
        const char* cur = lds + (kt & 1) * STG;
        char* nxt = lds + ((kt + 1) & 1) * STG;
        const bool more = kt + 1 < SL / 64;
        const int kv0 = kt * 64;
        if (more) {
            kg += (size_t)64 * INW; vg += 64;
#pragma unroll
            for (int i = 0; i < 2; ++i) rk[i] = *(const u32x4*)(kg + (size_t)(32 * i) * INW);
#pragma unroll
            for (int i = 0; i < NDT; ++i) rv[i] = *(const u32x4*)(vg + (size_t)(32 * i) * SL);
        }
        f32x16 st[2];
#pragma unroll
        for (int kk = 0; kk < 2; ++kk) {
#pragma unroll
            for (int i = 0; i < 16; ++i) st[kk][i] = 0.f;
#pragma unroll
            for (int s = 0; s < 4; ++s) {
                const bf16x8 kf = *(const bf16x8*)(cur + (32 * kk + r) * AROWB + (16 * s + 8 * h) * 2);
                st[kk] = MFMA32(kf, qf[s], st[kk]);
            }
        }
#pragma unroll
        for (int kk = 0; kk < 2; ++kk)
#pragma unroll
            for (int i = 0; i < 16; ++i) {
                const int m = kv0 + 32 * kk + (i & 3) + 8 * (i >> 2) + 4 * h;
                float pv;
                if (MODE == 0) pv = __builtin_amdgcn_exp2f(st[kk][i]);
                else if (MODE == 1) pv = __builtin_amdgcn_exp2f(st[kk][i] + sBias[m - qpos + 2047]);
                else pv = st[kk][i] * __builtin_amdgcn_exp2f(lgam * fabsf((float)(qpos - m)));
                if (MODE != 2) lsum += pv;
                st[kk][i] = pv;
            }
        const char* sV = cur + 64 * AROWB;
#pragma unroll
        for (int kk = 0; kk < 2; ++kk)
#pragma unroll
            for (int s2 = 0; s2 < 2; ++s2) {
                u32x4 pw;
#pragma unroll
                for (int j = 0; j < 4; ++j) pw[j] = pk2(st[kk][8 * s2 + 2 * j], st[kk][8 * s2 + 2 * j + 1]);
                const bf16x8 pf = __builtin_bit_cast(bf16x8, pw);
#pragma unroll
                for (int d = 0; d < NDT; ++d) {
                    const char* va = sV + (32 * d + r) * AROWB + (32 * kk + 16 * s2 + 4 * h) * 2;
                    const s16x4 lo = *(const s16x4*)va, hi = *(const s16x4*)(va + 16);
                    const bf16x8 vf = __builtin_shufflevector(lo, hi, 0, 1, 2, 3, 4, 5, 6, 7);
                    o[d] = MFMA32(vf, pf, o[d]);
                }
            }
        if (more) {
#pragma unroll
            for (int i = 0; i < 2; ++i) *(u32x4*)(nxt + soff + 32 * i * AROWB) = rk[i];
#pragma unroll
            for (int i = 0; i < NDT; ++i) *(u32x4*)(nxt + 64 * AROWB + soff + 32 * i * AROWB) = rv[i];
        }
        __syncthreads();
    }
    const size_t tok = (size_t)seq * SL + qpos;
    if (MODE != 2) {
        const float ltot = lsum + __shfl_xor(lsum, 32);
        const float inv = __builtin_amdgcn_rcpf(ltot);
        bf16_t* dst = MODE == 0 ? (bf16_t*)(p.ws + OFF_O) + tok * 512 + head * 64
                                : (bf16_t*)(p.ws + OFF_DT) + ((size_t)map * TG + tok) * 512 + head * 128;
#pragma unroll
        for (int d = 0; d < NDT; ++d)
#pragma unroll
            for (int a = 0; a < 4; ++a) {
                u32x2 wv; wv[0] = pk2(o[d][4 * a] * inv, o[d][4 * a + 1] * inv); wv[1] = pk2(o[d][4 * a + 2] * inv, o[d][4 * a + 3] * inv);
                *(u32x2*)(dst + 32 * d + 8 * a + 4 * h) = wv;
            }
    } else {
        float s = 0.f;
#pragma unroll
        for (int d = 0; d < NDT; ++d)
#pragma unroll
            for (int i = 0; i < 16; ++i) s += o[d][i];
        s += __shfl_xor(s, 32);
        const float mu = s * (1.0f / 128.0f);
        float vs = 0.f;
#pragma unroll
        for (int d = 0; d < NDT; ++d)
#pragma unroll
            for (int i = 0; i < 16; ++i) { const float dd = o[d][i] - mu; vs += dd * dd; }
        vs += __shfl_xor(vs, 32);
        const float rstd = rsqrtf(vs * (1.0f / 128.0f) + EPS);
        const bf16_t* gp = ub + tok * INW + 3840 + head * 128;
        bf16_t* dst = (bf16_t*)(p.ws + OFF_O) + ((size_t)3 * TG + tok) * 512 + head * 128;
#pragma unroll
        for (int d = 0; d < NDT; ++d)
#pragma unroll
            for (int a = 0; a < 4; ++a) {
                asm volatile("" ::: "memory");
                const u32x2 gw = *(const u32x2*)(gp + 32 * d + 8 * a + 4 * h);
                const float g0 = bflo(gw[0]), g1 = bfhi(gw[0]), g2 = bflo(gw[1]), g3 = bfhi(gw[1]);
                const float y0 = (o[d][4 * a] - mu) * rstd * g0 * sigmoidf_(g0), y1 = (o[d][4 * a + 1] - mu) * rstd * g1 * sigmoidf_(g1);
                const float y2 = (o[d][4 * a + 2] - mu) * rstd * g2 * sigmoidf_(g2), y3 = (o[d][4 * a + 3] - mu) * rstd * g3 * sigmoidf_(g3);
                u32x2 wv; wv[0] = pk2(y0, y1); wv[1] = pk2(y2, y3);
                *(u32x2*)(dst + 32 * d + 8 * a + 4 * h) = wv;
            }
    }
}

DI void tr_read8(unsigned a, s16x4 (&v)[8]) {
    asm volatile("ds_read_b64_tr_b16 %0, %8\n\tds_read_b64_tr_b16 %1, %8 offset:256\n\tds_read_b64_tr_b16 %2, %8 offset:1024\n\tds_read_b64_tr_b16 %3, %8 offset:1280\n\t"
                 "ds_read_b64_tr_b16 %4, %8 offset:2048\n\tds_read_b64_tr_b16 %5, %8 offset:2304\n\tds_read_b64_tr_b16 %6, %8 offset:3072\n\tds_read_b64_tr_b16 %7, %8 offset:3328\n\t"
                 "s_waitcnt lgkmcnt(0)"
                 : "=&v"(v[0]), "=&v"(v[1]), "=&v"(v[2]), "=&v"(v[3]), "=&v"(v[4]), "=&v"(v[5]), "=&v"(v[6]), "=&v"(v[7]) : "v"(a) : "memory");
}

DI void s5_wave_task(const Params& p, int layer, int wt, char* ldsw) {
    const int lane = tidx() & 63, r = lane & 31, h = lane >> 5;
    const int dir = wt & 1, g = (wt >> 1) & 31, pair = wt >> 6;
    const bf16_t* ub = (const bf16_t*)(p.ws + OFF_U);
    const int hp = (r >> 2) & 1, ia = 4 * (r >> 3) + (r & 3);
    const unsigned img = (unsigned)(size_t)ldsw;
    char* chunkbuf = ldsw + 8192;
    const int i16 = lane & 15, tq = i16 >> 2, tp = i16 & 3, blk = (lane >> 4) & 1;
    const unsigned trA = img + (8 * h + tq) * 64 + 8 * (4 * blk + tp);
    const float dsk = r < 16 ? p.in[I_SD][layer * 512 + g * 16 + r] : 0.f;
    bf16_t* yl = (bf16_t*)(p.ws + (dir ? OFF_YB : OFF_YF)) + ((size_t)(2 * pair + h) * 512 + g * 16 + (r & 15)) * SL;
    const int pb = (layer * 2 + dir) * 32 + g;
    const float dt = expf(p.in[I_SLDT][pb]);
    float abr[2], abi[2];
    bf16x8 bfrag[2][2], cfrag[2][2][2], dfrag;
    {
        u32x4 dw;
#pragma unroll
        for (int j = 0; j < 4; ++j) dw[j] = pk2((dir == 0 && r == 8 * h + 2 * j) ? dsk : 0.f, (dir == 0 && r == 8 * h + 2 * j + 1) ? dsk : 0.f);
        dfrag = __builtin_bit_cast(bf16x8, dw);
    }
#pragma unroll
    for (int st = 0; st < 2; ++st) {
        const int n = 32 * st + r;
        const float are = p.in[I_SARE][pb * 64 + n], aim = p.in[I_SAIM][pb * 64 + n];
        const float mag = expf(dt * are);
        abr[st] = mag * cosf(dt * aim); abi[st] = mag * sinf(dt * aim);
        const float den = are * are + aim * aim, nr = abr[st] - 1.0f;
        const float fre = (nr * are + abi[st] * aim) / den, fim = (abi[st] * are - nr * aim) / den;
        const float* bre = p.in[I_SBRE] + ((size_t)pb * 64 + n) * 16 + 8 * h;
        const float* bim = p.in[I_SBIM] + ((size_t)pb * 64 + n) * 16 + 8 * h;
        u32x4 wre, wim;
#pragma unroll
        for (int j = 0; j < 4; ++j) {
            const float br0 = bre[2 * j], bi0 = bim[2 * j], br1 = bre[2 * j + 1], bi1 = bim[2 * j + 1];
            wre[j] = pk2(fre * br0 - fim * bi0, fre * br1 - fim * bi1);
            wim[j] = pk2(fre * bi0 + fim * br0, fre * bi1 + fim * br1);
        }
        bfrag[st][0] = __builtin_bit_cast(bf16x8, wre); bfrag[st][1] = __builtin_bit_cast(bf16x8, wim);
#pragma unroll
        for (int s = 0; s < 2; ++s) {
            u32x4 cr = {0u, 0u, 0u, 0u}, ci = {0u, 0u, 0u, 0u};
            if (r < 16) {
                const float* cre = p.in[I_SCRE] + ((size_t)pb * 16 + r) * 64 + 32 * st + 16 * s + 8 * h;
                const float* cim = p.in[I_SCIM] + ((size_t)pb * 16 + r) * 64 + 32 * st + 16 * s + 8 * h;
#pragma unroll
                for (int j = 0; j < 4; ++j) { cr[j] = pk2(cre[2 * j], cre[2 * j + 1]); ci[j] = pk2(-cim[2 * j], -cim[2 * j + 1]); }
            }
            cfrag[st][s][0] = __builtin_bit_cast(bf16x8, cr); cfrag[st][s][1] = __builtin_bit_cast(bf16x8, ci);
        }
    }
    float sre[2] = {0.f, 0.f}, sim[2] = {0.f, 0.f};
    const bf16_t* gsrc[4]; int loff[4];
#pragma unroll
    for (int j = 0; j < 4; ++j) {
        const int c = lane + 64 * j, row = c >> 1, half = c & 1, ss = row >> 6, tau = row & 63;
        gsrc[j] = ub + ((size_t)(2 * pair + ss) * SL + (dir ? (SL - 1 - tau) : tau)) * INW + 768 + g * 16 + half * 8;
        loff[j] = row * 32 + half * 16;
    }
    const long cstep = dir ? -(long)64 * INW : (long)64 * INW;
    u32x4 crg[4];
#pragma unroll
    for (int j = 0; j < 4; ++j) crg[j] = *(const u32x4*)gsrc[j];
#pragma unroll
    for (int j = 0; j < 4; ++j) *(u32x4*)(chunkbuf + loff[j]) = crg[j];
    const int aoff = (hp * 64 + ia) * 32 + h * 16;
    for (int chunk = 0; chunk < SL / 64; ++chunk) {
        if (chunk + 1 < SL / 64) {
#pragma unroll
            for (int j = 0; j < 4; ++j) { gsrc[j] += cstep; crg[j] = *(const u32x4*)gsrc[j]; }
        }
        const char* cb = chunkbuf + (chunk & 1) * 4096;
#pragma unroll 1
        for (int tl = 0; tl < 4; ++tl) {
            const int s0 = chunk * 64 + tl * 16;
            const bf16x8 ua = *(const bf16x8*)(cb + aoff + tl * 512);
            f32x16 z;
#pragma unroll
            for (int i = 0; i < 16; ++i) z[i] = 0.f;
            f32x16 y0 = MFMA32(ua, dfrag, z);
            f32x16 y1 = z;
#pragma unroll
            for (int st = 0; st < 2; ++st) {
                f32x16 xr = MFMA32(ua, bfrag[st][0], z);
                f32x16 xi = MFMA32(ua, bfrag[st][1], z);
                float cr = sre[st], ci = sim[st];
#pragma unroll
                for (int i = 0; i < 16; ++i) {
                    const float nr = abr[st] * cr - abi[st] * ci + xr[i];
                    const float ni = abr[st] * ci + abi[st] * cr + xi[i];
                    cr = nr; ci = ni; xr[i] = nr; xi[i] = ni;
                }
                sre[st] = cr; sim[st] = ci;
#pragma unroll
                for (int a = 0; a < 4; ++a) {
                    u32x2 w0, w1; w0[0] = pk2(xr[4 * a], xr[4 * a + 1]); w0[1] = pk2(xr[4 * a + 2], xr[4 * a + 3]);
                    w1[0] = pk2(xi[4 * a], xi[4 * a + 1]); w1[1] = pk2(xi[4 * a + 2], xi[4 * a + 3]);
                    *(u32x2*)(ldsw + (st * 2 + 0) * 2048 + r * 64 + 8 * (2 * a + h)) = w0;
                    *(u32x2*)(ldsw + (st * 2 + 1) * 2048 + r * 64 + 8 * (2 * a + h)) = w1;
                }
            }
            asm volatile("s_waitcnt lgkmcnt(0)" ::: "memory");
            {
                s16x4 v[8];
                tr_read8(trA, v);
                y0 = MFMA32(__builtin_shufflevector(v[0], v[1], 0, 1, 2, 3, 4, 5, 6, 7), cfrag[0][0][0], y0);
                y0 = MFMA32(__builtin_shufflevector(v[2], v[3], 0, 1, 2, 3, 4, 5, 6, 7), cfrag[0][1][0], y0);
                y0 = MFMA32(__builtin_shufflevector(v[4], v[5], 0, 1, 2, 3, 4, 5, 6, 7), cfrag[0][0][1], y0);
                y0 = MFMA32(__builtin_shufflevector(v[6], v[7], 0, 1, 2, 3, 4, 5, 6, 7), cfrag[0][1][1], y0);
                s16x4 u[8];
                tr_read8(trA + 4096, u);
                y1 = MFMA32(__builtin_shufflevector(u[0], u[1], 0, 1, 2, 3, 4, 5, 6, 7), cfrag[1][0][0], y1);
                y1 = MFMA32(__builtin_shufflevector(u[2], u[3], 0, 1, 2, 3, 4, 5, 6, 7), cfrag[1][1][0], y1);
                y1 = MFMA32(__builtin_shufflevector(u[4], u[5], 0, 1, 2, 3, 4, 5, 6, 7), cfrag[1][0][1], y1);
                y1 = MFMA32(__builtin_shufflevector(u[6], u[7], 0, 1, 2, 3, 4, 5, 6, 7), cfrag[1][1][1], y1);
            }
            if (r < 16) {
                u32x4 o0, o1;
                if (dir == 0) {
#pragma unroll
                    for (int j = 0; j < 4; ++j) { o0[j] = pk2(y0[2 * j] + y1[2 * j], y0[2 * j + 1] + y1[2 * j + 1]); o1[j] = pk2(y0[8 + 2 * j] + y1[8 + 2 * j], y0[9 + 2 * j] + y1[9 + 2 * j]); }
                    *(u32x4*)(yl + s0) = o0; *(u32x4*)(yl + s0 + 8) = o1;
                } else {
#pragma unroll
                    for (int j = 0; j < 4; ++j) { o0[j] = pk2(y0[15 - 2 * j] + y1[15 - 2 * j], y0[14 - 2 * j] + y1[14 - 2 * j]); o1[j] = pk2(y0[7 - 2 * j] + y1[7 - 2 * j], y0[6 - 2 * j] + y1[6 - 2 * j]); }
                    *(u32x4*)(yl + (SL - 16 - s0)) = o0; *(u32x4*)(yl + (SL - 16 - s0) + 8) = o1;
                }
            }
        }
        if (chunk + 1 < SL / 64) {
#pragma unroll
            for (int j = 0; j < 4; ++j) *(u32x4*)(chunkbuf + ((chunk + 1) & 1) * 4096 + loff[j]) = crg[j];
        }
    }
}

DI void phase_mix(const Params& p, int layer, int qidx, char* lds, bool only_s5 = false) {
    __shared__ int s_task;
    int* qc = (int*)(p.ws + OFF_QCNT) + qidx;
    constexpr int N_S5 = (G / 2) * 32 * 2 / 4, N_DIFF = G * 4 * 2 * 16, N_RET = G * 4 * 16, N_GQA = G * 8 * 16;
    constexpr int NTOT = N_S5 + N_DIFF + N_RET + N_GQA;
    for (;;) {
        __syncthreads();
        if (tidx() == 0) s_task = atomicAdd(qc, 1);
        __syncthreads();
        int task = s_task;
        if (task >= (only_s5 ? N_S5 : NTOT)) break;
        if (task < N_S5) { const int wave = tidx() >> 6; s5_wave_task(p, layer, task * 4 + wave, lds + wave * 16384); }
        else if ((task -= N_S5) < N_DIFF) attn_task<128, 1>(p, task, lds);
        else if ((task -= N_DIFF) < N_RET) attn_task<128, 2>(p, task, lds);
        else attn_task<64, 0>(p, task - N_RET, lds);
    }
}

DI float gelu_tanh(float v) { const float z2 = 1.5957691216057308f * (v + 0.044715f * v * v * v); return v * __builtin_amdgcn_rcpf(1.0f + __builtin_amdgcn_exp2f(-LOG2E * z2)); }

DI void glu_tile(const Params& p, int layer, int tm, int tn, char* lds) {
    const int tid = tidx(), lane = tid & 63, w = tid >> 6, wr = w >> 1, wc = w & 1, r16 = lane & 15, q4 = lane >> 4;
    const bf16_t* yf = (const bf16_t*)(p.ws + OFF_YF);
    const bf16_t* yb = (const bf16_t*)(p.ws + OFF_YB);
    const bf16_t* B = wts(p, layer) + WGLU + (size_t)tn * 128 * 512;
    const int seq = (tm * 128) >> 11, t0 = (tm * 128) & 2047;
    const int ach = tid & 63, aseg0 = tid >> 6;
    const bf16_t* fg = yf + ((size_t)seq * 512 + ach) * SL + t0;
    const bf16_t* bg2 = yb + ((size_t)seq * 512 + ach) * SL + t0;
    const int srow = tid >> 3, scol = tid & 7;
    const bf16_t* bg = B + (size_t)srow * 512 + scol * 8;
    const int soff = srow * ROWB + ((scol ^ ((srow >> 1) & 7)) << 4);
    u32x4 rf[4], rbk[4], rb[4];
    f32x4 acc[4][4]; zero_acc(acc);
    const int aoff = (wr * 64 + (lane & 15)) * ROWB;
    const int boff = GT_BYTES + (wc * 64 + (lane & 15)) * ROWB;
    const int sw = ((lane >> 4) ^ ((lane & 15) >> 1)) << 4;
    for (int kt = 0; kt < 8; ++kt) {
#pragma unroll
        for (int j = 0; j < 4; ++j) {
            rf[j] = *(const u32x4*)(fg + (size_t)kt * 64 * SL + (aseg0 + 4 * j) * 8);
            rbk[j] = *(const u32x4*)(bg2 + (size_t)kt * 64 * SL + (aseg0 + 4 * j) * 8);
            rb[j] = *(const u32x4*)(bg + (size_t)(32 * j) * 512 + kt * 64);
        }
#pragma unroll
        for (int j = 0; j < 4; ++j) {
            *(u32x4*)(lds + GT_BYTES + soff + 32 * j * ROWB) = rb[j];
            char* abase = lds + (aseg0 + 4 * j) * 8 * ROWB + (ach & 7) * 2;
#pragma unroll
            for (int e = 0; e < 4; ++e) {
                const float v0 = gelu_tanh(bflo(rf[j][e]) + bflo(rbk[j][e])), v1 = gelu_tanh(bfhi(rf[j][e]) + bfhi(rbk[j][e]));
                const unsigned pw = pk2(v0, v1);
                const int cs = (((ach >> 3) ^ ((4 * aseg0 + e) & 7)) << 4);
                *(bf16_t*)(abase + (2 * e) * ROWB + cs) = (bf16_t)(pw & 0xffffu);
                *(bf16_t*)(abase + (2 * e + 1) * ROWB + cs) = (bf16_t)(pw >> 16);
            }
        }
        __syncthreads();
        gemm_compute<false, 0>(lds, aoff, boff, sw, acc);
        __syncthreads();
    }
    bf16_t* ob = (bf16_t*)(p.ws + OFF_O) + (size_t)1 * TG * 512;
    const float* bgl = p.in[I_SBGLU] + layer * 512;
#pragma unroll
    for (int n = 0; n < 4; ++n) {
        const int ch = tn * 128 + wc * 64 + n * 16 + r16;
        const float bias = bgl[ch];
#pragma unroll
        for (int m = 0; m < 4; ++m) {
            const int tl = wr * 64 + m * 16 + q4 * 4;
            const u32x2 fw = *(const u32x2*)(yf + ((size_t)seq * 512 + ch) * SL + t0 + tl);
            const u32x2 bw = *(const u32x2*)(yb + ((size_t)seq * 512 + ch) * SL + t0 + tl);
            const float y0 = gelu_tanh(bflo(fw[0]) + bflo(bw[0])), y1 = gelu_tanh(bfhi(fw[0]) + bfhi(bw[0]));
            const float y2 = gelu_tanh(bflo(fw[1]) + bflo(bw[1])), y3 = gelu_tanh(bfhi(fw[1]) + bfhi(bw[1]));
            const unsigned w01 = pk2(y0 * sigmoidf_(acc[m][n][0] + bias), y1 * sigmoidf_(acc[m][n][1] + bias));
            const unsigned w23 = pk2(y2 * sigmoidf_(acc[m][n][2] + bias), y3 * sigmoidf_(acc[m][n][3] + bias));
            bf16_t* orow = ob + (size_t)(tm * 128 + tl) * 512 + ch;
            orow[0] = (bf16_t)(w01 & 0xffffu); orow[512] = (bf16_t)(w01 >> 16); orow[1024] = (bf16_t)(w23 & 0xffffu); orow[1536] = (bf16_t)(w23 >> 16);
        }
    }
}

DI void phase_glu(const Params& p, int layer, char* lds) {
    const int lane = tidx() & 63, w = tidx() >> 6;
    { TileIter it; ti_init(it, TG / 128, 4, 16, 4); int tm, tn; while (ti_next(it, tm, tn)) glu_tile(p, layer, tm, tn, lds); }
    const float lam = ((const float*)(p.ws + OFF_LAM))[layer], li = ((const float*)(p.ws + OFF_LAM))[4 + layer];
    const bf16_t* d0 = (const bf16_t*)(p.ws + OFF_DT); const bf16_t* d1 = d0 + (size_t)TG * 512;
    bf16_t* oc = (bf16_t*)(p.ws + OFF_O) + (size_t)2 * TG * 512;
    const f32x2 sg = *(const f32x2*)(p.in[I_DSUB] + layer * 128 + 2 * lane);
    const int gw = bidx() * 4 + w, nw = gdim() * 4;
    for (int it = gw; it < TG * 4; it += nw) {
        const size_t off = (size_t)it * 128 + 2 * lane;
        const unsigned a = *(const unsigned*)(d0 + off), b = *(const unsigned*)(d1 + off);
        const float v0 = bflo(a) - lam * bflo(b), v1 = bfhi(a) - lam * bfhi(b);
        const float ss = wave_sum(v0 * v0 + v1 * v1);
        const float rs = rsqrtf(ss * (1.0f / 128.0f) + EPS) * (1.0f - li);
        *(unsigned*)(oc + off) = pk2(v0 * rs * sg[0], v1 * rs * sg[1]);
    }
}

DI void phase_merge(const Params& p, int layer, char* lds) {
    const int lane = tidx() & 63, w = tidx() >> 6, wr = w >> 1, wc = w & 1, r16 = lane & 15, q4 = lane >> 4;
    const bf16_t* ob = (const bf16_t*)(p.ws + OFF_O);
    const bf16_t* gb = (const bf16_t*)(p.ws + OFF_GATE);
    const bf16_t* W = wts(p, layer) + WB;
    bf16_t* mb = (bf16_t*)(p.ws + OFF_M);
    TileIter it; ti_init(it, TG / 128, 8, 8, 8);
    int tm, tn;
    while (ti_next(it, tm, tn)) {
        f32x4 macc[4][4]; zero_acc(macc);
#pragma unroll 1
        for (int b = 0; b < 4; ++b) {
            f32x4 acc[4][4]; zero_acc(acc);
            gemm128<true, 0, false>(ob + ((size_t)b * TG + tm * 128) * 512, 512, W + ((size_t)b * 1024 + tn * 128) * 512, 512, 512, acc, lds);
#pragma unroll
            for (int m = 0; m < 4; ++m) {
                const int row = tm * 128 + wr * 64 + m * 16 + r16;
#pragma unroll
                for (int n = 0; n < 4; ++n) {
                    const int col = tn * 128 + wc * 64 + n * 16 + q4 * 4;
                    const u32x2 gw = *(const u32x2*)(gb + (size_t)row * 4096 + b * 1024 + col);
                    macc[m][n][0] += acc[m][n][0] * bflo(gw[0]); macc[m][n][1] += acc[m][n][1] * bfhi(gw[0]);
                    macc[m][n][2] += acc[m][n][2] * bflo(gw[1]); macc[m][n][3] += acc[m][n][3] * bfhi(gw[1]);
                }
            }
        }
#pragma unroll
        for (int m = 0; m < 4; ++m) {
            const int row = tm * 128 + wr * 64 + m * 16 + r16;
#pragma unroll
            for (int n = 0; n < 4; ++n) {
                const int col = tn * 128 + wc * 64 + n * 16 + q4 * 4;
                otile_put(lds, wr * 64 + m * 16 + r16, wc * 64 + n * 16 + q4 * 4, pk2(macc[m][n][0], macc[m][n][1]), pk2(macc[m][n][2], macc[m][n][3]));
            }
        }
        otile_flush(lds, mb + (size_t)(tm * 128) * DM + tn * 128, DM);
    }
}

DI void phase_resid(const Params& p, int grp, const bf16_t* A, int K, const bf16_t* Wt, bool first, float* rss, char* lds) {
    const int lane = tidx() & 63, w = tidx() >> 6, wr = w >> 1, wc = w & 1, r16 = lane & 15, q4 = lane >> 4;
    TileIter it; ti_init(it, TG / 128, 8, 8, 8);
    int tm, tn, ntm = 0, ntn = 0;
    bool have = ti_next(it, tm, tn);
    GemmRegs g;
    if (have) gemm_prime(A + (size_t)tm * 128 * K, K, Wt + (size_t)tn * 128 * K, K, g);
    for (; have; tm = ntm, tn = ntn) {
        have = ti_next(it, ntm, ntn);
        const bf16_t* At = A + (size_t)tm * 128 * K; const bf16_t* Bt = Wt + (size_t)tn * 128 * K;
        const bf16_t* nAt = have ? A + (size_t)ntm * 128 * K : At; const bf16_t* nBt = have ? Wt + (size_t)ntn * 128 * K : Bt;
        f32x4 acc[4][4]; zero_acc(acc);
        gemm_stream<true>(At, Bt, nAt, nBt, K, K, K, g, acc, lds);
#pragma unroll
        for (int m = 0; m < 4; ++m)
#pragma unroll
            for (int n = 0; n < 4; ++n) *(f32x4*)(lds + (wr * 64 + m * 16 + r16) * OROWF + (wc * 64 + n * 16 + q4 * 4) * 4) = acc[m][n];
        __syncthreads();
        {
            const int tid = tidx();
#pragma unroll 4
            for (int i = 0; i < 16; ++i) {
                const int c = tid + 256 * i, rl = c >> 5, ch = c & 31, row = tm * 128 + rl;
                float* xo = p.out + ((size_t)grp * TG + row) * DM + tn * 128 + ch * 4;
                const float* xi = first ? x_in_row(p, grp, row) + tn * 128 + ch * 4 : xo;
                const f32x4 a = *(const f32x4*)(lds + rl * OROWF + ch * 16);
                const f32x4 xv = *(const f32x4*)xi;
                const f32x4 nv = xv + a;
                *(f32x4*)xo = nv;
                u32x2 wb; wb[0] = pk2(nv[0], nv[1]); wb[1] = pk2(nv[2], nv[3]);
                *(u32x2*)((bf16_t*)(p.ws + OFF_H) + (size_t)row * DM + tn * 128 + ch * 4) = wb;
                float ss = nv[0] * nv[0] + nv[1] * nv[1] + nv[2] * nv[2] + nv[3] * nv[3];
                ss += __shfl_xor(ss, 16); ss += __shfl_xor(ss, 8); ss += __shfl_xor(ss, 4); ss += __shfl_xor(ss, 2); ss += __shfl_xor(ss, 1);
                if (ch == 0) rss[(size_t)row * 8 + tn] = ss;
            }
        }
        __syncthreads();
    }
}

DI void phase_ffn1(const Params& p, int layer, char* lds) {
    const int lane = tidx() & 63, w = tidx() >> 6, wr = w >> 1, wc = w & 1, r16 = lane & 15, q4 = lane >> 4;
    const bf16_t* hb = (const bf16_t*)(p.ws + OFF_H);
    const bf16_t* W = wts(p, layer) + WFI;
    bf16_t* fb = (bf16_t*)(p.ws + OFF_F);
    const float* rss = (const float*)(p.ws + OFF_RSS2);
    constexpr int NT = DFF / 64;
    TileIter it; ti_init(it, TG / 128, NT, 8, 4);
    int tm, tn, ntm = 0, ntn = 0;
    bool have = ti_next(it, tm, tn);
    GemmRegs g;
    if (have) gemm_prime(hb + (size_t)tm * 128 * DM, DM, W + (size_t)tn * 128 * DM, DM, g);
    for (; have; tm = ntm, tn = ntn) {
        have = ti_next(it, ntm, ntn);
        const bf16_t* At = hb + (size_t)tm * 128 * DM; const bf16_t* Bt = W + (size_t)tn * 128 * DM;
        const bf16_t* nAt = have ? hb + (size_t)ntm * 128 * DM : At; const bf16_t* nBt = have ? W + (size_t)ntn * 128 * DM : Bt;
        f32x4 acc[4][4]; zero_acc(acc);
        gemm_stream<true, 1>(At, Bt, nAt, nBt, DM, DM, DM, g, acc, lds);
#pragma unroll
        for (int m = 0; m < 4; ++m) {
            const int row = tm * 128 + wr * 64 + m * 16 + r16;
            const float rs = row_rstd(rss, row);
#pragma unroll
            for (int n = 0; n < 2; ++n) {
                float f[4];
#pragma unroll
                for (int i = 0; i < 4; ++i) { const float gq = acc[m][n][i] * rs; f[i] = gq * sigmoidf_(gq) * (acc[m][n + 2][i] * rs); }
                otile_put(lds, wr * 64 + m * 16 + r16, wc * 32 + n * 16 + q4 * 4, pk2(f[0], f[1]), pk2(f[2], f[3]));
            }
        }
        {
            const int tid = tidx();
            __syncthreads();
#pragma unroll
            for (int i = 0; i < 4; ++i) {
                const int c = tid + 256 * i, row = c >> 3, ch = c & 7;
                const u32x4 v = *(const u32x4*)(lds + row * OROW + ch * 16);
                *(u32x4*)(fb + (size_t)(tm * 128 + row) * DFF + tn * 64 + ch * 8) = v;
            }
            __syncthreads();
        }
    }
}

#define XB_TMO      128
#define XB_XCNT(j)  (256  + 64 * (j))
#define XB_XSUB(j)  (1280 + 64 * (j))
#define XB_XGEN(j)  (2304 + 64 * (j))
#define XB_TOP      3328
#define XB_TOPGEN   3392
#define XCD_BAR_WORDS 3456
#define XB_SPIN_CAP (1u << 18)
#define LAS __attribute__((address_space(3)))

__device__ __forceinline__ unsigned xb_ld(unsigned* p)              { return __hip_atomic_load(p, __ATOMIC_RELAXED, __HIP_MEMORY_SCOPE_AGENT); }
__device__ __forceinline__ unsigned xb_add(unsigned* p, unsigned v) { return __hip_atomic_fetch_add(p, v, __ATOMIC_RELAXED, __HIP_MEMORY_SCOPE_AGENT); }
__device__ __forceinline__ unsigned xb_xcc_id() { return (unsigned)__builtin_amdgcn_s_getreg((3 << 11) | 20) & 0xFu; }
#define XB_SPIN(cond, bar) do { unsigned _sp = 0; while (cond) { __builtin_amdgcn_s_sleep(1); \
    if ((++_sp & 255u) == 0u) { if (xb_ld(&(bar)[XB_TMO])) break; if (_sp > XB_SPIN_CAP) { atomicAdd(&(bar)[XB_TMO], 1u); break; } } } } while (0)

struct XcdBarrier {
    unsigned* bar; unsigned x;
    volatile LAS unsigned* st;
};

__device__ __forceinline__ XcdBarrier xcd_barrier_post(unsigned* bar, volatile LAS unsigned* st) {
    XcdBarrier b; b.bar = bar; b.x = xb_xcc_id(); b.st = st;
    if (threadIdx.x == 0) (void)xb_add(&bar[XB_XCNT(b.x)], 1u);
    return b;
}
__device__ __forceinline__ void xcd_barrier_complete(unsigned* bar, unsigned x, unsigned& nloc, unsigned& nx) {
    const unsigned G = gdim() * gridDim.y * gridDim.z;
    unsigned sum, cnt, mine, sp = 0u;
    for (;;) {
        sum = 0u; cnt = 0u; mine = 0u;
#pragma unroll
        for (unsigned j = 0; j < 16; ++j) { const unsigned c = xb_ld(&bar[XB_XCNT(j)]); sum += c; cnt += (c > 0u) ? 1u : 0u; mine = (j == x) ? c : mine; }
        if (sum == G) break;
        __builtin_amdgcn_s_sleep(1);
        if ((++sp & 255u) == 0u) { if (xb_ld(&bar[XB_TMO])) break; if (sp > XB_SPIN_CAP) { atomicAdd(&bar[XB_TMO], 1u); break; } }
    }
    nloc = mine > 0u ? mine : 1u; nx = cnt > 0u ? cnt : 1u;
}

__device__ __forceinline__ void xcd_barrier(const XcdBarrier& b) {
    asm volatile("s_waitcnt vmcnt(0)" ::: "memory");
    __syncthreads();
    if (threadIdx.x == 0) {
        unsigned* bar = b.bar;
        __builtin_amdgcn_s_waitcnt(0);
        unsigned nloc = b.st[0], nx = b.st[1];
        if (nloc == 0u) { xcd_barrier_complete(bar, b.x, nloc, nx); b.st[0] = nloc; b.st[1] = nx; }
        const unsigned old = xb_add(&bar[XB_XSUB(b.x)], 1u);
        const unsigned gen = old / nloc;
        if (old + 1u == (gen + 1u) * nloc) {
            __builtin_amdgcn_fence(__ATOMIC_RELEASE, "agent");
            asm volatile("s_waitcnt vmcnt(0)" ::: "memory");
            const unsigned og = xb_add(&bar[XB_TOP], 1u);
            const unsigned tg = og / nx;
            if (og + 1u == (tg + 1u) * nx) xb_add(&bar[XB_TOPGEN], 1u);
            else XB_SPIN(xb_ld(&bar[XB_TOPGEN]) == tg, bar);
            __builtin_amdgcn_fence(__ATOMIC_ACQUIRE, "agent");
            xb_add(&bar[XB_XGEN(b.x)], 1u);
            asm volatile("s_waitcnt vmcnt(0)" ::: "memory");
        } else {
            XB_SPIN(xb_ld(&bar[XB_XGEN(b.x)]) == gen, bar);
            __builtin_amdgcn_fence(__ATOMIC_ACQUIRE, "agent");
            asm volatile("s_waitcnt vmcnt(0)" ::: "memory");
        }
    }
    __syncthreads();
}


constexpr int PH_PER_GRP = 4 * 9 + 1;
constexpr int NPHASE = 1 + NGRP * PH_PER_GRP;

#ifndef PROBE_K
#define PROBE_K (-1)
#endif
DI void run_phase(const Params& p, int ph, char* lds, int rep = 0) {
    if (ph == 0) { phase_prologue(p, lds); return; }
    const int q = ph - 1, grp = q / PH_PER_GRP, r = q % PH_PER_GRP;
    if (r == 36) { phase_norm(p, grp, p.in[I_NFIN], 2); return; }
    const int layer = r / 9, k = r % 9;
    switch (k) {
        case 0: phase_norm(p, grp, p.in[I_NFIN], 0); break;
        case 1: phase_in(p, layer, lds, rep == 1); break;
        case 2: phase_mix(p, layer, grp * 4 + layer + 20 * rep, lds); break;
        case 3: phase_glu(p, layer, lds); break;
        case 4: phase_merge(p, layer, lds); break;
        case 5: phase_resid(p, grp, (const bf16_t*)(p.ws + OFF_M), DM, wts(p, layer) + WO, layer == 0, (float*)(p.ws + OFF_RSS2), lds); break;
        case 6: break;
        case 7: phase_ffn1(p, layer, lds); break;
        default: phase_resid(p, grp, (const bf16_t*)(p.ws + OFF_F), DFF, wts(p, layer) + WFO, false, (float*)(p.ws + OFF_RSS1), lds); break;
    }
}
DI bool phase_noop(int ph) {
    if (ph == 0) return false;
    const int r = (ph - 1) % PH_PER_GRP;
    if (r == 36) return false;
    const int layer = r / 9, k = r % 9;
    return k == 6 || (k == 0 && layer > 0);
}

__global__ void __launch_bounds__(256, 2) mega(Params p, int only) {
    __shared__ __attribute__((aligned(16))) char lds[LDS_BYTES];
#if MULTI_LAUNCH
    if (only >= 0) { run_phase(p, only, lds); return; }
#endif
    cg::grid_group grid = cg::this_grid();
    __shared__ uint4 xb_words;
    if (threadIdx.x == 0) xb_words = make_uint4(0u, 0u, 0u, 0u);
    __syncthreads();
    XcdBarrier xb = xcd_barrier_post((unsigned*)(p.ws + OFF_BAR), (volatile LAS unsigned*)&xb_words);
    for (int ph = 0; ph < NPHASE; ++ph) {
        if (phase_noop(ph)) continue;
        run_phase(p, ph, lds);
        if (ph + 1 < NPHASE) { if (ph == 0) grid.sync(); else xcd_barrier(xb); }
        if (PROBE_K == 100) xcd_barrier(xb);
        if (PROBE_K >= 0 && PROBE_K < 9 && ph > 0 && ((ph - 1) % PH_PER_GRP) < 36 && (((ph - 1) % PH_PER_GRP) % 9) == PROBE_K) { run_phase(p, ph, lds, 1); xcd_barrier(xb); }
    }
}

extern "C" void kernel_launch(void* const* d_in, const int* in_sizes, int n_in, void* d_out, int out_size, void* d_ws, size_t ws_size, hipStream_t stream) {
    (void)in_sizes; (void)n_in; (void)out_size;
    static int grid_blocks = 0;
    if (!grid_blocks) {
        int dev = 0, cus = 0, per_cu = 0;
        hipGetDevice(&dev);
        hipDeviceGetAttribute(&cus, hipDeviceAttributeMultiprocessorCount, dev);
        hipOccupancyMaxActiveBlocksPerMultiprocessor(&per_cu, mega, 256, 0);
        if (per_cu < 1) per_cu = 1;
        if (per_cu > 2) per_cu = 2;
        grid_blocks = cus * per_cu;
    }
    if (ws_size < WS_END) { fprintf(stderr, "workspace too small: %zu < %zu\n", ws_size, (size_t)WS_END); return; }
    Params p{};
    for (int i = 0; i < 26; ++i) p.in[i] = (const float*)d_in[i];
    p.out = (float*)d_out; p.ws = (char*)d_ws;
    hipMemsetAsync((char*)d_ws + OFF_BAR, 0, XCD_BAR_WORDS * sizeof(unsigned), stream);
#if MULTI_LAUNCH
    for (int ph = 0; ph < NPHASE; ++ph) mega<<<dim3(grid_blocks), dim3(256), 0, stream>>>(p, ph);
#else
    int only = -1;
    void* args[] = {&p, &only};
    hipError_t e = hipLaunchCooperativeKernel((void*)mega, dim3(grid_blocks), dim3(256), args, 0, stream);
    if (e != hipSuccess) fprintf(stderr, "cooperative launch failed: %s (grid %d)\n", hipGetErrorString(e), grid_blocks);
#endif
}
```

```cpp
#include <hip/hip_runtime.h>
#include <hip/hip_cooperative_groups.h>
#include <cstdio>
#include <cstdint>
namespace cg = cooperative_groups;

#ifndef MULTI_LAUNCH
#define MULTI_LAUNCH 0
#endif

#define DI __device__ __forceinline__
typedef unsigned short bf16_t;
typedef __bf16 bf16v2 __attribute__((ext_vector_type(2)));
typedef float f32x2 __attribute__((ext_vector_type(2)));
typedef short bf16x8 __attribute__((ext_vector_type(8)));
typedef short s16x4 __attribute__((ext_vector_type(4)));
typedef float f32x4 __attribute__((ext_vector_type(4)));
typedef float f32x16 __attribute__((ext_vector_type(16)));
typedef unsigned u32x4 __attribute__((ext_vector_type(4)));
typedef unsigned u32x2 __attribute__((ext_vector_type(2)));

constexpr int DM = 1024, SL = 2048, NSEQ = 40, G = 8, NGRP = NSEQ / G, TG = G * SL;
constexpr int INW = 4352, NIN = INW + 4096, DFF = 2816;
constexpr float EPS = 1e-6f;
constexpr float LOG2E = 1.4426950408889634f;

constexpr size_t WING = 0;
constexpr size_t WB = 8650752;
constexpr size_t WO = WB + 2097152;
constexpr size_t WFI = WO + 1048576;
constexpr size_t WFO = WFI + 5767168;
constexpr size_t WGLU = WFO + 2883584;
constexpr size_t LW = WGLU + 262144;

constexpr size_t OFF_W = 0;
constexpr size_t OFF_TAB = OFF_W + 4 * LW * 2;
constexpr size_t OFF_COSA = OFF_TAB, OFF_SINA = OFF_TAB + 262144, OFF_COSD = OFF_TAB + 2 * 262144, OFF_SIND = OFF_TAB + 3 * 262144;
constexpr size_t OFF_BIAS = OFF_TAB + 1048576;
constexpr size_t OFF_LAM = OFF_BIAS + 65536;
constexpr size_t OFF_QCNT = OFF_LAM + 256;
constexpr size_t OFF_BAR = OFF_TAB + 1048576 + 131072;
constexpr size_t OFF_H = OFF_TAB + 2097152;
constexpr size_t OFF_U = OFF_H + (size_t)TG * 1024 * 2;
constexpr size_t OFF_GATE = OFF_U + (size_t)TG * INW * 2;
constexpr size_t OFF_VTA = OFF_GATE + (size_t)TG * 4096 * 2;
constexpr size_t OFF_VTC = OFF_VTA + (size_t)TG * 128 * 2;
constexpr size_t OFF_VTD = OFF_VTC + (size_t)TG * 512 * 2;
constexpr size_t OFF_O = OFF_VTD + (size_t)TG * 512 * 2;
constexpr size_t OFF_YF = OFF_O + (size_t)4 * TG * 512 * 2;
constexpr size_t OFF_YB = OFF_YF + (size_t)TG * 512 * 2;
constexpr size_t OFF_DT = OFF_YB + (size_t)TG * 512 * 2;
constexpr size_t WS_END = OFF_DT + (size_t)2 * TG * 512 * 2;
constexpr size_t OFF_M = OFF_U;
constexpr size_t OFF_F = OFF_U;

struct Params { const float* in[26]; float* out; char* ws; };

enum { I_XP = 0, I_XS, I_NMIX, I_WIN, I_QG, I_KG, I_SARE, I_SAIM, I_SLDT, I_SBRE, I_SBIM, I_SCRE, I_SCIM, I_SD, I_SWGLU, I_SBGLU,
       I_DLAM, I_DSUB, I_REL, I_WGATE, I_WBR, I_WOUT, I_NFFN, I_WFI, I_WFO, I_NFIN };

constexpr int LDS_BYTES = 71680;
constexpr int AROWB = 144;
constexpr int ROWB = 128;
constexpr int GT_BYTES = 128 * ROWB;

DI int bidx() { int b = blockIdx.x; asm volatile("" : "+s"(b)); return b; }
DI int gdim() { int g = gridDim.x; asm volatile("" : "+s"(g)); return g; }
DI int tidx() { int t = threadIdx.x; asm volatile("" : "+v"(t)); return t; }
DI unsigned pk2(float a, float b) { f32x2 v = {a, b}; bf16v2 r = __builtin_convertvector(v, bf16v2); return __builtin_bit_cast(unsigned, r); }
DI float bf2f(bf16_t v) { return __uint_as_float(((unsigned)v) << 16); }
DI float bflo(unsigned w) { return __uint_as_float(w << 16); }
DI float bfhi(unsigned w) { return __uint_as_float(w & 0xffff0000u); }
DI float sigmoidf_(float x) { return __builtin_amdgcn_rcpf(1.0f + __builtin_amdgcn_exp2f(-LOG2E * x)); }
DI float wave_sum(float v) { v += __shfl_xor(v, 32); v += __shfl_xor(v, 16); v += __shfl_xor(v, 8); v += __shfl_xor(v, 4); v += __shfl_xor(v, 2); v += __shfl_xor(v, 1); return v; }
DI bf16_t* wts(const Params& p, int layer) { return (bf16_t*)(p.ws + OFF_W) + (size_t)layer * LW; }
#define MFMA16(a, b, c) __builtin_amdgcn_mfma_f32_16x16x32_bf16((a), (b), (c), 0, 0, 0)
#define MFMA32(a, b, c) __builtin_amdgcn_mfma_f32_32x32x16_bf16((a), (b), (c), 0, 0, 0)

template <bool SWAP, int BMAP>
DI void gemm_compute(const char* cur, int aoff, int boff, int sw, f32x4 (&acc)[4][4]) {
#pragma unroll
    for (int ks = 0; ks < 2; ++ks) {
        bf16x8 af[4], bfr[4];
        if (ks) asm volatile("" ::: "memory");
        const int so = sw ^ (ks * 64);
#pragma unroll
        for (int m = 0; m < 4; ++m) af[m] = *(const bf16x8*)(cur + aoff + m * 16 * ROWB + so);
#pragma unroll
        for (int n = 0; n < 4; ++n) bfr[n] = *(const bf16x8*)(cur + boff + (BMAP ? ((n >> 1) * 64 + (n & 1) * 16) : n * 16) * ROWB + so);
#pragma unroll
        for (int m = 0; m < 4; ++m)
#pragma unroll
            for (int n = 0; n < 4; ++n) acc[m][n] = SWAP ? MFMA16(bfr[n], af[m], acc[m][n]) : MFMA16(af[m], bfr[n], acc[m][n]);
    }
}
#define GLOAD(RA, RB, KT) { _Pragma("unroll") for (int i_ = 0; i_ < 4; ++i_) { \
    const char* ua_ = Ab + (size_t)(((32 * i_) * lda + (KT) * 64) * 2); const char* ub_ = Bb + (size_t)(((32 * i_) * ldb + (KT) * 64) * 2); \
    RA[i_] = *(const u32x4*)(ua_ + avoff); RB[i_] = *(const u32x4*)(ub_ + bvoff); } }
#define LSTORE(RA, RB, ST) { _Pragma("unroll") for (int i_ = 0; i_ < 4; ++i_) { *(u32x4*)(lds + (ST) * (2 * GT_BYTES) + soff + 32 * i_ * ROWB) = RA[i_]; *(u32x4*)(lds + (ST) * (2 * GT_BYTES) + GT_BYTES + soff + 32 * i_ * ROWB) = RB[i_]; } }
template <bool SWAP, int BMAP = 0, bool DEEP = true>
DI void gemm128(const bf16_t* __restrict__ A, int lda, const bf16_t* __restrict__ B, int ldb, int K, f32x4 (&acc)[4][4], char* lds) {
    const int tid = tidx(), lane = tid & 63, w = tid >> 6, wr = w >> 1, wc = w & 1;
    const int srow = tid >> 3, scol = tid & 7;
    const char* Ab = (const char*)A; const char* Bb = (const char*)B;
    const unsigned avoff = (unsigned)(srow * lda + scol * 8) * 2u, bvoff = (unsigned)(srow * ldb + scol * 8) * 2u;
    const int soff = srow * ROWB + ((scol ^ ((srow >> 1) & 7)) << 4);
    const int nk = K >> 6;
    const int aoff = (wr * 64 + (lane & 15)) * ROWB;
    const int boff = GT_BYTES + ((BMAP ? wc * 32 : wc * 64) + (lane & 15)) * ROWB;
    const int sw = ((lane >> 4) ^ ((lane & 15) >> 1)) << 4;
    u32x4 ra0[4], rb0[4];
    GLOAD(ra0, rb0, 0);
    LSTORE(ra0, rb0, 0);
    if (DEEP) {
        u32x4 ra1[4], rb1[4];
        GLOAD(ra1, rb1, 1);
        __syncthreads();
        for (int kt = 0; kt < nk; kt += 2) {
            { const int k2 = kt + 2 < nk ? kt + 2 : nk - 1; GLOAD(ra0, rb0, k2); }
            gemm_compute<SWAP, BMAP>(lds, aoff, boff, sw, acc);
            LSTORE(ra1, rb1, 1);
            __syncthreads();
            { const int k3 = kt + 3 < nk ? kt + 3 : nk - 1; GLOAD(ra1, rb1, k3); }
            gemm_compute<SWAP, BMAP>(lds + 2 * GT_BYTES, aoff, boff, sw, acc);
            LSTORE(ra0, rb0, 0);
            __syncthreads();
        }
    } else {
        __syncthreads();
        for (int kt = 0; kt < nk; ++kt) {
            const bool more = (kt + 1 < nk);
            if (more) GLOAD(ra0, rb0, kt + 1);
            gemm_compute<SWAP, BMAP>(lds + (kt & 1) * (2 * GT_BYTES), aoff, boff, sw, acc);
            if (more) { if (kt & 1) { LSTORE(ra0, rb0, 0); } else { LSTORE(ra0, rb0, 1); } }
            __syncthreads();
        }
    }
}

struct TileIter { int per, SM, SN, nSn, sbase, len, q, nslot; };
DI void ti_init(TileIter& it, int NTm, int NTn, int SM, int SN) {
    const int x = bidx() & 7;
    it.nslot = (gdim() - x + 7) >> 3; it.per = SM * SN; it.SM = SM; it.SN = SN; it.nSn = NTn / SN;
    const int nS = (NTm / SM) * it.nSn;
    it.sbase = x * (nS >> 3); it.len = (nS >> 3) * it.per; it.q = bidx() >> 3;
}
DI bool ti_next(TileIter& it, int& tm, int& tn) {
    if (it.q >= it.len) return false;
    const int j = it.q / it.per, w = it.q % it.per, S = it.sbase + j, sm = S / it.nSn, sn = S % it.nSn;
    tm = sm * it.SM + (w % it.SM); tn = sn * it.SN + (w / it.SM);
    it.q += it.nslot;
    return true;
}

struct GemmRegs { u32x4 a0[4], b0[4], a1[4], b1[4]; };
typedef const __attribute__((address_space(1))) char* gptr_t;
typedef const __attribute__((address_space(1))) u32x4* gvec_t;
DI gptr_t uptr(const void* q) {
    const size_t v = (size_t)q;
    const unsigned lo = __builtin_amdgcn_readfirstlane((unsigned)v), hi = __builtin_amdgcn_readfirstlane((unsigned)(v >> 32));
    return (gptr_t)(((size_t)hi << 32) | lo);
}
#define GLOADP(RA, RB, PA, PB, KT) { _Pragma("unroll") for (int i_ = 0; i_ < 4; ++i_) { \
    gptr_t ua_ = (PA) + (size_t)(((32 * i_) * lda + (KT) * 64) * 2); gptr_t ub_ = (PB) + (size_t)(((32 * i_) * ldb + (KT) * 64) * 2); \
    RA[i_] = *(gvec_t)(ua_ + avoff); RB[i_] = *(gvec_t)(ub_ + bvoff); } }
DI void gemm_prime(const bf16_t* A, int lda, const bf16_t* B, int ldb, GemmRegs& g) {
    const int tid = tidx(), srow = tid >> 3, scol = tid & 7;
    const unsigned avoff = (unsigned)(srow * lda + scol * 8) * 2u, bvoff = (unsigned)(srow * ldb + scol * 8) * 2u;
    gptr_t Ab = uptr(A); gptr_t Bb = uptr(B);
    GLOADP(g.a0, g.b0, Ab, Bb, 0);
    GLOADP(g.a1, g.b1, Ab, Bb, 1);
}
template <bool SWAP, int BMAP = 0>
DI void gemm_stream(const bf16_t* A, const bf16_t* B, const bf16_t* nA, const bf16_t* nB, int lda, int ldb, int K, GemmRegs& g, f32x4 (&acc)[4][4], char* lds) {
    const int tid = tidx(), lane = tid & 63, w = tid >> 6, wr = w >> 1, wc = w & 1;
    const int srow = tid >> 3, scol = tid & 7;
    const unsigned avoff = (unsigned)(srow * lda + scol * 8) * 2u, bvoff = (unsigned)(srow * ldb + scol * 8) * 2u;
    gptr_t Ab = uptr(A); gptr_t Bb = uptr(B); gptr_t nAb = uptr(nA); gptr_t nBb = uptr(nB);
    const int soff = srow * ROWB + ((scol ^ ((srow >> 1) & 7)) << 4);
    const int nk = K >> 6;
    const int aoff = (wr * 64 + (lane & 15)) * ROWB;
    const int boff = GT_BYTES + ((BMAP ? wc * 32 : wc * 64) + (lane & 15)) * ROWB;
    const int sw = ((lane >> 4) ^ ((lane & 15) >> 1)) << 4;
    LSTORE(g.a0, g.b0, 0);
    __syncthreads();
    for (int kt = 0; kt < nk; kt += 2) {
        const bool last = kt + 2 >= nk;
        gptr_t pa = last ? nAb : Ab; gptr_t pb = last ? nBb : Bb;
        const int k2 = last ? 0 : kt + 2, k3 = last ? 1 : kt + 3;
        GLOADP(g.a0, g.b0, pa, pb, k2);
        gemm_compute<SWAP, BMAP>(lds, aoff, boff, sw, acc);
        LSTORE(g.a1, g.b1, 1);
        __syncthreads();
        GLOADP(g.a1, g.b1, pa, pb, k3);
        gemm_compute<SWAP, BMAP>(lds + 2 * GT_BYTES, aoff, boff, sw, acc);
        if (!last) LSTORE(g.a0, g.b0, 0);
        __syncthreads();
    }
}

DI void zero_acc(f32x4 (&acc)[4][4]) {
#pragma unroll
    for (int m = 0; m < 4; ++m)
#pragma unroll
        for (int n = 0; n < 4; ++n) acc[m][n] = (f32x4){0.f, 0.f, 0.f, 0.f};
}


constexpr int OROW = 272;
constexpr int OROWF = 528;
DI void otile_put(char* lds, int row, int col, unsigned w0, unsigned w1) { u32x2 w; w[0] = w0; w[1] = w1; *(u32x2*)(lds + row * OROW + col * 2) = w; }
DI void otile_flush(char* lds, bf16_t* dst, int ld) {
    const int tid = tidx();
    __syncthreads();
#pragma unroll
    for (int i = 0; i < 8; ++i) {
        const int c = tid + 256 * i, row = c >> 4, ch = c & 15;
        const u32x4 v = *(const u32x4*)(lds + row * OROW + ch * 16);
        *(u32x4*)(dst + (size_t)row * ld + ch * 8) = v;
    }
    __syncthreads();
}

DI void conv_tile(const float* __restrict__ src, bf16_t* __restrict__ dst, int K, int N, int tk, int tn, int drow0, float* tile) {
    const int tid = tidx(), ty = tid >> 4, tx = tid & 15;
#pragma unroll
    for (int i = 0; i < 4; ++i) {
        const int k = ty + 16 * i;
        const f32x4 v = *(const f32x4*)(src + (size_t)(tk * 64 + k) * N + tn * 64 + tx * 4);
        tile[k * 65 + tx * 4 + 0] = v[0]; tile[k * 65 + tx * 4 + 1] = v[1]; tile[k * 65 + tx * 4 + 2] = v[2]; tile[k * 65 + tx * 4 + 3] = v[3];
    }
    __syncthreads();
    const int n = tid >> 2, ks = (tid & 3) * 16;
    u32x4 w0, w1;
#pragma unroll
    for (int j = 0; j < 4; ++j) {
        w0[j] = pk2(tile[(ks + 2 * j) * 65 + n], tile[(ks + 2 * j + 1) * 65 + n]);
        w1[j] = pk2(tile[(ks + 8 + 2 * j) * 65 + n], tile[(ks + 8 + 2 * j + 1) * 65 + n]);
    }
    bf16_t* d = dst + (size_t)(drow0 + n) * K + tk * 64 + ks;
    *(u32x4*)d = w0; *(u32x4*)(d + 8) = w1;
    __syncthreads();
}

DI int t5_bucket(int rel) {
    const int base = rel > 0 ? 16 : 0;
    const int dist = rel < 0 ? -rel : rel;
    int b;
    if (dist < 8) b = dist;
    else {
        const float lr = logf((float)dist / 8.0f) / 2.772588722239781f;
        int lg = 8 + (int)(lr * 8.0f);
        b = lg < 15 ? lg : 15;
    }
    return base + b;
}

DI void phase_prologue(const Params& p, char* lds) {
    float* tile = (float*)lds;
    const int tid = tidx();
    for (int t = bidx(); t < 4 * 5056; t += gdim()) {
        const int layer = t / 5056; int q = t % 5056;
        bf16_t* wl = wts(p, layer);
        const float* src; bf16_t* dst; int K, N, nn;
        if (q < 1088) { src = p.in[I_WIN] + (size_t)layer * 1024 * INW; dst = wl + WING; K = 1024; N = INW; }
        else if ((q -= 1088) < 1024) { const int b = q >> 8; q &= 255; src = p.in[I_WGATE] + (size_t)(layer * 4 + b) * 1024 * 1024; dst = wl + WING + (size_t)(INW + b * 1024) * 1024; K = 1024; N = 1024; }
        else if ((q -= 1024) < 512) { const int b = q >> 7; q &= 127; src = p.in[I_WBR] + (size_t)(layer * 4 + b) * 512 * 1024; dst = wl + WB + (size_t)b * 1024 * 512; K = 512; N = 1024; }
        else if ((q -= 512) < 256) { src = p.in[I_WOUT] + (size_t)layer * 1024 * 1024; dst = wl + WO; K = 1024; N = 1024; }
        else if ((q -= 256) < 1408) { src = p.in[I_WFI] + (size_t)layer * 1024 * 5632; dst = wl + WFI; K = 1024; N = 5632; }
        else if ((q -= 1408) < 704) { src = p.in[I_WFO] + (size_t)layer * DFF * 1024; dst = wl + WFO; K = DFF; N = 1024; }
        else { q -= 704; src = p.in[I_SWGLU] + (size_t)layer * 512 * 512; dst = wl + WGLU; K = 512; N = 512; }
        nn = N >> 6;
        const int tk = q / nn, tn = q % nn;
        int drow0 = tn * 64;
        if (N == 5632) drow0 = tn < 44 ? tn * 128 : (tn - 44) * 128 + 64;
        conv_tile(src, dst, K, N, tk, tn, drow0, tile);
    }
    const int gt = bidx() * 256 + tid, gn = gdim() * 256;
    float* cosA = (float*)(p.ws + OFF_COSA); float* sinA = (float*)(p.ws + OFF_SINA);
    float* cosD = (float*)(p.ws + OFF_COSD); float* sinD = (float*)(p.ws + OFF_SIND);
    for (int i = gt; i < SL * 32; i += gn) {
        const int t = i >> 5, j = i & 31;
        const float invA = exp2f(-(float)(j & 15) * (13.287712379549449f / 16.0f));
        const float angA = (j < 16 ? (float)(t >> 6) : (float)(t & 63)) * invA;
        cosA[i] = cosf(angA); sinA[i] = sinf(angA);
        const float invD = exp2f(-(float)j * (13.287712379549449f / 32.0f));
        const float angD = (float)t * invD;
        cosD[i] = cosf(angD); sinD[i] = sinf(angD);
    }
    float* bias = (float*)(p.ws + OFF_BIAS);
    for (int i = gt; i < 4 * 4096; i += gn) {
        const int h = i >> 12, r = i & 4095;
        float v = 0.f;
        if (r < 4095) v = p.in[I_REL][t5_bucket(r - 2047) * 4 + h] * LOG2E;
        bias[i] = v;
    }
    if (bidx() == 0) {
        if (tid < 4) {
            const float* lv = p.in[I_DLAM] + tid * 256;
            float s1 = 0.f, s2 = 0.f;
            for (int j = 0; j < 64; ++j) { s1 += lv[j] * lv[64 + j]; s2 += lv[128 + j] * lv[192 + j]; }
            const float li = 0.8f - 0.6f * expf(-0.3f * (float)tid);
            float* lam = (float*)(p.ws + OFF_LAM);
            lam[tid] = expf(s1) - expf(s2) + li; lam[4 + tid] = li;
        }
        if (tid < 64) ((int*)(p.ws + OFF_QCNT))[tid] = 0;
    }
}

DI const float* x_in_row(const Params& p, int grp, int row) {
    const int seq = grp * G + (row >> 11), t = row & 2047;
    return seq < 8 ? p.in[I_XP] + ((size_t)seq * SL + t) * DM : p.in[I_XS] + ((size_t)(seq - 8) * SL + t) * DM;
}
DI void phase_norm(const Params& p, int grp, const float* gain, int mode) {
    const int lane = tidx() & 63;
    const int gw = bidx() * 4 + (tidx() >> 6), nw = gdim() * 4;
    bf16_t* hb = (bf16_t*)(p.ws + OFF_H);
    f32x4 gv[4];
#pragma unroll
    for (int i = 0; i < 4; ++i) gv[i] = *(const f32x4*)(gain + lane * 4 + 256 * i);
    for (int row = gw; row < TG; row += nw) {
        float* xo = p.out + ((size_t)grp * TG + row) * DM;
        const float* x = mode == 0 ? x_in_row(p, grp, row) : xo;
        f32x4 v[4]; float ss = 0.f;
#pragma unroll
        for (int i = 0; i < 4; ++i) { v[i] = *(const f32x4*)(x + lane * 4 + 256 * i); ss += v[i][0] * v[i][0] + v[i][1] * v[i][1] + v[i][2] * v[i][2] + v[i][3] * v[i][3]; }
        ss = wave_sum(ss);
        const float rstd = rsqrtf(ss * (1.0f / 1024.0f) + EPS);
#pragma unroll
        for (int i = 0; i < 4; ++i) {
            const f32x4 y = v[i] * rstd * gv[i];
            if (mode == 2) *(f32x4*)(xo + lane * 4 + 256 * i) = y;
            else { u32x2 w; w[0] = pk2(y[0], y[1]); w[1] = pk2(y[2], y[3]); *(u32x2*)(hb + (size_t)row * DM + lane * 4 + 256 * i) = w; }
        }
    }
}

DI void phase_in(const Params& p, int layer, char* lds, bool probe = false) {
    const bf16_t* hb = (const bf16_t*)(p.ws + OFF_H);
    const bf16_t* W = wts(p, layer) + WING;
    bf16_t* ub = (bf16_t*)(p.ws + OFF_U);
    bf16_t* gb = (bf16_t*)(p.ws + OFF_GATE);
    constexpr int NT = NIN / 128;
    const int lane = tidx() & 63, w = tidx() >> 6, wr = w >> 1, wc = w & 1, r16 = lane & 15, q4 = lane >> 4;
    TileIter it; ti_init(it, TG / 128, NT, 8, 6);
    int tm, tn;
    while (ti_next(it, tm, tn)) {
        const int c0 = tn * 128;
        const bool isV = (c0 == 640) || (c0 >= 2304 && c0 < 2816) || (c0 >= 3328 && c0 < 3840);
        f32x4 acc[4][4]; zero_acc(acc);
        const int cb = c0 + wc * 64;
        if (isV) {
            gemm128<false>(hb + (size_t)tm * 128 * DM, DM, W + (size_t)c0 * DM, DM, DM, acc, lds);
            bf16_t* vt; int cl, DV, NH;
            if (cb < 768) { vt = (bf16_t*)(p.ws + OFF_VTA); cl = cb - 640; DV = 64; NH = 2; }
            else if (cb < 2816) { vt = (bf16_t*)(p.ws + OFF_VTC); cl = cb - 2304; DV = 128; NH = 4; }
            else { vt = (bf16_t*)(p.ws + OFF_VTD); cl = cb - 3328; DV = 128; NH = 4; }
#pragma unroll
            for (int m = 0; m < 4; ++m) {
                const int row0 = tm * 128 + wr * 64 + m * 16 + q4 * 4, seq = row0 >> 11, t0 = row0 & 2047;
#pragma unroll
                for (int n = 0; n < 4; ++n) {
                    const int col = cl + n * 16 + r16, head = col / DV, d = col % DV;
                    u32x2 wv; wv[0] = pk2(acc[m][n][0], acc[m][n][1]); wv[1] = pk2(acc[m][n][2], acc[m][n][3]);
                    *(u32x2*)(vt + ((size_t)(seq * NH + head) * DV + d) * SL + t0) = wv;
                }
            }
        } else {
            gemm128<true>(hb + (size_t)tm * 128 * DM, DM, W + (size_t)c0 * DM, DM, DM, acc, lds);
            bool donorm = false, dosig = false; int rot = 0; float scale = 1.f; const float* gain = nullptr;
            bf16_t* dst = ub; int ld = INW, dcol = cb;
            if (cb < 512) { donorm = true; rot = 1; scale = 0.125f * LOG2E; gain = p.in[I_QG] + layer * 64; }
            else if (cb < 640) { donorm = true; rot = 1; gain = p.in[I_KG] + layer * 64; }
            else if (cb < 1280) { }
            else if (cb < 1792) { scale = 0.125f * LOG2E; }
            else if (cb < 2816) { }
            else if (cb < 3072) { rot = 2; scale = 0.125f; }
            else if (cb < 3328) { rot = 2; }
            else if (cb < INW) { }
            else { dosig = true; dst = gb; ld = 4096; dcol = cb - INW; }
            float gl[4][4];
            if (donorm) {
#pragma unroll
                for (int n = 0; n < 4; ++n) { const f32x4 g4 = *(const f32x4*)(gain + n * 16 + q4 * 4); gl[n][0] = g4[0]; gl[n][1] = g4[1]; gl[n][2] = g4[2]; gl[n][3] = g4[3]; }
            }
            const float* ct = (const float*)(p.ws + (rot == 2 ? OFF_COSD : OFF_COSA));
            const float* sn = (const float*)(p.ws + (rot == 2 ? OFF_SIND : OFF_SINA));
#pragma unroll
            for (int m = 0; m < 4; ++m) {
                asm volatile("" ::: "memory");
                const int row = tm * 128 + wr * 64 + m * 16 + r16, tpos = row & 2047;
                float v[4][4];
#pragma unroll
                for (int n = 0; n < 4; ++n)
#pragma unroll
                    for (int i = 0; i < 4; ++i) v[n][i] = acc[m][n][i];
                if (donorm) {
                    float ss = 0.f;
#pragma unroll
                    for (int n = 0; n < 4; ++n)
#pragma unroll
                        for (int i = 0; i < 4; ++i) ss += v[n][i] * v[n][i];
                    ss += __shfl_xor(ss, 16); ss += __shfl_xor(ss, 32);
                    const float rstd = rsqrtf(ss * (1.0f / 64.0f) + EPS);
#pragma unroll
                    for (int n = 0; n < 4; ++n)
#pragma unroll
                        for (int i = 0; i < 4; ++i) v[n][i] = v[n][i] * rstd * gl[n][i];
                }
                if (rot) {
#pragma unroll
                    for (int n = 0; n < 2; ++n) {
                        const f32x4 c4 = *(const f32x4*)(ct + tpos * 32 + n * 16 + q4 * 4), s4 = *(const f32x4*)(sn + tpos * 32 + n * 16 + q4 * 4);
#pragma unroll
                        for (int i = 0; i < 4; ++i) { const float x1 = v[n][i], x2 = v[n + 2][i]; v[n][i] = x1 * c4[i] - x2 * s4[i]; v[n + 2][i] = x2 * c4[i] + x1 * s4[i]; }
                    }
                }
#pragma unroll
                for (int n = 0; n < 4; ++n) {
                    float o0, o1, o2, o3;
                    if (dosig) { o0 = sigmoidf_(v[n][0]); o1 = sigmoidf_(v[n][1]); o2 = sigmoidf_(v[n][2]); o3 = sigmoidf_(v[n][3]); }
                    else { o0 = v[n][0] * scale; o1 = v[n][1] * scale; o2 = v[n][2] * scale; o3 = v[n][3] * scale; }
                    otile_put(lds, wr * 64 + m * 16 + r16, wc * 64 + n * 16 + q4 * 4, pk2(o0, o1), pk2(o2, o3));
                }
            }
            otile_flush(lds, dst + (size_t)(tm * 128) * ld + (dcol - wc * 64), ld);
        }
    }
}

template <int DV, int MODE>
DI void attn_task(const Params& p, int task, char* lds) {
    constexpr int NDT = DV / 32;
    constexpr int STG = 64 * AROWB + DV * AROWB;
    const int tid = tidx(), lane = tid & 63, wave = tid >> 6, r = lane & 31, h = lane >> 5;
    const bf16_t* ub = (const bf16_t*)(p.ws + OFF_U);
    const int qt = task & 15; const int rest = task >> 4;
    int seq, head, map = 0, qcol, kcol; const bf16_t* vt;
    if (MODE == 0) { head = rest & 7; seq = rest >> 3; qcol = head * 64; kcol = 512 + (head >> 2) * 64; vt = (const bf16_t*)(p.ws + OFF_VTA) + (size_t)(seq * 2 + (head >> 2)) * 64 * SL; }
    else if (MODE == 1) { map = rest & 1; head = (rest >> 1) & 3; seq = rest >> 3; qcol = 1280 + head * 128 + map * 64; kcol = 1792 + head * 128 + map * 64; vt = (const bf16_t*)(p.ws + OFF_VTC) + (size_t)(seq * 4 + head) * 128 * SL; }
    else { head = rest & 3; seq = rest >> 2; qcol = 2816 + head * 64; kcol = 3072 + head * 64; vt = (const bf16_t*)(p.ws + OFF_VTD) + (size_t)(seq * 4 + head) * 128 * SL; }
    const int qpos = qt * 128 + wave * 32 + r;
    const bf16_t* qptr = ub + ((size_t)seq * SL + qpos) * INW + qcol;
    bf16x8 qf[4];
#pragma unroll
    for (int s = 0; s < 4; ++s) qf[s] = *(const bf16x8*)(qptr + 16 * s + 8 * h);
    const bf16_t* kbase = ub + (size_t)seq * SL * INW + kcol;
    float* sBias = (float*)(lds + 2 * STG);
    if (MODE == 1) { const float* bl = (const float*)(p.ws + OFF_BIAS) + head * 4096; for (int i = tid; i < 4096; i += 256) sBias[i] = bl[i]; }
    float lgam = 0.f;
    if (MODE == 2) lgam = log2f(1.0f - exp2f(-5.0f - (float)head));
    f32x16 o[NDT];
#pragma unroll
    for (int d = 0; d < NDT; ++d)
#pragma unroll
        for (int i = 0; i < 16; ++i) o[d][i] = 0.f;
    float lsum = 0.f;
    const int srow = tid >> 3, sc = tid & 7;
    const bf16_t* kg = kbase + (size_t)srow * INW + sc * 8;
    const bf16_t* vg = vt + (size_t)srow * SL + sc * 8;
    u32x4 rk[2], rv[NDT];
#pragma unroll
    for (int i = 0; i < 2; ++i) rk[i] = *(const u32x4*)(kg + (size_t)(32 * i) * INW);
#pragma unroll
    for (int i = 0; i < NDT; ++i) rv[i] = *(const u32x4*)(vg + (size_t)(32 * i) * SL);
    const int soff = srow * AROWB + sc * 16;
#pragma unroll
    for (int i = 0; i < 2; ++i) *(u32x4*)(lds + soff + 32 * i * AROWB) = rk[i];
#pragma unroll
    for (int i = 0; i < NDT; ++i) *(u32x4*)(lds + 64 * AROWB + soff + 32 * i * AROWB) = rv[i];
    __syncthreads();
    for (int kt = 0; kt < SL / 64; ++kt) {
        const char* cur = lds + (kt & 1) * STG;
        char* nxt = lds + ((kt + 1) & 1) * STG;
        const bool more = kt + 1 < SL / 64;
        const int kv0 = kt * 64;
        if (more) {
            kg += (size_t)64 * INW; vg += 64;
#pragma unroll
            for (int i = 0; i < 2; ++i) rk[i] = *(const u32x4*)(kg + (size_t)(32 * i) * INW);
#pragma unroll
            for (int i = 0; i < NDT; ++i) rv[i] = *(const u32x4*)(vg + (size_t)(32 * i) * SL);
        }
        f32x16 st[2];
#pragma unroll
        for (int kk = 0; kk < 2; ++kk) {
#pragma unroll
            for (int i = 0; i < 16; ++i) st[kk][i] = 0.f;
#pragma unroll
            for (int s = 0; s < 4; ++s) {
                const bf16x8 kf = *(const bf16x8*)(cur + (32 * kk + r) * AROWB + (16 * s + 8 * h) * 2);
                st[kk] = MFMA32(kf, qf[s], st[kk]);
            }
        }
        const int qw0 = qt * 128 + wave * 32;
        const bool farL = MODE == 1 && (kv0 + 63 - qw0) <= -128, farR = MODE == 1 && (kv0 - (qw0 + 31)) >= 128;
        if (MODE == 1 && (farL || farR)) {
            const float bc = farL ? sBias[0] : sBias[4094];
#pragma unroll
            for (int kk = 0; kk < 2; ++kk)
#pragma unroll
                for (int i = 0; i < 16; ++i) { const float pv = __builtin_amdgcn_exp2f(st[kk][i] + bc); lsum += pv; st[kk][i] = pv; }
        } else
#pragma unroll
        for (int kk = 0; kk < 2; ++kk)
#pragma unroll
            for (int i = 0; i < 16; ++i) {
                const int m = kv0 + 32 * kk + (i & 3) + 8 * (i >> 2) + 4 * h;
                float pv;
                if (MODE == 0) pv = __builtin_amdgcn_exp2f(st[kk][i]);
                else if (MODE == 1) pv = __builtin_amdgcn_exp2f(st[kk][i] + sBias[m - qpos + 2047]);
                else pv = st[kk][i] * __builtin_amdgcn_exp2f(lgam * fabsf((float)(qpos - m)));
                if (MODE != 2) lsum += pv;
                st[kk][i] = pv;
            }
        const char* sV = cur + 64 * AROWB;
#pragma unroll
        for (int kk = 0; kk < 2; ++kk)
#pragma unroll
            for (int s2 = 0; s2 < 2; ++s2) {
                u32x4 pw;
#pragma unroll
                for (int j = 0; j < 4; ++j) pw[j] = pk2(st[kk][8 * s2 + 2 * j], st[kk][8 * s2 + 2 * j + 1]);
                const bf16x8 pf = __builtin_bit_cast(bf16x8, pw);
#pragma unroll
                for (int d = 0; d < NDT; ++d) {
                    const char* va = sV + (32 * d + r) * AROWB + (32 * kk + 16 * s2 + 4 * h) * 2;
                    const s16x4 lo = *(const s16x4*)va, hi = *(const s16x4*)(va + 16);
                    const bf16x8 vf = __builtin_shufflevector(lo, hi, 0, 1, 2, 3, 4, 5, 6, 7);
                    o[d] = MFMA32(vf, pf, o[d]);
                }
            }
        if (more) {
#pragma unroll
            for (int i = 0; i < 2; ++i) *(u32x4*)(nxt + soff + 32 * i * AROWB) = rk[i];
#pragma unroll
            for (int i = 0; i < NDT; ++i) *(u32x4*)(nxt + 64 * AROWB + soff + 32 * i * AROWB) = rv[i];
        }
        __syncthreads();
    }
    const size_t tok = (size_t)seq * SL + qpos;
    if (MODE != 2) {
        const float ltot = lsum + __shfl_xor(lsum, 32);
        const float inv = __builtin_amdgcn_rcpf(ltot);
        bf16_t* dst = MODE == 0 ? (bf16_t*)(p.ws + OFF_O) + tok * 512 + head * 64
                                : (bf16_t*)(p.ws + OFF_DT) + ((size_t)map * TG + tok) * 512 + head * 128;
#pragma unroll
        for (int d = 0; d < NDT; ++d)
#pragma unroll
            for (int a = 0; a < 4; ++a) {
                u32x2 wv; wv[0] = pk2(o[d][4 * a] * inv, o[d][4 * a + 1] * inv); wv[1] = pk2(o[d][4 * a + 2] * inv, o[d][4 * a + 3] * inv);
                *(u32x2*)(dst + 32 * d + 8 * a + 4 * h) = wv;
            }
    } else {
        float s = 0.f;
#pragma unroll
        for (int d = 0; d < NDT; ++d)
#pragma unroll
            for (int i = 0; i < 16; ++i) s += o[d][i];
        s += __shfl_xor(s, 32);
        const float mu = s * (1.0f / 128.0f);
        float vs = 0.f;
#pragma unroll
        for (int d = 0; d < NDT; ++d)
#pragma unroll
            for (int i = 0; i < 16; ++i) { const float dd = o[d][i] - mu; vs += dd * dd; }
        vs += __shfl_xor(vs, 32);
        const float rstd = rsqrtf(vs * (1.0f / 128.0f) + EPS);
        const bf16_t* gp = ub + tok * INW + 3840 + head * 128;
        bf16_t* dst = (bf16_t*)(p.ws + OFF_O) + ((size_t)3 * TG + tok) * 512 + head * 128;
#pragma unroll
        for (int d = 0; d < NDT; ++d)
#pragma unroll
            for (int a = 0; a < 4; ++a) {
                asm volatile("" ::: "memory");
                const u32x2 gw = *(const u32x2*)(gp + 32 * d + 8 * a + 4 * h);
                const float g0 = bflo(gw[0]), g1 = bfhi(gw[0]), g2 = bflo(gw[1]), g3 = bfhi(gw[1]);
                const float y0 = (o[d][4 * a] - mu) * rstd * g0 * sigmoidf_(g0), y1 = (o[d][4 * a + 1] - mu) * rstd * g1 * sigmoidf_(g1);
                const float y2 = (o[d][4 * a + 2] - mu) * rstd * g2 * sigmoidf_(g2), y3 = (o[d][4 * a + 3] - mu) * rstd * g3 * sigmoidf_(g3);
                u32x2 wv; wv[0] = pk2(y0, y1); wv[1] = pk2(y2, y3);
                *(u32x2*)(dst + 32 * d + 8 * a + 4 * h) = wv;
            }
    }
}

DI void tr_read8(unsigned a, s16x4 (&v)[8]) {
    asm volatile("ds_read_b64_tr_b16 %0, %8\n\tds_read_b64_tr_b16 %1, %8 offset:256\n\tds_read_b64_tr_b16 %2, %8 offset:1024\n\tds_read_b64_tr_b16 %3, %8 offset:1280\n\t"
                 "ds_read_b64_tr_b16 %4, %8 offset:2048\n\tds_read_b64_tr_b16 %5, %8 offset:2304\n\tds_read_b64_tr_b16 %6, %8 offset:3072\n\tds_read_b64_tr_b16 %7, %8 offset:3328\n\t"
                 "s_waitcnt lgkmcnt(0)"
                 : "=&v"(v[0]), "=&v"(v[1]), "=&v"(v[2]), "=&v"(v[3]), "=&v"(v[4]), "=&v"(v[5]), "=&v"(v[6]), "=&v"(v[7]) : "v"(a) : "memory");
}

DI void s5_wave_task(const Params& p, int layer, int wt, char* ldsw) {
    const int lane = tidx() & 63, r = lane & 31, h = lane >> 5;
    const int dir = wt & 1, g = (wt >> 1) & 31, pair = wt >> 6;
    const bf16_t* ub = (const bf16_t*)(p.ws + OFF_U);
    const int hp = (r >> 2) & 1, ia = 4 * (r >> 3) + (r & 3);
    const unsigned img = (unsigned)(size_t)ldsw;
    char* chunkbuf = ldsw + 8192;
    const int i16 = lane & 15, tq = i16 >> 2, tp = i16 & 3, blk = (lane >> 4) & 1;
    const unsigned trA = img + (8 * h + tq) * 64 + 8 * (4 * blk + tp);
    const float dsk = r < 16 ? p.in[I_SD][layer * 512 + g * 16 + r] : 0.f;
    bf16_t* yl = (bf16_t*)(p.ws + (dir ? OFF_YB : OFF_YF)) + ((size_t)(2 * pair + h) * 512 + g * 16 + (r & 15)) * SL;
    const int pb = (layer * 2 + dir) * 32 + g;
    const float dt = expf(p.in[I_SLDT][pb]);
    float abr[2], abi[2];
    bf16x8 bfrag[2][2], cfrag[2][2][2], dfrag;
    {
        u32x4 dw;
#pragma unroll
        for (int j = 0; j < 4; ++j) dw[j] = pk2((dir == 0 && r == 8 * h + 2 * j) ? dsk : 0.f, (dir == 0 && r == 8 * h + 2 * j + 1) ? dsk : 0.f);
        dfrag = __builtin_bit_cast(bf16x8, dw);
    }
#pragma unroll
    for (int st = 0; st < 2; ++st) {
        const int n = 32 * st + r;
        const float are = p.in[I_SARE][pb * 64 + n], aim = p.in[I_SAIM][pb * 64 + n];
        const float mag = expf(dt * are);
        abr[st] = mag * cosf(dt * aim); abi[st] = mag * sinf(dt * aim);
        const float den = are * are + aim * aim, nr = abr[st] - 1.0f;
        const float fre = (nr * are + abi[st] * aim) / den, fim = (abi[st] * are - nr * aim) / den;
        const float* bre = p.in[I_SBRE] + ((size_t)pb * 64 + n) * 16 + 8 * h;
        const float* bim = p.in[I_SBIM] + ((size_t)pb * 64 + n) * 16 + 8 * h;
        u32x4 wre, wim;
#pragma unroll
        for (int j = 0; j < 4; ++j) {
            const float br0 = bre[2 * j], bi0 = bim[2 * j], br1 = bre[2 * j + 1], bi1 = bim[2 * j + 1];
            wre[j] = pk2(fre * br0 - fim * bi0, fre * br1 - fim * bi1);
            wim[j] = pk2(fre * bi0 + fim * br0, fre * bi1 + fim * br1);
        }
        bfrag[st][0] = __builtin_bit_cast(bf16x8, wre); bfrag[st][1] = __builtin_bit_cast(bf16x8, wim);
#pragma unroll
        for (int s = 0; s < 2; ++s) {
            u32x4 cr = {0u, 0u, 0u, 0u}, ci = {0u, 0u, 0u, 0u};
            if (r < 16) {
                const float* cre = p.in[I_SCRE] + ((size_t)pb * 16 + r) * 64 + 32 * st + 16 * s + 8 * h;
                const float* cim = p.in[I_SCIM] + ((size_t)pb * 16 + r) * 64 + 32 * st + 16 * s + 8 * h;
#pragma unroll
                for (int j = 0; j < 4; ++j) { cr[j] = pk2(cre[2 * j], cre[2 * j + 1]); ci[j] = pk2(-cim[2 * j], -cim[2 * j + 1]); }
            }
            cfrag[st][s][0] = __builtin_bit_cast(bf16x8, cr); cfrag[st][s][1] = __builtin_bit_cast(bf16x8, ci);
        }
    }
    float sre[2] = {0.f, 0.f}, sim[2] = {0.f, 0.f};
    const bf16_t* gsrc[4]; int loff[4];
#pragma unroll
    for (int j = 0; j < 4; ++j) {
        const int c = lane + 64 * j, row = c >> 1, half = c & 1, ss = row >> 6, tau = row & 63;
        gsrc[j] = ub + ((size_t)(2 * pair + ss) * SL + (dir ? (SL - 1 - tau) : tau)) * INW + 768 + g * 16 + half * 8;
        loff[j] = row * 32 + half * 16;
    }
    const long cstep = dir ? -(long)64 * INW : (long)64 * INW;
    u32x4 crg[4];
#pragma unroll
    for (int j = 0; j < 4; ++j) crg[j] = *(const u32x4*)gsrc[j];
#pragma unroll
    for (int j = 0; j < 4; ++j) *(u32x4*)(chunkbuf + loff[j]) = crg[j];
    const int aoff = (hp * 64 + ia) * 32 + h * 16;
    for (int chunk = 0; chunk < SL / 64; ++chunk) {
        if (chunk + 1 < SL / 64) {
#pragma unroll
            for (int j = 0; j < 4; ++j) { gsrc[j] += cstep; crg[j] = *(const u32x4*)gsrc[j]; }
        }
        const char* cb = chunkbuf + (chunk & 1) * 4096;
#pragma unroll 1
        for (int tl = 0; tl < 4; ++tl) {
            const int s0 = chunk * 64 + tl * 16;
            const bf16x8 ua = *(const bf16x8*)(cb + aoff + tl * 512);
            f32x16 z;
#pragma unroll
            for (int i = 0; i < 16; ++i) z[i] = 0.f;
            f32x16 y0 = MFMA32(ua, dfrag, z);
            f32x16 y1 = z;
#pragma unroll
            for (int st = 0; st < 2; ++st) {
                f32x16 xr = MFMA32(ua, bfrag[st][0], z);
                f32x16 xi = MFMA32(ua, bfrag[st][1], z);
                float cr = sre[st], ci = sim[st];
#pragma unroll
                for (int i = 0; i < 16; ++i) {
                    const float nr = abr[st] * cr - abi[st] * ci + xr[i];
                    const float ni = abr[st] * ci + abi[st] * cr + xi[i];
                    cr = nr; ci = ni; xr[i] = nr; xi[i] = ni;
                }
                sre[st] = cr; sim[st] = ci;
#pragma unroll
                for (int a = 0; a < 4; ++a) {
                    u32x2 w0, w1; w0[0] = pk2(xr[4 * a], xr[4 * a + 1]); w0[1] = pk2(xr[4 * a + 2], xr[4 * a + 3]);
                    w1[0] = pk2(xi[4 * a], xi[4 * a + 1]); w1[1] = pk2(xi[4 * a + 2], xi[4 * a + 3]);
                    *(u32x2*)(ldsw + (st * 2 + 0) * 2048 + r * 64 + 8 * (2 * a + h)) = w0;
                    *(u32x2*)(ldsw + (st * 2 + 1) * 2048 + r * 64 + 8 * (2 * a + h)) = w1;
                }
            }
            asm volatile("s_waitcnt lgkmcnt(0)" ::: "memory");
            {
                s16x4 v[8];
                tr_read8(trA, v);
                y0 = MFMA32(__builtin_shufflevector(v[0], v[1], 0, 1, 2, 3, 4, 5, 6, 7), cfrag[0][0][0], y0);
                y0 = MFMA32(__builtin_shufflevector(v[2], v[3], 0, 1, 2, 3, 4, 5, 6, 7), cfrag[0][1][0], y0);
                y0 = MFMA32(__builtin_shufflevector(v[4], v[5], 0, 1, 2, 3, 4, 5, 6, 7), cfrag[0][0][1], y0);
                y0 = MFMA32(__builtin_shufflevector(v[6], v[7], 0, 1, 2, 3, 4, 5, 6, 7), cfrag[0][1][1], y0);
                s16x4 u[8];
                tr_read8(trA + 4096, u);
                y1 = MFMA32(__builtin_shufflevector(u[0], u[1], 0, 1, 2, 3, 4, 5, 6, 7), cfrag[1][0][0], y1);
                y1 = MFMA32(__builtin_shufflevector(u[2], u[3], 0, 1, 2, 3, 4, 5, 6, 7), cfrag[1][1][0], y1);
                y1 = MFMA32(__builtin_shufflevector(u[4], u[5], 0, 1, 2, 3, 4, 5, 6, 7), cfrag[1][0][1], y1);
                y1 = MFMA32(__builtin_shufflevector(u[6], u[7], 0, 1, 2, 3, 4, 5, 6, 7), cfrag[1][1][1], y1);
            }
            if (r < 16) {
                u32x4 o0, o1;
                if (dir == 0) {
#pragma unroll
                    for (int j = 0; j < 4; ++j) { o0[j] = pk2(y0[2 * j] + y1[2 * j], y0[2 * j + 1] + y1[2 * j + 1]); o1[j] = pk2(y0[8 + 2 * j] + y1[8 + 2 * j], y0[9 + 2 * j] + y1[9 + 2 * j]); }
                    *(u32x4*)(yl + s0) = o0; *(u32x4*)(yl + s0 + 8) = o1;
                } else {
#pragma unroll
                    for (int j = 0; j < 4; ++j) { o0[j] = pk2(y0[15 - 2 * j] + y1[15 - 2 * j], y0[14 - 2 * j] + y1[14 - 2 * j]); o1[j] = pk2(y0[7 - 2 * j] + y1[7 - 2 * j], y0[6 - 2 * j] + y1[6 - 2 * j]); }
                    *(u32x4*)(yl + (SL - 16 - s0)) = o0; *(u32x4*)(yl + (SL - 16 - s0) + 8) = o1;
                }
            }
        }
        if (chunk + 1 < SL / 64) {
#pragma unroll
            for (int j = 0; j < 4; ++j) *(u32x4*)(chunkbuf + ((chunk + 1) & 1) * 4096 + loff[j]) = crg[j];
        }
    }
}

DI void phase_mix(const Params& p, int layer, int qidx, char* lds, bool only_s5 = false) {
    __shared__ int s_task;
    int* qc = (int*)(p.ws + OFF_QCNT) + qidx;
    constexpr int N_S5 = (G / 2) * 32 * 2 / 4, N_DIFF = G * 4 * 2 * 16, N_RET = G * 4 * 16, N_GQA = G * 8 * 16;
    constexpr int NTOT = N_S5 + N_DIFF + N_RET + N_GQA;
    for (;;) {
        __syncthreads();
        if (tidx() == 0) s_task = atomicAdd(qc, 1);
        __syncthreads();
        int task = s_task;
        if (task >= (only_s5 ? N_S5 : NTOT)) break;
        if (task < N_S5) { const int wave = tidx() >> 6; s5_wave_task(p, layer, task * 4 + wave, lds + wave * 16384); }
        else if ((task -= N_S5) < N_DIFF) attn_task<128, 1>(p, task, lds);
        else if ((task -= N_DIFF) < N_RET) attn_task<128, 2>(p, task, lds);
        else attn_task<64, 0>(p, task - N_RET, lds);
    }
}

DI float gelu_tanh(float v) { const float z2 = 1.5957691216057308f * (v + 0.044715f * v * v * v); return v * __builtin_amdgcn_rcpf(1.0f + __builtin_amdgcn_exp2f(-LOG2E * z2)); }

DI void glu_tile(const Params& p, int layer, int tm, int tn, char* lds) {
    const int tid = tidx(), lane = tid & 63, w = tid >> 6, wr = w >> 1, wc = w & 1, r16 = lane & 15, q4 = lane >> 4;
    const bf16_t* yf = (const bf16_t*)(p.ws + OFF_YF);
    const bf16_t* yb = (const bf16_t*)(p.ws + OFF_YB);
    const bf16_t* B = wts(p, layer) + WGLU + (size_t)tn * 128 * 512;
    const int seq = (tm * 128) >> 11, t0 = (tm * 128) & 2047;
    const int ach = tid & 63, aseg0 = tid >> 6;
    const bf16_t* fg = yf + ((size_t)seq * 512 + ach) * SL + t0;
    const bf16_t* bg2 = yb + ((size_t)seq * 512 + ach) * SL + t0;
    const int srow = tid >> 3, scol = tid & 7;
    const bf16_t* bg = B + (size_t)srow * 512 + scol * 8;
    const int soff = srow * ROWB + ((scol ^ ((srow >> 1) & 7)) << 4);
    u32x4 rf[4], rbk[4], rb[4];
    f32x4 acc[4][4]; zero_acc(acc);
    const int aoff = (wr * 64 + (lane & 15)) * ROWB;
    const int boff = GT_BYTES + (wc * 64 + (lane & 15)) * ROWB;
    const int sw = ((lane >> 4) ^ ((lane & 15) >> 1)) << 4;
    for (int kt = 0; kt < 8; ++kt) {
#pragma unroll
        for (int j = 0; j < 4; ++j) {
            rf[j] = *(const u32x4*)(fg + (size_t)kt * 64 * SL + (aseg0 + 4 * j) * 8);
            rbk[j] = *(const u32x4*)(bg2 + (size_t)kt * 64 * SL + (aseg0 + 4 * j) * 8);
            rb[j] = *(const u32x4*)(bg + (size_t)(32 * j) * 512 + kt * 64);
        }
#pragma unroll
        for (int j = 0; j < 4; ++j) {
            *(u32x4*)(lds + GT_BYTES + soff + 32 * j * ROWB) = rb[j];
            char* abase = lds + (aseg0 + 4 * j) * 8 * ROWB + (ach & 7) * 2;
#pragma unroll
            for (int e = 0; e < 4; ++e) {
                const float v0 = gelu_tanh(bflo(rf[j][e]) + bflo(rbk[j][e])), v1 = gelu_tanh(bfhi(rf[j][e]) + bfhi(rbk[j][e]));
                const unsigned pw = pk2(v0, v1);
                const int cs = (((ach >> 3) ^ ((4 * aseg0 + e) & 7)) << 4);
                *(bf16_t*)(abase + (2 * e) * ROWB + cs) = (bf16_t)(pw & 0xffffu);
                *(bf16_t*)(abase + (2 * e + 1) * ROWB + cs) = (bf16_t)(pw >> 16);
            }
        }
        __syncthreads();
        gemm_compute<false, 0>(lds, aoff, boff, sw, acc);
        __syncthreads();
    }
    bf16_t* ob = (bf16_t*)(p.ws + OFF_O) + (size_t)1 * TG * 512;
    const float* bgl = p.in[I_SBGLU] + layer * 512;
#pragma unroll
    for (int n = 0; n < 4; ++n) {
        const int ch = tn * 128 + wc * 64 + n * 16 + r16;
        const float bias = bgl[ch];
#pragma unroll
        for (int m = 0; m < 4; ++m) {
            const int tl = wr * 64 + m * 16 + q4 * 4;
            const u32x2 fw = *(const u32x2*)(yf + ((size_t)seq * 512 + ch) * SL + t0 + tl);
            const u32x2 bw = *(const u32x2*)(yb + ((size_t)seq * 512 + ch) * SL + t0 + tl);
            const float y0 = gelu_tanh(bflo(fw[0]) + bflo(bw[0])), y1 = gelu_tanh(bfhi(fw[0]) + bfhi(bw[0]));
            const float y2 = gelu_tanh(bflo(fw[1]) + bflo(bw[1])), y3 = gelu_tanh(bfhi(fw[1]) + bfhi(bw[1]));
            const unsigned w01 = pk2(y0 * sigmoidf_(acc[m][n][0] + bias), y1 * sigmoidf_(acc[m][n][1] + bias));
            const unsigned w23 = pk2(y2 * sigmoidf_(acc[m][n][2] + bias), y3 * sigmoidf_(acc[m][n][3] + bias));
            bf16_t* orow = ob + (size_t)(tm * 128 + tl) * 512 + ch;
            orow[0] = (bf16_t)(w01 & 0xffffu); orow[512] = (bf16_t)(w01 >> 16); orow[1024] = (bf16_t)(w23 & 0xffffu); orow[1536] = (bf16_t)(w23 >> 16);
        }
    }
}

DI void phase_glu(const Params& p, int layer, char* lds) {
    const int lane = tidx() & 63, w = tidx() >> 6;
    { TileIter it; ti_init(it, TG / 128, 4, 16, 4); int tm, tn; while (ti_next(it, tm, tn)) glu_tile(p, layer, tm, tn, lds); }
    const float lam = ((const float*)(p.ws + OFF_LAM))[layer], li = ((const float*)(p.ws + OFF_LAM))[4 + layer];
    const bf16_t* d0 = (const bf16_t*)(p.ws + OFF_DT); const bf16_t* d1 = d0 + (size_t)TG * 512;
    bf16_t* oc = (bf16_t*)(p.ws + OFF_O) + (size_t)2 * TG * 512;
    const f32x2 sg = *(const f32x2*)(p.in[I_DSUB] + layer * 128 + 2 * lane);
    const int gw = bidx() * 4 + w, nw = gdim() * 4;
    for (int it = gw; it < TG * 4; it += nw) {
        const size_t off = (size_t)it * 128 + 2 * lane;
        const unsigned a = *(const unsigned*)(d0 + off), b = *(const unsigned*)(d1 + off);
        const float v0 = bflo(a) - lam * bflo(b), v1 = bfhi(a) - lam * bfhi(b);
        const float ss = wave_sum(v0 * v0 + v1 * v1);
        const float rs = rsqrtf(ss * (1.0f / 128.0f) + EPS) * (1.0f - li);
        *(unsigned*)(oc + off) = pk2(v0 * rs * sg[0], v1 * rs * sg[1]);
    }
}

DI void phase_merge(const Params& p, int layer, char* lds) {
    const int lane = tidx() & 63, w = tidx() >> 6, wr = w >> 1, wc = w & 1, r16 = lane & 15, q4 = lane >> 4;
    const bf16_t* ob = (const bf16_t*)(p.ws + OFF_O);
    const bf16_t* gb = (const bf16_t*)(p.ws + OFF_GATE);
    const bf16_t* W = wts(p, layer) + WB;
    bf16_t* mb = (bf16_t*)(p.ws + OFF_M);
    TileIter it; ti_init(it, TG / 128, 8, 8, 8);
    int tm, tn;
    while (ti_next(it, tm, tn)) {
        f32x4 macc[4][4]; zero_acc(macc);
#pragma unroll 1
        for (int b = 0; b < 4; ++b) {
            f32x4 acc[4][4]; zero_acc(acc);
            gemm128<true, 0, false>(ob + ((size_t)b * TG + tm * 128) * 512, 512, W + ((size_t)b * 1024 + tn * 128) * 512, 512, 512, acc, lds);
#pragma unroll
            for (int m = 0; m < 4; ++m) {
                const int row = tm * 128 + wr * 64 + m * 16 + r16;
#pragma unroll
                for (int n = 0; n < 4; ++n) {
                    const int col = tn * 128 + wc * 64 + n * 16 + q4 * 4;
                    const u32x2 gw = *(const u32x2*)(gb + (size_t)row * 4096 + b * 1024 + col);
                    macc[m][n][0] += acc[m][n][0] * bflo(gw[0]); macc[m][n][1] += acc[m][n][1] * bfhi(gw[0]);
                    macc[m][n][2] += acc[m][n][2] * bflo(gw[1]); macc[m][n][3] += acc[m][n][3] * bfhi(gw[1]);
                }
            }
        }
#pragma unroll
        for (int m = 0; m < 4; ++m) {
            const int row = tm * 128 + wr * 64 + m * 16 + r16;
#pragma unroll
            for (int n = 0; n < 4; ++n) {
                const int col = tn * 128 + wc * 64 + n * 16 + q4 * 4;
                otile_put(lds, wr * 64 + m * 16 + r16, wc * 64 + n * 16 + q4 * 4, pk2(macc[m][n][0], macc[m][n][1]), pk2(macc[m][n][2], macc[m][n][3]));
            }
        }
        otile_flush(lds, mb + (size_t)(tm * 128) * DM + tn * 128, DM);
    }
}

DI void phase_resid(const Params& p, int grp, const bf16_t* A, int K, const bf16_t* Wt, bool first, char* lds) {
    const int lane = tidx() & 63, w = tidx() >> 6, wr = w >> 1, wc = w & 1, r16 = lane & 15, q4 = lane >> 4;
    TileIter it; ti_init(it, TG / 128, 8, 8, 8);
    int tm, tn, ntm = 0, ntn = 0;
    bool have = ti_next(it, tm, tn);
    GemmRegs g;
    if (have) gemm_prime(A + (size_t)tm * 128 * K, K, Wt + (size_t)tn * 128 * K, K, g);
    for (; have; tm = ntm, tn = ntn) {
        have = ti_next(it, ntm, ntn);
        const bf16_t* At = A + (size_t)tm * 128 * K; const bf16_t* Bt = Wt + (size_t)tn * 128 * K;
        const bf16_t* nAt = have ? A + (size_t)ntm * 128 * K : At; const bf16_t* nBt = have ? Wt + (size_t)ntn * 128 * K : Bt;
        f32x4 acc[4][4]; zero_acc(acc);
        gemm_stream<true>(At, Bt, nAt, nBt, K, K, K, g, acc, lds);
#pragma unroll
        for (int m = 0; m < 4; ++m)
#pragma unroll
            for (int n = 0; n < 4; ++n) *(f32x4*)(lds + (wr * 64 + m * 16 + r16) * OROWF + (wc * 64 + n * 16 + q4 * 4) * 4) = acc[m][n];
        __syncthreads();
        {
            const int tid = tidx();
#pragma unroll 4
            for (int i = 0; i < 16; ++i) {
                const int c = tid + 256 * i, rl = c >> 5, ch = c & 31, row = tm * 128 + rl;
                float* xo = p.out + ((size_t)grp * TG + row) * DM + tn * 128 + ch * 4;
                const float* xi = first ? x_in_row(p, grp, row) + tn * 128 + ch * 4 : xo;
                const f32x4 a = *(const f32x4*)(lds + rl * OROWF + ch * 16);
                const f32x4 xv = *(const f32x4*)xi;
                *(f32x4*)xo = xv + a;
            }
        }
        __syncthreads();
    }
}

DI void phase_ffn1(const Params& p, int layer, char* lds) {
    const int lane = tidx() & 63, w = tidx() >> 6, wr = w >> 1, wc = w & 1, r16 = lane & 15, q4 = lane >> 4;
    const bf16_t* hb = (const bf16_t*)(p.ws + OFF_H);
    const bf16_t* W = wts(p, layer) + WFI;
    bf16_t* fb = (bf16_t*)(p.ws + OFF_F);
    constexpr int NT = DFF / 64;
    TileIter it; ti_init(it, TG / 128, NT, 8, 4);
    int tm, tn, ntm = 0, ntn = 0;
    bool have = ti_next(it, tm, tn);
    GemmRegs g;
    if (have) gemm_prime(hb + (size_t)tm * 128 * DM, DM, W + (size_t)tn * 128 * DM, DM, g);
    for (; have; tm = ntm, tn = ntn) {
        have = ti_next(it, ntm, ntn);
        const bf16_t* At = hb + (size_t)tm * 128 * DM; const bf16_t* Bt = W + (size_t)tn * 128 * DM;
        const bf16_t* nAt = have ? hb + (size_t)ntm * 128 * DM : At; const bf16_t* nBt = have ? W + (size_t)ntn * 128 * DM : Bt;
        f32x4 acc[4][4]; zero_acc(acc);
        gemm_stream<true, 1>(At, Bt, nAt, nBt, DM, DM, DM, g, acc, lds);
#pragma unroll
        for (int m = 0; m < 4; ++m) {
            const int row = tm * 128 + wr * 64 + m * 16 + r16;
#pragma unroll
            for (int n = 0; n < 2; ++n) {
                const int col = tn * 64 + wc * 32 + n * 16 + q4 * 4;
                float f[4];
#pragma unroll
                for (int i = 0; i < 4; ++i) { const float gq = acc[m][n][i]; f[i] = gq * sigmoidf_(gq) * acc[m][n + 2][i]; }
                otile_put(lds, wr * 64 + m * 16 + r16, wc * 32 + n * 16 + q4 * 4, pk2(f[0], f[1]), pk2(f[2], f[3]));
            }
        }
        {
            const int tid = tidx();
            __syncthreads();
#pragma unroll
            for (int i = 0; i < 4; ++i) {
                const int c = tid + 256 * i, row = c >> 3, ch = c & 7;
                const u32x4 v = *(const u32x4*)(lds + row * OROW + ch * 16);
                *(u32x4*)(fb + (size_t)(tm * 128 + row) * DFF + tn * 64 + ch * 8) = v;
            }
            __syncthreads();
        }
    }
}

#define XB_TMO      128
#define XB_XCNT(j)  (256  + 64 * (j))
#define XB_XSUB(j)  (1280 + 64 * (j))
#define XB_XGEN(j)  (2304 + 64 * (j))
#define XB_TOP      3328
#define XB_TOPGEN   3392
#define XCD_BAR_WORDS 3456
#define XB_SPIN_CAP (1u << 18)
#define LAS __attribute__((address_space(3)))

__device__ __forceinline__ unsigned xb_ld(unsigned* p)              { return __hip_atomic_load(p, __ATOMIC_RELAXED, __HIP_MEMORY_SCOPE_AGENT); }
__device__ __forceinline__ unsigned xb_add(unsigned* p, unsigned v) { return __hip_atomic_fetch_add(p, v, __ATOMIC_RELAXED, __HIP_MEMORY_SCOPE_AGENT); }
__device__ __forceinline__ unsigned xb_xcc_id() { return (unsigned)__builtin_amdgcn_s_getreg((3 << 11) | 20) & 0xFu; }
#define XB_SPIN(cond, bar) do { unsigned _sp = 0; while (cond) { __builtin_amdgcn_s_sleep(1); \
    if ((++_sp & 255u) == 0u) { if (xb_ld(&(bar)[XB_TMO])) break; if (_sp > XB_SPIN_CAP) { atomicAdd(&(bar)[XB_TMO], 1u); break; } } } } while (0)

struct XcdBarrier {
    unsigned* bar; unsigned x;
    volatile LAS unsigned* st;
};

__device__ __forceinline__ XcdBarrier xcd_barrier_post(unsigned* bar, volatile LAS unsigned* st) {
    XcdBarrier b; b.bar = bar; b.x = xb_xcc_id(); b.st = st;
    if (threadIdx.x == 0) (void)xb_add(&bar[XB_XCNT(b.x)], 1u);
    return b;
}
__device__ __forceinline__ void xcd_barrier_complete(unsigned* bar, unsigned x, unsigned& nloc, unsigned& nx) {
    const unsigned G = gdim() * gridDim.y * gridDim.z;
    unsigned sum, cnt, mine, sp = 0u;
    for (;;) {
        sum = 0u; cnt = 0u; mine = 0u;
#pragma unroll
        for (unsigned j = 0; j < 16; ++j) { const unsigned c = xb_ld(&bar[XB_XCNT(j)]); sum += c; cnt += (c > 0u) ? 1u : 0u; mine = (j == x) ? c : mine; }
        if (sum == G) break;
        __builtin_amdgcn_s_sleep(1);
        if ((++sp & 255u) == 0u) { if (xb_ld(&bar[XB_TMO])) break; if (sp > XB_SPIN_CAP) { atomicAdd(&bar[XB_TMO], 1u); break; } }
    }
    nloc = mine > 0u ? mine : 1u; nx = cnt > 0u ? cnt : 1u;
}

__device__ __forceinline__ void xcd_barrier(const XcdBarrier& b) {
    asm volatile("s_waitcnt vmcnt(0)" ::: "memory");
    __syncthreads();
    if (threadIdx.x == 0) {
        unsigned* bar = b.bar;
        __builtin_amdgcn_s_waitcnt(0);
        unsigned nloc = b.st[0], nx = b.st[1];
        if (nloc == 0u) { xcd_barrier_complete(bar, b.x, nloc, nx); b.st[0] = nloc; b.st[1] = nx; }
        const unsigned old = xb_add(&bar[XB_XSUB(b.x)], 1u);
        const unsigned gen = old / nloc;
        if (old + 1u == (gen + 1u) * nloc) {
            __builtin_amdgcn_fence(__ATOMIC_RELEASE, "agent");
            asm volatile("s_waitcnt vmcnt(0)" ::: "memory");
            const unsigned og = xb_add(&bar[XB_TOP], 1u);
            const unsigned tg = og / nx;
            if (og + 1u == (tg + 1u) * nx) xb_add(&bar[XB_TOPGEN], 1u);
            else XB_SPIN(xb_ld(&bar[XB_TOPGEN]) == tg, bar);
            __builtin_amdgcn_fence(__ATOMIC_ACQUIRE, "agent");
            xb_add(&bar[XB_XGEN(b.x)], 1u);
            asm volatile("s_waitcnt vmcnt(0)" ::: "memory");
        } else {
            XB_SPIN(xb_ld(&bar[XB_XGEN(b.x)]) == gen, bar);
            __builtin_amdgcn_fence(__ATOMIC_ACQUIRE, "agent");
            asm volatile("s_waitcnt vmcnt(0)" ::: "memory");
        }
    }
    __syncthreads();
}


constexpr int PH_PER_GRP = 4 * 9 + 1;
constexpr int NPHASE = 1 + NGRP * PH_PER_GRP;

#ifndef PROBE_K
#define PROBE_K (-1)
#endif
DI void run_phase(const Params& p, int ph, char* lds, int rep = 0) {
    if (ph == 0) { phase_prologue(p, lds); return; }
    const int q = ph - 1, grp = q / PH_PER_GRP, r = q % PH_PER_GRP;
    if (r == 36) { phase_norm(p, grp, p.in[I_NFIN], 2); return; }
    const int layer = r / 9, k = r % 9;
    switch (k) {
        case 0: phase_norm(p, grp, p.in[I_NMIX] + layer * DM, layer == 0 ? 0 : 1); break;
        case 1: phase_in(p, layer, lds, rep == 1); break;
        case 2: phase_mix(p, layer, grp * 4 + layer + 20 * rep, lds, rep == 1); break;
        case 3: phase_glu(p, layer, lds); break;
        case 4: phase_merge(p, layer, lds); break;
        case 5: phase_resid(p, grp, (const bf16_t*)(p.ws + OFF_M), DM, wts(p, layer) + WO, layer == 0, lds); break;
        case 6: phase_norm(p, grp, p.in[I_NFFN] + layer * DM, 1); break;
        case 7: phase_ffn1(p, layer, lds); break;
        default: phase_resid(p, grp, (const bf16_t*)(p.ws + OFF_F), DFF, wts(p, layer) + WFO, false, lds); break;
    }
}

__global__ void __launch_bounds__(256, 2) mega(Params p, int only) {
    __shared__ __attribute__((aligned(16))) char lds[LDS_BYTES];
#if MULTI_LAUNCH
    if (only >= 0) { run_phase(p, only, lds); return; }
#endif
    cg::grid_group grid = cg::this_grid();
    __shared__ uint4 xb_words;
    if (threadIdx.x == 0) xb_words = make_uint4(0u, 0u, 0u, 0u);
    __syncthreads();
    XcdBarrier xb = xcd_barrier_post((unsigned*)(p.ws + OFF_BAR), (volatile LAS unsigned*)&xb_words);
    for (int ph = 0; ph < NPHASE; ++ph) {
        run_phase(p, ph, lds);
        if (ph + 1 < NPHASE) { if (ph == 0) grid.sync(); else xcd_barrier(xb); }
        if (PROBE_K == 100) xcd_barrier(xb);
        if (PROBE_K >= 0 && PROBE_K < 9 && ph > 0 && ((ph - 1) % PH_PER_GRP) < 36 && (((ph - 1) % PH_PER_GRP) % 9) == PROBE_K) { run_phase(p, ph, lds, 1); xcd_barrier(xb); }
    }
}

extern "C" void kernel_launch(void* const* d_in, const int* in_sizes, int n_in, void* d_out, int out_size, void* d_ws, size_t ws_size, hipStream_t stream) {
    (void)in_sizes; (void)n_in; (void)out_size;
    static int grid_blocks = 0;
    if (!grid_blocks) {
        int dev = 0, cus = 0, per_cu = 0;
        hipGetDevice(&dev);
        hipDeviceGetAttribute(&cus, hipDeviceAttributeMultiprocessorCount, dev);
        hipOccupancyMaxActiveBlocksPerMultiprocessor(&per_cu, mega, 256, 0);
        if (per_cu < 1) per_cu = 1;
        if (per_cu > 2) per_cu = 2;
        grid_blocks = cus * per_cu;
    }
    if (ws_size < WS_END) { fprintf(stderr, "workspace too small: %zu < %zu\n", ws_size, (size_t)WS_END); return; }
    Params p{};
    for (int i = 0; i < 26; ++i) p.in[i] = (const float*)d_in[i];
    p.out = (float*)d_out; p.ws = (char*)d_ws;
    hipMemsetAsync((char*)d_ws + OFF_BAR, 0, XCD_BAR_WORDS * sizeof(unsigned), stream);
#if MULTI_LAUNCH
    for (int ph = 0; ph < NPHASE; ++ph) mega<<<dim3(grid_blocks), dim3(256), 0, stream>>>(p, ph);
#else
    int only = -1;
    void* args[] = {&p, &only};
    hipError_t e = hipLaunchCooperativeKernel((void*)mega, dim3(grid_blocks), dim3(256), args, 0, stream);
    if (e != hipSuccess) fprintf(stderr, "cooperative launch failed: %s (grid %d)\n", hipGetErrorString(e), grid_blocks);
#endif
}
```

```cpp
#include <hip/hip_runtime.h>
#include <hip/hip_cooperative_groups.h>
#include <cstdio>
#include <cstdint>
namespace cg = cooperative_groups;

#ifndef MULTI_LAUNCH
#define MULTI_LAUNCH 0
#endif

#define DI __device__ __forceinline__
typedef unsigned short bf16_t;
typedef __bf16 bf16v2 __attribute__((ext_vector_type(2)));
typedef float f32x2 __attribute__((ext_vector_type(2)));
typedef short bf16x8 __attribute__((ext_vector_type(8)));
typedef short s16x4 __attribute__((ext_vector_type(4)));
typedef float f32x4 __attribute__((ext_vector_type(4)));
typedef float f32x16 __attribute__((ext_vector_type(16)));
typedef unsigned u32x4 __attribute__((ext_vector_type(4)));
typedef unsigned u32x2 __attribute__((ext_vector_type(2)));

constexpr int DM = 1024, SL = 2048, NSEQ = 40, G = 8, NGRP = NSEQ / G, TG = G * SL;
constexpr int INW = 4352, NIN = INW + 4096, DFF = 2816;
constexpr float EPS = 1e-6f;
constexpr float LOG2E = 1.4426950408889634f;

constexpr size_t WING = 0;
constexpr size_t WB = 8650752;
constexpr size_t WO = WB + 2097152;
constexpr size_t WFI = WO + 1048576;
constexpr size_t WFO = WFI + 5767168;
constexpr size_t WGLU = WFO + 2883584;
constexpr size_t LW = WGLU + 262144;

constexpr size_t OFF_W = 0;
constexpr size_t OFF_TAB = OFF_W + 4 * LW * 2;
constexpr size_t OFF_COSA = OFF_TAB, OFF_SINA = OFF_TAB + 262144, OFF_COSD = OFF_TAB + 2 * 262144, OFF_SIND = OFF_TAB + 3 * 262144;
constexpr size_t OFF_BIAS = OFF_TAB + 1048576;
constexpr size_t OFF_LAM = OFF_BIAS + 65536;
constexpr size_t OFF_QCNT = OFF_LAM + 256;
constexpr size_t OFF_BAR = OFF_TAB + 1048576 + 131072;
constexpr size_t OFF_H = OFF_TAB + 2097152;
constexpr size_t OFF_U = OFF_H + (size_t)TG * 1024 * 2;
constexpr size_t OFF_GATE = OFF_U + (size_t)TG * INW * 2;
constexpr size_t OFF_VTA = OFF_GATE + (size_t)TG * 4096 * 2;
constexpr size_t OFF_VTC = OFF_VTA + (size_t)TG * 128 * 2;
constexpr size_t OFF_VTD = OFF_VTC + (size_t)TG * 512 * 2;
constexpr size_t OFF_O = OFF_VTD + (size_t)TG * 512 * 2;
constexpr size_t OFF_YF = OFF_O + (size_t)4 * TG * 512 * 2;
constexpr size_t OFF_YB = OFF_YF + (size_t)TG * 512 * 2;
constexpr size_t OFF_DT = OFF_YB + (size_t)TG * 512 * 2;
constexpr size_t WS_END = OFF_DT + (size_t)2 * TG * 512 * 2;
constexpr size_t OFF_M = OFF_U;
constexpr size_t OFF_F = OFF_U;

struct Params { const float* in[26]; float* out; char* ws; };

enum { I_XP = 0, I_XS, I_NMIX, I_WIN, I_QG, I_KG, I_SARE, I_SAIM, I_SLDT, I_SBRE, I_SBIM, I_SCRE, I_SCIM, I_SD, I_SWGLU, I_SBGLU,
       I_DLAM, I_DSUB, I_REL, I_WGATE, I_WBR, I_WOUT, I_NFFN, I_WFI, I_WFO, I_NFIN };

constexpr int LDS_BYTES = 71680;
constexpr int AROWB = 144;
constexpr int ROWB = 128;
constexpr int GT_BYTES = 128 * ROWB;

DI int bidx() { int b = blockIdx.x; asm volatile("" : "+s"(b)); return b; }
DI int gdim() { int g = gridDim.x; asm volatile("" : "+s"(g)); return g; }
DI int tidx() { int t = threadIdx.x; asm volatile("" : "+v"(t)); return t; }
DI unsigned pk2(float a, float b) { f32x2 v = {a, b}; bf16v2 r = __builtin_convertvector(v, bf16v2); return __builtin_bit_cast(unsigned, r); }
DI float bf2f(bf16_t v) { return __uint_as_float(((unsigned)v) << 16); }
DI float bflo(unsigned w) { return __uint_as_float(w << 16); }
DI float bfhi(unsigned w) { return __uint_as_float(w & 0xffff0000u); }
DI float sigmoidf_(float x) { return __builtin_amdgcn_rcpf(1.0f + __builtin_amdgcn_exp2f(-LOG2E * x)); }
DI float wave_sum(float v) { v += __shfl_xor(v, 32); v += __shfl_xor(v, 16); v += __shfl_xor(v, 8); v += __shfl_xor(v, 4); v += __shfl_xor(v, 2); v += __shfl_xor(v, 1); return v; }
DI bf16_t* wts(const Params& p, int layer) { return (bf16_t*)(p.ws + OFF_W) + (size_t)layer * LW; }
#define MFMA16(a, b, c) __builtin_amdgcn_mfma_f32_16x16x32_bf16((a), (b), (c), 0, 0, 0)
#define MFMA32(a, b, c) __builtin_amdgcn_mfma_f32_32x32x16_bf16((a), (b), (c), 0, 0, 0)

template <bool SWAP, int BMAP>
DI void gemm_compute(const char* cur, int aoff, int boff, int sw, f32x4 (&acc)[4][4]) {
#pragma unroll
    for (int ks = 0; ks < 2; ++ks) {
        bf16x8 af[4], bfr[4];
        if (ks) asm volatile("" ::: "memory");
        const int so = sw ^ (ks * 64);
#pragma unroll
        for (int m = 0; m < 4; ++m) af[m] = *(const bf16x8*)(cur + aoff + m * 16 * ROWB + so);
#pragma unroll
        for (int n = 0; n < 4; ++n) bfr[n] = *(const bf16x8*)(cur + boff + (BMAP ? ((n >> 1) * 64 + (n & 1) * 16) : n * 16) * ROWB + so);
#pragma unroll
        for (int m = 0; m < 4; ++m)
#pragma unroll
            for (int n = 0; n < 4; ++n) acc[m][n] = SWAP ? MFMA16(bfr[n], af[m], acc[m][n]) : MFMA16(af[m], bfr[n], acc[m][n]);
    }
}
#define GLOAD(RA, RB, KT) { _Pragma("unroll") for (int i_ = 0; i_ < 4; ++i_) { \
    const char* ua_ = Ab + (size_t)(((32 * i_) * lda + (KT) * 64) * 2); const char* ub_ = Bb + (size_t)(((32 * i_) * ldb + (KT) * 64) * 2); \
    RA[i_] = *(const u32x4*)(ua_ + avoff); RB[i_] = *(const u32x4*)(ub_ + bvoff); } }
#define LSTORE(RA, RB, ST) { _Pragma("unroll") for (int i_ = 0; i_ < 4; ++i_) { *(u32x4*)(lds + (ST) * (2 * GT_BYTES) + soff + 32 * i_ * ROWB) = RA[i_]; *(u32x4*)(lds + (ST) * (2 * GT_BYTES) + GT_BYTES + soff + 32 * i_ * ROWB) = RB[i_]; } }
template <bool SWAP, int BMAP = 0, bool DEEP = true>
DI void gemm128(const bf16_t* __restrict__ A, int lda, const bf16_t* __restrict__ B, int ldb, int K, f32x4 (&acc)[4][4], char* lds) {
    const int tid = tidx(), lane = tid & 63, w = tid >> 6, wr = w >> 1, wc = w & 1;
    const int srow = tid >> 3, scol = tid & 7;
    const char* Ab = (const char*)A; const char* Bb = (const char*)B;
    const unsigned avoff = (unsigned)(srow * lda + scol * 8) * 2u, bvoff = (unsigned)(srow * ldb + scol * 8) * 2u;
    const int soff = srow * ROWB + ((scol ^ ((srow >> 1) & 7)) << 4);
    const int nk = K >> 6;
    const int aoff = (wr * 64 + (lane & 15)) * ROWB;
    const int boff = GT_BYTES + ((BMAP ? wc * 32 : wc * 64) + (lane & 15)) * ROWB;
    const int sw = ((lane >> 4) ^ ((lane & 15) >> 1)) << 4;
    u32x4 ra0[4], rb0[4];
    GLOAD(ra0, rb0, 0);
    LSTORE(ra0, rb0, 0);
    if (DEEP) {
        u32x4 ra1[4], rb1[4];
        GLOAD(ra1, rb1, 1);
        __syncthreads();
        for (int kt = 0; kt < nk; kt += 2) {
            { const int k2 = kt + 2 < nk ? kt + 2 : nk - 1; GLOAD(ra0, rb0, k2); }
            gemm_compute<SWAP, BMAP>(lds, aoff, boff, sw, acc);
            LSTORE(ra1, rb1, 1);
            __syncthreads();
            { const int k3 = kt + 3 < nk ? kt + 3 : nk - 1; GLOAD(ra1, rb1, k3); }
            gemm_compute<SWAP, BMAP>(lds + 2 * GT_BYTES, aoff, boff, sw, acc);
            LSTORE(ra0, rb0, 0);
            __syncthreads();
        }
    } else {
        __syncthreads();
        for (int kt = 0; kt < nk; ++kt) {
            const bool more = (kt + 1 < nk);
            if (more) GLOAD(ra0, rb0, kt + 1);
            gemm_compute<SWAP, BMAP>(lds + (kt & 1) * (2 * GT_BYTES), aoff, boff, sw, acc);
            if (more) { if (kt & 1) { LSTORE(ra0, rb0, 0); } else { LSTORE(ra0, rb0, 1); } }
            __syncthreads();
        }
    }
}

struct TileIter { int per, SM, SN, nSn, sbase, len, q, nslot; };
DI void ti_init(TileIter& it, int NTm, int NTn, int SM, int SN) {
    const int x = bidx() & 7;
    it.nslot = (gdim() - x + 7) >> 3; it.per = SM * SN; it.SM = SM; it.SN = SN; it.nSn = NTn / SN;
    const int nS = (NTm / SM) * it.nSn;
    it.sbase = x * (nS >> 3); it.len = (nS >> 3) * it.per; it.q = bidx() >> 3;
}
DI bool ti_next(TileIter& it, int& tm, int& tn) {
    if (it.q >= it.len) return false;
    const int j = it.q / it.per, w = it.q % it.per, S = it.sbase + j, sm = S / it.nSn, sn = S % it.nSn;
    tm = sm * it.SM + (w % it.SM); tn = sn * it.SN + (w / it.SM);
    it.q += it.nslot;
    return true;
}

struct GemmRegs { u32x4 a0[4], b0[4], a1[4], b1[4]; };
typedef const __attribute__((address_space(1))) char* gptr_t;
typedef const __attribute__((address_space(1))) u32x4* gvec_t;
DI gptr_t uptr(const void* q) {
    const size_t v = (size_t)q;
    const unsigned lo = __builtin_amdgcn_readfirstlane((unsigned)v), hi = __builtin_amdgcn_readfirstlane((unsigned)(v >> 32));
    return (gptr_t)(((size_t)hi << 32) | lo);
}
#define GLOADP(RA, RB, PA, PB, KT) { _Pragma("unroll") for (int i_ = 0; i_ < 4; ++i_) { \
    gptr_t ua_ = (PA) + (size_t)(((32 * i_) * lda + (KT) * 64) * 2); gptr_t ub_ = (PB) + (size_t)(((32 * i_) * ldb + (KT) * 64) * 2); \
    RA[i_] = *(gvec_t)(ua_ + avoff); RB[i_] = *(gvec_t)(ub_ + bvoff); } }
DI void gemm_prime(const bf16_t* A, int lda, const bf16_t* B, int ldb, GemmRegs& g) {
    const int tid = tidx(), srow = tid >> 3, scol = tid & 7;
    const unsigned avoff = (unsigned)(srow * lda + scol * 8) * 2u, bvoff = (unsigned)(srow * ldb + scol * 8) * 2u;
    gptr_t Ab = uptr(A); gptr_t Bb = uptr(B);
    GLOADP(g.a0, g.b0, Ab, Bb, 0);
    GLOADP(g.a1, g.b1, Ab, Bb, 1);
}
template <bool SWAP, int BMAP = 0>
DI void gemm_stream(const bf16_t* A, const bf16_t* B, const bf16_t* nA, const bf16_t* nB, int lda, int ldb, int K, GemmRegs& g, f32x4 (&acc)[4][4], char* lds) {
    const int tid = tidx(), lane = tid & 63, w = tid >> 6, wr = w >> 1, wc = w & 1;
    const int srow = tid >> 3, scol = tid & 7;
    const unsigned avoff = (unsigned)(srow * lda + scol * 8) * 2u, bvoff = (unsigned)(srow * ldb + scol * 8) * 2u;
    gptr_t Ab = uptr(A); gptr_t Bb = uptr(B); gptr_t nAb = uptr(nA); gptr_t nBb = uptr(nB);
    const int soff = srow * ROWB + ((scol ^ ((srow >> 1) & 7)) << 4);
    const int nk = K >> 6;
    const int aoff = (wr * 64 + (lane & 15)) * ROWB;
    const int boff = GT_BYTES + ((BMAP ? wc * 32 : wc * 64) + (lane & 15)) * ROWB;
    const int sw = ((lane >> 4) ^ ((lane & 15) >> 1)) << 4;
    LSTORE(g.a0, g.b0, 0);
    __syncthreads();
    for (int kt = 0; kt < nk; kt += 2) {
        const bool last = kt + 2 >= nk;
        gptr_t pa = last ? nAb : Ab; gptr_t pb = last ? nBb : Bb;
        const int k2 = last ? 0 : kt + 2, k3 = last ? 1 : kt + 3;
        GLOADP(g.a0, g.b0, pa, pb, k2);
        gemm_compute<SWAP, BMAP>(lds, aoff, boff, sw, acc);
        LSTORE(g.a1, g.b1, 1);
        __syncthreads();
        GLOADP(g.a1, g.b1, pa, pb, k3);
        gemm_compute<SWAP, BMAP>(lds + 2 * GT_BYTES, aoff, boff, sw, acc);
        if (!last) LSTORE(g.a0, g.b0, 0);
        __syncthreads();
    }
}

DI void zero_acc(f32x4 (&acc)[4][4]) {
#pragma unroll
    for (int m = 0; m < 4; ++m)
#pragma unroll
        for (int n = 0; n < 4; ++n) acc[m][n] = (f32x4){0.f, 0.f, 0.f, 0.f};
}


constexpr int OROW = 272;
constexpr int OROWF = 528;
DI void otile_put(char* lds, int row, int col, unsigned w0, unsigned w1) { u32x2 w; w[0] = w0; w[1] = w1; *(u32x2*)(lds + row * OROW + col * 2) = w; }
DI void otile_flush(char* lds, bf16_t* dst, int ld) {
    const int tid = tidx();
    __syncthreads();
#pragma unroll
    for (int i = 0; i < 8; ++i) {
        const int c = tid + 256 * i, row = c >> 4, ch = c & 15;
        const u32x4 v = *(const u32x4*)(lds + row * OROW + ch * 16);
        *(u32x4*)(dst + (size_t)row * ld + ch * 8) = v;
    }
    __syncthreads();
}

DI void conv_tile(const float* __restrict__ src, bf16_t* __restrict__ dst, int K, int N, int tk, int tn, int drow0, float* tile) {
    const int tid = tidx(), ty = tid >> 4, tx = tid & 15;
#pragma unroll
    for (int i = 0; i < 4; ++i) {
        const int k = ty + 16 * i;
        const f32x4 v = *(const f32x4*)(src + (size_t)(tk * 64 + k) * N + tn * 64 + tx * 4);
        tile[k * 65 + tx * 4 + 0] = v[0]; tile[k * 65 + tx * 4 + 1] = v[1]; tile[k * 65 + tx * 4 + 2] = v[2]; tile[k * 65 + tx * 4 + 3] = v[3];
    }
    __syncthreads();
    const int n = tid >> 2, ks = (tid & 3) * 16;
    u32x4 w0, w1;
#pragma unroll
    for (int j = 0; j < 4; ++j) {
        w0[j] = pk2(tile[(ks + 2 * j) * 65 + n], tile[(ks + 2 * j + 1) * 65 + n]);
        w1[j] = pk2(tile[(ks + 8 + 2 * j) * 65 + n], tile[(ks + 8 + 2 * j + 1) * 65 + n]);
    }
    bf16_t* d = dst + (size_t)(drow0 + n) * K + tk * 64 + ks;
    *(u32x4*)d = w0; *(u32x4*)(d + 8) = w1;
    __syncthreads();
}

DI int t5_bucket(int rel) {
    const int base = rel > 0 ? 16 : 0;
    const int dist = rel < 0 ? -rel : rel;
    int b;
    if (dist < 8) b = dist;
    else {
        const float lr = logf((float)dist / 8.0f) / 2.772588722239781f;
        int lg = 8 + (int)(lr * 8.0f);
        b = lg < 15 ? lg : 15;
    }
    return base + b;
}

DI void phase_prologue(const Params& p, char* lds) {
    float* tile = (float*)lds;
    const int tid = tidx();
    for (int t = bidx(); t < 4 * 5056; t += gdim()) {
        const int layer = t / 5056; int q = t % 5056;
        bf16_t* wl = wts(p, layer);
        const float* src; bf16_t* dst; int K, N, nn;
        if (q < 1088) { src = p.in[I_WIN] + (size_t)layer * 1024 * INW; dst = wl + WING; K = 1024; N = INW; }
        else if ((q -= 1088) < 1024) { const int b = q >> 8; q &= 255; src = p.in[I_WGATE] + (size_t)(layer * 4 + b) * 1024 * 1024; dst = wl + WING + (size_t)(INW + b * 1024) * 1024; K = 1024; N = 1024; }
        else if ((q -= 1024) < 512) { const int b = q >> 7; q &= 127; src = p.in[I_WBR] + (size_t)(layer * 4 + b) * 512 * 1024; dst = wl + WB + (size_t)b * 1024 * 512; K = 512; N = 1024; }
        else if ((q -= 512) < 256) { src = p.in[I_WOUT] + (size_t)layer * 1024 * 1024; dst = wl + WO; K = 1024; N = 1024; }
        else if ((q -= 256) < 1408) { src = p.in[I_WFI] + (size_t)layer * 1024 * 5632; dst = wl + WFI; K = 1024; N = 5632; }
        else if ((q -= 1408) < 704) { src = p.in[I_WFO] + (size_t)layer * DFF * 1024; dst = wl + WFO; K = DFF; N = 1024; }
        else { q -= 704; src = p.in[I_SWGLU] + (size_t)layer * 512 * 512; dst = wl + WGLU; K = 512; N = 512; }
        nn = N >> 6;
        const int tk = q / nn, tn = q % nn;
        int drow0 = tn * 64;
        if (N == 5632) drow0 = tn < 44 ? tn * 128 : (tn - 44) * 128 + 64;
        conv_tile(src, dst, K, N, tk, tn, drow0, tile);
    }
    const int gt = bidx() * 256 + tid, gn = gdim() * 256;
    float* cosA = (float*)(p.ws + OFF_COSA); float* sinA = (float*)(p.ws + OFF_SINA);
    float* cosD = (float*)(p.ws + OFF_COSD); float* sinD = (float*)(p.ws + OFF_SIND);
    for (int i = gt; i < SL * 32; i += gn) {
        const int t = i >> 5, j = i & 31;
        const float invA = exp2f(-(float)(j & 15) * (13.287712379549449f / 16.0f));
        const float angA = (j < 16 ? (float)(t >> 6) : (float)(t & 63)) * invA;
        cosA[i] = cosf(angA); sinA[i] = sinf(angA);
        const float invD = exp2f(-(float)j * (13.287712379549449f / 32.0f));
        const float angD = (float)t * invD;
        cosD[i] = cosf(angD); sinD[i] = sinf(angD);
    }
    float* bias = (float*)(p.ws + OFF_BIAS);
    for (int i = gt; i < 4 * 4096; i += gn) {
        const int h = i >> 12, r = i & 4095;
        float v = 0.f;
        if (r < 4095) v = p.in[I_REL][t5_bucket(r - 2047) * 4 + h] * LOG2E;
        bias[i] = v;
    }
    if (bidx() == 0) {
        if (tid < 4) {
            const float* lv = p.in[I_DLAM] + tid * 256;
            float s1 = 0.f, s2 = 0.f;
            for (int j = 0; j < 64; ++j) { s1 += lv[j] * lv[64 + j]; s2 += lv[128 + j] * lv[192 + j]; }
            const float li = 0.8f - 0.6f * expf(-0.3f * (float)tid);
            float* lam = (float*)(p.ws + OFF_LAM);
            lam[tid] = expf(s1) - expf(s2) + li; lam[4 + tid] = li;
        }
        if (tid < 64) ((int*)(p.ws + OFF_QCNT))[tid] = 0;
    }
}

DI const float* x_in_row(const Params& p, int grp, int row) {
    const int seq = grp * G + (row >> 11), t = row & 2047;
    return seq < 8 ? p.in[I_XP] + ((size_t)seq * SL + t) * DM : p.in[I_XS] + ((size_t)(seq - 8) * SL + t) * DM;
}
DI void phase_norm(const Params& p, int grp, const float* gain, int mode) {
    const int lane = tidx() & 63;
    const int gw = bidx() * 4 + (tidx() >> 6), nw = gdim() * 4;
    bf16_t* hb = (bf16_t*)(p.ws + OFF_H);
    f32x4 gv[4];
#pragma unroll
    for (int i = 0; i < 4; ++i) gv[i] = *(const f32x4*)(gain + lane * 4 + 256 * i);
    for (int row = gw; row < TG; row += nw) {
        float* xo = p.out + ((size_t)grp * TG + row) * DM;
        const float* x = mode == 0 ? x_in_row(p, grp, row) : xo;
        f32x4 v[4]; float ss = 0.f;
#pragma unroll
        for (int i = 0; i < 4; ++i) { v[i] = *(const f32x4*)(x + lane * 4 + 256 * i); ss += v[i][0] * v[i][0] + v[i][1] * v[i][1] + v[i][2] * v[i][2] + v[i][3] * v[i][3]; }
        ss = wave_sum(ss);
        const float rstd = rsqrtf(ss * (1.0f / 1024.0f) + EPS);
#pragma unroll
        for (int i = 0; i < 4; ++i) {
            const f32x4 y = v[i] * rstd * gv[i];
            if (mode == 2) *(f32x4*)(xo + lane * 4 + 256 * i) = y;
            else { u32x2 w; w[0] = pk2(y[0], y[1]); w[1] = pk2(y[2], y[3]); *(u32x2*)(hb + (size_t)row * DM + lane * 4 + 256 * i) = w; }
        }
    }
}

DI void phase_in(const Params& p, int layer, char* lds, bool probe = false) {
    const bf16_t* hb = (const bf16_t*)(p.ws + OFF_H);
    const bf16_t* W = wts(p, layer) + WING;
    bf16_t* ub = (bf16_t*)(p.ws + OFF_U);
    bf16_t* gb = (bf16_t*)(p.ws + OFF_GATE);
    constexpr int NT = NIN / 128;
    const int lane = tidx() & 63, w = tidx() >> 6, wr = w >> 1, wc = w & 1, r16 = lane & 15, q4 = lane >> 4;
    TileIter it; ti_init(it, TG / 128, NT, 8, 6);
    int tm, tn;
    while (ti_next(it, tm, tn)) {
        const int c0 = tn * 128;
        const bool isV = (c0 == 640) || (c0 >= 2304 && c0 < 2816) || (c0 >= 3328 && c0 < 3840);
        f32x4 acc[4][4]; zero_acc(acc);
        const int cb = c0 + wc * 64;
        if (isV) {
            gemm128<false>(hb + (size_t)tm * 128 * DM, DM, W + (size_t)c0 * DM, DM, DM, acc, lds);
            bf16_t* vt; int cl, DV, NH;
            if (cb < 768) { vt = (bf16_t*)(p.ws + OFF_VTA); cl = cb - 640; DV = 64; NH = 2; }
            else if (cb < 2816) { vt = (bf16_t*)(p.ws + OFF_VTC); cl = cb - 2304; DV = 128; NH = 4; }
            else { vt = (bf16_t*)(p.ws + OFF_VTD); cl = cb - 3328; DV = 128; NH = 4; }
#pragma unroll
            for (int m = 0; m < 4; ++m) {
                const int row0 = tm * 128 + wr * 64 + m * 16 + q4 * 4, seq = row0 >> 11, t0 = row0 & 2047;
#pragma unroll
                for (int n = 0; n < 4; ++n) {
                    const int col = cl + n * 16 + r16, head = col / DV, d = col % DV;
                    u32x2 wv; wv[0] = pk2(acc[m][n][0], acc[m][n][1]); wv[1] = pk2(acc[m][n][2], acc[m][n][3]);
                    *(u32x2*)(vt + ((size_t)(seq * NH + head) * DV + d) * SL + t0) = wv;
                }
            }
        } else {
            gemm128<true>(hb + (size_t)tm * 128 * DM, DM, W + (size_t)c0 * DM, DM, DM, acc, lds);
            bool donorm = false, dosig = false; int rot = 0; float scale = 1.f; const float* gain = nullptr;
            bf16_t* dst = ub; int ld = INW, dcol = cb;
            if (cb < 512) { donorm = true; rot = 1; scale = 0.125f * LOG2E; gain = p.in[I_QG] + layer * 64; }
            else if (cb < 640) { donorm = true; rot = 1; gain = p.in[I_KG] + layer * 64; }
            else if (cb < 1280) { }
            else if (cb < 1792) { scale = 0.125f * LOG2E; }
            else if (cb < 2816) { }
            else if (cb < 3072) { rot = 2; scale = 0.125f; }
            else if (cb < 3328) { rot = 2; }
            else if (cb < INW) { }
            else { dosig = true; dst = gb; ld = 4096; dcol = cb - INW; }
            float gl[4][4];
            if (donorm) {
#pragma unroll
                for (int n = 0; n < 4; ++n) { const f32x4 g4 = *(const f32x4*)(gain + n * 16 + q4 * 4); gl[n][0] = g4[0]; gl[n][1] = g4[1]; gl[n][2] = g4[2]; gl[n][3] = g4[3]; }
            }
            const float* ct = (const float*)(p.ws + (rot == 2 ? OFF_COSD : OFF_COSA));
            const float* sn = (const float*)(p.ws + (rot == 2 ? OFF_SIND : OFF_SINA));
#pragma unroll
            for (int m = 0; m < 4; ++m) {
                asm volatile("" ::: "memory");
                const int row = tm * 128 + wr * 64 + m * 16 + r16, tpos = row & 2047;
                float v[4][4];
#pragma unroll
                for (int n = 0; n < 4; ++n)
#pragma unroll
                    for (int i = 0; i < 4; ++i) v[n][i] = acc[m][n][i];
                if (donorm) {
                    float ss = 0.f;
#pragma unroll
                    for (int n = 0; n < 4; ++n)
#pragma unroll
                        for (int i = 0; i < 4; ++i) ss += v[n][i] * v[n][i];
                    ss += __shfl_xor(ss, 16); ss += __shfl_xor(ss, 32);
                    const float rstd = rsqrtf(ss * (1.0f / 64.0f) + EPS);
#pragma unroll
                    for (int n = 0; n < 4; ++n)
#pragma unroll
                        for (int i = 0; i < 4; ++i) v[n][i] = v[n][i] * rstd * gl[n][i];
                }
                if (rot) {
#pragma unroll
                    for (int n = 0; n < 2; ++n) {
                        const f32x4 c4 = *(const f32x4*)(ct + tpos * 32 + n * 16 + q4 * 4), s4 = *(const f32x4*)(sn + tpos * 32 + n * 16 + q4 * 4);
#pragma unroll
                        for (int i = 0; i < 4; ++i) { const float x1 = v[n][i], x2 = v[n + 2][i]; v[n][i] = x1 * c4[i] - x2 * s4[i]; v[n + 2][i] = x2 * c4[i] + x1 * s4[i]; }
                    }
                }
#pragma unroll
                for (int n = 0; n < 4; ++n) {
                    float o0, o1, o2, o3;
                    if (dosig) { o0 = sigmoidf_(v[n][0]); o1 = sigmoidf_(v[n][1]); o2 = sigmoidf_(v[n][2]); o3 = sigmoidf_(v[n][3]); }
                    else { o0 = v[n][0] * scale; o1 = v[n][1] * scale; o2 = v[n][2] * scale; o3 = v[n][3] * scale; }
                    otile_put(lds, wr * 64 + m * 16 + r16, wc * 64 + n * 16 + q4 * 4, pk2(o0, o1), pk2(o2, o3));
                }
            }
            otile_flush(lds, dst + (size_t)(tm * 128) * ld + (dcol - wc * 64), ld);
        }
    }
}

template <int DV, int MODE>
DI void attn_task(const Params& p, int task, char* lds) {
    constexpr int NDT = DV / 32;
    constexpr int STG = 64 * AROWB + DV * AROWB;
    const int tid = tidx(), lane = tid & 63, wave = tid >> 6, r = lane & 31, h = lane >> 5;
    const bf16_t* ub = (const bf16_t*)(p.ws + OFF_U);
    const int qt = task & 15; const int rest = task >> 4;
    int seq, head, map = 0, qcol, kcol; const bf16_t* vt;
    if (MODE == 0) { head = rest & 7; seq = rest >> 3; qcol = head * 64; kcol = 512 + (head >> 2) * 64; vt = (const bf16_t*)(p.ws + OFF_VTA) + (size_t)(seq * 2 + (head >> 2)) * 64 * SL; }
    else if (MODE == 1) { map = rest & 1; head = (rest >> 1) & 3; seq = rest >> 3; qcol = 1280 + head * 128 + map * 64; kcol = 1792 + head * 128 + map * 64; vt = (const bf16_t*)(p.ws + OFF_VTC) + (size_t)(seq * 4 + head) * 128 * SL; }
    else { head = rest & 3; seq = rest >> 2; qcol = 2816 + head * 64; kcol = 3072 + head * 64; vt = (const bf16_t*)(p.ws + OFF_VTD) + (size_t)(seq * 4 + head) * 128 * SL; }
    const int qpos = qt * 128 + wave * 32 + r;
    const bf16_t* qptr = ub + ((size_t)seq * SL + qpos) * INW + qcol;
    bf16x8 qf[4];
#pragma unroll
    for (int s = 0; s < 4; ++s) qf[s] = *(const bf16x8*)(qptr + 16 * s + 8 * h);
    const bf16_t* kbase = ub + (size_t)seq * SL * INW + kcol;
    float* sBias = (float*)(lds + 2 * STG);
    if (MODE == 1) { const float* bl = (const float*)(p.ws + OFF_BIAS) + head * 4096; for (int i = tid; i < 4096; i += 256) sBias[i] = bl[i]; }
    float lgam = 0.f;
    if (MODE == 2) lgam = log2f(1.0f - exp2f(-5.0f - (float)head));
    f32x16 o[NDT];
#pragma unroll
    for (int d = 0; d < NDT; ++d)
#pragma unroll
        for (int i = 0; i < 16; ++i) o[d][i] = 0.f;
    float lsum = 0.f;
    const int srow = tid >> 3, sc = tid & 7;
    const bf16_t* kg = kbase + (size_t)srow * INW + sc * 8;
    const bf16_t* vg = vt + (size_t)srow * SL + sc * 8;
    u32x4 rk[2], rv[NDT];
#pragma unroll
    for (int i = 0; i < 2; ++i) rk[i] = *(const u32x4*)(kg + (size_t)(32 * i) * INW);
#pragma unroll
    for (int i = 0; i < NDT; ++i) rv[i] = *(const u32x4*)(vg + (size_t)(32 * i) * SL);
    const int soff = srow * AROWB + sc * 16;
#pragma unroll
    for (int i = 0; i < 2; ++i) *(u32x4*)(lds + soff + 32 * i * AROWB) = rk[i];
#pragma unroll
    for (int i = 0; i < NDT; ++i) *(u32x4*)(lds + 64 * AROWB + soff + 32 * i * AROWB) = rv[i];
    __syncthreads();
    for (int kt = 0; kt < SL / 64; ++kt) {
        const char* cur = lds + (kt & 1) * STG;
        char* nxt = lds + ((kt + 1) & 1) * STG;
        const bool more = kt + 1 < SL / 64;
        const int kv0 = kt * 64;
        if (more) {
            kg += (size_t)64 * INW; vg += 64;
#pragma unroll
            for (int i = 0; i < 2; ++i) rk[i] = *(const u32x4*)(kg + (size_t)(32 * i) * INW);
#pragma unroll
            for (int i = 0; i < NDT; ++i) rv[i] = *(const u32x4*)(vg + (size_t)(32 * i) * SL);
        }
        f32x16 st[2];
#pragma unroll
        for (int kk = 0; kk < 2; ++kk) {
#pragma unroll
            for (int i = 0; i < 16; ++i) st[kk][i] = 0.f;
#pragma unroll
            for (int s = 0; s < 4; ++s) {
                const bf16x8 kf = *(const bf16x8*)(cur + (32 * kk + r) * AROWB + (16 * s + 8 * h) * 2);
                st[kk] = MFMA32(kf, qf[s], st[kk]);
            }
        }
        const int qw0 = qt * 128 + wave * 32;
        const bool farL = MODE == 1 && (kv0 + 63 - qw0) <= -128, farR = MODE == 1 && (kv0 - (qw0 + 31)) >= 128;
        if (MODE == 1 && (farL || farR)) {
            const float bc = farL ? sBias[0] : sBias[4094];
#pragma unroll
            for (int kk = 0; kk < 2; ++kk)
#pragma unroll
                for (int i = 0; i < 16; ++i) { const float pv = __builtin_amdgcn_exp2f(st[kk][i] + bc); lsum += pv; st[kk][i] = pv; }
        } else
#pragma unroll
        for (int kk = 0; kk < 2; ++kk)
#pragma unroll
            for (int i = 0; i < 16; ++i) {
                const int m = kv0 + 32 * kk + (i & 3) + 8 * (i >> 2) + 4 * h;
                float pv;
                if (MODE == 0) pv = __builtin_amdgcn_exp2f(st[kk][i]);
                else if (MODE == 1) pv = __builtin_amdgcn_exp2f(st[kk][i] + sBias[m - qpos + 2047]);
                else pv = st[kk][i] * __builtin_amdgcn_exp2f(lgam * fabsf((float)(qpos - m)));
                if (MODE != 2) lsum += pv;
                st[kk][i] = pv;
            }
        const char* sV = cur + 64 * AROWB;
#pragma unroll
        for (int kk = 0; kk < 2; ++kk)
#pragma unroll
            for (int s2 = 0; s2 < 2; ++s2) {
                u32x4 pw;
#pragma unroll
                for (int j = 0; j < 4; ++j) pw[j] = pk2(st[kk][8 * s2 + 2 * j], st[kk][8 * s2 + 2 * j + 1]);
                const bf16x8 pf = __builtin_bit_cast(bf16x8, pw);
#pragma unroll
                for (int d = 0; d < NDT; ++d) {
                    const char* va = sV + (32 * d + r) * AROWB + (32 * kk + 16 * s2 + 4 * h) * 2;
                    const s16x4 lo = *(const s16x4*)va, hi = *(const s16x4*)(va + 16);
                    const bf16x8 vf = __builtin_shufflevector(lo, hi, 0, 1, 2, 3, 4, 5, 6, 7);
                    o[d] = MFMA32(vf, pf, o[d]);
                }
            }
        if (more) {
#pragma unroll
            for (int i = 0; i < 2; ++i) *(u32x4*)(nxt + soff + 32 * i * AROWB) = rk[i];
#pragma unroll
            for (int i = 0; i < NDT; ++i) *(u32x4*)(nxt + 64 * AROWB + soff + 32 * i * AROWB) = rv[i];
        }
        __syncthreads();
    }
    const size_t tok = (size_t)seq * SL + qpos;
    if (MODE != 2) {
        const float ltot = lsum + __shfl_xor(lsum, 32);
        const float inv = __builtin_amdgcn_rcpf(ltot);
        bf16_t* dst = MODE == 0 ? (bf16_t*)(p.ws + OFF_O) + tok * 512 + head * 64
                                : (bf16_t*)(p.ws + OFF_DT) + ((size_t)map * TG + tok) * 512 + head * 128;
#pragma unroll
        for (int d = 0; d < NDT; ++d)
#pragma unroll
            for (int a = 0; a < 4; ++a) {
                u32x2 wv; wv[0] = pk2(o[d][4 * a] * inv, o[d][4 * a + 1] * inv); wv[1] = pk2(o[d][4 * a + 2] * inv, o[d][4 * a + 3] * inv);
                *(u32x2*)(dst + 32 * d + 8 * a + 4 * h) = wv;
            }
    } else {
        float s = 0.f;
#pragma unroll
        for (int d = 0; d < NDT; ++d)
#pragma unroll
            for (int i = 0; i < 16; ++i) s += o[d][i];
        s += __shfl_xor(s, 32);
        const float mu = s * (1.0f / 128.0f);
        float vs = 0.f;
#pragma unroll
        for (int d = 0; d < NDT; ++d)
#pragma unroll
            for (int i = 0; i < 16; ++i) { const float dd = o[d][i] - mu; vs += dd * dd; }
        vs += __shfl_xor(vs, 32);
        const float rstd = rsqrtf(vs * (1.0f / 128.0f) + EPS);
        const bf16_t* gp = ub + tok * INW + 3840 + head * 128;
        bf16_t* dst = (bf16_t*)(p.ws + OFF_O) + ((size_t)3 * TG + tok) * 512 + head * 128;
#pragma unroll
        for (int d = 0; d < NDT; ++d)
#pragma unroll
            for (int a = 0; a < 4; ++a) {
                asm volatile("" ::: "memory");
                const u32x2 gw = *(const u32x2*)(gp + 32 * d + 8 * a + 4 * h);
                const float g0 = bflo(gw[0]), g1 = bfhi(gw[0]), g2 = bflo(gw[1]), g3 = bfhi(gw[1]);
                const float y0 = (o[d][4 * a] - mu) * rstd * g0 * sigmoidf_(g0), y1 = (o[d][4 * a + 1] - mu) * rstd * g1 * sigmoidf_(g1);
                const float y2 = (o[d][4 * a + 2] - mu) * rstd * g2 * sigmoidf_(g2), y3 = (o[d][4 * a + 3] - mu) * rstd * g3 * sigmoidf_(g3);
                u32x2 wv; wv[0] = pk2(y0, y1); wv[1] = pk2(y2, y3);
                *(u32x2*)(dst + 32 * d + 8 * a + 4 * h) = wv;
            }
    }
}

DI void attn_gqa2(const Params& p, int task, char* lds) {
    constexpr int DV = 64, NDT = 2;
    constexpr int STG = 64 * AROWB + DV * AROWB;
    const int tid = tidx(), lane = tid & 63, wave = tid >> 6, r = lane & 31, h = lane >> 5;
    const bf16_t* ub = (const bf16_t*)(p.ws + OFF_U);
    const int qt = task & 7, rest = task >> 3, head = rest & 7, seq = rest >> 3;
    const int qcol = head * 64, kcol = 512 + (head >> 2) * 64;
    const bf16_t* vt = (const bf16_t*)(p.ws + OFF_VTA) + (size_t)(seq * 2 + (head >> 2)) * 64 * SL;
    const int qpos0 = qt * 256 + wave * 64 + r;
    bf16x8 qf[2][4];
#pragma unroll
    for (int qs = 0; qs < 2; ++qs) {
        const bf16_t* qptr = ub + ((size_t)seq * SL + qpos0 + 32 * qs) * INW + qcol;
#pragma unroll
        for (int s = 0; s < 4; ++s) qf[qs][s] = *(const bf16x8*)(qptr + 16 * s + 8 * h);
    }
    const bf16_t* kbase = ub + (size_t)seq * SL * INW + kcol;
    f32x16 o[2][NDT];
#pragma unroll
    for (int qs = 0; qs < 2; ++qs)
#pragma unroll
        for (int d = 0; d < NDT; ++d)
#pragma unroll
            for (int i = 0; i < 16; ++i) o[qs][d][i] = 0.f;
    float lsum[2] = {0.f, 0.f};
    const int srow = tid >> 3, sc = tid & 7;
    const bf16_t* kg = kbase + (size_t)srow * INW + sc * 8;
    const bf16_t* vg = vt + (size_t)srow * SL + sc * 8;
    u32x4 rk[2], rv[NDT];
#pragma unroll
    for (int i = 0; i < 2; ++i) rk[i] = *(const u32x4*)(kg + (size_t)(32 * i) * INW);
#pragma unroll
    for (int i = 0; i < NDT; ++i) rv[i] = *(const u32x4*)(vg + (size_t)(32 * i) * SL);
    const int soff = srow * AROWB + sc * 16;
#pragma unroll
    for (int i = 0; i < 2; ++i) *(u32x4*)(lds + soff + 32 * i * AROWB) = rk[i];
#pragma unroll
    for (int i = 0; i < NDT; ++i) *(u32x4*)(lds + 64 * AROWB + soff + 32 * i * AROWB) = rv[i];
    __syncthreads();
    for (int kt = 0; kt < SL / 64; ++kt) {
        const char* cur = lds + (kt & 1) * STG;
        char* nxt = lds + ((kt + 1) & 1) * STG;
        const bool more = kt + 1 < SL / 64;
        if (more) {
            kg += (size_t)64 * INW; vg += 64;
#pragma unroll
            for (int i = 0; i < 2; ++i) rk[i] = *(const u32x4*)(kg + (size_t)(32 * i) * INW);
#pragma unroll
            for (int i = 0; i < NDT; ++i) rv[i] = *(const u32x4*)(vg + (size_t)(32 * i) * SL);
        }
        f32x16 st[2][2];
#pragma unroll
        for (int kk = 0; kk < 2; ++kk) {
#pragma unroll
            for (int i = 0; i < 16; ++i) { st[0][kk][i] = 0.f; st[1][kk][i] = 0.f; }
#pragma unroll
            for (int s = 0; s < 4; ++s) {
                const bf16x8 kf = *(const bf16x8*)(cur + (32 * kk + r) * AROWB + (16 * s + 8 * h) * 2);
                st[0][kk] = MFMA32(kf, qf[0][s], st[0][kk]);
                st[1][kk] = MFMA32(kf, qf[1][s], st[1][kk]);
            }
        }
#pragma unroll
        for (int qs = 0; qs < 2; ++qs)
#pragma unroll
            for (int kk = 0; kk < 2; ++kk)
#pragma unroll
                for (int i = 0; i < 16; ++i) { const float pv = __builtin_amdgcn_exp2f(st[qs][kk][i]); lsum[qs] += pv; st[qs][kk][i] = pv; }
        const char* sV = cur + 64 * AROWB;
#pragma unroll
        for (int kk = 0; kk < 2; ++kk)
#pragma unroll
            for (int s2 = 0; s2 < 2; ++s2) {
                bf16x8 pf[2];
#pragma unroll
                for (int qs = 0; qs < 2; ++qs) {
                    u32x4 pw;
#pragma unroll
                    for (int j = 0; j < 4; ++j) pw[j] = pk2(st[qs][kk][8 * s2 + 2 * j], st[qs][kk][8 * s2 + 2 * j + 1]);
                    pf[qs] = __builtin_bit_cast(bf16x8, pw);
                }
#pragma unroll
                for (int d = 0; d < NDT; ++d) {
                    const char* va = sV + (32 * d + r) * AROWB + (32 * kk + 16 * s2 + 4 * h) * 2;
                    const s16x4 lo = *(const s16x4*)va, hi = *(const s16x4*)(va + 16);
                    const bf16x8 vf = __builtin_shufflevector(lo, hi, 0, 1, 2, 3, 4, 5, 6, 7);
                    o[0][d] = MFMA32(vf, pf[0], o[0][d]);
                    o[1][d] = MFMA32(vf, pf[1], o[1][d]);
                }
            }
        if (more) {
#pragma unroll
            for (int i = 0; i < 2; ++i) *(u32x4*)(nxt + soff + 32 * i * AROWB) = rk[i];
#pragma unroll
            for (int i = 0; i < NDT; ++i) *(u32x4*)(nxt + 64 * AROWB + soff + 32 * i * AROWB) = rv[i];
        }
        __syncthreads();
    }
#pragma unroll
    for (int qs = 0; qs < 2; ++qs) {
        const size_t tok = (size_t)seq * SL + qpos0 + 32 * qs;
        const float ltot = lsum[qs] + __shfl_xor(lsum[qs], 32);
        const float inv = __builtin_amdgcn_rcpf(ltot);
        bf16_t* dst = (bf16_t*)(p.ws + OFF_O) + tok * 512 + head * 64;
#pragma unroll
        for (int d = 0; d < NDT; ++d)
#pragma unroll
            for (int a = 0; a < 4; ++a) {
                u32x2 wv; wv[0] = pk2(o[qs][d][4 * a] * inv, o[qs][d][4 * a + 1] * inv); wv[1] = pk2(o[qs][d][4 * a + 2] * inv, o[qs][d][4 * a + 3] * inv);
                *(u32x2*)(dst + 32 * d + 8 * a + 4 * h) = wv;
            }
    }
}

DI void tr_read8(unsigned a, s16x4 (&v)[8]) {
    asm volatile("ds_read_b64_tr_b16 %0, %8\n\tds_read_b64_tr_b16 %1, %8 offset:256\n\tds_read_b64_tr_b16 %2, %8 offset:1024\n\tds_read_b64_tr_b16 %3, %8 offset:1280\n\t"
                 "ds_read_b64_tr_b16 %4, %8 offset:2048\n\tds_read_b64_tr_b16 %5, %8 offset:2304\n\tds_read_b64_tr_b16 %6, %8 offset:3072\n\tds_read_b64_tr_b16 %7, %8 offset:3328\n\t"
                 "s_waitcnt lgkmcnt(0)"
                 : "=&v"(v[0]), "=&v"(v[1]), "=&v"(v[2]), "=&v"(v[3]), "=&v"(v[4]), "=&v"(v[5]), "=&v"(v[6]), "=&v"(v[7]) : "v"(a) : "memory");
}

DI void s5_wave_task(const Params& p, int layer, int wt, char* ldsw) {
    const int lane = tidx() & 63, r = lane & 31, h = lane >> 5;
    const int dir = wt & 1, g = (wt >> 1) & 31, pair = wt >> 6;
    const bf16_t* ub = (const bf16_t*)(p.ws + OFF_U);
    const int hp = (r >> 2) & 1, ia = 4 * (r >> 3) + (r & 3);
    const unsigned img = (unsigned)(size_t)ldsw;
    char* chunkbuf = ldsw + 8192;
    const int i16 = lane & 15, tq = i16 >> 2, tp = i16 & 3, blk = (lane >> 4) & 1;
    const unsigned trA = img + (8 * h + tq) * 64 + 8 * (4 * blk + tp);
    const float dsk = r < 16 ? p.in[I_SD][layer * 512 + g * 16 + r] : 0.f;
    bf16_t* yl = (bf16_t*)(p.ws + (dir ? OFF_YB : OFF_YF)) + ((size_t)(2 * pair + h) * 512 + g * 16 + (r & 15)) * SL;
    const int pb = (layer * 2 + dir) * 32 + g;
    const float dt = expf(p.in[I_SLDT][pb]);
    float abr[2], abi[2];
    bf16x8 bfrag[2][2], cfrag[2][2][2], dfrag;
    {
        u32x4 dw;
#pragma unroll
        for (int j = 0; j < 4; ++j) dw[j] = pk2((dir == 0 && r == 8 * h + 2 * j) ? dsk : 0.f, (dir == 0 && r == 8 * h + 2 * j + 1) ? dsk : 0.f);
        dfrag = __builtin_bit_cast(bf16x8, dw);
    }
#pragma unroll
    for (int st = 0; st < 2; ++st) {
        const int n = 32 * st + r;
        const float are = p.in[I_SARE][pb * 64 + n], aim = p.in[I_SAIM][pb * 64 + n];
        const float mag = expf(dt * are);
        abr[st] = mag * cosf(dt * aim); abi[st] = mag * sinf(dt * aim);
        const float den = are * are + aim * aim, nr = abr[st] - 1.0f;
        const float fre = (nr * are + abi[st] * aim) / den, fim = (abi[st] * are - nr * aim) / den;
        const float* bre = p.in[I_SBRE] + ((size_t)pb * 64 + n) * 16 + 8 * h;
        const float* bim = p.in[I_SBIM] + ((size_t)pb * 64 + n) * 16 + 8 * h;
        u32x4 wre, wim;
#pragma unroll
        for (int j = 0; j < 4; ++j) {
            const float br0 = bre[2 * j], bi0 = bim[2 * j], br1 = bre[2 * j + 1], bi1 = bim[2 * j + 1];
            wre[j] = pk2(fre * br0 - fim * bi0, fre * br1 - fim * bi1);
            wim[j] = pk2(fre * bi0 + fim * br0, fre * bi1 + fim * br1);
        }
        bfrag[st][0] = __builtin_bit_cast(bf16x8, wre); bfrag[st][1] = __builtin_bit_cast(bf16x8, wim);
#pragma unroll
        for (int s = 0; s < 2; ++s) {
            u32x4 cr = {0u, 0u, 0u, 0u}, ci = {0u, 0u, 0u, 0u};
            if (r < 16) {
                const float* cre = p.in[I_SCRE] + ((size_t)pb * 16 + r) * 64 + 32 * st + 16 * s + 8 * h;
                const float* cim = p.in[I_SCIM] + ((size_t)pb * 16 + r) * 64 + 32 * st + 16 * s + 8 * h;
#pragma unroll
                for (int j = 0; j < 4; ++j) { cr[j] = pk2(cre[2 * j], cre[2 * j + 1]); ci[j] = pk2(-cim[2 * j], -cim[2 * j + 1]); }
            }
            cfrag[st][s][0] = __builtin_bit_cast(bf16x8, cr); cfrag[st][s][1] = __builtin_bit_cast(bf16x8, ci);
        }
    }
    float sre[2] = {0.f, 0.f}, sim[2] = {0.f, 0.f};
    const bf16_t* gsrc[4]; int loff[4];
#pragma unroll
    for (int j = 0; j < 4; ++j) {
        const int c = lane + 64 * j, row = c >> 1, half = c & 1, ss = row >> 6, tau = row & 63;
        gsrc[j] = ub + ((size_t)(2 * pair + ss) * SL + (dir ? (SL - 1 - tau) : tau)) * INW + 768 + g * 16 + half * 8;
        loff[j] = row * 32 + half * 16;
    }
    const long cstep = dir ? -(long)64 * INW : (long)64 * INW;
    u32x4 crg[4];
#pragma unroll
    for (int j = 0; j < 4; ++j) crg[j] = *(const u32x4*)gsrc[j];
#pragma unroll
    for (int j = 0; j < 4; ++j) *(u32x4*)(chunkbuf + loff[j]) = crg[j];
    const int aoff = (hp * 64 + ia) * 32 + h * 16;
    for (int chunk = 0; chunk < SL / 64; ++chunk) {
        if (chunk + 1 < SL / 64) {
#pragma unroll
            for (int j = 0; j < 4; ++j) { gsrc[j] += cstep; crg[j] = *(const u32x4*)gsrc[j]; }
        }
        const char* cb = chunkbuf + (chunk & 1) * 4096;
#pragma unroll 1
        for (int tl = 0; tl < 4; ++tl) {
            const int s0 = chunk * 64 + tl * 16;
            const bf16x8 ua = *(const bf16x8*)(cb + aoff + tl * 512);
            f32x16 z;
#pragma unroll
            for (int i = 0; i < 16; ++i) z[i] = 0.f;
            f32x16 y0 = MFMA32(ua, dfrag, z);
            f32x16 y1 = z;
#pragma unroll
            for (int st = 0; st < 2; ++st) {
                f32x16 xr = MFMA32(ua, bfrag[st][0], z);
                f32x16 xi = MFMA32(ua, bfrag[st][1], z);
                float cr = sre[st], ci = sim[st];
#pragma unroll
                for (int i = 0; i < 16; ++i) {
                    const float nr = abr[st] * cr - abi[st] * ci + xr[i];
                    const float ni = abr[st] * ci + abi[st] * cr + xi[i];
                    cr = nr; ci = ni; xr[i] = nr; xi[i] = ni;
                }
                sre[st] = cr; sim[st] = ci;
#pragma unroll
                for (int a = 0; a < 4; ++a) {
                    u32x2 w0, w1; w0[0] = pk2(xr[4 * a], xr[4 * a + 1]); w0[1] = pk2(xr[4 * a + 2], xr[4 * a + 3]);
                    w1[0] = pk2(xi[4 * a], xi[4 * a + 1]); w1[1] = pk2(xi[4 * a + 2], xi[4 * a + 3]);
                    *(u32x2*)(ldsw + (st * 2 + 0) * 2048 + r * 64 + 8 * (2 * a + h)) = w0;
                    *(u32x2*)(ldsw + (st * 2 + 1) * 2048 + r * 64 + 8 * (2 * a + h)) = w1;
                }
            }
            asm volatile("s_waitcnt lgkmcnt(0)" ::: "memory");
            {
                s16x4 v[8];
                tr_read8(trA, v);
                y0 = MFMA32(__builtin_shufflevector(v[0], v[1], 0, 1, 2, 3, 4, 5, 6, 7), cfrag[0][0][0], y0);
                y0 = MFMA32(__builtin_shufflevector(v[2], v[3], 0, 1, 2, 3, 4, 5, 6, 7), cfrag[0][1][0], y0);
                y0 = MFMA32(__builtin_shufflevector(v[4], v[5], 0, 1, 2, 3, 4, 5, 6, 7), cfrag[0][0][1], y0);
                y0 = MFMA32(__builtin_shufflevector(v[6], v[7], 0, 1, 2, 3, 4, 5, 6, 7), cfrag[0][1][1], y0);
                s16x4 u[8];
                tr_read8(trA + 4096, u);
                y1 = MFMA32(__builtin_shufflevector(u[0], u[1], 0, 1, 2, 3, 4, 5, 6, 7), cfrag[1][0][0], y1);
                y1 = MFMA32(__builtin_shufflevector(u[2], u[3], 0, 1, 2, 3, 4, 5, 6, 7), cfrag[1][1][0], y1);
                y1 = MFMA32(__builtin_shufflevector(u[4], u[5], 0, 1, 2, 3, 4, 5, 6, 7), cfrag[1][0][1], y1);
                y1 = MFMA32(__builtin_shufflevector(u[6], u[7], 0, 1, 2, 3, 4, 5, 6, 7), cfrag[1][1][1], y1);
            }
            if (r < 16) {
                u32x4 o0, o1;
                if (dir == 0) {
#pragma unroll
                    for (int j = 0; j < 4; ++j) { o0[j] = pk2(y0[2 * j] + y1[2 * j], y0[2 * j + 1] + y1[2 * j + 1]); o1[j] = pk2(y0[8 + 2 * j] + y1[8 + 2 * j], y0[9 + 2 * j] + y1[9 + 2 * j]); }
                    *(u32x4*)(yl + s0) = o0; *(u32x4*)(yl + s0 + 8) = o1;
                } else {
#pragma unroll
                    for (int j = 0; j < 4; ++j) { o0[j] = pk2(y0[15 - 2 * j] + y1[15 - 2 * j], y0[14 - 2 * j] + y1[14 - 2 * j]); o1[j] = pk2(y0[7 - 2 * j] + y1[7 - 2 * j], y0[6 - 2 * j] + y1[6 - 2 * j]); }
                    *(u32x4*)(yl + (SL - 16 - s0)) = o0; *(u32x4*)(yl + (SL - 16 - s0) + 8) = o1;
                }
            }
        }
        if (chunk + 1 < SL / 64) {
#pragma unroll
            for (int j = 0; j < 4; ++j) *(u32x4*)(chunkbuf + ((chunk + 1) & 1) * 4096 + loff[j]) = crg[j];
        }
    }
}

DI void phase_mix(const Params& p, int layer, int qidx, char* lds, bool only_s5 = false) {
    __shared__ int s_task;
    int* qc = (int*)(p.ws + OFF_QCNT) + qidx;
    constexpr int N_S5 = (G / 2) * 32 * 2 / 4, N_DIFF = G * 4 * 2 * 16, N_RET = G * 4 * 16, N_GQA = G * 8 * 8;
    constexpr int NTOT = N_S5 + N_DIFF + N_RET + N_GQA;
    for (;;) {
        __syncthreads();
        if (tidx() == 0) s_task = atomicAdd(qc, 1);
        __syncthreads();
        int task = s_task;
        if (task >= (only_s5 ? N_S5 : NTOT)) break;
        if (task < N_S5) { const int wave = tidx() >> 6; s5_wave_task(p, layer, task * 4 + wave, lds + wave * 16384); }
        else if ((task -= N_S5) < N_DIFF) attn_task<128, 1>(p, task, lds);
        else if ((task -= N_DIFF) < N_RET) attn_task<128, 2>(p, task, lds);
        else attn_gqa2(p, task - N_RET, lds);
    }
}

DI float gelu_tanh(float v) { const float z2 = 1.5957691216057308f * (v + 0.044715f * v * v * v); return v * __builtin_amdgcn_rcpf(1.0f + __builtin_amdgcn_exp2f(-LOG2E * z2)); }

DI void glu_tile(const Params& p, int layer, int tm, int tn, char* lds) {
    const int tid = tidx(), lane = tid & 63, w = tid >> 6, wr = w >> 1, wc = w & 1, r16 = lane & 15, q4 = lane >> 4;
    const bf16_t* yf = (const bf16_t*)(p.ws + OFF_YF);
    const bf16_t* yb = (const bf16_t*)(p.ws + OFF_YB);
    const bf16_t* B = wts(p, layer) + WGLU + (size_t)tn * 128 * 512;
    const int seq = (tm * 128) >> 11, t0 = (tm * 128) & 2047;
    const int ach = tid & 63, aseg0 = tid >> 6;
    const bf16_t* fg = yf + ((size_t)seq * 512 + ach) * SL + t0;
    const bf16_t* bg2 = yb + ((size_t)seq * 512 + ach) * SL + t0;
    const int srow = tid >> 3, scol = tid & 7;
    const bf16_t* bg = B + (size_t)srow * 512 + scol * 8;
    const int soff = srow * ROWB + ((scol ^ ((srow >> 1) & 7)) << 4);
    u32x4 rf[4], rbk[4], rb[4];
    f32x4 acc[4][4]; zero_acc(acc);
    const int aoff = (wr * 64 + (lane & 15)) * ROWB;
    const int boff = GT_BYTES + (wc * 64 + (lane & 15)) * ROWB;
    const int sw = ((lane >> 4) ^ ((lane & 15) >> 1)) << 4;
    for (int kt = 0; kt < 8; ++kt) {
#pragma unroll
        for (int j = 0; j < 4; ++j) {
            rf[j] = *(const u32x4*)(fg + (size_t)kt * 64 * SL + (aseg0 + 4 * j) * 8);
            rbk[j] = *(const u32x4*)(bg2 + (size_t)kt * 64 * SL + (aseg0 + 4 * j) * 8);
            rb[j] = *(const u32x4*)(bg + (size_t)(32 * j) * 512 + kt * 64);
        }
#pragma unroll
        for (int j = 0; j < 4; ++j) {
            *(u32x4*)(lds + GT_BYTES + soff + 32 * j * ROWB) = rb[j];
            char* abase = lds + (aseg0 + 4 * j) * 8 * ROWB + (ach & 7) * 2;
#pragma unroll
            for (int e = 0; e < 4; ++e) {
                const float v0 = gelu_tanh(bflo(rf[j][e]) + bflo(rbk[j][e])), v1 = gelu_tanh(bfhi(rf[j][e]) + bfhi(rbk[j][e]));
                const unsigned pw = pk2(v0, v1);
                const int cs = (((ach >> 3) ^ ((4 * aseg0 + e) & 7)) << 4);
                *(bf16_t*)(abase + (2 * e) * ROWB + cs) = (bf16_t)(pw & 0xffffu);
                *(bf16_t*)(abase + (2 * e + 1) * ROWB + cs) = (bf16_t)(pw >> 16);
            }
        }
        __syncthreads();
        gemm_compute<false, 0>(lds, aoff, boff, sw, acc);
        __syncthreads();
    }
    bf16_t* ob = (bf16_t*)(p.ws + OFF_O) + (size_t)1 * TG * 512;
    const float* bgl = p.in[I_SBGLU] + layer * 512;
#pragma unroll
    for (int n = 0; n < 4; ++n) {
        const int ch = tn * 128 + wc * 64 + n * 16 + r16;
        const float bias = bgl[ch];
#pragma unroll
        for (int m = 0; m < 4; ++m) {
            const int tl = wr * 64 + m * 16 + q4 * 4;
            const u32x2 fw = *(const u32x2*)(yf + ((size_t)seq * 512 + ch) * SL + t0 + tl);
            const u32x2 bw = *(const u32x2*)(yb + ((size_t)seq * 512 + ch) * SL + t0 + tl);
            const float y0 = gelu_tanh(bflo(fw[0]) + bflo(bw[0])), y1 = gelu_tanh(bfhi(fw[0]) + bfhi(bw[0]));
            const float y2 = gelu_tanh(bflo(fw[1]) + bflo(bw[1])), y3 = gelu_tanh(bfhi(fw[1]) + bfhi(bw[1]));
            const unsigned w01 = pk2(y0 * sigmoidf_(acc[m][n][0] + bias), y1 * sigmoidf_(acc[m][n][1] + bias));
            const unsigned w23 = pk2(y2 * sigmoidf_(acc[m][n][2] + bias), y3 * sigmoidf_(acc[m][n][3] + bias));
            bf16_t* orow = ob + (size_t)(tm * 128 + tl) * 512 + ch;
            orow[0] = (bf16_t)(w01 & 0xffffu); orow[512] = (bf16_t)(w01 >> 16); orow[1024] = (bf16_t)(w23 & 0xffffu); orow[1536] = (bf16_t)(w23 >> 16);
        }
    }
}

DI void phase_glu(const Params& p, int layer, char* lds) {
    const int lane = tidx() & 63, w = tidx() >> 6;
    { TileIter it; ti_init(it, TG / 128, 4, 16, 4); int tm, tn; while (ti_next(it, tm, tn)) glu_tile(p, layer, tm, tn, lds); }
    const float lam = ((const float*)(p.ws + OFF_LAM))[layer], li = ((const float*)(p.ws + OFF_LAM))[4 + layer];
    const bf16_t* d0 = (const bf16_t*)(p.ws + OFF_DT); const bf16_t* d1 = d0 + (size_t)TG * 512;
    bf16_t* oc = (bf16_t*)(p.ws + OFF_O) + (size_t)2 * TG * 512;
    const f32x2 sg = *(const f32x2*)(p.in[I_DSUB] + layer * 128 + 2 * lane);
    const int gw = bidx() * 4 + w, nw = gdim() * 4;
    for (int it = gw; it < TG * 4; it += nw) {
        const size_t off = (size_t)it * 128 + 2 * lane;
        const unsigned a = *(const unsigned*)(d0 + off), b = *(const unsigned*)(d1 + off);
        const float v0 = bflo(a) - lam * bflo(b), v1 = bfhi(a) - lam * bfhi(b);
        const float ss = wave_sum(v0 * v0 + v1 * v1);
        const float rs = rsqrtf(ss * (1.0f / 128.0f) + EPS) * (1.0f - li);
        *(unsigned*)(oc + off) = pk2(v0 * rs * sg[0], v1 * rs * sg[1]);
    }
}

DI void phase_merge(const Params& p, int layer, char* lds) {
    const int lane = tidx() & 63, w = tidx() >> 6, wr = w >> 1, wc = w & 1, r16 = lane & 15, q4 = lane >> 4;
    const bf16_t* ob = (const bf16_t*)(p.ws + OFF_O);
    const bf16_t* gb = (const bf16_t*)(p.ws + OFF_GATE);
    const bf16_t* W = wts(p, layer) + WB;
    bf16_t* mb = (bf16_t*)(p.ws + OFF_M);
    TileIter it; ti_init(it, TG / 128, 8, 8, 8);
    int tm, tn;
    while (ti_next(it, tm, tn)) {
        f32x4 macc[4][4]; zero_acc(macc);
#pragma unroll 1
        for (int b = 0; b < 4; ++b) {
            f32x4 acc[4][4]; zero_acc(acc);
            gemm128<true, 0, false>(ob + ((size_t)b * TG + tm * 128) * 512, 512, W + ((size_t)b * 1024 + tn * 128) * 512, 512, 512, acc, lds);
#pragma unroll
            for (int m = 0; m < 4; ++m) {
                const int row = tm * 128 + wr * 64 + m * 16 + r16;
#pragma unroll
                for (int n = 0; n < 4; ++n) {
                    const int col = tn * 128 + wc * 64 + n * 16 + q4 * 4;
                    const u32x2 gw = *(const u32x2*)(gb + (size_t)row * 4096 + b * 1024 + col);
                    macc[m][n][0] += acc[m][n][0] * bflo(gw[0]); macc[m][n][1] += acc[m][n][1] * bfhi(gw[0]);
                    macc[m][n][2] += acc[m][n][2] * bflo(gw[1]); macc[m][n][3] += acc[m][n][3] * bfhi(gw[1]);
                }
            }
        }
#pragma unroll
        for (int m = 0; m < 4; ++m) {
            const int row = tm * 128 + wr * 64 + m * 16 + r16;
#pragma unroll
            for (int n = 0; n < 4; ++n) {
                const int col = tn * 128 + wc * 64 + n * 16 + q4 * 4;
                otile_put(lds, wr * 64 + m * 16 + r16, wc * 64 + n * 16 + q4 * 4, pk2(macc[m][n][0], macc[m][n][1]), pk2(macc[m][n][2], macc[m][n][3]));
            }
        }
        otile_flush(lds, mb + (size_t)(tm * 128) * DM + tn * 128, DM);
    }
}

DI void phase_resid(const Params& p, int grp, const bf16_t* A, int K, const bf16_t* Wt, bool first, char* lds) {
    const int lane = tidx() & 63, w = tidx() >> 6, wr = w >> 1, wc = w & 1, r16 = lane & 15, q4 = lane >> 4;
    TileIter it; ti_init(it, TG / 128, 8, 8, 8);
    int tm, tn, ntm = 0, ntn = 0;
    bool have = ti_next(it, tm, tn);
    GemmRegs g;
    if (have) gemm_prime(A + (size_t)tm * 128 * K, K, Wt + (size_t)tn * 128 * K, K, g);
    for (; have; tm = ntm, tn = ntn) {
        have = ti_next(it, ntm, ntn);
        const bf16_t* At = A + (size_t)tm * 128 * K; const bf16_t* Bt = Wt + (size_t)tn * 128 * K;
        const bf16_t* nAt = have ? A + (size_t)ntm * 128 * K : At; const bf16_t* nBt = have ? Wt + (size_t)ntn * 128 * K : Bt;
        f32x4 acc[4][4]; zero_acc(acc);
        gemm_stream<true>(At, Bt, nAt, nBt, K, K, K, g, acc, lds);
#pragma unroll
        for (int m = 0; m < 4; ++m)
#pragma unroll
            for (int n = 0; n < 4; ++n) *(f32x4*)(lds + (wr * 64 + m * 16 + r16) * OROWF + (wc * 64 + n * 16 + q4 * 4) * 4) = acc[m][n];
        __syncthreads();
        {
            const int tid = tidx();
#pragma unroll 4
            for (int i = 0; i < 16; ++i) {
                const int c = tid + 256 * i, rl = c >> 5, ch = c & 31, row = tm * 128 + rl;
                float* xo = p.out + ((size_t)grp * TG + row) * DM + tn * 128 + ch * 4;
                const float* xi = first ? x_in_row(p, grp, row) + tn * 128 + ch * 4 : xo;
                const f32x4 a = *(const f32x4*)(lds + rl * OROWF + ch * 16);
                const f32x4 xv = *(const f32x4*)xi;
                *(f32x4*)xo = xv + a;
            }
        }
        __syncthreads();
    }
}

DI void phase_ffn1(const Params& p, int layer, char* lds) {
    const int lane = tidx() & 63, w = tidx() >> 6, wr = w >> 1, wc = w & 1, r16 = lane & 15, q4 = lane >> 4;
    const bf16_t* hb = (const bf16_t*)(p.ws + OFF_H);
    const bf16_t* W = wts(p, layer) + WFI;
    bf16_t* fb = (bf16_t*)(p.ws + OFF_F);
    constexpr int NT = DFF / 64;
    TileIter it; ti_init(it, TG / 128, NT, 8, 4);
    int tm, tn, ntm = 0, ntn = 0;
    bool have = ti_next(it, tm, tn);
    GemmRegs g;
    if (have) gemm_prime(hb + (size_t)tm * 128 * DM, DM, W + (size_t)tn * 128 * DM, DM, g);
    for (; have; tm = ntm, tn = ntn) {
        have = ti_next(it, ntm, ntn);
        const bf16_t* At = hb + (size_t)tm * 128 * DM; const bf16_t* Bt = W + (size_t)tn * 128 * DM;
        const bf16_t* nAt = have ? hb + (size_t)ntm * 128 * DM : At; const bf16_t* nBt = have ? W + (size_t)ntn * 128 * DM : Bt;
        f32x4 acc[4][4]; zero_acc(acc);
        gemm_stream<true, 1>(At, Bt, nAt, nBt, DM, DM, DM, g, acc, lds);
#pragma unroll
        for (int m = 0; m < 4; ++m) {
            const int row = tm * 128 + wr * 64 + m * 16 + r16;
#pragma unroll
            for (int n = 0; n < 2; ++n) {
                const int col = tn * 64 + wc * 32 + n * 16 + q4 * 4;
                float f[4];
#pragma unroll
                for (int i = 0; i < 4; ++i) { const float gq = acc[m][n][i]; f[i] = gq * sigmoidf_(gq) * acc[m][n + 2][i]; }
                otile_put(lds, wr * 64 + m * 16 + r16, wc * 32 + n * 16 + q4 * 4, pk2(f[0], f[1]), pk2(f[2], f[3]));
            }
        }
        {
            const int tid = tidx();
            __syncthreads();
#pragma unroll
            for (int i = 0; i < 4; ++i) {
                const int c = tid + 256 * i, row = c >> 3, ch = c & 7;
                const u32x4 v = *(const u32x4*)(lds + row * OROW + ch * 16);
                *(u32x4*)(fb + (size_t)(tm * 128 + row) * DFF + tn * 64 + ch * 8) = v;
            }
            __syncthreads();
        }
    }
}

#define XB_TMO      128
#define XB_XCNT(j)  (256  + 64 * (j))
#define XB_XSUB(j)  (1280 + 64 * (j))
#define XB_XGEN(j)  (2304 + 64 * (j))
#define XB_TOP      3328
#define XB_TOPGEN   3392
#define XCD_BAR_WORDS 3456
#define XB_SPIN_CAP (1u << 18)
#define LAS __attribute__((address_space(3)))

__device__ __forceinline__ unsigned xb_ld(unsigned* p)              { return __hip_atomic_load(p, __ATOMIC_RELAXED, __HIP_MEMORY_SCOPE_AGENT); }
__device__ __forceinline__ unsigned xb_add(unsigned* p, unsigned v) { return __hip_atomic_fetch_add(p, v, __ATOMIC_RELAXED, __HIP_MEMORY_SCOPE_AGENT); }
__device__ __forceinline__ unsigned xb_xcc_id() { return (unsigned)__builtin_amdgcn_s_getreg((3 << 11) | 20) & 0xFu; }
#define XB_SPIN(cond, bar) do { unsigned _sp = 0; while (cond) { __builtin_amdgcn_s_sleep(1); \
    if ((++_sp & 255u) == 0u) { if (xb_ld(&(bar)[XB_TMO])) break; if (_sp > XB_SPIN_CAP) { atomicAdd(&(bar)[XB_TMO], 1u); break; } } } } while (0)

struct XcdBarrier {
    unsigned* bar; unsigned x;
    volatile LAS unsigned* st;
};

__device__ __forceinline__ XcdBarrier xcd_barrier_post(unsigned* bar, volatile LAS unsigned* st) {
    XcdBarrier b; b.bar = bar; b.x = xb_xcc_id(); b.st = st;
    if (threadIdx.x == 0) (void)xb_add(&bar[XB_XCNT(b.x)], 1u);
    return b;
}
__device__ __forceinline__ void xcd_barrier_complete(unsigned* bar, unsigned x, unsigned& nloc, unsigned& nx) {
    const unsigned G = gdim() * gridDim.y * gridDim.z;
    unsigned sum, cnt, mine, sp = 0u;
    for (;;) {
        sum = 0u; cnt = 0u; mine = 0u;
#pragma unroll
        for (unsigned j = 0; j < 16; ++j) { const unsigned c = xb_ld(&bar[XB_XCNT(j)]); sum += c; cnt += (c > 0u) ? 1u : 0u; mine = (j == x) ? c : mine; }
        if (sum == G) break;
        __builtin_amdgcn_s_sleep(1);
        if ((++sp & 255u) == 0u) { if (xb_ld(&bar[XB_TMO])) break; if (sp > XB_SPIN_CAP) { atomicAdd(&bar[XB_TMO], 1u); break; } }
    }
    nloc = mine > 0u ? mine : 1u; nx = cnt > 0u ? cnt : 1u;
}

__device__ __forceinline__ void xcd_barrier(const XcdBarrier& b) {
    asm volatile("s_waitcnt vmcnt(0)" ::: "memory");
    __syncthreads();
    if (threadIdx.x == 0) {
        unsigned* bar = b.bar;
        __builtin_amdgcn_s_waitcnt(0);
        unsigned nloc = b.st[0], nx = b.st[1];
        if (nloc == 0u) { xcd_barrier_complete(bar, b.x, nloc, nx); b.st[0] = nloc; b.st[1] = nx; }
        const unsigned old = xb_add(&bar[XB_XSUB(b.x)], 1u);
        const unsigned gen = old / nloc;
        if (old + 1u == (gen + 1u) * nloc) {
            __builtin_amdgcn_fence(__ATOMIC_RELEASE, "agent");
            asm volatile("s_waitcnt vmcnt(0)" ::: "memory");
            const unsigned og = xb_add(&bar[XB_TOP], 1u);
            const unsigned tg = og / nx;
            if (og + 1u == (tg + 1u) * nx) xb_add(&bar[XB_TOPGEN], 1u);
            else XB_SPIN(xb_ld(&bar[XB_TOPGEN]) == tg, bar);
            __builtin_amdgcn_fence(__ATOMIC_ACQUIRE, "agent");
            xb_add(&bar[XB_XGEN(b.x)], 1u);
            asm volatile("s_waitcnt vmcnt(0)" ::: "memory");
        } else {
            XB_SPIN(xb_ld(&bar[XB_XGEN(b.x)]) == gen, bar);
            __builtin_amdgcn_fence(__ATOMIC_ACQUIRE, "agent");
            asm volatile("s_waitcnt vmcnt(0)" ::: "memory");
        }
    }
    __syncthreads();
}


constexpr int PH_PER_GRP = 4 * 9 + 1;
constexpr int NPHASE = 1 + NGRP * PH_PER_GRP;

#ifndef PROBE_K
#define PROBE_K (-1)
#endif
DI void run_phase(const Params& p, int ph, char* lds, int rep = 0) {
    if (ph == 0) { phase_prologue(p, lds); return; }
    const int q = ph - 1, grp = q / PH_PER_GRP, r = q % PH_PER_GRP;
    if (r == 36) { phase_norm(p, grp, p.in[I_NFIN], 2); return; }
    const int layer = r / 9, k = r % 9;
    switch (k) {
        case 0: phase_norm(p, grp, p.in[I_NMIX] + layer * DM, layer == 0 ? 0 : 1); break;
        case 1: phase_in(p, layer, lds, rep == 1); break;
        case 2: phase_mix(p, layer, grp * 4 + layer + 20 * rep, lds, rep == 1); break;
        case 3: phase_glu(p, layer, lds); break;
        case 4: phase_merge(p, layer, lds); break;
        case 5: phase_resid(p, grp, (const bf16_t*)(p.ws + OFF_M), DM, wts(p, layer) + WO, layer == 0, lds); break;
        case 6: phase_norm(p, grp, p.in[I_NFFN] + layer * DM, 1); break;
        case 7: phase_ffn1(p, layer, lds); break;
        default: phase_resid(p, grp, (const bf16_t*)(p.ws + OFF_F), DFF, wts(p, layer) + WFO, false, lds); break;
    }
}

__global__ void __launch_bounds__(256, 2) mega(Params p, int only) {
    __shared__ __attribute__((aligned(16))) char lds[LDS_BYTES];
#if MULTI_LAUNCH
    if (only >= 0) { run_phase(p, only, lds); return; }
#endif
    cg::grid_group grid = cg::this_grid();
    __shared__ uint4 xb_words;
    if (threadIdx.x == 0) xb_words = make_uint4(0u, 0u, 0u, 0u);
    __syncthreads();
    XcdBarrier xb = xcd_barrier_post((unsigned*)(p.ws + OFF_BAR), (volatile LAS unsigned*)&xb_words);
    for (int ph = 0; ph < NPHASE; ++ph) {
        run_phase(p, ph, lds);
        if (ph + 1 < NPHASE) { if (ph == 0) grid.sync(); else xcd_barrier(xb); }
        if (PROBE_K == 100) xcd_barrier(xb);
        if (PROBE_K >= 0 && PROBE_K < 9 && ph > 0 && ((ph - 1) % PH_PER_GRP) < 36 && (((ph - 1) % PH_PER_GRP) % 9) == PROBE_K) { run_phase(p, ph, lds, 1); xcd_barrier(xb); }
    }
}

extern "C" void kernel_launch(void* const* d_in, const int* in_sizes, int n_in, void* d_out, int out_size, void* d_ws, size_t ws_size, hipStream_t stream) {
    (void)in_sizes; (void)n_in; (void)out_size;
    static int grid_blocks = 0;
    if (!grid_blocks) {
        int dev = 0, cus = 0, per_cu = 0;
        hipGetDevice(&dev);
        hipDeviceGetAttribute(&cus, hipDeviceAttributeMultiprocessorCount, dev);
        hipOccupancyMaxActiveBlocksPerMultiprocessor(&per_cu, mega, 256, 0);
        if (per_cu < 1) per_cu = 1;
        if (per_cu > 2) per_cu = 2;
        grid_blocks = cus * per_cu;
    }
    if (ws_size < WS_END) { fprintf(stderr, "workspace too small: %zu < %zu\n", ws_size, (size_t)WS_END); return; }
    Params p{};
    for (int i = 0; i < 26; ++i) p.in[i] = (const float*)d_in[i];
    p.out = (float*)d_out; p.ws = (char*)d_ws;
    hipMemsetAsync((char*)d_ws + OFF_BAR, 0, XCD_BAR_WORDS * sizeof(unsigned), stream);
#if MULTI_LAUNCH
    for (int ph = 0; ph < NPHASE; ++ph) mega<<<dim3(grid_blocks), dim3(256), 0, stream>>>(p, ph);
#else
    int only = -1;
    void* args[] = {&p, &only};
    hipError_t e = hipLaunchCooperativeKernel((void*)mega, dim3(grid_blocks), dim3(256), args, 0, stream);
    if (e != hipSuccess) fprintf(stderr, "cooperative launch failed: %s (grid %d)\n", hipGetErrorString(e), grid_blocks);
#endif
}
```

```cpp
#include <hip/hip_runtime.h>
#include <hip/hip_cooperative_groups.h>
#include <cstdio>
#include <cstdint>
namespace cg = cooperative_groups;

#ifndef MULTI_LAUNCH
#define MULTI_LAUNCH 0
#endif

#define DI __device__ __forceinline__
typedef unsigned short bf16_t;
typedef __bf16 bf16v2 __attribute__((ext_vector_type(2)));
typedef float f32x2 __attribute__((ext_vector_type(2)));
typedef short bf16x8 __attribute__((ext_vector_type(8)));
typedef short s16x4 __attribute__((ext_vector_type(4)));
typedef float f32x4 __attribute__((ext_vector_type(4)));
typedef float f32x16 __attribute__((ext_vector_type(16)));
typedef unsigned u32x4 __attribute__((ext_vector_type(4)));
typedef unsigned u32x2 __attribute__((ext_vector_type(2)));

constexpr int DM = 1024, SL = 2048, NSEQ = 40, G = 8, NGRP = NSEQ / G, TG = G * SL;
constexpr int INW = 4352, NIN = INW + 4096, DFF = 2816;
constexpr float EPS = 1e-6f;
constexpr float LOG2E = 1.4426950408889634f;

constexpr size_t WING = 0;
constexpr size_t WB = 8650752;
constexpr size_t WO = WB + 2097152;
constexpr size_t WFI = WO + 1048576;
constexpr size_t WFO = WFI + 5767168;
constexpr size_t WGLU = WFO + 2883584;
constexpr size_t LW = WGLU + 262144;

constexpr size_t OFF_W = 0;
constexpr size_t OFF_TAB = OFF_W + 4 * LW * 2;
constexpr size_t OFF_COSA = OFF_TAB, OFF_SINA = OFF_TAB + 262144, OFF_COSD = OFF_TAB + 2 * 262144, OFF_SIND = OFF_TAB + 3 * 262144;
constexpr size_t OFF_BIAS = OFF_TAB + 1048576;
constexpr size_t OFF_LAM = OFF_BIAS + 65536;
constexpr size_t OFF_QCNT = OFF_LAM + 256;
constexpr size_t OFF_BAR = OFF_TAB + 1048576 + 131072;
constexpr size_t OFF_H = OFF_TAB + 2097152;
constexpr size_t OFF_U = OFF_H + (size_t)TG * 1024 * 2;
constexpr size_t OFF_GATE = OFF_U + (size_t)TG * INW * 2;
constexpr size_t OFF_VTA = OFF_GATE + (size_t)TG * 4096 * 2;
constexpr size_t OFF_VTC = OFF_VTA + (size_t)TG * 128 * 2;
constexpr size_t OFF_VTD = OFF_VTC + (size_t)TG * 512 * 2;
constexpr size_t OFF_O = OFF_VTD + (size_t)TG * 512 * 2;
constexpr size_t OFF_YF = OFF_O + (size_t)4 * TG * 512 * 2;
constexpr size_t OFF_YB = OFF_YF + (size_t)TG * 512 * 2;
constexpr size_t OFF_DT = OFF_YB + (size_t)TG * 512 * 2;
constexpr size_t WS_END = OFF_DT + (size_t)2 * TG * 512 * 2;
constexpr size_t OFF_M = OFF_U;
constexpr size_t OFF_F = OFF_U;

struct Params { const float* in[26]; float* out; char* ws; };

enum { I_XP = 0, I_XS, I_NMIX, I_WIN, I_QG, I_KG, I_SARE, I_SAIM, I_SLDT, I_SBRE, I_SBIM, I_SCRE, I_SCIM, I_SD, I_SWGLU, I_SBGLU,
       I_DLAM, I_DSUB, I_REL, I_WGATE, I_WBR, I_WOUT, I_NFFN, I_WFI, I_WFO, I_NFIN };

constexpr int LDS_BYTES = 71680;
constexpr int AROWB = 144;
constexpr int ROWB = 128;
constexpr int GT_BYTES = 128 * ROWB;

DI int bidx() { int b = blockIdx.x; asm volatile("" : "+s"(b)); return b; }
DI int gdim() { int g = gridDim.x; asm volatile("" : "+s"(g)); return g; }
DI int tidx() { int t = threadIdx.x; asm volatile("" : "+v"(t)); return t; }
DI unsigned pk2(float a, float b) { f32x2 v = {a, b}; bf16v2 r = __builtin_convertvector(v, bf16v2); return __builtin_bit_cast(unsigned, r); }
DI float bf2f(bf16_t v) { return __uint_as_float(((unsigned)v) << 16); }
DI float bflo(unsigned w) { return __uint_as_float(w << 16); }
DI float bfhi(unsigned w) { return __uint_as_float(w & 0xffff0000u); }
DI float sigmoidf_(float x) { return __builtin_amdgcn_rcpf(1.0f + __builtin_amdgcn_exp2f(-LOG2E * x)); }
DI float wave_sum(float v) { v += __shfl_xor(v, 32); v += __shfl_xor(v, 16); v += __shfl_xor(v, 8); v += __shfl_xor(v, 4); v += __shfl_xor(v, 2); v += __shfl_xor(v, 1); return v; }
DI bf16_t* wts(const Params& p, int layer) { return (bf16_t*)(p.ws + OFF_W) + (size_t)layer * LW; }
#define MFMA16(a, b, c) __builtin_amdgcn_mfma_f32_16x16x32_bf16((a), (b), (c), 0, 0, 0)
#define MFMA32(a, b, c) __builtin_amdgcn_mfma_f32_32x32x16_bf16((a), (b), (c), 0, 0, 0)

template <bool SWAP, int BMAP>
DI void gemm_compute(const char* cur, int aoff, int boff, int sw, f32x4 (&acc)[4][4]) {
#pragma unroll
    for (int ks = 0; ks < 2; ++ks) {
        bf16x8 af[4], bfr[4];
        if (ks) asm volatile("" ::: "memory");
        const int so = sw ^ (ks * 64);
#pragma unroll
        for (int m = 0; m < 4; ++m) af[m] = *(const bf16x8*)(cur + aoff + m * 16 * ROWB + so);
#pragma unroll
        for (int n = 0; n < 4; ++n) bfr[n] = *(const bf16x8*)(cur + boff + (BMAP ? ((n >> 1) * 64 + (n & 1) * 16) : n * 16) * ROWB + so);
#pragma unroll
        for (int m = 0; m < 4; ++m)
#pragma unroll
            for (int n = 0; n < 4; ++n) acc[m][n] = SWAP ? MFMA16(bfr[n], af[m], acc[m][n]) : MFMA16(af[m], bfr[n], acc[m][n]);
    }
}
#define GLOAD(RA, RB, KT) { _Pragma("unroll") for (int i_ = 0; i_ < 4; ++i_) { \
    const char* ua_ = Ab + (size_t)(((32 * i_) * lda + (KT) * 64) * 2); const char* ub_ = Bb + (size_t)(((32 * i_) * ldb + (KT) * 64) * 2); \
    RA[i_] = *(const u32x4*)(ua_ + avoff); RB[i_] = *(const u32x4*)(ub_ + bvoff); } }
#define LSTORE(RA, RB, ST) { _Pragma("unroll") for (int i_ = 0; i_ < 4; ++i_) { *(u32x4*)(lds + (ST) * (2 * GT_BYTES) + soff + 32 * i_ * ROWB) = RA[i_]; *(u32x4*)(lds + (ST) * (2 * GT_BYTES) + GT_BYTES + soff + 32 * i_ * ROWB) = RB[i_]; } }
template <bool SWAP, int BMAP = 0, bool DEEP = true>
DI void gemm128(const bf16_t* __restrict__ A, int lda, const bf16_t* __restrict__ B, int ldb, int K, f32x4 (&acc)[4][4], char* lds) {
    const int tid = tidx(), lane = tid & 63, w = tid >> 6, wr = w >> 1, wc = w & 1;
    const int srow = tid >> 3, scol = tid & 7;
    const char* Ab = (const char*)A; const char* Bb = (const char*)B;
    const unsigned avoff = (unsigned)(srow * lda + scol * 8) * 2u, bvoff = (unsigned)(srow * ldb + scol * 8) * 2u;
    const int soff = srow * ROWB + ((scol ^ ((srow >> 1) & 7)) << 4);
    const int nk = K >> 6;
    const int aoff = (wr * 64 + (lane & 15)) * ROWB;
    const int boff = GT_BYTES + ((BMAP ? wc * 32 : wc * 64) + (lane & 15)) * ROWB;
    const int sw = ((lane >> 4) ^ ((lane & 15) >> 1)) << 4;
    u32x4 ra0[4], rb0[4];
    GLOAD(ra0, rb0, 0);
    LSTORE(ra0, rb0, 0);
    if (DEEP) {
        u32x4 ra1[4], rb1[4];
        GLOAD(ra1, rb1, 1);
        __syncthreads();
        for (int kt = 0; kt < nk; kt += 2) {
            { const int k2 = kt + 2 < nk ? kt + 2 : nk - 1; GLOAD(ra0, rb0, k2); }
            gemm_compute<SWAP, BMAP>(lds, aoff, boff, sw, acc);
            LSTORE(ra1, rb1, 1);
            __syncthreads();
            { const int k3 = kt + 3 < nk ? kt + 3 : nk - 1; GLOAD(ra1, rb1, k3); }
            gemm_compute<SWAP, BMAP>(lds + 2 * GT_BYTES, aoff, boff, sw, acc);
            LSTORE(ra0, rb0, 0);
            __syncthreads();
        }
    } else {
        __syncthreads();
        for (int kt = 0; kt < nk; ++kt) {
            const bool more = (kt + 1 < nk);
            if (more) GLOAD(ra0, rb0, kt + 1);
            gemm_compute<SWAP, BMAP>(lds + (kt & 1) * (2 * GT_BYTES), aoff, boff, sw, acc);
            if (more) { if (kt & 1) { LSTORE(ra0, rb0, 0); } else { LSTORE(ra0, rb0, 1); } }
            __syncthreads();
        }
    }
}

struct TileIter { int per, SM, SN, nSn, sbase, len, q, nslot; };
DI void ti_init(TileIter& it, int NTm, int NTn, int SM, int SN) {
    const int x = bidx() & 7;
    it.nslot = (gdim() - x + 7) >> 3; it.per = SM * SN; it.SM = SM; it.SN = SN; it.nSn = NTn / SN;
    const int nS = (NTm / SM) * it.nSn;
    it.sbase = x * (nS >> 3); it.len = (nS >> 3) * it.per; it.q = bidx() >> 3;
}
DI bool ti_next(TileIter& it, int& tm, int& tn) {
    if (it.q >= it.len) return false;
    const int j = it.q / it.per, w = it.q % it.per, S = it.sbase + j, sm = S / it.nSn, sn = S % it.nSn;
    tm = sm * it.SM + (w % it.SM); tn = sn * it.SN + (w / it.SM);
    it.q += it.nslot;
    return true;
}

struct GemmRegs { u32x4 a0[4], b0[4], a1[4], b1[4]; };
typedef const __attribute__((address_space(1))) char* gptr_t;
typedef const __attribute__((address_space(1))) u32x4* gvec_t;
DI gptr_t uptr(const void* q) {
    const size_t v = (size_t)q;
    const unsigned lo = __builtin_amdgcn_readfirstlane((unsigned)v), hi = __builtin_amdgcn_readfirstlane((unsigned)(v >> 32));
    return (gptr_t)(((size_t)hi << 32) | lo);
}
#define GLOADP(RA, RB, PA, PB, KT) { _Pragma("unroll") for (int i_ = 0; i_ < 4; ++i_) { \
    gptr_t ua_ = (PA) + (size_t)(((32 * i_) * lda + (KT) * 64) * 2); gptr_t ub_ = (PB) + (size_t)(((32 * i_) * ldb + (KT) * 64) * 2); \
    RA[i_] = *(gvec_t)(ua_ + avoff); RB[i_] = *(gvec_t)(ub_ + bvoff); } }
DI void gemm_prime(const bf16_t* A, int lda, const bf16_t* B, int ldb, GemmRegs& g) {
    const int tid = tidx(), srow = tid >> 3, scol = tid & 7;
    const unsigned avoff = (unsigned)(srow * lda + scol * 8) * 2u, bvoff = (unsigned)(srow * ldb + scol * 8) * 2u;
    gptr_t Ab = uptr(A); gptr_t Bb = uptr(B);
    GLOADP(g.a0, g.b0, Ab, Bb, 0);
    GLOADP(g.a1, g.b1, Ab, Bb, 1);
}
template <bool SWAP, int BMAP = 0>
DI void gemm_stream(const bf16_t* A, const bf16_t* B, const bf16_t* nA, const bf16_t* nB, int lda, int ldb, int K, GemmRegs& g, f32x4 (&acc)[4][4], char* lds) {
    const int tid = tidx(), lane = tid & 63, w = tid >> 6, wr = w >> 1, wc = w & 1;
    const int srow = tid >> 3, scol = tid & 7;
    const unsigned avoff = (unsigned)(srow * lda + scol * 8) * 2u, bvoff = (unsigned)(srow * ldb + scol * 8) * 2u;
    gptr_t Ab = uptr(A); gptr_t Bb = uptr(B); gptr_t nAb = uptr(nA); gptr_t nBb = uptr(nB);
    const int soff = srow * ROWB + ((scol ^ ((srow >> 1) & 7)) << 4);
    const int nk = K >> 6;
    const int aoff = (wr * 64 + (lane & 15)) * ROWB;
    const int boff = GT_BYTES + ((BMAP ? wc * 32 : wc * 64) + (lane & 15)) * ROWB;
    const int sw = ((lane >> 4) ^ ((lane & 15) >> 1)) << 4;
    LSTORE(g.a0, g.b0, 0);
    __syncthreads();
    for (int kt = 0; kt < nk; kt += 2) {
        const bool last = kt + 2 >= nk;
        gptr_t pa = last ? nAb : Ab; gptr_t pb = last ? nBb : Bb;
        const int k2 = last ? 0 : kt + 2, k3 = last ? 1 : kt + 3;
        GLOADP(g.a0, g.b0, pa, pb, k2);
        gemm_compute<SWAP, BMAP>(lds, aoff, boff, sw, acc);
        LSTORE(g.a1, g.b1, 1);
        __syncthreads();
        GLOADP(g.a1, g.b1, pa, pb, k3);
        gemm_compute<SWAP, BMAP>(lds + 2 * GT_BYTES, aoff, boff, sw, acc);
        if (!last) LSTORE(g.a0, g.b0, 0);
        __syncthreads();
    }
}

DI void zero_acc(f32x4 (&acc)[4][4]) {
#pragma unroll
    for (int m = 0; m < 4; ++m)
#pragma unroll
        for (int n = 0; n < 4; ++n) acc[m][n] = (f32x4){0.f, 0.f, 0.f, 0.f};
}


constexpr int OROW = 272;
constexpr int OROWF = 528;
DI void otile_put(char* lds, int row, int col, unsigned w0, unsigned w1) { u32x2 w; w[0] = w0; w[1] = w1; *(u32x2*)(lds + row * OROW + col * 2) = w; }
DI void otile_flush(char* lds, bf16_t* dst, int ld) {
    const int tid = tidx();
    __syncthreads();
#pragma unroll
    for (int i = 0; i < 8; ++i) {
        const int c = tid + 256 * i, row = c >> 4, ch = c & 15;
        const u32x4 v = *(const u32x4*)(lds + row * OROW + ch * 16);
        *(u32x4*)(dst + (size_t)row * ld + ch * 8) = v;
    }
    __syncthreads();
}

DI void conv_tile(const float* __restrict__ src, bf16_t* __restrict__ dst, int K, int N, int tk, int tn, int drow0, float* tile) {
    const int tid = tidx(), ty = tid >> 4, tx = tid & 15;
#pragma unroll
    for (int i = 0; i < 4; ++i) {
        const int k = ty + 16 * i;
        const f32x4 v = *(const f32x4*)(src + (size_t)(tk * 64 + k) * N + tn * 64 + tx * 4);
        tile[k * 65 + tx * 4 + 0] = v[0]; tile[k * 65 + tx * 4 + 1] = v[1]; tile[k * 65 + tx * 4 + 2] = v[2]; tile[k * 65 + tx * 4 + 3] = v[3];
    }
    __syncthreads();
    const int n = tid >> 2, ks = (tid & 3) * 16;
    u32x4 w0, w1;
#pragma unroll
    for (int j = 0; j < 4; ++j) {
        w0[j] = pk2(tile[(ks + 2 * j) * 65 + n], tile[(ks + 2 * j + 1) * 65 + n]);
        w1[j] = pk2(tile[(ks + 8 + 2 * j) * 65 + n], tile[(ks + 8 + 2 * j + 1) * 65 + n]);
    }
    bf16_t* d = dst + (size_t)(drow0 + n) * K + tk * 64 + ks;
    *(u32x4*)d = w0; *(u32x4*)(d + 8) = w1;
    __syncthreads();
}

DI int t5_bucket(int rel) {
    const int base = rel > 0 ? 16 : 0;
    const int dist = rel < 0 ? -rel : rel;
    int b;
    if (dist < 8) b = dist;
    else {
        const float lr = logf((float)dist / 8.0f) / 2.772588722239781f;
        int lg = 8 + (int)(lr * 8.0f);
        b = lg < 15 ? lg : 15;
    }
    return base + b;
}

DI void phase_prologue(const Params& p, char* lds) {
    float* tile = (float*)lds;
    const int tid = tidx();
    for (int t = bidx(); t < 4 * 5056; t += gdim()) {
        const int layer = t / 5056; int q = t % 5056;
        bf16_t* wl = wts(p, layer);
        const float* src; bf16_t* dst; int K, N, nn;
        if (q < 1088) { src = p.in[I_WIN] + (size_t)layer * 1024 * INW; dst = wl + WING; K = 1024; N = INW; }
        else if ((q -= 1088) < 1024) { const int b = q >> 8; q &= 255; src = p.in[I_WGATE] + (size_t)(layer * 4 + b) * 1024 * 1024; dst = wl + WING + (size_t)(INW + b * 1024) * 1024; K = 1024; N = 1024; }
        else if ((q -= 1024) < 512) { const int b = q >> 7; q &= 127; src = p.in[I_WBR] + (size_t)(layer * 4 + b) * 512 * 1024; dst = wl + WB + (size_t)b * 1024 * 512; K = 512; N = 1024; }
        else if ((q -= 512) < 256) { src = p.in[I_WOUT] + (size_t)layer * 1024 * 1024; dst = wl + WO; K = 1024; N = 1024; }
        else if ((q -= 256) < 1408) { src = p.in[I_WFI] + (size_t)layer * 1024 * 5632; dst = wl + WFI; K = 1024; N = 5632; }
        else if ((q -= 1408) < 704) { src = p.in[I_WFO] + (size_t)layer * DFF * 1024; dst = wl + WFO; K = DFF; N = 1024; }
        else { q -= 704; src = p.in[I_SWGLU] + (size_t)layer * 512 * 512; dst = wl + WGLU; K = 512; N = 512; }
        nn = N >> 6;
        const int tk = q / nn, tn = q % nn;
        int drow0 = tn * 64;
        if (N == 5632) drow0 = tn < 44 ? tn * 128 : (tn - 44) * 128 + 64;
        conv_tile(src, dst, K, N, tk, tn, drow0, tile);
    }
    const int gt = bidx() * 256 + tid, gn = gdim() * 256;
    float* cosA = (float*)(p.ws + OFF_COSA); float* sinA = (float*)(p.ws + OFF_SINA);
    float* cosD = (float*)(p.ws + OFF_COSD); float* sinD = (float*)(p.ws + OFF_SIND);
    for (int i = gt; i < SL * 32; i += gn) {
        const int t = i >> 5, j = i & 31;
        const float invA = exp2f(-(float)(j & 15) * (13.287712379549449f / 16.0f));
        const float angA = (j < 16 ? (float)(t >> 6) : (float)(t & 63)) * invA;
        cosA[i] = cosf(angA); sinA[i] = sinf(angA);
        const float invD = exp2f(-(float)j * (13.287712379549449f / 32.0f));
        const float angD = (float)t * invD;
        cosD[i] = cosf(angD); sinD[i] = sinf(angD);
    }
    float* bias = (float*)(p.ws + OFF_BIAS);
    for (int i = gt; i < 4 * 4096; i += gn) {
        const int h = i >> 12, r = i & 4095;
        float v = 0.f;
        if (r < 4095) v = p.in[I_REL][t5_bucket(r - 2047) * 4 + h] * LOG2E;
        bias[i] = v;
    }
    if (bidx() == 0) {
        if (tid < 4) {
            const float* lv = p.in[I_DLAM] + tid * 256;
            float s1 = 0.f, s2 = 0.f;
            for (int j = 0; j < 64; ++j) { s1 += lv[j] * lv[64 + j]; s2 += lv[128 + j] * lv[192 + j]; }
            const float li = 0.8f - 0.6f * expf(-0.3f * (float)tid);
            float* lam = (float*)(p.ws + OFF_LAM);
            lam[tid] = expf(s1) - expf(s2) + li; lam[4 + tid] = li;
        }
        if (tid < 64) ((int*)(p.ws + OFF_QCNT))[tid] = 0;
    }
}

DI const float* x_in_row(const Params& p, int grp, int row) {
    const int seq = grp * G + (row >> 11), t = row & 2047;
    return seq < 8 ? p.in[I_XP] + ((size_t)seq * SL + t) * DM : p.in[I_XS] + ((size_t)(seq - 8) * SL + t) * DM;
}
DI void phase_norm(const Params& p, int grp, const float* gain, int mode) {
    const int lane = tidx() & 63;
    const int gw = bidx() * 4 + (tidx() >> 6), nw = gdim() * 4;
    bf16_t* hb = (bf16_t*)(p.ws + OFF_H);
    f32x4 gv[4];
#pragma unroll
    for (int i = 0; i < 4; ++i) gv[i] = *(const f32x4*)(gain + lane * 4 + 256 * i);
    for (int row = gw; row < TG; row += nw) {
        float* xo = p.out + ((size_t)grp * TG + row) * DM;
        const float* x = mode == 0 ? x_in_row(p, grp, row) : xo;
        f32x4 v[4]; float ss = 0.f;
#pragma unroll
        for (int i = 0; i < 4; ++i) { v[i] = *(const f32x4*)(x + lane * 4 + 256 * i); ss += v[i][0] * v[i][0] + v[i][1] * v[i][1] + v[i][2] * v[i][2] + v[i][3] * v[i][3]; }
        ss = wave_sum(ss);
        const float rstd = rsqrtf(ss * (1.0f / 1024.0f) + EPS);
#pragma unroll
        for (int i = 0; i < 4; ++i) {
            const f32x4 y = v[i] * rstd * gv[i];
            if (mode == 2) *(f32x4*)(xo + lane * 4 + 256 * i) = y;
            else { u32x2 w; w[0] = pk2(y[0], y[1]); w[1] = pk2(y[2], y[3]); *(u32x2*)(hb + (size_t)row * DM + lane * 4 + 256 * i) = w; }
        }
    }
}

DI void phase_in(const Params& p, int layer, char* lds, bool probe = false) {
    const bf16_t* hb = (const bf16_t*)(p.ws + OFF_H);
    const bf16_t* W = wts(p, layer) + WING;
    bf16_t* ub = (bf16_t*)(p.ws + OFF_U);
    bf16_t* gb = (bf16_t*)(p.ws + OFF_GATE);
    constexpr int NT = NIN / 128;
    const int lane = tidx() & 63, w = tidx() >> 6, wr = w >> 1, wc = w & 1, r16 = lane & 15, q4 = lane >> 4;
    TileIter it; ti_init(it, TG / 128, NT, 8, 6);
    int tm, tn;
    while (ti_next(it, tm, tn)) {
        const int c0 = tn * 128;
        const bool isV = (c0 == 640) || (c0 >= 2304 && c0 < 2816) || (c0 >= 3328 && c0 < 3840);
        f32x4 acc[4][4]; zero_acc(acc);
        const int cb = c0 + wc * 64;
        if (isV) {
            gemm128<false>(hb + (size_t)tm * 128 * DM, DM, W + (size_t)c0 * DM, DM, DM, acc, lds);
            bf16_t* vt; int cl, DV, NH;
            if (cb < 768) { vt = (bf16_t*)(p.ws + OFF_VTA); cl = cb - 640; DV = 64; NH = 2; }
            else if (cb < 2816) { vt = (bf16_t*)(p.ws + OFF_VTC); cl = cb - 2304; DV = 128; NH = 4; }
            else { vt = (bf16_t*)(p.ws + OFF_VTD); cl = cb - 3328; DV = 128; NH = 4; }
#pragma unroll
            for (int m = 0; m < 4; ++m) {
                const int row0 = tm * 128 + wr * 64 + m * 16 + q4 * 4, seq = row0 >> 11, t0 = row0 & 2047;
#pragma unroll
                for (int n = 0; n < 4; ++n) {
                    const int col = cl + n * 16 + r16, head = col / DV, d = col % DV;
                    u32x2 wv; wv[0] = pk2(acc[m][n][0], acc[m][n][1]); wv[1] = pk2(acc[m][n][2], acc[m][n][3]);
                    *(u32x2*)(vt + ((size_t)(seq * NH + head) * DV + d) * SL + t0) = wv;
                }
            }
        } else {
            gemm128<true>(hb + (size_t)tm * 128 * DM, DM, W + (size_t)c0 * DM, DM, DM, acc, lds);
            bool donorm = false, dosig = false; int rot = 0; float scale = 1.f; const float* gain = nullptr;
            bf16_t* dst = ub; int ld = INW, dcol = cb;
            if (cb < 512) { donorm = true; rot = 1; scale = 0.125f * LOG2E; gain = p.in[I_QG] + layer * 64; }
            else if (cb < 640) { donorm = true; rot = 1; gain = p.in[I_KG] + layer * 64; }
            else if (cb < 1280) { }
            else if (cb < 1792) { scale = 0.125f * LOG2E; }
            else if (cb < 2816) { }
            else if (cb < 3072) { rot = 2; scale = 0.125f; }
            else if (cb < 3328) { rot = 2; }
            else if (cb < INW) { }
            else { dosig = true; dst = gb; ld = 4096; dcol = cb - INW; }
            float gl[4][4];
            if (donorm) {
#pragma unroll
                for (int n = 0; n < 4; ++n) { const f32x4 g4 = *(const f32x4*)(gain + n * 16 + q4 * 4); gl[n][0] = g4[0]; gl[n][1] = g4[1]; gl[n][2] = g4[2]; gl[n][3] = g4[3]; }
            }
            const float* ct = (const float*)(p.ws + (rot == 2 ? OFF_COSD : OFF_COSA));
            const float* sn = (const float*)(p.ws + (rot == 2 ? OFF_SIND : OFF_SINA));
#pragma unroll
            for (int m = 0; m < 4; ++m) {
                asm volatile("" ::: "memory");
                const int row = tm * 128 + wr * 64 + m * 16 + r16, tpos = row & 2047;
                float v[4][4];
#pragma unroll
                for (int n = 0; n < 4; ++n)
#pragma unroll
                    for (int i = 0; i < 4; ++i) v[n][i] = acc[m][n][i];
                if (donorm) {
                    float ss = 0.f;
#pragma unroll
                    for (int n = 0; n < 4; ++n)
#pragma unroll
                        for (int i = 0; i < 4; ++i) ss += v[n][i] * v[n][i];
                    ss += __shfl_xor(ss, 16); ss += __shfl_xor(ss, 32);
                    const float rstd = rsqrtf(ss * (1.0f / 64.0f) + EPS);
#pragma unroll
                    for (int n = 0; n < 4; ++n)
#pragma unroll
                        for (int i = 0; i < 4; ++i) v[n][i] = v[n][i] * rstd * gl[n][i];
                }
                if (rot) {
#pragma unroll
                    for (int n = 0; n < 2; ++n) {
                        const f32x4 c4 = *(const f32x4*)(ct + tpos * 32 + n * 16 + q4 * 4), s4 = *(const f32x4*)(sn + tpos * 32 + n * 16 + q4 * 4);
#pragma unroll
                        for (int i = 0; i < 4; ++i) { const float x1 = v[n][i], x2 = v[n + 2][i]; v[n][i] = x1 * c4[i] - x2 * s4[i]; v[n + 2][i] = x2 * c4[i] + x1 * s4[i]; }
                    }
                }
#pragma unroll
                for (int n = 0; n < 4; ++n) {
                    float o0, o1, o2, o3;
                    if (dosig) { o0 = sigmoidf_(v[n][0]); o1 = sigmoidf_(v[n][1]); o2 = sigmoidf_(v[n][2]); o3 = sigmoidf_(v[n][3]); }
                    else { o0 = v[n][0] * scale; o1 = v[n][1] * scale; o2 = v[n][2] * scale; o3 = v[n][3] * scale; }
                    otile_put(lds, wr * 64 + m * 16 + r16, wc * 64 + n * 16 + q4 * 4, pk2(o0, o1), pk2(o2, o3));
                }
            }
            otile_flush(lds, dst + (size_t)(tm * 128) * ld + (dcol - wc * 64), ld);
        }
    }
}

template <int DV, int MODE>
DI void attn_task(const Params& p, int task, char* lds) {
    constexpr int NDT = DV / 32;
    constexpr int STG = 64 * AROWB + DV * AROWB;
    const int tid = tidx(), lane = tid & 63, wave = tid >> 6, r = lane & 31, h = lane >> 5;
    const bf16_t* ub = (const bf16_t*)(p.ws + OFF_U);
    const int qt = task & 15; const int rest = task >> 4;
    int seq, head, map = 0, qcol, kcol; const bf16_t* vt;
    if (MODE == 0) { head = rest & 7; seq = rest >> 3; qcol = head * 64; kcol = 512 + (head >> 2) * 64; vt = (const bf16_t*)(p.ws + OFF_VTA) + (size_t)(seq * 2 + (head >> 2)) * 64 * SL; }
    else if (MODE == 1) { map = rest & 1; head = (rest >> 1) & 3; seq = rest >> 3; qcol = 1280 + head * 128 + map * 64; kcol = 1792 + head * 128 + map * 64; vt = (const bf16_t*)(p.ws + OFF_VTC) + (size_t)(seq * 4 + head) * 128 * SL; }
    else { head = rest & 3; seq = rest >> 2; qcol = 2816 + head * 64; kcol = 3072 + head * 64; vt = (const bf16_t*)(p.ws + OFF_VTD) + (size_t)(seq * 4 + head) * 128 * SL; }
    const int qpos = qt * 128 + wave * 32 + r;
    const bf16_t* qptr = ub + ((size_t)seq * SL + qpos) * INW + qcol;
    bf16x8 qf[4];
#pragma unroll
    for (int s = 0; s < 4; ++s) qf[s] = *(const bf16x8*)(qptr + 16 * s + 8 * h);
    const bf16_t* kbase = ub + (size_t)seq * SL * INW + kcol;
    float* sBias = (float*)(lds + 2 * STG);
    if (MODE == 1) { const float* bl = (const float*)(p.ws + OFF_BIAS) + head * 4096; for (int i = tid; i < 4096; i += 256) sBias[i] = bl[i]; }
    float lgam = 0.f;
    if (MODE == 2) lgam = log2f(1.0f - exp2f(-5.0f - (float)head));
    f32x16 o[NDT];
#pragma unroll
    for (int d = 0; d < NDT; ++d)
#pragma unroll
        for (int i = 0; i < 16; ++i) o[d][i] = 0.f;
    float lsum = 0.f;
    const int srow = tid >> 3, sc = tid & 7;
    const bf16_t* kg = kbase + (size_t)srow * INW + sc * 8;
    const bf16_t* vg = vt + (size_t)srow * SL + sc * 8;
    u32x4 rk[2], rv[NDT];
#pragma unroll
    for (int i = 0; i < 2; ++i) rk[i] = *(const u32x4*)(kg + (size_t)(32 * i) * INW);
#pragma unroll
    for (int i = 0; i < NDT; ++i) rv[i] = *(const u32x4*)(vg + (size_t)(32 * i) * SL);
    const int soff = srow * AROWB + sc * 16;
#pragma unroll
    for (int i = 0; i < 2; ++i) *(u32x4*)(lds + soff + 32 * i * AROWB) = rk[i];
#pragma unroll
    for (int i = 0; i < NDT; ++i) *(u32x4*)(lds + 64 * AROWB + soff + 32 * i * AROWB) = rv[i];
    __syncthreads();
    for (int kt = 0; kt < SL / 64; ++kt) {
        const char* cur = lds + (kt & 1) * STG;
        char* nxt = lds + ((kt + 1) & 1) * STG;
        const bool more = kt + 1 < SL / 64;
        const int kv0 = kt * 64;
        if (more) {
            kg += (size_t)64 * INW; vg += 64;
#pragma unroll
            for (int i = 0; i < 2; ++i) rk[i] = *(const u32x4*)(kg + (size_t)(32 * i) * INW);
#pragma unroll
            for (int i = 0; i < NDT; ++i) rv[i] = *(const u32x4*)(vg + (size_t)(32 * i) * SL);
        }
        f32x16 st[2];
#pragma unroll
        for (int kk = 0; kk < 2; ++kk) {
#pragma unroll
            for (int i = 0; i < 16; ++i) st[kk][i] = 0.f;
#pragma unroll
            for (int s = 0; s < 4; ++s) {
                const bf16x8 kf = *(const bf16x8*)(cur + (32 * kk + r) * AROWB + (16 * s + 8 * h) * 2);
                st[kk] = MFMA32(kf, qf[s], st[kk]);
            }
        }
        const int qw0 = qt * 128 + wave * 32;
        const bool farL = MODE == 1 && (kv0 + 63 - qw0) <= -128, farR = MODE == 1 && (kv0 - (qw0 + 31)) >= 128;
        if (MODE == 1 && (farL || farR)) {
            const float bc = farL ? sBias[0] : sBias[4094];
#pragma unroll
            for (int kk = 0; kk < 2; ++kk)
#pragma unroll
                for (int i = 0; i < 16; ++i) { const float pv = __builtin_amdgcn_exp2f(st[kk][i] + bc); lsum += pv; st[kk][i] = pv; }
        } else
#pragma unroll
        for (int kk = 0; kk < 2; ++kk)
#pragma unroll
            for (int i = 0; i < 16; ++i) {
                const int m = kv0 + 32 * kk + (i & 3) + 8 * (i >> 2) + 4 * h;
                float pv;
                if (MODE == 0) pv = __builtin_amdgcn_exp2f(st[kk][i]);
                else if (MODE == 1) pv = __builtin_amdgcn_exp2f(st[kk][i] + sBias[m - qpos + 2047]);
                else pv = st[kk][i] * __builtin_amdgcn_exp2f(lgam * fabsf((float)(qpos - m)));
                if (MODE != 2) lsum += pv;
                st[kk][i] = pv;
            }
        const char* sV = cur + 64 * AROWB;
#pragma unroll
        for (int kk = 0; kk < 2; ++kk)
#pragma unroll
            for (int s2 = 0; s2 < 2; ++s2) {
                u32x4 pw;
#pragma unroll
                for (int j = 0; j < 4; ++j) pw[j] = pk2(st[kk][8 * s2 + 2 * j], st[kk][8 * s2 + 2 * j + 1]);
                const bf16x8 pf = __builtin_bit_cast(bf16x8, pw);
#pragma unroll
                for (int d = 0; d < NDT; ++d) {
                    const char* va = sV + (32 * d + r) * AROWB + (32 * kk + 16 * s2 + 4 * h) * 2;
                    const s16x4 lo = *(const s16x4*)va, hi = *(const s16x4*)(va + 16);
                    const bf16x8 vf = __builtin_shufflevector(lo, hi, 0, 1, 2, 3, 4, 5, 6, 7);
                    o[d] = MFMA32(vf, pf, o[d]);
                }
            }
        if (more) {
#pragma unroll
            for (int i = 0; i < 2; ++i) *(u32x4*)(nxt + soff + 32 * i * AROWB) = rk[i];
#pragma unroll
            for (int i = 0; i < NDT; ++i) *(u32x4*)(nxt + 64 * AROWB + soff + 32 * i * AROWB) = rv[i];
        }
        __syncthreads();
    }
    const size_t tok = (size_t)seq * SL + qpos;
    if (MODE != 2) {
        const float ltot = lsum + __shfl_xor(lsum, 32);
        const float inv = __builtin_amdgcn_rcpf(ltot);
        bf16_t* dst = MODE == 0 ? (bf16_t*)(p.ws + OFF_O) + tok * 512 + head * 64
                                : (bf16_t*)(p.ws + OFF_DT) + ((size_t)map * TG + tok) * 512 + head * 128;
#pragma unroll
        for (int d = 0; d < NDT; ++d)
#pragma unroll
            for (int a = 0; a < 4; ++a) {
                u32x2 wv; wv[0] = pk2(o[d][4 * a] * inv, o[d][4 * a + 1] * inv); wv[1] = pk2(o[d][4 * a + 2] * inv, o[d][4 * a + 3] * inv);
                *(u32x2*)(dst + 32 * d + 8 * a + 4 * h) = wv;
            }
    } else {
        float s = 0.f;
#pragma unroll
        for (int d = 0; d < NDT; ++d)
#pragma unroll
            for (int i = 0; i < 16; ++i) s += o[d][i];
        s += __shfl_xor(s, 32);
        const float mu = s * (1.0f / 128.0f);
        float vs = 0.f;
#pragma unroll
        for (int d = 0; d < NDT; ++d)
#pragma unroll
            for (int i = 0; i < 16; ++i) { const float dd = o[d][i] - mu; vs += dd * dd; }
        vs += __shfl_xor(vs, 32);
        const float rstd = rsqrtf(vs * (1.0f / 128.0f) + EPS);
        const bf16_t* gp = ub + tok * INW + 3840 + head * 128;
        bf16_t* dst = (bf16_t*)(p.ws + OFF_O) + ((size_t)3 * TG + tok) * 512 + head * 128;
#pragma unroll
        for (int d = 0; d < NDT; ++d)
#pragma unroll
            for (int a = 0; a < 4; ++a) {
                asm volatile("" ::: "memory");
                const u32x2 gw = *(const u32x2*)(gp + 32 * d + 8 * a + 4 * h);
                const float g0 = bflo(gw[0]), g1 = bfhi(gw[0]), g2 = bflo(gw[1]), g3 = bfhi(gw[1]);
                const float y0 = (o[d][4 * a] - mu) * rstd * g0 * sigmoidf_(g0), y1 = (o[d][4 * a + 1] - mu) * rstd * g1 * sigmoidf_(g1);
                const float y2 = (o[d][4 * a + 2] - mu) * rstd * g2 * sigmoidf_(g2), y3 = (o[d][4 * a + 3] - mu) * rstd * g3 * sigmoidf_(g3);
                u32x2 wv; wv[0] = pk2(y0, y1); wv[1] = pk2(y2, y3);
                *(u32x2*)(dst + 32 * d + 8 * a + 4 * h) = wv;
            }
    }
}

DI void attn_gqa2(const Params& p, int task, char* lds) {
    constexpr int DV = 64, NDT = 2;
    constexpr int STG = 64 * AROWB + DV * AROWB;
    const int tid = tidx(), lane = tid & 63, wave = tid >> 6, r = lane & 31, h = lane >> 5;
    const bf16_t* ub = (const bf16_t*)(p.ws + OFF_U);
    const int qt = task & 7, rest = task >> 3, head = rest & 7, seq = rest >> 3;
    const int qcol = head * 64, kcol = 512 + (head >> 2) * 64;
    const bf16_t* vt = (const bf16_t*)(p.ws + OFF_VTA) + (size_t)(seq * 2 + (head >> 2)) * 64 * SL;
    const int qpos0 = qt * 256 + wave * 64 + r;
    bf16x8 qf[2][4];
#pragma unroll
    for (int qs = 0; qs < 2; ++qs) {
        const bf16_t* qptr = ub + ((size_t)seq * SL + qpos0 + 32 * qs) * INW + qcol;
#pragma unroll
        for (int s = 0; s < 4; ++s) qf[qs][s] = *(const bf16x8*)(qptr + 16 * s + 8 * h);
    }
    const bf16_t* kbase = ub + (size_t)seq * SL * INW + kcol;
    f32x16 o[2][NDT];
#pragma unroll
    for (int qs = 0; qs < 2; ++qs)
#pragma unroll
        for (int d = 0; d < NDT; ++d)
#pragma unroll
            for (int i = 0; i < 16; ++i) o[qs][d][i] = 0.f;
    float lsum[2] = {0.f, 0.f};
    const int srow = tid >> 3, sc = tid & 7;
    const bf16_t* kg = kbase + (size_t)srow * INW + sc * 8;
    const bf16_t* vg = vt + (size_t)srow * SL + sc * 8;
    u32x4 rk[2], rv[NDT];
#pragma unroll
    for (int i = 0; i < 2; ++i) rk[i] = *(const u32x4*)(kg + (size_t)(32 * i) * INW);
#pragma unroll
    for (int i = 0; i < NDT; ++i) rv[i] = *(const u32x4*)(vg + (size_t)(32 * i) * SL);
    const int soff = srow * AROWB + sc * 16;
#pragma unroll
    for (int i = 0; i < 2; ++i) *(u32x4*)(lds + soff + 32 * i * AROWB) = rk[i];
#pragma unroll
    for (int i = 0; i < NDT; ++i) *(u32x4*)(lds + 64 * AROWB + soff + 32 * i * AROWB) = rv[i];
    __syncthreads();
    for (int kt = 0; kt < SL / 64; ++kt) {
        const char* cur = lds + (kt & 1) * STG;
        char* nxt = lds + ((kt + 1) & 1) * STG;
        const bool more = kt + 1 < SL / 64;
        if (more) {
            kg += (size_t)64 * INW; vg += 64;
#pragma unroll
            for (int i = 0; i < 2; ++i) rk[i] = *(const u32x4*)(kg + (size_t)(32 * i) * INW);
#pragma unroll
            for (int i = 0; i < NDT; ++i) rv[i] = *(const u32x4*)(vg + (size_t)(32 * i) * SL);
        }
        f32x16 st[2][2];
#pragma unroll
        for (int kk = 0; kk < 2; ++kk) {
#pragma unroll
            for (int i = 0; i < 16; ++i) { st[0][kk][i] = 0.f; st[1][kk][i] = 0.f; }
#pragma unroll
            for (int s = 0; s < 4; ++s) {
                const bf16x8 kf = *(const bf16x8*)(cur + (32 * kk + r) * AROWB + (16 * s + 8 * h) * 2);
                st[0][kk] = MFMA32(kf, qf[0][s], st[0][kk]);
                st[1][kk] = MFMA32(kf, qf[1][s], st[1][kk]);
            }
        }
#pragma unroll
        for (int qs = 0; qs < 2; ++qs)
#pragma unroll
            for (int kk = 0; kk < 2; ++kk)
#pragma unroll
                for (int i = 0; i < 16; ++i) { const float pv = __builtin_amdgcn_exp2f(st[qs][kk][i]); lsum[qs] += pv; st[qs][kk][i] = pv; }
        const char* sV = cur + 64 * AROWB;
#pragma unroll
        for (int kk = 0; kk < 2; ++kk)
#pragma unroll
            for (int s2 = 0; s2 < 2; ++s2) {
                bf16x8 pf[2];
#pragma unroll
                for (int qs = 0; qs < 2; ++qs) {
                    u32x4 pw;
#pragma unroll
                    for (int j = 0; j < 4; ++j) pw[j] = pk2(st[qs][kk][8 * s2 + 2 * j], st[qs][kk][8 * s2 + 2 * j + 1]);
                    pf[qs] = __builtin_bit_cast(bf16x8, pw);
                }
#pragma unroll
                for (int d = 0; d < NDT; ++d) {
                    const char* va = sV + (32 * d + r) * AROWB + (32 * kk + 16 * s2 + 4 * h) * 2;
                    const s16x4 lo = *(const s16x4*)va, hi = *(const s16x4*)(va + 16);
                    const bf16x8 vf = __builtin_shufflevector(lo, hi, 0, 1, 2, 3, 4, 5, 6, 7);
                    o[0][d] = MFMA32(vf, pf[0], o[0][d]);
                    o[1][d] = MFMA32(vf, pf[1], o[1][d]);
                }
            }
        if (more) {
#pragma unroll
            for (int i = 0; i < 2; ++i) *(u32x4*)(nxt + soff + 32 * i * AROWB) = rk[i];
#pragma unroll
            for (int i = 0; i < NDT; ++i) *(u32x4*)(nxt + 64 * AROWB + soff + 32 * i * AROWB) = rv[i];
        }
        __syncthreads();
    }
#pragma unroll
    for (int qs = 0; qs < 2; ++qs) {
        const size_t tok = (size_t)seq * SL + qpos0 + 32 * qs;
        const float ltot = lsum[qs] + __shfl_xor(lsum[qs], 32);
        const float inv = __builtin_amdgcn_rcpf(ltot);
        bf16_t* dst = (bf16_t*)(p.ws + OFF_O) + tok * 512 + head * 64;
#pragma unroll
        for (int d = 0; d < NDT; ++d)
#pragma unroll
            for (int a = 0; a < 4; ++a) {
                u32x2 wv; wv[0] = pk2(o[qs][d][4 * a] * inv, o[qs][d][4 * a + 1] * inv); wv[1] = pk2(o[qs][d][4 * a + 2] * inv, o[qs][d][4 * a + 3] * inv);
                *(u32x2*)(dst + 32 * d + 8 * a + 4 * h) = wv;
            }
    }
}

DI void tr_read8(unsigned a, s16x4 (&v)[8]) {
    asm volatile("ds_read_b64_tr_b16 %0, %8\n\tds_read_b64_tr_b16 %1, %8 offset:256\n\tds_read_b64_tr_b16 %2, %8 offset:1024\n\tds_read_b64_tr_b16 %3, %8 offset:1280\n\t"
                 "ds_read_b64_tr_b16 %4, %8 offset:2048\n\tds_read_b64_tr_b16 %5, %8 offset:2304\n\tds_read_b64_tr_b16 %6, %8 offset:3072\n\tds_read_b64_tr_b16 %7, %8 offset:3328\n\t"
                 "s_waitcnt lgkmcnt(0)"
                 : "=&v"(v[0]), "=&v"(v[1]), "=&v"(v[2]), "=&v"(v[3]), "=&v"(v[4]), "=&v"(v[5]), "=&v"(v[6]), "=&v"(v[7]) : "v"(a) : "memory");
}

DI void s5_wave_task(const Params& p, int layer, int wt, char* ldsw) {
    const int lane = tidx() & 63, r = lane & 31, h = lane >> 5;
    const int dir = wt & 1, g = (wt >> 1) & 31, pair = wt >> 6;
    const bf16_t* ub = (const bf16_t*)(p.ws + OFF_U);
    const int hp = (r >> 2) & 1, ia = 4 * (r >> 3) + (r & 3);
    const unsigned img = (unsigned)(size_t)ldsw;
    char* chunkbuf = ldsw + 8192;
    const int i16 = lane & 15, tq = i16 >> 2, tp = i16 & 3, blk = (lane >> 4) & 1;
    const unsigned trA = img + (8 * h + tq) * 64 + 8 * (4 * blk + tp);
    const float dsk = r < 16 ? p.in[I_SD][layer * 512 + g * 16 + r] : 0.f;
    bf16_t* yl = (bf16_t*)(p.ws + (dir ? OFF_YB : OFF_YF)) + ((size_t)(2 * pair + h) * 512 + g * 16 + (r & 15)) * SL;
    const int pb = (layer * 2 + dir) * 32 + g;
    const float dt = expf(p.in[I_SLDT][pb]);
    float abr[2], abi[2];
    bf16x8 bfrag[2][2], cfrag[2][2][2], dfrag;
    {
        u32x4 dw;
#pragma unroll
        for (int j = 0; j < 4; ++j) dw[j] = pk2((dir == 0 && r == 8 * h + 2 * j) ? dsk : 0.f, (dir == 0 && r == 8 * h + 2 * j + 1) ? dsk : 0.f);
        dfrag = __builtin_bit_cast(bf16x8, dw);
    }
#pragma unroll
    for (int st = 0; st < 2; ++st) {
        const int n = 32 * st + r;
        const float are = p.in[I_SARE][pb * 64 + n], aim = p.in[I_SAIM][pb * 64 + n];
        const float mag = expf(dt * are);
        abr[st] = mag * cosf(dt * aim); abi[st] = mag * sinf(dt * aim);
        const float den = are * are + aim * aim, nr = abr[st] - 1.0f;
        const float fre = (nr * are + abi[st] * aim) / den, fim = (abi[st] * are - nr * aim) / den;
        const float* bre = p.in[I_SBRE] + ((size_t)pb * 64 + n) * 16 + 8 * h;
        const float* bim = p.in[I_SBIM] + ((size_t)pb * 64 + n) * 16 + 8 * h;
        u32x4 wre, wim;
#pragma unroll
        for (int j = 0; j < 4; ++j) {
            const float br0 = bre[2 * j], bi0 = bim[2 * j], br1 = bre[2 * j + 1], bi1 = bim[2 * j + 1];
            wre[j] = pk2(fre * br0 - fim * bi0, fre * br1 - fim * bi1);
            wim[j] = pk2(fre * bi0 + fim * br0, fre * bi1 + fim * br1);
        }
        bfrag[st][0] = __builtin_bit_cast(bf16x8, wre); bfrag[st][1] = __builtin_bit_cast(bf16x8, wim);
#pragma unroll
        for (int s = 0; s < 2; ++s) {
            u32x4 cr = {0u, 0u, 0u, 0u}, ci = {0u, 0u, 0u, 0u};
            if (r < 16) {
                const float* cre = p.in[I_SCRE] + ((size_t)pb * 16 + r) * 64 + 32 * st + 16 * s + 8 * h;
                const float* cim = p.in[I_SCIM] + ((size_t)pb * 16 + r) * 64 + 32 * st + 16 * s + 8 * h;
#pragma unroll
                for (int j = 0; j < 4; ++j) { cr[j] = pk2(cre[2 * j], cre[2 * j + 1]); ci[j] = pk2(-cim[2 * j], -cim[2 * j + 1]); }
            }
            cfrag[st][s][0] = __builtin_bit_cast(bf16x8, cr); cfrag[st][s][1] = __builtin_bit_cast(bf16x8, ci);
        }
    }
    float sre[2] = {0.f, 0.f}, sim[2] = {0.f, 0.f};
    const bf16_t* gsrc[4]; int loff[4];
#pragma unroll
    for (int j = 0; j < 4; ++j) {
        const int c = lane + 64 * j, row = c >> 1, half = c & 1, ss = row >> 6, tau = row & 63;
        gsrc[j] = ub + ((size_t)(2 * pair + ss) * SL + (dir ? (SL - 1 - tau) : tau)) * INW + 768 + g * 16 + half * 8;
        loff[j] = row * 32 + half * 16;
    }
    const long cstep = dir ? -(long)64 * INW : (long)64 * INW;
    u32x4 crg[4];
#pragma unroll
    for (int j = 0; j < 4; ++j) crg[j] = *(const u32x4*)gsrc[j];
#pragma unroll
    for (int j = 0; j < 4; ++j) *(u32x4*)(chunkbuf + loff[j]) = crg[j];
    const int aoff = (hp * 64 + ia) * 32 + h * 16;
    for (int chunk = 0; chunk < SL / 64; ++chunk) {
        if (chunk + 1 < SL / 64) {
#pragma unroll
            for (int j = 0; j < 4; ++j) { gsrc[j] += cstep; crg[j] = *(const u32x4*)gsrc[j]; }
        }
        const char* cb = chunkbuf + (chunk & 1) * 4096;
#pragma unroll 1
        for (int tl = 0; tl < 4; ++tl) {
            const int s0 = chunk * 64 + tl * 16;
            const bf16x8 ua = *(const bf16x8*)(cb + aoff + tl * 512);
            f32x16 z;
#pragma unroll
            for (int i = 0; i < 16; ++i) z[i] = 0.f;
            f32x16 y0 = MFMA32(ua, dfrag, z);
            f32x16 y1 = z;
#pragma unroll
            for (int st = 0; st < 2; ++st) {
                f32x16 xr = MFMA32(ua, bfrag[st][0], z);
                f32x16 xi = MFMA32(ua, bfrag[st][1], z);
                float cr = sre[st], ci = sim[st];
#pragma unroll
                for (int i = 0; i < 16; ++i) {
                    const float nr = abr[st] * cr - abi[st] * ci + xr[i];
                    const float ni = abr[st] * ci + abi[st] * cr + xi[i];
                    cr = nr; ci = ni; xr[i] = nr; xi[i] = ni;
                }
                sre[st] = cr; sim[st] = ci;
#pragma unroll
                for (int a = 0; a < 4; ++a) {
                    u32x2 w0, w1; w0[0] = pk2(xr[4 * a], xr[4 * a + 1]); w0[1] = pk2(xr[4 * a + 2], xr[4 * a + 3]);
                    w1[0] = pk2(xi[4 * a], xi[4 * a + 1]); w1[1] = pk2(xi[4 * a + 2], xi[4 * a + 3]);
                    *(u32x2*)(ldsw + (st * 2 + 0) * 2048 + r * 64 + 8 * (2 * a + h)) = w0;
                    *(u32x2*)(ldsw + (st * 2 + 1) * 2048 + r * 64 + 8 * (2 * a + h)) = w1;
                }
            }
            asm volatile("s_waitcnt lgkmcnt(0)" ::: "memory");
            {
                s16x4 v[8];
                tr_read8(trA, v);
                y0 = MFMA32(__builtin_shufflevector(v[0], v[1], 0, 1, 2, 3, 4, 5, 6, 7), cfrag[0][0][0], y0);
                y0 = MFMA32(__builtin_shufflevector(v[2], v[3], 0, 1, 2, 3, 4, 5, 6, 7), cfrag[0][1][0], y0);
                y0 = MFMA32(__builtin_shufflevector(v[4], v[5], 0, 1, 2, 3, 4, 5, 6, 7), cfrag[0][0][1], y0);
                y0 = MFMA32(__builtin_shufflevector(v[6], v[7], 0, 1, 2, 3, 4, 5, 6, 7), cfrag[0][1][1], y0);
                s16x4 u[8];
                tr_read8(trA + 4096, u);
                y1 = MFMA32(__builtin_shufflevector(u[0], u[1], 0, 1, 2, 3, 4, 5, 6, 7), cfrag[1][0][0], y1);
                y1 = MFMA32(__builtin_shufflevector(u[2], u[3], 0, 1, 2, 3, 4, 5, 6, 7), cfrag[1][1][0], y1);
                y1 = MFMA32(__builtin_shufflevector(u[4], u[5], 0, 1, 2, 3, 4, 5, 6, 7), cfrag[1][0][1], y1);
                y1 = MFMA32(__builtin_shufflevector(u[6], u[7], 0, 1, 2, 3, 4, 5, 6, 7), cfrag[1][1][1], y1);
            }
            if (r < 16) {
                u32x4 o0, o1;
                if (dir == 0) {
#pragma unroll
                    for (int j = 0; j < 4; ++j) { o0[j] = pk2(y0[2 * j] + y1[2 * j], y0[2 * j + 1] + y1[2 * j + 1]); o1[j] = pk2(y0[8 + 2 * j] + y1[8 + 2 * j], y0[9 + 2 * j] + y1[9 + 2 * j]); }
                    *(u32x4*)(yl + s0) = o0; *(u32x4*)(yl + s0 + 8) = o1;
                } else {
#pragma unroll
                    for (int j = 0; j < 4; ++j) { o0[j] = pk2(y0[15 - 2 * j] + y1[15 - 2 * j], y0[14 - 2 * j] + y1[14 - 2 * j]); o1[j] = pk2(y0[7 - 2 * j] + y1[7 - 2 * j], y0[6 - 2 * j] + y1[6 - 2 * j]); }
                    *(u32x4*)(yl + (SL - 16 - s0)) = o0; *(u32x4*)(yl + (SL - 16 - s0) + 8) = o1;
                }
            }
        }
        if (chunk + 1 < SL / 64) {
#pragma unroll
            for (int j = 0; j < 4; ++j) *(u32x4*)(chunkbuf + ((chunk + 1) & 1) * 4096 + loff[j]) = crg[j];
        }
    }
}

DI void phase_mix(const Params& p, int layer, int qidx, char* lds, bool only_s5 = false) {
    __shared__ int s_task;
    int* qc = (int*)(p.ws + OFF_QCNT) + qidx;
    constexpr int N_S5 = (G / 2) * 32 * 2 / 4, N_DIFF = G * 4 * 2 * 16, N_RET = G * 4 * 16, N_GQA = G * 8 * 8;
    constexpr int NTOT = N_S5 + N_DIFF + N_RET + N_GQA;
    for (;;) {
        __syncthreads();
        if (tidx() == 0) s_task = atomicAdd(qc, 1);
        __syncthreads();
        int task = s_task;
        if (task >= (only_s5 ? N_S5 : NTOT)) break;
        if (task < N_S5) { const int wave = tidx() >> 6; s5_wave_task(p, layer, task * 4 + wave, lds + wave * 16384); }
        else if ((task -= N_S5) < N_DIFF) attn_task<128, 1>(p, task, lds);
        else if ((task -= N_DIFF) < N_RET) attn_task<128, 2>(p, task, lds);
        else attn_gqa2(p, task - N_RET, lds);
    }
}

DI float gelu_tanh(float v) { const float z2 = 1.5957691216057308f * (v + 0.044715f * v * v * v); return v * __builtin_amdgcn_rcpf(1.0f + __builtin_amdgcn_exp2f(-LOG2E * z2)); }

DI void glu_tile(const Params& p, int layer, int tm, int tn, char* lds) {
    const int tid = tidx(), lane = tid & 63, w = tid >> 6, wr = w >> 1, wc = w & 1, r16 = lane & 15, q4 = lane >> 4;
    const bf16_t* yf = (const bf16_t*)(p.ws + OFF_YF);
    const bf16_t* yb = (const bf16_t*)(p.ws + OFF_YB);
    const bf16_t* B = wts(p, layer) + WGLU + (size_t)tn * 128 * 512;
    const int seq = (tm * 128) >> 11, t0 = (tm * 128) & 2047;
    const int ach = tid & 63, aseg0 = tid >> 6;
    const bf16_t* fg = yf + ((size_t)seq * 512 + ach) * SL + t0;
    const bf16_t* bg2 = yb + ((size_t)seq * 512 + ach) * SL + t0;
    const int srow = tid >> 3, scol = tid & 7;
    const bf16_t* bg = B + (size_t)srow * 512 + scol * 8;
    const int soff = srow * ROWB + ((scol ^ ((srow >> 1) & 7)) << 4);
    u32x4 rf[4], rbk[4], rb[4];
    f32x4 acc[4][4]; zero_acc(acc);
    const int aoff = (wr * 64 + (lane & 15)) * ROWB;
    const int boff = GT_BYTES + (wc * 64 + (lane & 15)) * ROWB;
    const int sw = ((lane >> 4) ^ ((lane & 15) >> 1)) << 4;
    for (int kt = 0; kt < 8; ++kt) {
#pragma unroll
        for (int j = 0; j < 4; ++j) {
            rf[j] = *(const u32x4*)(fg + (size_t)kt * 64 * SL + (aseg0 + 4 * j) * 8);
            rbk[j] = *(const u32x4*)(bg2 + (size_t)kt * 64 * SL + (aseg0 + 4 * j) * 8);
            rb[j] = *(const u32x4*)(bg + (size_t)(32 * j) * 512 + kt * 64);
        }
#pragma unroll
        for (int j = 0; j < 4; ++j) {
            *(u32x4*)(lds + GT_BYTES + soff + 32 * j * ROWB) = rb[j];
            char* abase = lds + (aseg0 + 4 * j) * 8 * ROWB + (ach & 7) * 2;
#pragma unroll
            for (int e = 0; e < 4; ++e) {
                const float v0 = gelu_tanh(bflo(rf[j][e]) + bflo(rbk[j][e])), v1 = gelu_tanh(bfhi(rf[j][e]) + bfhi(rbk[j][e]));
                const unsigned pw = pk2(v0, v1);
                const int cs = (((ach >> 3) ^ ((4 * aseg0 + e) & 7)) << 4);
                *(bf16_t*)(abase + (2 * e) * ROWB + cs) = (bf16_t)(pw & 0xffffu);
                *(bf16_t*)(abase + (2 * e + 1) * ROWB + cs) = (bf16_t)(pw >> 16);
            }
        }
        __syncthreads();
        gemm_compute<false, 0>(lds, aoff, boff, sw, acc);
        __syncthreads();
    }
    bf16_t* ob = (bf16_t*)(p.ws + OFF_O) + (size_t)1 * TG * 512;
    const float* bgl = p.in[I_SBGLU] + layer * 512;
#pragma unroll
    for (int n = 0; n < 4; ++n) {
        const int ch = tn * 128 + wc * 64 + n * 16 + r16;
        const float bias = bgl[ch];
#pragma unroll
        for (int m = 0; m < 4; ++m) {
            const int tl = wr * 64 + m * 16 + q4 * 4;
            const u32x2 fw = *(const u32x2*)(yf + ((size_t)seq * 512 + ch) * SL + t0 + tl);
            const u32x2 bw = *(const u32x2*)(yb + ((size_t)seq * 512 + ch) * SL + t0 + tl);
            const float y0 = gelu_tanh(bflo(fw[0]) + bflo(bw[0])), y1 = gelu_tanh(bfhi(fw[0]) + bfhi(bw[0]));
            const float y2 = gelu_tanh(bflo(fw[1]) + bflo(bw[1])), y3 = gelu_tanh(bfhi(fw[1]) + bfhi(bw[1]));
            const unsigned w01 = pk2(y0 * sigmoidf_(acc[m][n][0] + bias), y1 * sigmoidf_(acc[m][n][1] + bias));
            const unsigned w23 = pk2(y2 * sigmoidf_(acc[m][n][2] + bias), y3 * sigmoidf_(acc[m][n][3] + bias));
            bf16_t* orow = ob + (size_t)(tm * 128 + tl) * 512 + ch;
            orow[0] = (bf16_t)(w01 & 0xffffu); orow[512] = (bf16_t)(w01 >> 16); orow[1024] = (bf16_t)(w23 & 0xffffu); orow[1536] = (bf16_t)(w23 >> 16);
        }
    }
}

DI void phase_glu(const Params& p, int layer, char* lds) {
    const int lane = tidx() & 63, w = tidx() >> 6;
    { TileIter it; ti_init(it, TG / 128, 4, 16, 4); int tm, tn; while (ti_next(it, tm, tn)) glu_tile(p, layer, tm, tn, lds); }
    const float lam = ((const float*)(p.ws + OFF_LAM))[layer], li = ((const float*)(p.ws + OFF_LAM))[4 + layer];
    const bf16_t* d0 = (const bf16_t*)(p.ws + OFF_DT); const bf16_t* d1 = d0 + (size_t)TG * 512;
    bf16_t* oc = (bf16_t*)(p.ws + OFF_O) + (size_t)2 * TG * 512;
    const f32x2 sg = *(const f32x2*)(p.in[I_DSUB] + layer * 128 + 2 * lane);
    const int gw = bidx() * 4 + w, nw = gdim() * 4;
    for (int it0 = gw; it0 < TG * 4; it0 += 8 * nw) {
        unsigned a[8], b[8];
#pragma unroll
        for (int j = 0; j < 8; ++j) {
            const int it = it0 + j * nw;
            const size_t off = (size_t)(it < TG * 4 ? it : gw) * 128 + 2 * lane;
            a[j] = *(const unsigned*)(d0 + off); b[j] = *(const unsigned*)(d1 + off);
        }
#pragma unroll
        for (int j = 0; j < 8; ++j) {
            const int it = it0 + j * nw;
            const float v0 = bflo(a[j]) - lam * bflo(b[j]), v1 = bfhi(a[j]) - lam * bfhi(b[j]);
            const float ss = wave_sum(v0 * v0 + v1 * v1);
            const float rs = rsqrtf(ss * (1.0f / 128.0f) + EPS) * (1.0f - li);
            if (it < TG * 4) *(unsigned*)(oc + (size_t)it * 128 + 2 * lane) = pk2(v0 * rs * sg[0], v1 * rs * sg[1]);
        }
    }
}

DI void phase_merge(const Params& p, int layer, char* lds) {
    const int lane = tidx() & 63, w = tidx() >> 6, wr = w >> 1, wc = w & 1, r16 = lane & 15, q4 = lane >> 4;
    const bf16_t* ob = (const bf16_t*)(p.ws + OFF_O);
    const bf16_t* gb = (const bf16_t*)(p.ws + OFF_GATE);
    const bf16_t* W = wts(p, layer) + WB;
    bf16_t* mb = (bf16_t*)(p.ws + OFF_M);
    TileIter it; ti_init(it, TG / 128, 8, 8, 8);
    int tm, tn;
    while (ti_next(it, tm, tn)) {
        f32x4 macc[4][4]; zero_acc(macc);
#pragma unroll 1
        for (int b = 0; b < 4; ++b) {
            f32x4 acc[4][4]; zero_acc(acc);
            gemm128<true, 0, false>(ob + ((size_t)b * TG + tm * 128) * 512, 512, W + ((size_t)b * 1024 + tn * 128) * 512, 512, 512, acc, lds);
#pragma unroll
            for (int m = 0; m < 4; ++m) {
                const int row = tm * 128 + wr * 64 + m * 16 + r16;
#pragma unroll
                for (int n = 0; n < 4; ++n) {
                    const int col = tn * 128 + wc * 64 + n * 16 + q4 * 4;
                    const u32x2 gw = *(const u32x2*)(gb + (size_t)row * 4096 + b * 1024 + col);
                    macc[m][n][0] += acc[m][n][0] * bflo(gw[0]); macc[m][n][1] += acc[m][n][1] * bfhi(gw[0]);
                    macc[m][n][2] += acc[m][n][2] * bflo(gw[1]); macc[m][n][3] += acc[m][n][3] * bfhi(gw[1]);
                }
            }
        }
#pragma unroll
        for (int m = 0; m < 4; ++m) {
            const int row = tm * 128 + wr * 64 + m * 16 + r16;
#pragma unroll
            for (int n = 0; n < 4; ++n) {
                const int col = tn * 128 + wc * 64 + n * 16 + q4 * 4;
                otile_put(lds, wr * 64 + m * 16 + r16, wc * 64 + n * 16 + q4 * 4, pk2(macc[m][n][0], macc[m][n][1]), pk2(macc[m][n][2], macc[m][n][3]));
            }
        }
        otile_flush(lds, mb + (size_t)(tm * 128) * DM + tn * 128, DM);
    }
}

DI void phase_resid(const Params& p, int grp, const bf16_t* A, int K, const bf16_t* Wt, bool first, char* lds) {
    const int lane = tidx() & 63, w = tidx() >> 6, wr = w >> 1, wc = w & 1, r16 = lane & 15, q4 = lane >> 4;
    TileIter it; ti_init(it, TG / 128, 8, 8, 8);
    int tm, tn, ntm = 0, ntn = 0;
    bool have = ti_next(it, tm, tn);
    GemmRegs g;
    if (have) gemm_prime(A + (size_t)tm * 128 * K, K, Wt + (size_t)tn * 128 * K, K, g);
    for (; have; tm = ntm, tn = ntn) {
        have = ti_next(it, ntm, ntn);
        const bf16_t* At = A + (size_t)tm * 128 * K; const bf16_t* Bt = Wt + (size_t)tn * 128 * K;
        const bf16_t* nAt = have ? A + (size_t)ntm * 128 * K : At; const bf16_t* nBt = have ? Wt + (size_t)ntn * 128 * K : Bt;
        f32x4 acc[4][4]; zero_acc(acc);
        gemm_stream<true>(At, Bt, nAt, nBt, K, K, K, g, acc, lds);
#pragma unroll
        for (int m = 0; m < 4; ++m)
#pragma unroll
            for (int n = 0; n < 4; ++n) *(f32x4*)(lds + (wr * 64 + m * 16 + r16) * OROWF + (wc * 64 + n * 16 + q4 * 4) * 4) = acc[m][n];
        __syncthreads();
        {
            const int tid = tidx();
#pragma unroll 4
            for (int i = 0; i < 16; ++i) {
                const int c = tid + 256 * i, rl = c >> 5, ch = c & 31, row = tm * 128 + rl;
                float* xo = p.out + ((size_t)grp * TG + row) * DM + tn * 128 + ch * 4;
                const float* xi = first ? x_in_row(p, grp, row) + tn * 128 + ch * 4 : xo;
                const f32x4 a = *(const f32x4*)(lds + rl * OROWF + ch * 16);
                const f32x4 xv = *(const f32x4*)xi;
                *(f32x4*)xo = xv + a;
            }
        }
        __syncthreads();
    }
}

DI void phase_ffn1(const Params& p, int layer, char* lds) {
    const int lane = tidx() & 63, w = tidx() >> 6, wr = w >> 1, wc = w & 1, r16 = lane & 15, q4 = lane >> 4;
    const bf16_t* hb = (const bf16_t*)(p.ws + OFF_H);
    const bf16_t* W = wts(p, layer) + WFI;
    bf16_t* fb = (bf16_t*)(p.ws + OFF_F);
    constexpr int NT = DFF / 64;
    TileIter it; ti_init(it, TG / 128, NT, 8, 4);
    int tm, tn, ntm = 0, ntn = 0;
    bool have = ti_next(it, tm, tn);
    GemmRegs g;
    if (have) gemm_prime(hb + (size_t)tm * 128 * DM, DM, W + (size_t)tn * 128 * DM, DM, g);
    for (; have; tm = ntm, tn = ntn) {
        have = ti_next(it, ntm, ntn);
        const bf16_t* At = hb + (size_t)tm * 128 * DM; const bf16_t* Bt = W + (size_t)tn * 128 * DM;
        const bf16_t* nAt = have ? hb + (size_t)ntm * 128 * DM : At; const bf16_t* nBt = have ? W + (size_t)ntn * 128 * DM : Bt;
        f32x4 acc[4][4]; zero_acc(acc);
        gemm_stream<true, 1>(At, Bt, nAt, nBt, DM, DM, DM, g, acc, lds);
#pragma unroll
        for (int m = 0; m < 4; ++m) {
            const int row = tm * 128 + wr * 64 + m * 16 + r16;
#pragma unroll
            for (int n = 0; n < 2; ++n) {
                const int col = tn * 64 + wc * 32 + n * 16 + q4 * 4;
                float f[4];
#pragma unroll
                for (int i = 0; i < 4; ++i) { const float gq = acc[m][n][i]; f[i] = gq * sigmoidf_(gq) * acc[m][n + 2][i]; }
                otile_put(lds, wr * 64 + m * 16 + r16, wc * 32 + n * 16 + q4 * 4, pk2(f[0], f[1]), pk2(f[2], f[3]));
            }
        }
        {
            const int tid = tidx();
            __syncthreads();
#pragma unroll
            for (int i = 0; i < 4; ++i) {
                const int c = tid + 256 * i, row = c >> 3, ch = c & 7;
                const u32x4 v = *(const u32x4*)(lds + row * OROW + ch * 16);
                *(u32x4*)(fb + (size_t)(tm * 128 + row) * DFF + tn * 64 + ch * 8) = v;
            }
            __syncthreads();
        }
    }
}

#define XB_TMO      128
#define XB_XCNT(j)  (256  + 64 * (j))
#define XB_XSUB(j)  (1280 + 64 * (j))
#define XB_XGEN(j)  (2304 + 64 * (j))
#define XB_TOP      3328
#define XB_TOPGEN   3392
#define XCD_BAR_WORDS 3456
#define XB_SPIN_CAP (1u << 18)
#define LAS __attribute__((address_space(3)))

__device__ __forceinline__ unsigned xb_ld(unsigned* p)              { return __hip_atomic_load(p, __ATOMIC_RELAXED, __HIP_MEMORY_SCOPE_AGENT); }
__device__ __forceinline__ unsigned xb_add(unsigned* p, unsigned v) { return __hip_atomic_fetch_add(p, v, __ATOMIC_RELAXED, __HIP_MEMORY_SCOPE_AGENT); }
__device__ __forceinline__ unsigned xb_xcc_id() { return (unsigned)__builtin_amdgcn_s_getreg((3 << 11) | 20) & 0xFu; }
#define XB_SPIN(cond, bar) do { unsigned _sp = 0; while (cond) { __builtin_amdgcn_s_sleep(1); \
    if ((++_sp & 255u) == 0u) { if (xb_ld(&(bar)[XB_TMO])) break; if (_sp > XB_SPIN_CAP) { atomicAdd(&(bar)[XB_TMO], 1u); break; } } } } while (0)

struct XcdBarrier {
    unsigned* bar; unsigned x;
    volatile LAS unsigned* st;
};

__device__ __forceinline__ XcdBarrier xcd_barrier_post(unsigned* bar, volatile LAS unsigned* st) {
    XcdBarrier b; b.bar = bar; b.x = xb_xcc_id(); b.st = st;
    if (threadIdx.x == 0) (void)xb_add(&bar[XB_XCNT(b.x)], 1u);
    return b;
}
__device__ __forceinline__ void xcd_barrier_complete(unsigned* bar, unsigned x, unsigned& nloc, unsigned& nx) {
    const unsigned G = gdim() * gridDim.y * gridDim.z;
    unsigned sum, cnt, mine, sp = 0u;
    for (;;) {
        sum = 0u; cnt = 0u; mine = 0u;
#pragma unroll
        for (unsigned j = 0; j < 16; ++j) { const unsigned c = xb_ld(&bar[XB_XCNT(j)]); sum += c; cnt += (c > 0u) ? 1u : 0u; mine = (j == x) ? c : mine; }
        if (sum == G) break;
        __builtin_amdgcn_s_sleep(1);
        if ((++sp & 255u) == 0u) { if (xb_ld(&bar[XB_TMO])) break; if (sp > XB_SPIN_CAP) { atomicAdd(&bar[XB_TMO], 1u); break; } }
    }
    nloc = mine > 0u ? mine : 1u; nx = cnt > 0u ? cnt : 1u;
}

__device__ __forceinline__ void xcd_barrier(const XcdBarrier& b) {
    asm volatile("s_waitcnt vmcnt(0)" ::: "memory");
    __syncthreads();
    if (threadIdx.x == 0) {
        unsigned* bar = b.bar;
        __builtin_amdgcn_s_waitcnt(0);
        unsigned nloc = b.st[0], nx = b.st[1];
        if (nloc == 0u) { xcd_barrier_complete(bar, b.x, nloc, nx); b.st[0] = nloc; b.st[1] = nx; }
        const unsigned old = xb_add(&bar[XB_XSUB(b.x)], 1u);
        const unsigned gen = old / nloc;
        if (old + 1u == (gen + 1u) * nloc) {
            __builtin_amdgcn_fence(__ATOMIC_RELEASE, "agent");
            asm volatile("s_waitcnt vmcnt(0)" ::: "memory");
            const unsigned og = xb_add(&bar[XB_TOP], 1u);
            const unsigned tg = og / nx;
            if (og + 1u == (tg + 1u) * nx) xb_add(&bar[XB_TOPGEN], 1u);
            else XB_SPIN(xb_ld(&bar[XB_TOPGEN]) == tg, bar);
            __builtin_amdgcn_fence(__ATOMIC_ACQUIRE, "agent");
            xb_add(&bar[XB_XGEN(b.x)], 1u);
            asm volatile("s_waitcnt vmcnt(0)" ::: "memory");
        } else {
            XB_SPIN(xb_ld(&bar[XB_XGEN(b.x)]) == gen, bar);
            __builtin_amdgcn_fence(__ATOMIC_ACQUIRE, "agent");
            asm volatile("s_waitcnt vmcnt(0)" ::: "memory");
        }
    }
    __syncthreads();
}


constexpr int PH_PER_GRP = 4 * 9 + 1;
constexpr int NPHASE = 1 + NGRP * PH_PER_GRP;

#ifndef PROBE_K
#define PROBE_K (-1)
#endif
DI void run_phase(const Params& p, int ph, char* lds, int rep = 0) {
    if (ph == 0) { phase_prologue(p, lds); return; }
    const int q = ph - 1, grp = q / PH_PER_GRP, r = q % PH_PER_GRP;
    if (r == 36) { phase_norm(p, grp, p.in[I_NFIN], 2); return; }
    const int layer = r / 9, k = r % 9;
    switch (k) {
        case 0: phase_norm(p, grp, p.in[I_NMIX] + layer * DM, layer == 0 ? 0 : 1); break;
        case 1: phase_in(p, layer, lds, rep == 1); break;
        case 2: phase_mix(p, layer, grp * 4 + layer + 20 * rep, lds, rep == 1); break;
        case 3: phase_glu(p, layer, lds); break;
        case 4: phase_merge(p, layer, lds); break;
        case 5: phase_resid(p, grp, (const bf16_t*)(p.ws + OFF_M), DM, wts(p, layer) + WO, layer == 0, lds); break;
        case 6: phase_norm(p, grp, p.in[I_NFFN] + layer * DM, 1); break;
        case 7: phase_ffn1(p, layer, lds); break;
        default: phase_resid(p, grp, (const bf16_t*)(p.ws + OFF_F), DFF, wts(p, layer) + WFO, false, lds); break;
    }
}

__global__ void __launch_bounds__(256, 2) mega(Params p, int only) {
    __shared__ __attribute__((aligned(16))) char lds[LDS_BYTES];
#if MULTI_LAUNCH
    if (only >= 0) { run_phase(p, only, lds); return; }
#endif
    cg::grid_group grid = cg::this_grid();
    __shared__ uint4 xb_words;
    if (threadIdx.x == 0) xb_words = make_uint4(0u, 0u, 0u, 0u);
    __syncthreads();
    XcdBarrier xb = xcd_barrier_post((unsigned*)(p.ws + OFF_BAR), (volatile LAS unsigned*)&xb_words);
    for (int ph = 0; ph < NPHASE; ++ph) {
        run_phase(p, ph, lds);
        if (ph + 1 < NPHASE) { if (ph == 0) grid.sync(); else xcd_barrier(xb); }
        if (PROBE_K == 100) xcd_barrier(xb);
        if (PROBE_K >= 0 && PROBE_K < 9 && ph > 0 && ((ph - 1) % PH_PER_GRP) < 36 && (((ph - 1) % PH_PER_GRP) % 9) == PROBE_K) { run_phase(p, ph, lds, 1); xcd_barrier(xb); }
    }
}

extern "C" void kernel_launch(void* const* d_in, const int* in_sizes, int n_in, void* d_out, int out_size, void* d_ws, size_t ws_size, hipStream_t stream) {
    (void)in_sizes; (void)n_in; (void)out_size;
    static int grid_blocks = 0;
    if (!grid_blocks) {
        int dev = 0, cus = 0, per_cu = 0;
        hipGetDevice(&dev);
        hipDeviceGetAttribute(&cus, hipDeviceAttributeMultiprocessorCount, dev);
        hipOccupancyMaxActiveBlocksPerMultiprocessor(&per_cu, mega, 256, 0);
        if (per_cu < 1) per_cu = 1;
        if (per_cu > 2) per_cu = 2;
        grid_blocks = cus * per_cu;
    }
    if (ws_size < WS_END) { fprintf(stderr, "workspace too small: %zu < %zu\n", ws_size, (size_t)WS_END); return; }
    Params p{};
    for (int i = 0; i < 26; ++i) p.in[i] = (const float*)d_in[i];
    p.out = (float*)d_out; p.ws = (char*)d_ws;
    hipMemsetAsync((char*)d_ws + OFF_BAR, 0, XCD_BAR_WORDS * sizeof(unsigned), stream);
#if MULTI_LAUNCH
    for (int ph = 0; ph < NPHASE; ++ph) mega<<<dim3(grid_blocks), dim3(256), 0, stream>>>(p, ph);
#else
    int only = -1;
    void* args[] = {&p, &only};
    hipError_t e = hipLaunchCooperativeKernel((void*)mega, dim3(grid_blocks), dim3(256), args, 0, stream);
    if (e != hipSuccess) fprintf(stderr, "cooperative launch failed: %s (grid %d)\n", hipGetErrorString(e), grid_blocks);
#endif
}
```

```cpp
#include <hip/hip_runtime.h>
#include <hip/hip_cooperative_groups.h>
#include <cstdio>
#include <cstdint>
namespace cg = cooperative_groups;

#ifndef MULTI_LAUNCH
#define MULTI_LAUNCH 0
#endif

#define DI __device__ __forceinline__
typedef unsigned short bf16_t;
typedef __bf16 bf16v2 __attribute__((ext_vector_type(2)));
typedef float f32x2 __attribute__((ext_vector_type(2)));
typedef short bf16x8 __attribute__((ext_vector_type(8)));
typedef short s16x4 __attribute__((ext_vector_type(4)));
typedef float f32x4 __attribute__((ext_vector_type(4)));
typedef float f32x16 __attribute__((ext_vector_type(16)));
typedef unsigned u32x4 __attribute__((ext_vector_type(4)));
typedef unsigned u32x2 __attribute__((ext_vector_type(2)));

constexpr int DM = 1024, SL = 2048, NSEQ = 40, G = 8, NGRP = NSEQ / G, TG = G * SL;
constexpr int INW = 4352, NIN = INW + 4096, DFF = 2816;
constexpr float EPS = 1e-6f;
constexpr float LOG2E = 1.4426950408889634f;

constexpr size_t WING = 0;
constexpr size_t WB = 8650752;
constexpr size_t WO = WB + 2097152;
constexpr size_t WFI = WO + 1048576;
constexpr size_t WFO = WFI + 5767168;
constexpr size_t WGLU = WFO + 2883584;
constexpr size_t LW = WGLU + 262144;

constexpr size_t OFF_W = 0;
constexpr size_t OFF_TAB = OFF_W + 4 * LW * 2;
constexpr size_t OFF_COSA = OFF_TAB, OFF_SINA = OFF_TAB + 262144, OFF_COSD = OFF_TAB + 2 * 262144, OFF_SIND = OFF_TAB + 3 * 262144;
constexpr size_t OFF_BIAS = OFF_TAB + 1048576;
constexpr size_t OFF_LAM = OFF_BIAS + 65536;
constexpr size_t OFF_QCNT = OFF_LAM + 256;
constexpr size_t OFF_BAR = OFF_TAB + 1048576 + 131072;
constexpr size_t OFF_H = OFF_TAB + 2097152;
constexpr size_t OFF_U = OFF_H + (size_t)TG * 1024 * 2;
constexpr size_t OFF_GATE = OFF_U + (size_t)TG * INW * 2;
constexpr size_t OFF_VTA = OFF_GATE + (size_t)TG * 4096 * 2;
constexpr size_t OFF_VTC = OFF_VTA + (size_t)TG * 128 * 2;
constexpr size_t OFF_VTD = OFF_VTC + (size_t)TG * 512 * 2;
constexpr size_t OFF_O = OFF_VTD + (size_t)TG * 512 * 2;
constexpr size_t OFF_YF = OFF_O + (size_t)4 * TG * 512 * 2;
constexpr size_t OFF_YB = OFF_YF + (size_t)TG * 512 * 2;
constexpr size_t OFF_DT = OFF_YB + (size_t)TG * 512 * 2;
constexpr size_t WS_END = OFF_DT + (size_t)2 * TG * 512 * 2;
constexpr size_t OFF_M = OFF_U;
constexpr size_t OFF_F = OFF_U;

struct Params { const float* in[26]; float* out; char* ws; };

enum { I_XP = 0, I_XS, I_NMIX, I_WIN, I_QG, I_KG, I_SARE, I_SAIM, I_SLDT, I_SBRE, I_SBIM, I_SCRE, I_SCIM, I_SD, I_SWGLU, I_SBGLU,
       I_DLAM, I_DSUB, I_REL, I_WGATE, I_WBR, I_WOUT, I_NFFN, I_WFI, I_WFO, I_NFIN };

constexpr int LDS_BYTES = 71680;
constexpr int AROWB = 144;
constexpr int ROWB = 128;
constexpr int GT_BYTES = 128 * ROWB;

DI int bidx() { int b = blockIdx.x; asm volatile("" : "+s"(b)); return b; }
DI int gdim() { int g = gridDim.x; asm volatile("" : "+s"(g)); return g; }
DI int tidx() { int t = threadIdx.x; asm volatile("" : "+v"(t)); return t; }
DI unsigned pk2(float a, float b) { f32x2 v = {a, b}; bf16v2 r = __builtin_convertvector(v, bf16v2); return __builtin_bit_cast(unsigned, r); }
DI float bf2f(bf16_t v) { return __uint_as_float(((unsigned)v) << 16); }
DI float bflo(unsigned w) { return __uint_as_float(w << 16); }
DI float bfhi(unsigned w) { return __uint_as_float(w & 0xffff0000u); }
DI float sigmoidf_(float x) { return __builtin_amdgcn_rcpf(1.0f + __builtin_amdgcn_exp2f(-LOG2E * x)); }
DI float wave_sum(float v) { v += __shfl_xor(v, 32); v += __shfl_xor(v, 16); v += __shfl_xor(v, 8); v += __shfl_xor(v, 4); v += __shfl_xor(v, 2); v += __shfl_xor(v, 1); return v; }
DI bf16_t* wts(const Params& p, int layer) { return (bf16_t*)(p.ws + OFF_W) + (size_t)layer * LW; }
#define MFMA16(a, b, c) __builtin_amdgcn_mfma_f32_16x16x32_bf16((a), (b), (c), 0, 0, 0)
#define MFMA32(a, b, c) __builtin_amdgcn_mfma_f32_32x32x16_bf16((a), (b), (c), 0, 0, 0)

template <bool SWAP, int BMAP>
DI void gemm_compute(const char* cur, int aoff, int boff, int sw, f32x4 (&acc)[4][4]) {
#pragma unroll
    for (int ks = 0; ks < 2; ++ks) {
        bf16x8 af[4], bfr[4];
        if (ks) asm volatile("" ::: "memory");
        const int so = sw ^ (ks * 64);
#pragma unroll
        for (int m = 0; m < 4; ++m) af[m] = *(const bf16x8*)(cur + aoff + m * 16 * ROWB + so);
#pragma unroll
        for (int n = 0; n < 4; ++n) bfr[n] = *(const bf16x8*)(cur + boff + (BMAP ? ((n >> 1) * 64 + (n & 1) * 16) : n * 16) * ROWB + so);
#pragma unroll
        for (int m = 0; m < 4; ++m)
#pragma unroll
            for (int n = 0; n < 4; ++n) acc[m][n] = SWAP ? MFMA16(bfr[n], af[m], acc[m][n]) : MFMA16(af[m], bfr[n], acc[m][n]);
    }
}
#define GLOAD(RA, RB, KT) { _Pragma("unroll") for (int i_ = 0; i_ < 4; ++i_) { \
    const char* ua_ = Ab + (size_t)(((32 * i_) * lda + (KT) * 64) * 2); const char* ub_ = Bb + (size_t)(((32 * i_) * ldb + (KT) * 64) * 2); \
    RA[i_] = *(const u32x4*)(ua_ + avoff); RB[i_] = *(const u32x4*)(ub_ + bvoff); } }
#define LSTORE(RA, RB, ST) { _Pragma("unroll") for (int i_ = 0; i_ < 4; ++i_) { *(u32x4*)(lds + (ST) * (2 * GT_BYTES) + soff + 32 * i_ * ROWB) = RA[i_]; *(u32x4*)(lds + (ST) * (2 * GT_BYTES) + GT_BYTES + soff + 32 * i_ * ROWB) = RB[i_]; } }
template <bool SWAP, int BMAP = 0, bool DEEP = true>
DI void gemm128(const bf16_t* __restrict__ A, int lda, const bf16_t* __restrict__ B, int ldb, int K, f32x4 (&acc)[4][4], char* lds) {
    const int tid = tidx(), lane = tid & 63, w = tid >> 6, wr = w >> 1, wc = w & 1;
    const int srow = tid >> 3, scol = tid & 7;
    const char* Ab = (const char*)A; const char* Bb = (const char*)B;
    const unsigned avoff = (unsigned)(srow * lda + scol * 8) * 2u, bvoff = (unsigned)(srow * ldb + scol * 8) * 2u;
    const int soff = srow * ROWB + ((scol ^ ((srow >> 1) & 7)) << 4);
    const int nk = K >> 6;
    const int aoff = (wr * 64 + (lane & 15)) * ROWB;
    const int boff = GT_BYTES + ((BMAP ? wc * 32 : wc * 64) + (lane & 15)) * ROWB;
    const int sw = ((lane >> 4) ^ ((lane & 15) >> 1)) << 4;
    u32x4 ra0[4], rb0[4];
    GLOAD(ra0, rb0, 0);
    LSTORE(ra0, rb0, 0);
    if (DEEP) {
        u32x4 ra1[4], rb1[4];
        GLOAD(ra1, rb1, 1);
        __syncthreads();
        for (int kt = 0; kt < nk; kt += 2) {
            { const int k2 = kt + 2 < nk ? kt + 2 : nk - 1; GLOAD(ra0, rb0, k2); }
            gemm_compute<SWAP, BMAP>(lds, aoff, boff, sw, acc);
            LSTORE(ra1, rb1, 1);
            __syncthreads();
            { const int k3 = kt + 3 < nk ? kt + 3 : nk - 1; GLOAD(ra1, rb1, k3); }
            gemm_compute<SWAP, BMAP>(lds + 2 * GT_BYTES, aoff, boff, sw, acc);
            LSTORE(ra0, rb0, 0);
            __syncthreads();
        }
    } else {
        __syncthreads();
        for (int kt = 0; kt < nk; ++kt) {
            const bool more = (kt + 1 < nk);
            if (more) GLOAD(ra0, rb0, kt + 1);
            gemm_compute<SWAP, BMAP>(lds + (kt & 1) * (2 * GT_BYTES), aoff, boff, sw, acc);
            if (more) { if (kt & 1) { LSTORE(ra0, rb0, 0); } else { LSTORE(ra0, rb0, 1); } }
            __syncthreads();
        }
    }
}

struct GemmR { u32x4 a[4], b[4]; };
DI void prime_k0(const bf16_t* A, int lda, const bf16_t* B, int ldb, GemmR& g) {
    const int tid = tidx(), srow = tid >> 3, scol = tid & 7;
    const char* Ab = (const char*)A; const char* Bb = (const char*)B;
    const unsigned avoff = (unsigned)(srow * lda + scol * 8) * 2u, bvoff = (unsigned)(srow * ldb + scol * 8) * 2u;
    GLOAD(g.a, g.b, 0);
}
template <bool SWAP, int BMAP = 0>
DI void gemm128pre(const bf16_t* __restrict__ A, int lda, const bf16_t* __restrict__ B, int ldb, int K, GemmR& pre, f32x4 (&acc)[4][4], char* lds) {
    const int tid = tidx(), lane = tid & 63, w = tid >> 6, wr = w >> 1, wc = w & 1;
    const int srow = tid >> 3, scol = tid & 7;
    const char* Ab = (const char*)A; const char* Bb = (const char*)B;
    const unsigned avoff = (unsigned)(srow * lda + scol * 8) * 2u, bvoff = (unsigned)(srow * ldb + scol * 8) * 2u;
    const int soff = srow * ROWB + ((scol ^ ((srow >> 1) & 7)) << 4);
    const int nk = K >> 6;
    const int aoff = (wr * 64 + (lane & 15)) * ROWB;
    const int boff = GT_BYTES + ((BMAP ? wc * 32 : wc * 64) + (lane & 15)) * ROWB;
    const int sw = ((lane >> 4) ^ ((lane & 15) >> 1)) << 4;
    u32x4 ra1[4], rb1[4];
    LSTORE(pre.a, pre.b, 0);
    GLOAD(ra1, rb1, 1);
    __syncthreads();
    for (int kt = 0; kt < nk; kt += 2) {
        { const int k2 = kt + 2 < nk ? kt + 2 : nk - 1; GLOAD(pre.a, pre.b, k2); }
        gemm_compute<SWAP, BMAP>(lds, aoff, boff, sw, acc);
        LSTORE(ra1, rb1, 1);
        __syncthreads();
        { const int k3 = kt + 3 < nk ? kt + 3 : nk - 1; GLOAD(ra1, rb1, k3); }
        gemm_compute<SWAP, BMAP>(lds + 2 * GT_BYTES, aoff, boff, sw, acc);
        LSTORE(pre.a, pre.b, 0);
        __syncthreads();
    }
}

struct TileIter { int per, SM, SN, nSn, sbase, len, q, nslot; };
DI void ti_init(TileIter& it, int NTm, int NTn, int SM, int SN) {
    const int x = bidx() & 7;
    it.nslot = (gdim() - x + 7) >> 3; it.per = SM * SN; it.SM = SM; it.SN = SN; it.nSn = NTn / SN;
    const int nS = (NTm / SM) * it.nSn;
    it.sbase = x * (nS >> 3); it.len = (nS >> 3) * it.per; it.q = bidx() >> 3;
}
DI bool ti_next(TileIter& it, int& tm, int& tn) {
    if (it.q >= it.len) return false;
    const int j = it.q / it.per, w = it.q % it.per, S = it.sbase + j, sm = S / it.nSn, sn = S % it.nSn;
    tm = sm * it.SM + (w % it.SM); tn = sn * it.SN + (w / it.SM);
    it.q += it.nslot;
    return true;
}

struct GemmRegs { u32x4 a0[4], b0[4], a1[4], b1[4]; };
typedef const __attribute__((address_space(1))) char* gptr_t;
typedef const __attribute__((address_space(1))) u32x4* gvec_t;
DI gptr_t uptr(const void* q) {
    const size_t v = (size_t)q;
    const unsigned lo = __builtin_amdgcn_readfirstlane((unsigned)v), hi = __builtin_amdgcn_readfirstlane((unsigned)(v >> 32));
    return (gptr_t)(((size_t)hi << 32) | lo);
}
#define GLOADP(RA, RB, PA, PB, KT) { _Pragma("unroll") for (int i_ = 0; i_ < 4; ++i_) { \
    gptr_t ua_ = (PA) + (size_t)(((32 * i_) * lda + (KT) * 64) * 2); gptr_t ub_ = (PB) + (size_t)(((32 * i_) * ldb + (KT) * 64) * 2); \
    RA[i_] = *(gvec_t)(ua_ + avoff); RB[i_] = *(gvec_t)(ub_ + bvoff); } }
DI void gemm_prime(const bf16_t* A, int lda, const bf16_t* B, int ldb, GemmRegs& g) {
    const int tid = tidx(), srow = tid >> 3, scol = tid & 7;
    const unsigned avoff = (unsigned)(srow * lda + scol * 8) * 2u, bvoff = (unsigned)(srow * ldb + scol * 8) * 2u;
    gptr_t Ab = uptr(A); gptr_t Bb = uptr(B);
    GLOADP(g.a0, g.b0, Ab, Bb, 0);
    GLOADP(g.a1, g.b1, Ab, Bb, 1);
}
template <bool SWAP, int BMAP = 0>
DI void gemm_stream(const bf16_t* A, const bf16_t* B, const bf16_t* nA, const bf16_t* nB, int lda, int ldb, int K, GemmRegs& g, f32x4 (&acc)[4][4], char* lds) {
    const int tid = tidx(), lane = tid & 63, w = tid >> 6, wr = w >> 1, wc = w & 1;
    const int srow = tid >> 3, scol = tid & 7;
    const unsigned avoff = (unsigned)(srow * lda + scol * 8) * 2u, bvoff = (unsigned)(srow * ldb + scol * 8) * 2u;
    gptr_t Ab = uptr(A); gptr_t Bb = uptr(B); gptr_t nAb = uptr(nA); gptr_t nBb = uptr(nB);
    const int soff = srow * ROWB + ((scol ^ ((srow >> 1) & 7)) << 4);
    const int nk = K >> 6;
    const int aoff = (wr * 64 + (lane & 15)) * ROWB;
    const int boff = GT_BYTES + ((BMAP ? wc * 32 : wc * 64) + (lane & 15)) * ROWB;
    const int sw = ((lane >> 4) ^ ((lane & 15) >> 1)) << 4;
    LSTORE(g.a0, g.b0, 0);
    __syncthreads();
    for (int kt = 0; kt < nk; kt += 2) {
        const bool last = kt + 2 >= nk;
        gptr_t pa = last ? nAb : Ab; gptr_t pb = last ? nBb : Bb;
        const int k2 = last ? 0 : kt + 2, k3 = last ? 1 : kt + 3;
        GLOADP(g.a0, g.b0, pa, pb, k2);
        gemm_compute<SWAP, BMAP>(lds, aoff, boff, sw, acc);
        LSTORE(g.a1, g.b1, 1);
        __syncthreads();
        GLOADP(g.a1, g.b1, pa, pb, k3);
        gemm_compute<SWAP, BMAP>(lds + 2 * GT_BYTES, aoff, boff, sw, acc);
        if (!last) LSTORE(g.a0, g.b0, 0);
        __syncthreads();
    }
}

DI void zero_acc(f32x4 (&acc)[4][4]) {
#pragma unroll
    for (int m = 0; m < 4; ++m)
#pragma unroll
        for (int n = 0; n < 4; ++n) acc[m][n] = (f32x4){0.f, 0.f, 0.f, 0.f};
}


constexpr int OROW = 272;
constexpr int OROWF = 528;
DI void otile_put(char* lds, int row, int col, unsigned w0, unsigned w1) { u32x2 w; w[0] = w0; w[1] = w1; *(u32x2*)(lds + row * OROW + col * 2) = w; }
DI void otile_flush(char* lds, bf16_t* dst, int ld) {
    const int tid = tidx();
    __syncthreads();
#pragma unroll
    for (int i = 0; i < 8; ++i) {
        const int c = tid + 256 * i, row = c >> 4, ch = c & 15;
        const u32x4 v = *(const u32x4*)(lds + row * OROW + ch * 16);
        *(u32x4*)(dst + (size_t)row * ld + ch * 8) = v;
    }
    __syncthreads();
}

DI void conv_tile(const float* __restrict__ src, bf16_t* __restrict__ dst, int K, int N, int tk, int tn, int drow0, float* tile) {
    const int tid = tidx(), ty = tid >> 4, tx = tid & 15;
#pragma unroll
    for (int i = 0; i < 4; ++i) {
        const int k = ty + 16 * i;
        const f32x4 v = *(const f32x4*)(src + (size_t)(tk * 64 + k) * N + tn * 64 + tx * 4);
        tile[k * 65 + tx * 4 + 0] = v[0]; tile[k * 65 + tx * 4 + 1] = v[1]; tile[k * 65 + tx * 4 + 2] = v[2]; tile[k * 65 + tx * 4 + 3] = v[3];
    }
    __syncthreads();
    const int n = tid >> 2, ks = (tid & 3) * 16;
    u32x4 w0, w1;
#pragma unroll
    for (int j = 0; j < 4; ++j) {
        w0[j] = pk2(tile[(ks + 2 * j) * 65 + n], tile[(ks + 2 * j + 1) * 65 + n]);
        w1[j] = pk2(tile[(ks + 8 + 2 * j) * 65 + n], tile[(ks + 8 + 2 * j + 1) * 65 + n]);
    }
    bf16_t* d = dst + (size_t)(drow0 + n) * K + tk * 64 + ks;
    *(u32x4*)d = w0; *(u32x4*)(d + 8) = w1;
    __syncthreads();
}

DI int t5_bucket(int rel) {
    const int base = rel > 0 ? 16 : 0;
    const int dist = rel < 0 ? -rel : rel;
    int b;
    if (dist < 8) b = dist;
    else {
        const float lr = logf((float)dist / 8.0f) / 2.772588722239781f;
        int lg = 8 + (int)(lr * 8.0f);
        b = lg < 15 ? lg : 15;
    }
    return base + b;
}

DI void phase_prologue(const Params& p, char* lds) {
    float* tile = (float*)lds;
    const int tid = tidx();
    for (int t = bidx(); t < 4 * 5056; t += gdim()) {
        const int layer = t / 5056; int q = t % 5056;
        bf16_t* wl = wts(p, layer);
        const float* src; bf16_t* dst; int K, N, nn;
        if (q < 1088) { src = p.in[I_WIN] + (size_t)layer * 1024 * INW; dst = wl + WING; K = 1024; N = INW; }
        else if ((q -= 1088) < 1024) { const int b = q >> 8; q &= 255; src = p.in[I_WGATE] + (size_t)(layer * 4 + b) * 1024 * 1024; dst = wl + WING + (size_t)(INW + b * 1024) * 1024; K = 1024; N = 1024; }
        else if ((q -= 1024) < 512) { const int b = q >> 7; q &= 127; src = p.in[I_WBR] + (size_t)(layer * 4 + b) * 512 * 1024; dst = wl + WB + (size_t)b * 1024 * 512; K = 512; N = 1024; }
        else if ((q -= 512) < 256) { src = p.in[I_WOUT] + (size_t)layer * 1024 * 1024; dst = wl + WO; K = 1024; N = 1024; }
        else if ((q -= 256) < 1408) { src = p.in[I_WFI] + (size_t)layer * 1024 * 5632; dst = wl + WFI; K = 1024; N = 5632; }
        else if ((q -= 1408) < 704) { src = p.in[I_WFO] + (size_t)layer * DFF * 1024; dst = wl + WFO; K = DFF; N = 1024; }
        else { q -= 704; src = p.in[I_SWGLU] + (size_t)layer * 512 * 512; dst = wl + WGLU; K = 512; N = 512; }
        nn = N >> 6;
        const int tk = q / nn, tn = q % nn;
        int drow0 = tn * 64;
        if (N == 5632) drow0 = tn < 44 ? tn * 128 : (tn - 44) * 128 + 64;
        conv_tile(src, dst, K, N, tk, tn, drow0, tile);
    }
    const int gt = bidx() * 256 + tid, gn = gdim() * 256;
    float* cosA = (float*)(p.ws + OFF_COSA); float* sinA = (float*)(p.ws + OFF_SINA);
    float* cosD = (float*)(p.ws + OFF_COSD); float* sinD = (float*)(p.ws + OFF_SIND);
    for (int i = gt; i < SL * 32; i += gn) {
        const int t = i >> 5, j = i & 31;
        const float invA = exp2f(-(float)(j & 15) * (13.287712379549449f / 16.0f));
        const float angA = (j < 16 ? (float)(t >> 6) : (float)(t & 63)) * invA;
        cosA[i] = cosf(angA); sinA[i] = sinf(angA);
        const float invD = exp2f(-(float)j * (13.287712379549449f / 32.0f));
        const float angD = (float)t * invD;
        cosD[i] = cosf(angD); sinD[i] = sinf(angD);
    }
    float* bias = (float*)(p.ws + OFF_BIAS);
    for (int i = gt; i < 4 * 4096; i += gn) {
        const int h = i >> 12, r = i & 4095;
        float v = 0.f;
        if (r < 4095) v = p.in[I_REL][t5_bucket(r - 2047) * 4 + h] * LOG2E;
        bias[i] = v;
    }
    if (bidx() == 0) {
        if (tid < 4) {
            const float* lv = p.in[I_DLAM] + tid * 256;
            float s1 = 0.f, s2 = 0.f;
            for (int j = 0; j < 64; ++j) { s1 += lv[j] * lv[64 + j]; s2 += lv[128 + j] * lv[192 + j]; }
            const float li = 0.8f - 0.6f * expf(-0.3f * (float)tid);
            float* lam = (float*)(p.ws + OFF_LAM);
            lam[tid] = expf(s1) - expf(s2) + li; lam[4 + tid] = li;
        }
        if (tid < 64) ((int*)(p.ws + OFF_QCNT))[tid] = 0;
    }
}

DI const float* x_in_row(const Params& p, int grp, int row) {
    const int seq = grp * G + (row >> 11), t = row & 2047;
    return seq < 8 ? p.in[I_XP] + ((size_t)seq * SL + t) * DM : p.in[I_XS] + ((size_t)(seq - 8) * SL + t) * DM;
}
DI void phase_norm(const Params& p, int grp, const float* gain, int mode) {
    const int lane = tidx() & 63;
    const int gw = bidx() * 4 + (tidx() >> 6), nw = gdim() * 4;
    bf16_t* hb = (bf16_t*)(p.ws + OFF_H);
    f32x4 gv[4];
#pragma unroll
    for (int i = 0; i < 4; ++i) gv[i] = *(const f32x4*)(gain + lane * 4 + 256 * i);
    for (int row = gw; row < TG; row += nw) {
        float* xo = p.out + ((size_t)grp * TG + row) * DM;
        const float* x = mode == 0 ? x_in_row(p, grp, row) : xo;
        f32x4 v[4]; float ss = 0.f;
#pragma unroll
        for (int i = 0; i < 4; ++i) { v[i] = *(const f32x4*)(x + lane * 4 + 256 * i); ss += v[i][0] * v[i][0] + v[i][1] * v[i][1] + v[i][2] * v[i][2] + v[i][3] * v[i][3]; }
        ss = wave_sum(ss);
        const float rstd = rsqrtf(ss * (1.0f / 1024.0f) + EPS);
#pragma unroll
        for (int i = 0; i < 4; ++i) {
            const f32x4 y = v[i] * rstd * gv[i];
            if (mode == 2) *(f32x4*)(xo + lane * 4 + 256 * i) = y;
            else { u32x2 w; w[0] = pk2(y[0], y[1]); w[1] = pk2(y[2], y[3]); *(u32x2*)(hb + (size_t)row * DM + lane * 4 + 256 * i) = w; }
        }
    }
}

DI void phase_in(const Params& p, int layer, char* lds, bool probe = false) {
    const bf16_t* hb = (const bf16_t*)(p.ws + OFF_H);
    const bf16_t* W = wts(p, layer) + WING;
    bf16_t* ub = (bf16_t*)(p.ws + OFF_U);
    bf16_t* gb = (bf16_t*)(p.ws + OFF_GATE);
    constexpr int NT = NIN / 128;
    const int lane = tidx() & 63, w = tidx() >> 6, wr = w >> 1, wc = w & 1, r16 = lane & 15, q4 = lane >> 4;
    TileIter it; ti_init(it, TG / 128, NT, 8, 6);
    int tm, tn, ntm = 0, ntn = 0;
    bool have = ti_next(it, tm, tn);
    GemmR pre;
    if (have) prime_k0(hb + (size_t)tm * 128 * DM, DM, W + (size_t)(tn * 128) * DM, DM, pre);
    for (; have; tm = ntm, tn = ntn) {
        have = ti_next(it, ntm, ntn);
        const bf16_t* nAt = have ? hb + (size_t)ntm * 128 * DM : hb; const bf16_t* nBt = have ? W + (size_t)(ntn * 128) * DM : W;
        const int c0 = tn * 128;
        const bool isV = (c0 == 640) || (c0 >= 2304 && c0 < 2816) || (c0 >= 3328 && c0 < 3840);
        f32x4 acc[4][4]; zero_acc(acc);
        const int cb = c0 + wc * 64;
        if (isV) {
            gemm128pre<false>(hb + (size_t)tm * 128 * DM, DM, W + (size_t)c0 * DM, DM, DM, pre, acc, lds);
            prime_k0(nAt, DM, nBt, DM, pre);
            bf16_t* vt; int cl, DV, NH;
            if (cb < 768) { vt = (bf16_t*)(p.ws + OFF_VTA); cl = cb - 640; DV = 64; NH = 2; }
            else if (cb < 2816) { vt = (bf16_t*)(p.ws + OFF_VTC); cl = cb - 2304; DV = 128; NH = 4; }
            else { vt = (bf16_t*)(p.ws + OFF_VTD); cl = cb - 3328; DV = 128; NH = 4; }
#pragma unroll
            for (int m = 0; m < 4; ++m) {
                const int row0 = tm * 128 + wr * 64 + m * 16 + q4 * 4, seq = row0 >> 11, t0 = row0 & 2047;
#pragma unroll
                for (int n = 0; n < 4; ++n) {
                    const int col = cl + n * 16 + r16, head = col / DV, d = col % DV;
                    u32x2 wv; wv[0] = pk2(acc[m][n][0], acc[m][n][1]); wv[1] = pk2(acc[m][n][2], acc[m][n][3]);
                    *(u32x2*)(vt + ((size_t)(seq * NH + head) * DV + d) * SL + t0) = wv;
                }
            }
        } else {
            gemm128pre<true>(hb + (size_t)tm * 128 * DM, DM, W + (size_t)c0 * DM, DM, DM, pre, acc, lds);
            bool donorm = false, dosig = false; int rot = 0; float scale = 1.f; const float* gain = nullptr;
            bf16_t* dst = ub; int ld = INW, dcol = cb;
            if (cb < 512) { donorm = true; rot = 1; scale = 0.125f * LOG2E; gain = p.in[I_QG] + layer * 64; }
            else if (cb < 640) { donorm = true; rot = 1; gain = p.in[I_KG] + layer * 64; }
            else if (cb < 1280) { }
            else if (cb < 1792) { scale = 0.125f * LOG2E; }
            else if (cb < 2816) { }
            else if (cb < 3072) { rot = 2; scale = 0.125f; }
            else if (cb < 3328) { rot = 2; }
            else if (cb < INW) { }
            else { dosig = true; dst = gb; ld = 4096; dcol = cb - INW; }
            float gl[4][4];
            if (donorm) {
#pragma unroll
                for (int n = 0; n < 4; ++n) { const f32x4 g4 = *(const f32x4*)(gain + n * 16 + q4 * 4); gl[n][0] = g4[0]; gl[n][1] = g4[1]; gl[n][2] = g4[2]; gl[n][3] = g4[3]; }
            }
            const float* ct = (const float*)(p.ws + (rot == 2 ? OFF_COSD : OFF_COSA));
            const float* sn = (const float*)(p.ws + (rot == 2 ? OFF_SIND : OFF_SINA));
#pragma unroll
            for (int m = 0; m < 4; ++m) {
                asm volatile("" ::: "memory");
                const int row = tm * 128 + wr * 64 + m * 16 + r16, tpos = row & 2047;
                float v[4][4];
#pragma unroll
                for (int n = 0; n < 4; ++n)
#pragma unroll
                    for (int i = 0; i < 4; ++i) v[n][i] = acc[m][n][i];
                if (donorm) {
                    float ss = 0.f;
#pragma unroll
                    for (int n = 0; n < 4; ++n)
#pragma unroll
                        for (int i = 0; i < 4; ++i) ss += v[n][i] * v[n][i];
                    ss += __shfl_xor(ss, 16); ss += __shfl_xor(ss, 32);
                    const float rstd = rsqrtf(ss * (1.0f / 64.0f) + EPS);
#pragma unroll
                    for (int n = 0; n < 4; ++n)
#pragma unroll
                        for (int i = 0; i < 4; ++i) v[n][i] = v[n][i] * rstd * gl[n][i];
                }
                if (rot) {
#pragma unroll
                    for (int n = 0; n < 2; ++n) {
                        const f32x4 c4 = *(const f32x4*)(ct + tpos * 32 + n * 16 + q4 * 4), s4 = *(const f32x4*)(sn + tpos * 32 + n * 16 + q4 * 4);
#pragma unroll
                        for (int i = 0; i < 4; ++i) { const float x1 = v[n][i], x2 = v[n + 2][i]; v[n][i] = x1 * c4[i] - x2 * s4[i]; v[n + 2][i] = x2 * c4[i] + x1 * s4[i]; }
                    }
                }
#pragma unroll
                for (int n = 0; n < 4; ++n) {
                    float o0, o1, o2, o3;
                    if (dosig) { o0 = sigmoidf_(v[n][0]); o1 = sigmoidf_(v[n][1]); o2 = sigmoidf_(v[n][2]); o3 = sigmoidf_(v[n][3]); }
                    else { o0 = v[n][0] * scale; o1 = v[n][1] * scale; o2 = v[n][2] * scale; o3 = v[n][3] * scale; }
                    otile_put(lds, wr * 64 + m * 16 + r16, wc * 64 + n * 16 + q4 * 4, pk2(o0, o1), pk2(o2, o3));
                }
            }
            prime_k0(nAt, DM, nBt, DM, pre);
            otile_flush(lds, dst + (size_t)(tm * 128) * ld + (dcol - wc * 64), ld);
        }
    }
}

template <int DV, int MODE>
DI void attn_task(const Params& p, int task, char* lds) {
    constexpr int NDT = DV / 32;
    constexpr int STG = 64 * AROWB + DV * AROWB;
    const int tid = tidx(), lane = tid & 63, wave = tid >> 6, r = lane & 31, h = lane >> 5;
    const bf16_t* ub = (const bf16_t*)(p.ws + OFF_U);
    const int qt = task & 15; const int rest = task >> 4;
    int seq, head, map = 0, qcol, kcol; const bf16_t* vt;
    if (MODE == 0) { head = rest & 7; seq = rest >> 3; qcol = head * 64; kcol = 512 + (head >> 2) * 64; vt = (const bf16_t*)(p.ws + OFF_VTA) + (size_t)(seq * 2 + (head >> 2)) * 64 * SL; }
    else if (MODE == 1) { map = rest & 1; head = (rest >> 1) & 3; seq = rest >> 3; qcol = 1280 + head * 128 + map * 64; kcol = 1792 + head * 128 + map * 64; vt = (const bf16_t*)(p.ws + OFF_VTC) + (size_t)(seq * 4 + head) * 128 * SL; }
    else { head = rest & 3; seq = rest >> 2; qcol = 2816 + head * 64; kcol = 3072 + head * 64; vt = (const bf16_t*)(p.ws + OFF_VTD) + (size_t)(seq * 4 + head) * 128 * SL; }
    const int qpos = qt * 128 + wave * 32 + r;
    const bf16_t* qptr = ub + ((size_t)seq * SL + qpos) * INW + qcol;
    bf16x8 qf[4];
#pragma unroll
    for (int s = 0; s < 4; ++s) qf[s] = *(const bf16x8*)(qptr + 16 * s + 8 * h);
    const bf16_t* kbase = ub + (size_t)seq * SL * INW + kcol;
    float* sBias = (float*)(lds + 2 * STG);
    if (MODE == 1) { const float* bl = (const float*)(p.ws + OFF_BIAS) + head * 4096; for (int i = tid; i < 4096; i += 256) sBias[i] = bl[i]; }
    float lgam = 0.f;
    if (MODE == 2) lgam = log2f(1.0f - exp2f(-5.0f - (float)head));
    f32x16 o[NDT];
#pragma unroll
    for (int d = 0; d < NDT; ++d)
#pragma unroll
        for (int i = 0; i < 16; ++i) o[d][i] = 0.f;
    float lsum = 0.f;
    const int srow = tid >> 3, sc = tid & 7;
    const bf16_t* kg = kbase + (size_t)srow * INW + sc * 8;
    const bf16_t* vg = vt + (size_t)srow * SL + sc * 8;
    u32x4 rk[2], rv[NDT];
#pragma unroll
    for (int i = 0; i < 2; ++i) rk[i] = *(const u32x4*)(kg + (size_t)(32 * i) * INW);
#pragma unroll
    for (int i = 0; i < NDT; ++i) rv[i] = *(const u32x4*)(vg + (size_t)(32 * i) * SL);
    const int soff = srow * AROWB + sc * 16;
#pragma unroll
    for (int i = 0; i < 2; ++i) *(u32x4*)(lds + soff + 32 * i * AROWB) = rk[i];
#pragma unroll
    for (int i = 0; i < NDT; ++i) *(u32x4*)(lds + 64 * AROWB + soff + 32 * i * AROWB) = rv[i];
    __syncthreads();
    for (int kt = 0; kt < SL / 64; ++kt) {
        const char* cur = lds + (kt & 1) * STG;
        char* nxt = lds + ((kt + 1) & 1) * STG;
        const bool more = kt + 1 < SL / 64;
        const int kv0 = kt * 64;
        if (more) {
            kg += (size_t)64 * INW; vg += 64;
#pragma unroll
            for (int i = 0; i < 2; ++i) rk[i] = *(const u32x4*)(kg + (size_t)(32 * i) * INW);
#pragma unroll
            for (int i = 0; i < NDT; ++i) rv[i] = *(const u32x4*)(vg + (size_t)(32 * i) * SL);
        }
        f32x16 st[2];
#pragma unroll
        for (int kk = 0; kk < 2; ++kk) {
#pragma unroll
            for (int i = 0; i < 16; ++i) st[kk][i] = 0.f;
#pragma unroll
            for (int s = 0; s < 4; ++s) {
                const bf16x8 kf = *(const bf16x8*)(cur + (32 * kk + r) * AROWB + (16 * s + 8 * h) * 2);
                st[kk] = MFMA32(kf, qf[s], st[kk]);
            }
        }
        const int qw0 = qt * 128 + wave * 32;
        const bool farL = MODE == 1 && (kv0 + 63 - qw0) <= -128, farR = MODE == 1 && (kv0 - (qw0 + 31)) >= 128;
        if (MODE == 1 && (farL || farR)) {
            const float bc = farL ? sBias[0] : sBias[4094];
#pragma unroll
            for (int kk = 0; kk < 2; ++kk)
#pragma unroll
                for (int i = 0; i < 16; ++i) { const float pv = __builtin_amdgcn_exp2f(st[kk][i] + bc); lsum += pv; st[kk][i] = pv; }
        } else
#pragma unroll
        for (int kk = 0; kk < 2; ++kk)
#pragma unroll
            for (int i = 0; i < 16; ++i) {
                const int m = kv0 + 32 * kk + (i & 3) + 8 * (i >> 2) + 4 * h;
                float pv;
                if (MODE == 0) pv = __builtin_amdgcn_exp2f(st[kk][i]);
                else if (MODE == 1) pv = __builtin_amdgcn_exp2f(st[kk][i] + sBias[m - qpos + 2047]);
                else pv = st[kk][i] * __builtin_amdgcn_exp2f(lgam * fabsf((float)(qpos - m)));
                if (MODE != 2) lsum += pv;
                st[kk][i] = pv;
            }
        const char* sV = cur + 64 * AROWB;
#pragma unroll
        for (int kk = 0; kk < 2; ++kk)
#pragma unroll
            for (int s2 = 0; s2 < 2; ++s2) {
                u32x4 pw;
#pragma unroll
                for (int j = 0; j < 4; ++j) pw[j] = pk2(st[kk][8 * s2 + 2 * j], st[kk][8 * s2 + 2 * j + 1]);
                const bf16x8 pf = __builtin_bit_cast(bf16x8, pw);
#pragma unroll
                for (int d = 0; d < NDT; ++d) {
                    const char* va = sV + (32 * d + r) * AROWB + (32 * kk + 16 * s2 + 4 * h) * 2;
                    const s16x4 lo = *(const s16x4*)va, hi = *(const s16x4*)(va + 16);
                    const bf16x8 vf = __builtin_shufflevector(lo, hi, 0, 1, 2, 3, 4, 5, 6, 7);
                    o[d] = MFMA32(vf, pf, o[d]);
                }
            }
        if (more) {
#pragma unroll
            for (int i = 0; i < 2; ++i) *(u32x4*)(nxt + soff + 32 * i * AROWB) = rk[i];
#pragma unroll
            for (int i = 0; i < NDT; ++i) *(u32x4*)(nxt + 64 * AROWB + soff + 32 * i * AROWB) = rv[i];
        }
        __syncthreads();
    }
    const size_t tok = (size_t)seq * SL + qpos;
    if (MODE != 2) {
        const float ltot = lsum + __shfl_xor(lsum, 32);
        const float inv = __builtin_amdgcn_rcpf(ltot);
        bf16_t* dst = MODE == 0 ? (bf16_t*)(p.ws + OFF_O) + tok * 512 + head * 64
                                : (bf16_t*)(p.ws + OFF_DT) + ((size_t)map * TG + tok) * 512 + head * 128;
#pragma unroll
        for (int d = 0; d < NDT; ++d)
#pragma unroll
            for (int a = 0; a < 4; ++a) {
                u32x2 wv; wv[0] = pk2(o[d][4 * a] * inv, o[d][4 * a + 1] * inv); wv[1] = pk2(o[d][4 * a + 2] * inv, o[d][4 * a + 3] * inv);
                *(u32x2*)(dst + 32 * d + 8 * a + 4 * h) = wv;
            }
    } else {
        float s = 0.f;
#pragma unroll
        for (int d = 0; d < NDT; ++d)
#pragma unroll
            for (int i = 0; i < 16; ++i) s += o[d][i];
        s += __shfl_xor(s, 32);
        const float mu = s * (1.0f / 128.0f);
        float vs = 0.f;
#pragma unroll
        for (int d = 0; d < NDT; ++d)
#pragma unroll
            for (int i = 0; i < 16; ++i) { const float dd = o[d][i] - mu; vs += dd * dd; }
        vs += __shfl_xor(vs, 32);
        const float rstd = rsqrtf(vs * (1.0f / 128.0f) + EPS);
        const bf16_t* gp = ub + tok * INW + 3840 + head * 128;
        bf16_t* dst = (bf16_t*)(p.ws + OFF_O) + ((size_t)3 * TG + tok) * 512 + head * 128;
#pragma unroll
        for (int d = 0; d < NDT; ++d)
#pragma unroll
            for (int a = 0; a < 4; ++a) {
                asm volatile("" ::: "memory");
                const u32x2 gw = *(const u32x2*)(gp + 32 * d + 8 * a + 4 * h);
                const float g0 = bflo(gw[0]), g1 = bfhi(gw[0]), g2 = bflo(gw[1]), g3 = bfhi(gw[1]);
                const float y0 = (o[d][4 * a] - mu) * rstd * g0 * sigmoidf_(g0), y1 = (o[d][4 * a + 1] - mu) * rstd * g1 * sigmoidf_(g1);
                const float y2 = (o[d][4 * a + 2] - mu) * rstd * g2 * sigmoidf_(g2), y3 = (o[d][4 * a + 3] - mu) * rstd * g3 * sigmoidf_(g3);
                u32x2 wv; wv[0] = pk2(y0, y1); wv[1] = pk2(y2, y3);
                *(u32x2*)(dst + 32 * d + 8 * a + 4 * h) = wv;
            }
    }
}

DI void attn_gqa2(const Params& p, int task, char* lds) {
    constexpr int DV = 64, NDT = 2;
    constexpr int STG = 64 * AROWB + DV * AROWB;
    const int tid = tidx(), lane = tid & 63, wave = tid >> 6, r = lane & 31, h = lane >> 5;
    const bf16_t* ub = (const bf16_t*)(p.ws + OFF_U);
    const int qt = task & 7, rest = task >> 3, head = rest & 7, seq = rest >> 3;
    const int qcol = head * 64, kcol = 512 + (head >> 2) * 64;
    const bf16_t* vt = (const bf16_t*)(p.ws + OFF_VTA) + (size_t)(seq * 2 + (head >> 2)) * 64 * SL;
    const int qpos0 = qt * 256 + wave * 64 + r;
    bf16x8 qf[2][4];
#pragma unroll
    for (int qs = 0; qs < 2; ++qs) {
        const bf16_t* qptr = ub + ((size_t)seq * SL + qpos0 + 32 * qs) * INW + qcol;
#pragma unroll
        for (int s = 0; s < 4; ++s) qf[qs][s] = *(const bf16x8*)(qptr + 16 * s + 8 * h);
    }
    const bf16_t* kbase = ub + (size_t)seq * SL * INW + kcol;
    f32x16 o[2][NDT];
#pragma unroll
    for (int qs = 0; qs < 2; ++qs)
#pragma unroll
        for (int d = 0; d < NDT; ++d)
#pragma unroll
            for (int i = 0; i < 16; ++i) o[qs][d][i] = 0.f;
    float lsum[2] = {0.f, 0.f};
    const int srow = tid >> 3, sc = tid & 7;
    const bf16_t* kg = kbase + (size_t)srow * INW + sc * 8;
    const bf16_t* vg = vt + (size_t)srow * SL + sc * 8;
    u32x4 rk[2], rv[NDT];
#pragma unroll
    for (int i = 0; i < 2; ++i) rk[i] = *(const u32x4*)(kg + (size_t)(32 * i) * INW);
#pragma unroll
    for (int i = 0; i < NDT; ++i) rv[i] = *(const u32x4*)(vg + (size_t)(32 * i) * SL);
    const int soff = srow * AROWB + sc * 16;
#pragma unroll
    for (int i = 0; i < 2; ++i) *(u32x4*)(lds + soff + 32 * i * AROWB) = rk[i];
#pragma unroll
    for (int i = 0; i < NDT; ++i) *(u32x4*)(lds + 64 * AROWB + soff + 32 * i * AROWB) = rv[i];
    __syncthreads();
    for (int kt = 0; kt < SL / 64; ++kt) {
        const char* cur = lds + (kt & 1) * STG;
        char* nxt = lds + ((kt + 1) & 1) * STG;
        const bool more = kt + 1 < SL / 64;
        if (more) {
            kg += (size_t)64 * INW; vg += 64;
#pragma unroll
            for (int i = 0; i < 2; ++i) rk[i] = *(const u32x4*)(kg + (size_t)(32 * i) * INW);
#pragma unroll
            for (int i = 0; i < NDT; ++i) rv[i] = *(const u32x4*)(vg + (size_t)(32 * i) * SL);
        }
        f32x16 st[2][2];
#pragma unroll
        for (int kk = 0; kk < 2; ++kk) {
#pragma unroll
            for (int i = 0; i < 16; ++i) { st[0][kk][i] = 0.f; st[1][kk][i] = 0.f; }
#pragma unroll
            for (int s = 0; s < 4; ++s) {
                const bf16x8 kf = *(const bf16x8*)(cur + (32 * kk + r) * AROWB + (16 * s + 8 * h) * 2);
                st[0][kk] = MFMA32(kf, qf[0][s], st[0][kk]);
                st[1][kk] = MFMA32(kf, qf[1][s], st[1][kk]);
            }
        }
#pragma unroll
        for (int qs = 0; qs < 2; ++qs)
#pragma unroll
            for (int kk = 0; kk < 2; ++kk)
#pragma unroll
                for (int i = 0; i < 16; ++i) { const float pv = __builtin_amdgcn_exp2f(st[qs][kk][i]); lsum[qs] += pv; st[qs][kk][i] = pv; }
        const char* sV = cur + 64 * AROWB;
#pragma unroll
        for (int kk = 0; kk < 2; ++kk)
#pragma unroll
            for (int s2 = 0; s2 < 2; ++s2) {
                bf16x8 pf[2];
#pragma unroll
                for (int qs = 0; qs < 2; ++qs) {
                    u32x4 pw;
#pragma unroll
                    for (int j = 0; j < 4; ++j) pw[j] = pk2(st[qs][kk][8 * s2 + 2 * j], st[qs][kk][8 * s2 + 2 * j + 1]);
                    pf[qs] = __builtin_bit_cast(bf16x8, pw);
                }
#pragma unroll
                for (int d = 0; d < NDT; ++d) {
                    const char* va = sV + (32 * d + r) * AROWB + (32 * kk + 16 * s2 + 4 * h) * 2;
                    const s16x4 lo = *(const s16x4*)va, hi = *(const s16x4*)(va + 16);
                    const bf16x8 vf = __builtin_shufflevector(lo, hi, 0, 1, 2, 3, 4, 5, 6, 7);
                    o[0][d] = MFMA32(vf, pf[0], o[0][d]);
                    o[1][d] = MFMA32(vf, pf[1], o[1][d]);
                }
            }
        if (more) {
#pragma unroll
            for (int i = 0; i < 2; ++i) *(u32x4*)(nxt + soff + 32 * i * AROWB) = rk[i];
#pragma unroll
            for (int i = 0; i < NDT; ++i) *(u32x4*)(nxt + 64 * AROWB + soff + 32 * i * AROWB) = rv[i];
        }
        __syncthreads();
    }
#pragma unroll
    for (int qs = 0; qs < 2; ++qs) {
        const size_t tok = (size_t)seq * SL + qpos0 + 32 * qs;
        const float ltot = lsum[qs] + __shfl_xor(lsum[qs], 32);
        const float inv = __builtin_amdgcn_rcpf(ltot);
        bf16_t* dst = (bf16_t*)(p.ws + OFF_O) + tok * 512 + head * 64;
#pragma unroll
        for (int d = 0; d < NDT; ++d)
#pragma unroll
            for (int a = 0; a < 4; ++a) {
                u32x2 wv; wv[0] = pk2(o[qs][d][4 * a] * inv, o[qs][d][4 * a + 1] * inv); wv[1] = pk2(o[qs][d][4 * a + 2] * inv, o[qs][d][4 * a + 3] * inv);
                *(u32x2*)(dst + 32 * d + 8 * a + 4 * h) = wv;
            }
    }
}

DI void tr_read8(unsigned a, s16x4 (&v)[8]) {
    asm volatile("ds_read_b64_tr_b16 %0, %8\n\tds_read_b64_tr_b16 %1, %8 offset:256\n\tds_read_b64_tr_b16 %2, %8 offset:1024\n\tds_read_b64_tr_b16 %3, %8 offset:1280\n\t"
                 "ds_read_b64_tr_b16 %4, %8 offset:2048\n\tds_read_b64_tr_b16 %5, %8 offset:2304\n\tds_read_b64_tr_b16 %6, %8 offset:3072\n\tds_read_b64_tr_b16 %7, %8 offset:3328\n\t"
                 "s_waitcnt lgkmcnt(0)"
                 : "=&v"(v[0]), "=&v"(v[1]), "=&v"(v[2]), "=&v"(v[3]), "=&v"(v[4]), "=&v"(v[5]), "=&v"(v[6]), "=&v"(v[7]) : "v"(a) : "memory");
}

DI void s5_wave_task(const Params& p, int layer, int wt, char* ldsw) {
    const int lane = tidx() & 63, r = lane & 31, h = lane >> 5;
    const int dir = wt & 1, g = (wt >> 1) & 31, pair = wt >> 6;
    const bf16_t* ub = (const bf16_t*)(p.ws + OFF_U);
    const int hp = (r >> 2) & 1, ia = 4 * (r >> 3) + (r & 3);
    const unsigned img = (unsigned)(size_t)ldsw;
    char* chunkbuf = ldsw + 8192;
    const int i16 = lane & 15, tq = i16 >> 2, tp = i16 & 3, blk = (lane >> 4) & 1;
    const unsigned trA = img + (8 * h + tq) * 64 + 8 * (4 * blk + tp);
    const float dsk = r < 16 ? p.in[I_SD][layer * 512 + g * 16 + r] : 0.f;
    bf16_t* yl = (bf16_t*)(p.ws + (dir ? OFF_YB : OFF_YF)) + ((size_t)(2 * pair + h) * 512 + g * 16 + (r & 15)) * SL;
    const int pb = (layer * 2 + dir) * 32 + g;
    const float dt = expf(p.in[I_SLDT][pb]);
    float abr[2], abi[2];
    bf16x8 bfrag[2][2], cfrag[2][2][2], dfrag;
    {
        u32x4 dw;
#pragma unroll
        for (int j = 0; j < 4; ++j) dw[j] = pk2((dir == 0 && r == 8 * h + 2 * j) ? dsk : 0.f, (dir == 0 && r == 8 * h + 2 * j + 1) ? dsk : 0.f);
        dfrag = __builtin_bit_cast(bf16x8, dw);
    }
#pragma unroll
    for (int st = 0; st < 2; ++st) {
        const int n = 32 * st + r;
        const float are = p.in[I_SARE][pb * 64 + n], aim = p.in[I_SAIM][pb * 64 + n];
        const float mag = expf(dt * are);
        abr[st] = mag * cosf(dt * aim); abi[st] = mag * sinf(dt * aim);
        const float den = are * are + aim * aim, nr = abr[st] - 1.0f;
        const float fre = (nr * are + abi[st] * aim) / den, fim = (abi[st] * are - nr * aim) / den;
        const float* bre = p.in[I_SBRE] + ((size_t)pb * 64 + n) * 16 + 8 * h;
        const float* bim = p.in[I_SBIM] + ((size_t)pb * 64 + n) * 16 + 8 * h;
        u32x4 wre, wim;
#pragma unroll
        for (int j = 0; j < 4; ++j) {
            const float br0 = bre[2 * j], bi0 = bim[2 * j], br1 = bre[2 * j + 1], bi1 = bim[2 * j + 1];
            wre[j] = pk2(fre * br0 - fim * bi0, fre * br1 - fim * bi1);
            wim[j] = pk2(fre * bi0 + fim * br0, fre * bi1 + fim * br1);
        }
        bfrag[st][0] = __builtin_bit_cast(bf16x8, wre); bfrag[st][1] = __builtin_bit_cast(bf16x8, wim);
#pragma unroll
        for (int s = 0; s < 2; ++s) {
            u32x4 cr = {0u, 0u, 0u, 0u}, ci = {0u, 0u, 0u, 0u};
            if (r < 16) {
                const float* cre = p.in[I_SCRE] + ((size_t)pb * 16 + r) * 64 + 32 * st + 16 * s + 8 * h;
                const float* cim = p.in[I_SCIM] + ((size_t)pb * 16 + r) * 64 + 32 * st + 16 * s + 8 * h;
#pragma unroll
                for (int j = 0; j < 4; ++j) { cr[j] = pk2(cre[2 * j], cre[2 * j + 1]); ci[j] = pk2(-cim[2 * j], -cim[2 * j + 1]); }
            }
            cfrag[st][s][0] = __builtin_bit_cast(bf16x8, cr); cfrag[st][s][1] = __builtin_bit_cast(bf16x8, ci);
        }
    }
    float sre[2] = {0.f, 0.f}, sim[2] = {0.f, 0.f};
    const bf16_t* gsrc[4]; int loff[4];
#pragma unroll
    for (int j = 0; j < 4; ++j) {
        const int c = lane + 64 * j, row = c >> 1, half = c & 1, ss = row >> 6, tau = row & 63;
        gsrc[j] = ub + ((size_t)(2 * pair + ss) * SL + (dir ? (SL - 1 - tau) : tau)) * INW + 768 + g * 16 + half * 8;
        loff[j] = row * 32 + half * 16;
    }
    const long cstep = dir ? -(long)64 * INW : (long)64 * INW;
    u32x4 crg[4];
#pragma unroll
    for (int j = 0; j < 4; ++j) crg[j] = *(const u32x4*)gsrc[j];
#pragma unroll
    for (int j = 0; j < 4; ++j) *(u32x4*)(chunkbuf + loff[j]) = crg[j];
    const int aoff = (hp * 64 + ia) * 32 + h * 16;
    for (int chunk = 0; chunk < SL / 64; ++chunk) {
        if (chunk + 1 < SL / 64) {
#pragma unroll
            for (int j = 0; j < 4; ++j) { gsrc[j] += cstep; crg[j] = *(const u32x4*)gsrc[j]; }
        }
        const char* cb = chunkbuf + (chunk & 1) * 4096;
#pragma unroll 1
        for (int tl = 0; tl < 4; ++tl) {
            const int s0 = chunk * 64 + tl * 16;
            const bf16x8 ua = *(const bf16x8*)(cb + aoff + tl * 512);
            f32x16 z;
#pragma unroll
            for (int i = 0; i < 16; ++i) z[i] = 0.f;
            f32x16 y0 = MFMA32(ua, dfrag, z);
            f32x16 y1 = z;
#pragma unroll
            for (int st = 0; st < 2; ++st) {
                f32x16 xr = MFMA32(ua, bfrag[st][0], z);
                f32x16 xi = MFMA32(ua, bfrag[st][1], z);
                float cr = sre[st], ci = sim[st];
#pragma unroll
                for (int i = 0; i < 16; ++i) {
                    const float nr = abr[st] * cr - abi[st] * ci + xr[i];
                    const float ni = abr[st] * ci + abi[st] * cr + xi[i];
                    cr = nr; ci = ni; xr[i] = nr; xi[i] = ni;
                }
                sre[st] = cr; sim[st] = ci;
#pragma unroll
                for (int a = 0; a < 4; ++a) {
                    u32x2 w0, w1; w0[0] = pk2(xr[4 * a], xr[4 * a + 1]); w0[1] = pk2(xr[4 * a + 2], xr[4 * a + 3]);
                    w1[0] = pk2(xi[4 * a], xi[4 * a + 1]); w1[1] = pk2(xi[4 * a + 2], xi[4 * a + 3]);
                    *(u32x2*)(ldsw + (st * 2 + 0) * 2048 + r * 64 + 8 * (2 * a + h)) = w0;
                    *(u32x2*)(ldsw + (st * 2 + 1) * 2048 + r * 64 + 8 * (2 * a + h)) = w1;
                }
            }
            asm volatile("s_waitcnt lgkmcnt(0)" ::: "memory");
            {
                s16x4 v[8];
                tr_read8(trA, v);
                y0 = MFMA32(__builtin_shufflevector(v[0], v[1], 0, 1, 2, 3, 4, 5, 6, 7), cfrag[0][0][0], y0);
                y0 = MFMA32(__builtin_shufflevector(v[2], v[3], 0, 1, 2, 3, 4, 5, 6, 7), cfrag[0][1][0], y0);
                y0 = MFMA32(__builtin_shufflevector(v[4], v[5], 0, 1, 2, 3, 4, 5, 6, 7), cfrag[0][0][1], y0);
                y0 = MFMA32(__builtin_shufflevector(v[6], v[7], 0, 1, 2, 3, 4, 5, 6, 7), cfrag[0][1][1], y0);
                s16x4 u[8];
                tr_read8(trA + 4096, u);
                y1 = MFMA32(__builtin_shufflevector(u[0], u[1], 0, 1, 2, 3, 4, 5, 6, 7), cfrag[1][0][0], y1);
                y1 = MFMA32(__builtin_shufflevector(u[2], u[3], 0, 1, 2, 3, 4, 5, 6, 7), cfrag[1][1][0], y1);
                y1 = MFMA32(__builtin_shufflevector(u[4], u[5], 0, 1, 2, 3, 4, 5, 6, 7), cfrag[1][0][1], y1);
                y1 = MFMA32(__builtin_shufflevector(u[6], u[7], 0, 1, 2, 3, 4, 5, 6, 7), cfrag[1][1][1], y1);
            }
            if (r < 16) {
                u32x4 o0, o1;
                if (dir == 0) {
#pragma unroll
                    for (int j = 0; j < 4; ++j) { o0[j] = pk2(y0[2 * j] + y1[2 * j], y0[2 * j + 1] + y1[2 * j + 1]); o1[j] = pk2(y0[8 + 2 * j] + y1[8 + 2 * j], y0[9 + 2 * j] + y1[9 + 2 * j]); }
                    *(u32x4*)(yl + s0) = o0; *(u32x4*)(yl + s0 + 8) = o1;
                } else {
#pragma unroll
                    for (int j = 0; j < 4; ++j) { o0[j] = pk2(y0[15 - 2 * j] + y1[15 - 2 * j], y0[14 - 2 * j] + y1[14 - 2 * j]); o1[j] = pk2(y0[7 - 2 * j] + y1[7 - 2 * j], y0[6 - 2 * j] + y1[6 - 2 * j]); }
                    *(u32x4*)(yl + (SL - 16 - s0)) = o0; *(u32x4*)(yl + (SL - 16 - s0) + 8) = o1;
                }
            }
        }
        if (chunk + 1 < SL / 64) {
#pragma unroll
            for (int j = 0; j < 4; ++j) *(u32x4*)(chunkbuf + ((chunk + 1) & 1) * 4096 + loff[j]) = crg[j];
        }
    }
}

DI void phase_mix(const Params& p, int layer, int qidx, char* lds, bool only_s5 = false) {
    __shared__ int s_task;
    int* qc = (int*)(p.ws + OFF_QCNT) + qidx;
    constexpr int N_S5 = (G / 2) * 32 * 2 / 4, N_DIFF = G * 4 * 2 * 16, N_RET = G * 4 * 16, N_GQA = G * 8 * 8;
    constexpr int NTOT = N_S5 + N_DIFF + N_RET + N_GQA;
    for (;;) {
        __syncthreads();
        if (tidx() == 0) s_task = atomicAdd(qc, 1);
        __syncthreads();
        int task = s_task;
        if (task >= (only_s5 ? N_S5 : NTOT)) break;
        if (task < N_S5) { const int wave = tidx() >> 6; s5_wave_task(p, layer, task * 4 + wave, lds + wave * 16384); }
        else if ((task -= N_S5) < N_DIFF) attn_task<128, 1>(p, task, lds);
        else if ((task -= N_DIFF) < N_RET) attn_task<128, 2>(p, task, lds);
        else attn_gqa2(p, task - N_RET, lds);
    }
}

DI float gelu_tanh(float v) { const float z2 = 1.5957691216057308f * (v + 0.044715f * v * v * v); return v * __builtin_amdgcn_rcpf(1.0f + __builtin_amdgcn_exp2f(-LOG2E * z2)); }

DI void glu_tile(const Params& p, int layer, int tm, int tn, char* lds) {
    const int tid = tidx(), lane = tid & 63, w = tid >> 6, wr = w >> 1, wc = w & 1, r16 = lane & 15, q4 = lane >> 4;
    const bf16_t* yf = (const bf16_t*)(p.ws + OFF_YF);
    const bf16_t* yb = (const bf16_t*)(p.ws + OFF_YB);
    const bf16_t* B = wts(p, layer) + WGLU + (size_t)tn * 128 * 512;
    const int seq = (tm * 128) >> 11, t0 = (tm * 128) & 2047;
    const int ach = tid & 63, aseg0 = tid >> 6;
    const bf16_t* fg = yf + ((size_t)seq * 512 + ach) * SL + t0;
    const bf16_t* bg2 = yb + ((size_t)seq * 512 + ach) * SL + t0;
    const int srow = tid >> 3, scol = tid & 7;
    const bf16_t* bg = B + (size_t)srow * 512 + scol * 8;
    const int soff = srow * ROWB + ((scol ^ ((srow >> 1) & 7)) << 4);
    u32x4 rf[4], rbk[4], rb[4];
    f32x4 acc[4][4]; zero_acc(acc);
    const int aoff = (wr * 64 + (lane & 15)) * ROWB;
    const int boff = GT_BYTES + (wc * 64 + (lane & 15)) * ROWB;
    const int sw = ((lane >> 4) ^ ((lane & 15) >> 1)) << 4;
    for (int kt = 0; kt < 8; ++kt) {
#pragma unroll
        for (int j = 0; j < 4; ++j) {
            rf[j] = *(const u32x4*)(fg + (size_t)kt * 64 * SL + (aseg0 + 4 * j) * 8);
            rbk[j] = *(const u32x4*)(bg2 + (size_t)kt * 64 * SL + (aseg0 + 4 * j) * 8);
            rb[j] = *(const u32x4*)(bg + (size_t)(32 * j) * 512 + kt * 64);
        }
#pragma unroll
        for (int j = 0; j < 4; ++j) {
            *(u32x4*)(lds + GT_BYTES + soff + 32 * j * ROWB) = rb[j];
            char* abase = lds + (aseg0 + 4 * j) * 8 * ROWB + (ach & 7) * 2;
#pragma unroll
            for (int e = 0; e < 4; ++e) {
                const float v0 = gelu_tanh(bflo(rf[j][e]) + bflo(rbk[j][e])), v1 = gelu_tanh(bfhi(rf[j][e]) + bfhi(rbk[j][e]));
                const unsigned pw = pk2(v0, v1);
                const int cs = (((ach >> 3) ^ ((4 * aseg0 + e) & 7)) << 4);
                *(bf16_t*)(abase + (2 * e) * ROWB + cs) = (bf16_t)(pw & 0xffffu);
                *(bf16_t*)(abase + (2 * e + 1) * ROWB + cs) = (bf16_t)(pw >> 16);
            }
        }
        __syncthreads();
        gemm_compute<false, 0>(lds, aoff, boff, sw, acc);
        __syncthreads();
    }
    bf16_t* ob = (bf16_t*)(p.ws + OFF_O) + (size_t)1 * TG * 512;
    const float* bgl = p.in[I_SBGLU] + layer * 512;
#pragma unroll
    for (int n = 0; n < 4; ++n) {
        const int ch = tn * 128 + wc * 64 + n * 16 + r16;
        const float bias = bgl[ch];
#pragma unroll
        for (int m = 0; m < 4; ++m) {
            const int tl = wr * 64 + m * 16 + q4 * 4;
            const u32x2 fw = *(const u32x2*)(yf + ((size_t)seq * 512 + ch) * SL + t0 + tl);
            const u32x2 bw = *(const u32x2*)(yb + ((size_t)seq * 512 + ch) * SL + t0 + tl);
            const float y0 = gelu_tanh(bflo(fw[0]) + bflo(bw[0])), y1 = gelu_tanh(bfhi(fw[0]) + bfhi(bw[0]));
            const float y2 = gelu_tanh(bflo(fw[1]) + bflo(bw[1])), y3 = gelu_tanh(bfhi(fw[1]) + bfhi(bw[1]));
            const unsigned w01 = pk2(y0 * sigmoidf_(acc[m][n][0] + bias), y1 * sigmoidf_(acc[m][n][1] + bias));
            const unsigned w23 = pk2(y2 * sigmoidf_(acc[m][n][2] + bias), y3 * sigmoidf_(acc[m][n][3] + bias));
            bf16_t* orow = ob + (size_t)(tm * 128 + tl) * 512 + ch;
            orow[0] = (bf16_t)(w01 & 0xffffu); orow[512] = (bf16_t)(w01 >> 16); orow[1024] = (bf16_t)(w23 & 0xffffu); orow[1536] = (bf16_t)(w23 >> 16);
        }
    }
}

DI void phase_glu(const Params& p, int layer, char* lds) {
    const int lane = tidx() & 63, w = tidx() >> 6;
    { TileIter it; ti_init(it, TG / 128, 4, 16, 4); int tm, tn; while (ti_next(it, tm, tn)) glu_tile(p, layer, tm, tn, lds); }
    const float lam = ((const float*)(p.ws + OFF_LAM))[layer], li = ((const float*)(p.ws + OFF_LAM))[4 + layer];
    const bf16_t* d0 = (const bf16_t*)(p.ws + OFF_DT); const bf16_t* d1 = d0 + (size_t)TG * 512;
    bf16_t* oc = (bf16_t*)(p.ws + OFF_O) + (size_t)2 * TG * 512;
    const f32x2 sg = *(const f32x2*)(p.in[I_DSUB] + layer * 128 + 2 * lane);
    const int gw = bidx() * 4 + w, nw = gdim() * 4;
    for (int it0 = gw; it0 < TG * 4; it0 += 8 * nw) {
        unsigned a[8], b[8];
#pragma unroll
        for (int j = 0; j < 8; ++j) {
            const int it = it0 + j * nw;
            const size_t off = (size_t)(it < TG * 4 ? it : gw) * 128 + 2 * lane;
            a[j] = *(const unsigned*)(d0 + off); b[j] = *(const unsigned*)(d1 + off);
        }
#pragma unroll
        for (int j = 0; j < 8; ++j) {
            const int it = it0 + j * nw;
            const float v0 = bflo(a[j]) - lam * bflo(b[j]), v1 = bfhi(a[j]) - lam * bfhi(b[j]);
            const float ss = wave_sum(v0 * v0 + v1 * v1);
            const float rs = rsqrtf(ss * (1.0f / 128.0f) + EPS) * (1.0f - li);
            if (it < TG * 4) *(unsigned*)(oc + (size_t)it * 128 + 2 * lane) = pk2(v0 * rs * sg[0], v1 * rs * sg[1]);
        }
    }
}

DI void phase_merge(const Params& p, int layer, char* lds) {
    const int lane = tidx() & 63, w = tidx() >> 6, wr = w >> 1, wc = w & 1, r16 = lane & 15, q4 = lane >> 4;
    const bf16_t* ob = (const bf16_t*)(p.ws + OFF_O);
    const bf16_t* gb = (const bf16_t*)(p.ws + OFF_GATE);
    const bf16_t* W = wts(p, layer) + WB;
    bf16_t* mb = (bf16_t*)(p.ws + OFF_M);
    TileIter it; ti_init(it, TG / 128, 8, 8, 8);
    int tm, tn;
    while (ti_next(it, tm, tn)) {
        f32x4 macc[4][4]; zero_acc(macc);
#pragma unroll 1
        for (int b = 0; b < 4; ++b) {
            f32x4 acc[4][4]; zero_acc(acc);
            gemm128<true, 0, false>(ob + ((size_t)b * TG + tm * 128) * 512, 512, W + ((size_t)b * 1024 + tn * 128) * 512, 512, 512, acc, lds);
#pragma unroll
            for (int m = 0; m < 4; ++m) {
                const int row = tm * 128 + wr * 64 + m * 16 + r16;
#pragma unroll
                for (int n = 0; n < 4; ++n) {
                    const int col = tn * 128 + wc * 64 + n * 16 + q4 * 4;
                    const u32x2 gw = *(const u32x2*)(gb + (size_t)row * 4096 + b * 1024 + col);
                    macc[m][n][0] += acc[m][n][0] * bflo(gw[0]); macc[m][n][1] += acc[m][n][1] * bfhi(gw[0]);
                    macc[m][n][2] += acc[m][n][2] * bflo(gw[1]); macc[m][n][3] += acc[m][n][3] * bfhi(gw[1]);
                }
            }
        }
#pragma unroll
        for (int m = 0; m < 4; ++m) {
            const int row = tm * 128 + wr * 64 + m * 16 + r16;
#pragma unroll
            for (int n = 0; n < 4; ++n) {
                const int col = tn * 128 + wc * 64 + n * 16 + q4 * 4;
                otile_put(lds, wr * 64 + m * 16 + r16, wc * 64 + n * 16 + q4 * 4, pk2(macc[m][n][0], macc[m][n][1]), pk2(macc[m][n][2], macc[m][n][3]));
            }
        }
        otile_flush(lds, mb + (size_t)(tm * 128) * DM + tn * 128, DM);
    }
}

DI void phase_resid(const Params& p, int grp, const bf16_t* A, int K, const bf16_t* Wt, bool first, char* lds) {
    const int lane = tidx() & 63, w = tidx() >> 6, wr = w >> 1, wc = w & 1, r16 = lane & 15, q4 = lane >> 4;
    TileIter it; ti_init(it, TG / 128, 8, 8, 8);
    int tm, tn, ntm = 0, ntn = 0;
    bool have = ti_next(it, tm, tn);
    GemmRegs g;
    if (have) gemm_prime(A + (size_t)tm * 128 * K, K, Wt + (size_t)tn * 128 * K, K, g);
    for (; have; tm = ntm, tn = ntn) {
        have = ti_next(it, ntm, ntn);
        const bf16_t* At = A + (size_t)tm * 128 * K; const bf16_t* Bt = Wt + (size_t)tn * 128 * K;
        const bf16_t* nAt = have ? A + (size_t)ntm * 128 * K : At; const bf16_t* nBt = have ? Wt + (size_t)ntn * 128 * K : Bt;
        f32x4 acc[4][4]; zero_acc(acc);
        gemm_stream<true>(At, Bt, nAt, nBt, K, K, K, g, acc, lds);
#pragma unroll
        for (int m = 0; m < 4; ++m)
#pragma unroll
            for (int n = 0; n < 4; ++n) *(f32x4*)(lds + (wr * 64 + m * 16 + r16) * OROWF + (wc * 64 + n * 16 + q4 * 4) * 4) = acc[m][n];
        __syncthreads();
        {
            const int tid = tidx();
#pragma unroll 4
            for (int i = 0; i < 16; ++i) {
                const int c = tid + 256 * i, rl = c >> 5, ch = c & 31, row = tm * 128 + rl;
                float* xo = p.out + ((size_t)grp * TG + row) * DM + tn * 128 + ch * 4;
                const float* xi = first ? x_in_row(p, grp, row) + tn * 128 + ch * 4 : xo;
                const f32x4 a = *(const f32x4*)(lds + rl * OROWF + ch * 16);
                const f32x4 xv = *(const f32x4*)xi;
                *(f32x4*)xo = xv + a;
            }
        }
        __syncthreads();
    }
}

DI void phase_ffn1(const Params& p, int layer, char* lds) {
    const int lane = tidx() & 63, w = tidx() >> 6, wr = w >> 1, wc = w & 1, r16 = lane & 15, q4 = lane >> 4;
    const bf16_t* hb = (const bf16_t*)(p.ws + OFF_H);
    const bf16_t* W = wts(p, layer) + WFI;
    bf16_t* fb = (bf16_t*)(p.ws + OFF_F);
    constexpr int NT = DFF / 64;
    TileIter it; ti_init(it, TG / 128, NT, 8, 4);
    int tm, tn, ntm = 0, ntn = 0;
    bool have = ti_next(it, tm, tn);
    GemmRegs g;
    if (have) gemm_prime(hb + (size_t)tm * 128 * DM, DM, W + (size_t)tn * 128 * DM, DM, g);
    for (; have; tm = ntm, tn = ntn) {
        have = ti_next(it, ntm, ntn);
        const bf16_t* At = hb + (size_t)tm * 128 * DM; const bf16_t* Bt = W + (size_t)tn * 128 * DM;
        const bf16_t* nAt = have ? hb + (size_t)ntm * 128 * DM : At; const bf16_t* nBt = have ? W + (size_t)ntn * 128 * DM : Bt;
        f32x4 acc[4][4]; zero_acc(acc);
        gemm_stream<true, 1>(At, Bt, nAt, nBt, DM, DM, DM, g, acc, lds);
#pragma unroll
        for (int m = 0; m < 4; ++m) {
            const int row = tm * 128 + wr * 64 + m * 16 + r16;
#pragma unroll
            for (int n = 0; n < 2; ++n) {
                const int col = tn * 64 + wc * 32 + n * 16 + q4 * 4;
                float f[4];
#pragma unroll
                for (int i = 0; i < 4; ++i) { const float gq = acc[m][n][i]; f[i] = gq * sigmoidf_(gq) * acc[m][n + 2][i]; }
                otile_put(lds, wr * 64 + m * 16 + r16, wc * 32 + n * 16 + q4 * 4, pk2(f[0], f[1]), pk2(f[2], f[3]));
            }
        }
        {
            const int tid = tidx();
            __syncthreads();
#pragma unroll
            for (int i = 0; i < 4; ++i) {
                const int c = tid + 256 * i, row = c >> 3, ch = c & 7;
                const u32x4 v = *(const u32x4*)(lds + row * OROW + ch * 16);
                *(u32x4*)(fb + (size_t)(tm * 128 + row) * DFF + tn * 64 + ch * 8) = v;
            }
            __syncthreads();
        }
    }
}

#define XB_TMO      128
#define XB_XCNT(j)  (256  + 64 * (j))
#define XB_XSUB(j)  (1280 + 64 * (j))
#define XB_XGEN(j)  (2304 + 64 * (j))
#define XB_TOP      3328
#define XB_TOPGEN   3392
#define XCD_BAR_WORDS 3456
#define XB_SPIN_CAP (1u << 18)
#define LAS __attribute__((address_space(3)))

__device__ __forceinline__ unsigned xb_ld(unsigned* p)              { return __hip_atomic_load(p, __ATOMIC_RELAXED, __HIP_MEMORY_SCOPE_AGENT); }
__device__ __forceinline__ unsigned xb_add(unsigned* p, unsigned v) { return __hip_atomic_fetch_add(p, v, __ATOMIC_RELAXED, __HIP_MEMORY_SCOPE_AGENT); }
__device__ __forceinline__ unsigned xb_xcc_id() { return (unsigned)__builtin_amdgcn_s_getreg((3 << 11) | 20) & 0xFu; }
#define XB_SPIN(cond, bar) do { unsigned _sp = 0; while (cond) { __builtin_amdgcn_s_sleep(1); \
    if ((++_sp & 255u) == 0u) { if (xb_ld(&(bar)[XB_TMO])) break; if (_sp > XB_SPIN_CAP) { atomicAdd(&(bar)[XB_TMO], 1u); break; } } } } while (0)

struct XcdBarrier {
    unsigned* bar; unsigned x;
    volatile LAS unsigned* st;
};

__device__ __forceinline__ XcdBarrier xcd_barrier_post(unsigned* bar, volatile LAS unsigned* st) {
    XcdBarrier b; b.bar = bar; b.x = xb_xcc_id(); b.st = st;
    if (threadIdx.x == 0) (void)xb_add(&bar[XB_XCNT(b.x)], 1u);
    return b;
}
__device__ __forceinline__ void xcd_barrier_complete(unsigned* bar, unsigned x, unsigned& nloc, unsigned& nx) {
    const unsigned G = gdim() * gridDim.y * gridDim.z;
    unsigned sum, cnt, mine, sp = 0u;
    for (;;) {
        sum = 0u; cnt = 0u; mine = 0u;
#pragma unroll
        for (unsigned j = 0; j < 16; ++j) { const unsigned c = xb_ld(&bar[XB_XCNT(j)]); sum += c; cnt += (c > 0u) ? 1u : 0u; mine = (j == x) ? c : mine; }
        if (sum == G) break;
        __builtin_amdgcn_s_sleep(1);
        if ((++sp & 255u) == 0u) { if (xb_ld(&bar[XB_TMO])) break; if (sp > XB_SPIN_CAP) { atomicAdd(&bar[XB_TMO], 1u); break; } }
    }
    nloc = mine > 0u ? mine : 1u; nx = cnt > 0u ? cnt : 1u;
}

__device__ __forceinline__ void xcd_barrier(const XcdBarrier& b) {
    asm volatile("s_waitcnt vmcnt(0)" ::: "memory");
    __syncthreads();
    if (threadIdx.x == 0) {
        unsigned* bar = b.bar;
        __builtin_amdgcn_s_waitcnt(0);
        unsigned nloc = b.st[0], nx = b.st[1];
        if (nloc == 0u) { xcd_barrier_complete(bar, b.x, nloc, nx); b.st[0] = nloc; b.st[1] = nx; }
        const unsigned old = xb_add(&bar[XB_XSUB(b.x)], 1u);
        const unsigned gen = old / nloc;
        if (old + 1u == (gen + 1u) * nloc) {
            __builtin_amdgcn_fence(__ATOMIC_RELEASE, "agent");
            asm volatile("s_waitcnt vmcnt(0)" ::: "memory");
            const unsigned og = xb_add(&bar[XB_TOP], 1u);
            const unsigned tg = og / nx;
            if (og + 1u == (tg + 1u) * nx) xb_add(&bar[XB_TOPGEN], 1u);
            else XB_SPIN(xb_ld(&bar[XB_TOPGEN]) == tg, bar);
            __builtin_amdgcn_fence(__ATOMIC_ACQUIRE, "agent");
            xb_add(&bar[XB_XGEN(b.x)], 1u);
            asm volatile("s_waitcnt vmcnt(0)" ::: "memory");
        } else {
            XB_SPIN(xb_ld(&bar[XB_XGEN(b.x)]) == gen, bar);
            __builtin_amdgcn_fence(__ATOMIC_ACQUIRE, "agent");
            asm volatile("s_waitcnt vmcnt(0)" ::: "memory");
        }
    }
    __syncthreads();
}


constexpr int PH_PER_GRP = 4 * 9 + 1;
constexpr int NPHASE = 1 + NGRP * PH_PER_GRP;

#ifndef PROBE_K
#define PROBE_K (-1)
#endif
DI void run_phase(const Params& p, int ph, char* lds, int rep = 0) {
    if (ph == 0) { phase_prologue(p, lds); return; }
    const int q = ph - 1, grp = q / PH_PER_GRP, r = q % PH_PER_GRP;
    if (r == 36) { phase_norm(p, grp, p.in[I_NFIN], 2); return; }
    const int layer = r / 9, k = r % 9;
    switch (k) {
        case 0: phase_norm(p, grp, p.in[I_NMIX] + layer * DM, layer == 0 ? 0 : 1); break;
        case 1: phase_in(p, layer, lds, rep == 1); break;
        case 2: phase_mix(p, layer, grp * 4 + layer + 20 * rep, lds, rep == 1); break;
        case 3: phase_glu(p, layer, lds); break;
        case 4: phase_merge(p, layer, lds); break;
        case 5: phase_resid(p, grp, (const bf16_t*)(p.ws + OFF_M), DM, wts(p, layer) + WO, layer == 0, lds); break;
        case 6: phase_norm(p, grp, p.in[I_NFFN] + layer * DM, 1); break;
        case 7: phase_ffn1(p, layer, lds); break;
        default: phase_resid(p, grp, (const bf16_t*)(p.ws + OFF_F), DFF, wts(p, layer) + WFO, false, lds); break;
    }
}

__global__ void __launch_bounds__(256, 2) mega(Params p, int only) {
    __shared__ __attribute__((aligned(16))) char lds[LDS_BYTES];
#if MULTI_LAUNCH
    if (only >= 0) { run_phase(p, only, lds); return; }
#endif
    cg::grid_group grid = cg::this_grid();
    __shared__ uint4 xb_words;
    if (threadIdx.x == 0) xb_words = make_uint4(0u, 0u, 0u, 0u);
    __syncthreads();
    XcdBarrier xb = xcd_barrier_post((unsigned*)(p.ws + OFF_BAR), (volatile LAS unsigned*)&xb_words);
    for (int ph = 0; ph < NPHASE; ++ph) {
        run_phase(p, ph, lds);
        if (ph + 1 < NPHASE) { if (ph == 0) grid.sync(); else xcd_barrier(xb); }
        if (PROBE_K == 100) xcd_barrier(xb);
        if (PROBE_K >= 0 && PROBE_K < 9 && ph > 0 && ((ph - 1) % PH_PER_GRP) < 36 && (((ph - 1) % PH_PER_GRP) % 9) == PROBE_K) { run_phase(p, ph, lds, 1); xcd_barrier(xb); }
    }
}

extern "C" void kernel_launch(void* const* d_in, const int* in_sizes, int n_in, void* d_out, int out_size, void* d_ws, size_t ws_size, hipStream_t stream) {
    (void)in_sizes; (void)n_in; (void)out_size;
    static int grid_blocks = 0;
    if (!grid_blocks) {
        int dev = 0, cus = 0, per_cu = 0;
        hipGetDevice(&dev);
        hipDeviceGetAttribute(&cus, hipDeviceAttributeMultiprocessorCount, dev);
        hipOccupancyMaxActiveBlocksPerMultiprocessor(&per_cu, mega, 256, 0);
        if (per_cu < 1) per_cu = 1;
        if (per_cu > 2) per_cu = 2;
        grid_blocks = cus * per_cu;
    }
    if (ws_size < WS_END) { fprintf(stderr, "workspace too small: %zu < %zu\n", ws_size, (size_t)WS_END); return; }
    Params p{};
    for (int i = 0; i < 26; ++i) p.in[i] = (const float*)d_in[i];
    p.out = (float*)d_out; p.ws = (char*)d_ws;
    hipMemsetAsync((char*)d_ws + OFF_BAR, 0, XCD_BAR_WORDS * sizeof(unsigned), stream);
#if MULTI_LAUNCH
    for (int ph = 0; ph < NPHASE; ++ph) mega<<<dim3(grid_blocks), dim3(256), 0, stream>>>(p, ph);
#else
    int only = -1;
    void* args[] = {&p, &only};
    hipError_t e = hipLaunchCooperativeKernel((void*)mega, dim3(grid_blocks), dim3(256), args, 0, stream);
    if (e != hipSuccess) fprintf(stderr, "cooperative launch failed: %s (grid %d)\n", hipGetErrorString(e), grid_blocks);
#endif
}
```

```cpp
#include <hip/hip_runtime.h>
#include <hip/hip_cooperative_groups.h>
#include <cstdio>
#include <cstdint>
namespace cg = cooperative_groups;

#ifndef MULTI_LAUNCH
#define MULTI_LAUNCH 0
#endif

#define DI __device__ __forceinline__
typedef unsigned short bf16_t;
typedef __bf16 bf16v2 __attribute__((ext_vector_type(2)));
typedef float f32x2 __attribute__((ext_vector_type(2)));
typedef short bf16x8 __attribute__((ext_vector_type(8)));
typedef short s16x4 __attribute__((ext_vector_type(4)));
typedef float f32x4 __attribute__((ext_vector_type(4)));
typedef float f32x16 __attribute__((ext_vector_type(16)));
typedef unsigned u32x4 __attribute__((ext_vector_type(4)));
typedef unsigned u32x2 __attribute__((ext_vector_type(2)));

constexpr int DM = 1024, SL = 2048, NSEQ = 40, G = 8, NGRP = NSEQ / G, TG = G * SL;
constexpr int INW = 4352, NIN = INW + 4096, DFF = 2816;
constexpr float EPS = 1e-6f;
constexpr float LOG2E = 1.4426950408889634f;

constexpr size_t WING = 0;
constexpr size_t WB = 8650752;
constexpr size_t WO = WB + 2097152;
constexpr size_t WFI = WO + 1048576;
constexpr size_t WFO = WFI + 5767168;
constexpr size_t WGLU = WFO + 2883584;
constexpr size_t LW = WGLU + 262144;

constexpr size_t OFF_W = 0;
constexpr size_t OFF_TAB = OFF_W + 4 * LW * 2;
constexpr size_t OFF_COSA = OFF_TAB, OFF_SINA = OFF_TAB + 262144, OFF_COSD = OFF_TAB + 2 * 262144, OFF_SIND = OFF_TAB + 3 * 262144;
constexpr size_t OFF_BIAS = OFF_TAB + 1048576;
constexpr size_t OFF_LAM = OFF_BIAS + 65536;
constexpr size_t OFF_QCNT = OFF_LAM + 256;
constexpr size_t OFF_BAR = OFF_TAB + 1048576 + 131072;
constexpr size_t OFF_H = OFF_TAB + 2097152;
constexpr size_t OFF_U = OFF_H + (size_t)TG * 1024 * 2;
constexpr size_t OFF_GATE = OFF_U + (size_t)TG * INW * 2;
constexpr size_t OFF_VTA = OFF_GATE + (size_t)TG * 4096 * 2;
constexpr size_t OFF_VTC = OFF_VTA + (size_t)TG * 128 * 2;
constexpr size_t OFF_VTD = OFF_VTC + (size_t)TG * 512 * 2;
constexpr size_t OFF_O = OFF_VTD + (size_t)TG * 512 * 2;
constexpr size_t OFF_YF = OFF_O + (size_t)4 * TG * 512 * 2;
constexpr size_t OFF_YB = OFF_YF + (size_t)TG * 512 * 2;
constexpr size_t OFF_DT = OFF_YB + (size_t)TG * 512 * 2;
constexpr size_t WS_END = OFF_DT + (size_t)2 * TG * 512 * 2;
constexpr size_t OFF_M = OFF_U;
constexpr size_t OFF_F = OFF_U;

struct Params { const float* in[26]; float* out; char* ws; };

enum { I_XP = 0, I_XS, I_NMIX, I_WIN, I_QG, I_KG, I_SARE, I_SAIM, I_SLDT, I_SBRE, I_SBIM, I_SCRE, I_SCIM, I_SD, I_SWGLU, I_SBGLU,
       I_DLAM, I_DSUB, I_REL, I_WGATE, I_WBR, I_WOUT, I_NFFN, I_WFI, I_WFO, I_NFIN };

constexpr int LDS_BYTES = 71680;
constexpr int AROWB = 144;
constexpr int ROWB = 128;
constexpr int GT_BYTES = 128 * ROWB;

DI int bidx() { int b = blockIdx.x; asm volatile("" : "+s"(b)); return b; }
DI int gdim() { int g = gridDim.x; asm volatile("" : "+s"(g)); return g; }
DI int tidx() { int t = threadIdx.x; asm volatile("" : "+v"(t)); return t; }
DI unsigned pk2(float a, float b) { f32x2 v = {a, b}; bf16v2 r = __builtin_convertvector(v, bf16v2); return __builtin_bit_cast(unsigned, r); }
DI float bf2f(bf16_t v) { return __uint_as_float(((unsigned)v) << 16); }
DI float bflo(unsigned w) { return __uint_as_float(w << 16); }
DI float bfhi(unsigned w) { return __uint_as_float(w & 0xffff0000u); }
DI float sigmoidf_(float x) { return __builtin_amdgcn_rcpf(1.0f + __builtin_amdgcn_exp2f(-LOG2E * x)); }
DI float wave_sum(float v) { v += __shfl_xor(v, 32); v += __shfl_xor(v, 16); v += __shfl_xor(v, 8); v += __shfl_xor(v, 4); v += __shfl_xor(v, 2); v += __shfl_xor(v, 1); return v; }
DI bf16_t* wts(const Params& p, int layer) { return (bf16_t*)(p.ws + OFF_W) + (size_t)layer * LW; }
#define MFMA16(a, b, c) __builtin_amdgcn_mfma_f32_16x16x32_bf16((a), (b), (c), 0, 0, 0)
#define MFMA32(a, b, c) __builtin_amdgcn_mfma_f32_32x32x16_bf16((a), (b), (c), 0, 0, 0)

template <bool SWAP, int BMAP>
DI void gemm_compute(const char* cur, int aoff, int boff, int sw, f32x4 (&acc)[4][4]) {
#pragma unroll
    for (int ks = 0; ks < 2; ++ks) {
        bf16x8 af[4], bfr[4];
        if (ks) asm volatile("" ::: "memory");
        const int so = sw ^ (ks * 64);
#pragma unroll
        for (int m = 0; m < 4; ++m) af[m] = *(const bf16x8*)(cur + aoff + m * 16 * ROWB + so);
#pragma unroll
        for (int n = 0; n < 4; ++n) bfr[n] = *(const bf16x8*)(cur + boff + (BMAP ? ((n >> 1) * 64 + (n & 1) * 16) : n * 16) * ROWB + so);
#pragma unroll
        for (int m = 0; m < 4; ++m)
#pragma unroll
            for (int n = 0; n < 4; ++n) acc[m][n] = SWAP ? MFMA16(bfr[n], af[m], acc[m][n]) : MFMA16(af[m], bfr[n], acc[m][n]);
    }
}
#define GLOAD(RA, RB, KT) { _Pragma("unroll") for (int i_ = 0; i_ < 4; ++i_) { \
    const char* ua_ = Ab + (size_t)(((32 * i_) * lda + (KT) * 64) * 2); const char* ub_ = Bb + (size_t)(((32 * i_) * ldb + (KT) * 64) * 2); \
    RA[i_] = *(const u32x4*)(ua_ + avoff); RB[i_] = *(const u32x4*)(ub_ + bvoff); } }
#define LSTORE(RA, RB, ST) { _Pragma("unroll") for (int i_ = 0; i_ < 4; ++i_) { *(u32x4*)(lds + (ST) * (2 * GT_BYTES) + soff + 32 * i_ * ROWB) = RA[i_]; *(u32x4*)(lds + (ST) * (2 * GT_BYTES) + GT_BYTES + soff + 32 * i_ * ROWB) = RB[i_]; } }
template <bool SWAP, int BMAP = 0, bool DEEP = true>
DI void gemm128(const bf16_t* __restrict__ A, int lda, const bf16_t* __restrict__ B, int ldb, int K, f32x4 (&acc)[4][4], char* lds) {
    const int tid = tidx(), lane = tid & 63, w = tid >> 6, wr = w >> 1, wc = w & 1;
    const int srow = tid >> 3, scol = tid & 7;
    const char* Ab = (const char*)A; const char* Bb = (const char*)B;
    const unsigned avoff = (unsigned)(srow * lda + scol * 8) * 2u, bvoff = (unsigned)(srow * ldb + scol * 8) * 2u;
    const int soff = srow * ROWB + ((scol ^ ((srow >> 1) & 7)) << 4);
    const int nk = K >> 6;
    const int aoff = (wr * 64 + (lane & 15)) * ROWB;
    const int boff = GT_BYTES + ((BMAP ? wc * 32 : wc * 64) + (lane & 15)) * ROWB;
    const int sw = ((lane >> 4) ^ ((lane & 15) >> 1)) << 4;
    u32x4 ra0[4], rb0[4];
    GLOAD(ra0, rb0, 0);
    LSTORE(ra0, rb0, 0);
    if (DEEP) {
        u32x4 ra1[4], rb1[4];
        GLOAD(ra1, rb1, 1);
        __syncthreads();
        for (int kt = 0; kt < nk; kt += 2) {
            { const int k2 = kt + 2 < nk ? kt + 2 : nk - 1; GLOAD(ra0, rb0, k2); }
            gemm_compute<SWAP, BMAP>(lds, aoff, boff, sw, acc);
            LSTORE(ra1, rb1, 1);
            __syncthreads();
            { const int k3 = kt + 3 < nk ? kt + 3 : nk - 1; GLOAD(ra1, rb1, k3); }
            gemm_compute<SWAP, BMAP>(lds + 2 * GT_BYTES, aoff, boff, sw, acc);
            LSTORE(ra0, rb0, 0);
            __syncthreads();
        }
    } else {
        __syncthreads();
        for (int kt = 0; kt < nk; ++kt) {
            const bool more = (kt + 1 < nk);
            if (more) GLOAD(ra0, rb0, kt + 1);
            gemm_compute<SWAP, BMAP>(lds + (kt & 1) * (2 * GT_BYTES), aoff, boff, sw, acc);
            if (more) { if (kt & 1) { LSTORE(ra0, rb0, 0); } else { LSTORE(ra0, rb0, 1); } }
            __syncthreads();
        }
    }
}

struct GemmR { u32x4 a[4], b[4]; };
DI void prime_k0(const bf16_t* A, int lda, const bf16_t* B, int ldb, GemmR& g) {
    const int tid = tidx(), srow = tid >> 3, scol = tid & 7;
    const char* Ab = (const char*)A; const char* Bb = (const char*)B;
    const unsigned avoff = (unsigned)(srow * lda + scol * 8) * 2u, bvoff = (unsigned)(srow * ldb + scol * 8) * 2u;
    GLOAD(g.a, g.b, 0);
}
template <bool SWAP, int BMAP = 0>
DI void gemm128pre(const bf16_t* __restrict__ A, int lda, const bf16_t* __restrict__ B, int ldb, int K, GemmR& pre, f32x4 (&acc)[4][4], char* lds) {
    const int tid = tidx(), lane = tid & 63, w = tid >> 6, wr = w >> 1, wc = w & 1;
    const int srow = tid >> 3, scol = tid & 7;
    const char* Ab = (const char*)A; const char* Bb = (const char*)B;
    const unsigned avoff = (unsigned)(srow * lda + scol * 8) * 2u, bvoff = (unsigned)(srow * ldb + scol * 8) * 2u;
    const int soff = srow * ROWB + ((scol ^ ((srow >> 1) & 7)) << 4);
    const int nk = K >> 6;
    const int aoff = (wr * 64 + (lane & 15)) * ROWB;
    const int boff = GT_BYTES + ((BMAP ? wc * 32 : wc * 64) + (lane & 15)) * ROWB;
    const int sw = ((lane >> 4) ^ ((lane & 15) >> 1)) << 4;
    u32x4 ra1[4], rb1[4];
    LSTORE(pre.a, pre.b, 0);
    GLOAD(ra1, rb1, 1);
    __syncthreads();
    for (int kt = 0; kt < nk; kt += 2) {
        { const int k2 = kt + 2 < nk ? kt + 2 : nk - 1; GLOAD(pre.a, pre.b, k2); }
        gemm_compute<SWAP, BMAP>(lds, aoff, boff, sw, acc);
        LSTORE(ra1, rb1, 1);
        __syncthreads();
        { const int k3 = kt + 3 < nk ? kt + 3 : nk - 1; GLOAD(ra1, rb1, k3); }
        gemm_compute<SWAP, BMAP>(lds + 2 * GT_BYTES, aoff, boff, sw, acc);
        LSTORE(pre.a, pre.b, 0);
        __syncthreads();
    }
}

struct TileIter { int per, SM, SN, nSn, sbase, len, q, nslot; };
DI void ti_init(TileIter& it, int NTm, int NTn, int SM, int SN) {
    const int x = bidx() & 7;
    it.nslot = (gdim() - x + 7) >> 3; it.per = SM * SN; it.SM = SM; it.SN = SN; it.nSn = NTn / SN;
    const int nS = (NTm / SM) * it.nSn;
    it.sbase = x * (nS >> 3); it.len = (nS >> 3) * it.per; it.q = bidx() >> 3;
}
DI bool ti_next(TileIter& it, int& tm, int& tn) {
    if (it.q >= it.len) return false;
    const int j = it.q / it.per, w = it.q % it.per, S = it.sbase + j, sm = S / it.nSn, sn = S % it.nSn;
    tm = sm * it.SM + (w % it.SM); tn = sn * it.SN + (w / it.SM);
    it.q += it.nslot;
    return true;
}

struct GemmRegs { u32x4 a0[4], b0[4], a1[4], b1[4]; };
typedef const __attribute__((address_space(1))) char* gptr_t;
typedef const __attribute__((address_space(1))) u32x4* gvec_t;
DI gptr_t uptr(const void* q) {
    const size_t v = (size_t)q;
    const unsigned lo = __builtin_amdgcn_readfirstlane((unsigned)v), hi = __builtin_amdgcn_readfirstlane((unsigned)(v >> 32));
    return (gptr_t)(((size_t)hi << 32) | lo);
}
#define GLOADP(RA, RB, PA, PB, KT) { _Pragma("unroll") for (int i_ = 0; i_ < 4; ++i_) { \
    gptr_t ua_ = (PA) + (size_t)(((32 * i_) * lda + (KT) * 64) * 2); gptr_t ub_ = (PB) + (size_t)(((32 * i_) * ldb + (KT) * 64) * 2); \
    RA[i_] = *(gvec_t)(ua_ + avoff); RB[i_] = *(gvec_t)(ub_ + bvoff); } }
DI void gemm_prime(const bf16_t* A, int lda, const bf16_t* B, int ldb, GemmRegs& g) {
    const int tid = tidx(), srow = tid >> 3, scol = tid & 7;
    const unsigned avoff = (unsigned)(srow * lda + scol * 8) * 2u, bvoff = (unsigned)(srow * ldb + scol * 8) * 2u;
    gptr_t Ab = uptr(A); gptr_t Bb = uptr(B);
    GLOADP(g.a0, g.b0, Ab, Bb, 0);
    GLOADP(g.a1, g.b1, Ab, Bb, 1);
}
template <bool SWAP, int BMAP = 0>
DI void gemm_stream(const bf16_t* A, const bf16_t* B, const bf16_t* nA, const bf16_t* nB, int lda, int ldb, int K, GemmRegs& g, f32x4 (&acc)[4][4], char* lds) {
    const int tid = tidx(), lane = tid & 63, w = tid >> 6, wr = w >> 1, wc = w & 1;
    const int srow = tid >> 3, scol = tid & 7;
    const unsigned avoff = (unsigned)(srow * lda + scol * 8) * 2u, bvoff = (unsigned)(srow * ldb + scol * 8) * 2u;
    gptr_t Ab = uptr(A); gptr_t Bb = uptr(B); gptr_t nAb = uptr(nA); gptr_t nBb = uptr(nB);
    const int soff = srow * ROWB + ((scol ^ ((srow >> 1) & 7)) << 4);
    const int nk = K >> 6;
    const int aoff = (wr * 64 + (lane & 15)) * ROWB;
    const int boff = GT_BYTES + ((BMAP ? wc * 32 : wc * 64) + (lane & 15)) * ROWB;
    const int sw = ((lane >> 4) ^ ((lane & 15) >> 1)) << 4;
    LSTORE(g.a0, g.b0, 0);
    __syncthreads();
    for (int kt = 0; kt < nk; kt += 2) {
        const bool last = kt + 2 >= nk;
        gptr_t pa = last ? nAb : Ab; gptr_t pb = last ? nBb : Bb;
        const int k2 = last ? 0 : kt + 2, k3 = last ? 1 : kt + 3;
        GLOADP(g.a0, g.b0, pa, pb, k2);
        gemm_compute<SWAP, BMAP>(lds, aoff, boff, sw, acc);
        LSTORE(g.a1, g.b1, 1);
        __syncthreads();
        GLOADP(g.a1, g.b1, pa, pb, k3);
        gemm_compute<SWAP, BMAP>(lds + 2 * GT_BYTES, aoff, boff, sw, acc);
        if (!last) LSTORE(g.a0, g.b0, 0);
        __syncthreads();
    }
}

DI void zero_acc(f32x4 (&acc)[4][4]) {
#pragma unroll
    for (int m = 0; m < 4; ++m)
#pragma unroll
        for (int n = 0; n < 4; ++n) acc[m][n] = (f32x4){0.f, 0.f, 0.f, 0.f};
}


constexpr int OROW = 272;
constexpr int OROWF = 528;
DI void otile_put(char* lds, int row, int col, unsigned w0, unsigned w1) { u32x2 w; w[0] = w0; w[1] = w1; *(u32x2*)(lds + row * OROW + col * 2) = w; }
DI void otile_flush(char* lds, bf16_t* dst, int ld) {
    const int tid = tidx();
    __syncthreads();
#pragma unroll
    for (int i = 0; i < 8; ++i) {
        const int c = tid + 256 * i, row = c >> 4, ch = c & 15;
        const u32x4 v = *(const u32x4*)(lds + row * OROW + ch * 16);
        *(u32x4*)(dst + (size_t)row * ld + ch * 8) = v;
    }
    __syncthreads();
}

DI void conv_tile(const float* __restrict__ src, bf16_t* __restrict__ dst, int K, int N, int tk, int tn, int drow0, float* tile) {
    const int tid = tidx(), ty = tid >> 4, tx = tid & 15;
#pragma unroll
    for (int i = 0; i < 4; ++i) {
        const int k = ty + 16 * i;
        const f32x4 v = *(const f32x4*)(src + (size_t)(tk * 64 + k) * N + tn * 64 + tx * 4);
        tile[k * 65 + tx * 4 + 0] = v[0]; tile[k * 65 + tx * 4 + 1] = v[1]; tile[k * 65 + tx * 4 + 2] = v[2]; tile[k * 65 + tx * 4 + 3] = v[3];
    }
    __syncthreads();
    const int n = tid >> 2, ks = (tid & 3) * 16;
    u32x4 w0, w1;
#pragma unroll
    for (int j = 0; j < 4; ++j) {
        w0[j] = pk2(tile[(ks + 2 * j) * 65 + n], tile[(ks + 2 * j + 1) * 65 + n]);
        w1[j] = pk2(tile[(ks + 8 + 2 * j) * 65 + n], tile[(ks + 8 + 2 * j + 1) * 65 + n]);
    }
    bf16_t* d = dst + (size_t)(drow0 + n) * K + tk * 64 + ks;
    *(u32x4*)d = w0; *(u32x4*)(d + 8) = w1;
    __syncthreads();
}

DI int t5_bucket(int rel) {
    const int base = rel > 0 ? 16 : 0;
    const int dist = rel < 0 ? -rel : rel;
    int b;
    if (dist < 8) b = dist;
    else {
        const float lr = logf((float)dist / 8.0f) / 2.772588722239781f;
        int lg = 8 + (int)(lr * 8.0f);
        b = lg < 15 ? lg : 15;
    }
    return base + b;
}

DI void phase_prologue(const Params& p, char* lds) {
    float* tile = (float*)lds;
    const int tid = tidx();
    for (int t = bidx(); t < 4 * 5056; t += gdim()) {
        const int layer = t / 5056; int q = t % 5056;
        bf16_t* wl = wts(p, layer);
        const float* src; bf16_t* dst; int K, N, nn;
        if (q < 1088) { src = p.in[I_WIN] + (size_t)layer * 1024 * INW; dst = wl + WING; K = 1024; N = INW; }
        else if ((q -= 1088) < 1024) { const int b = q >> 8; q &= 255; src = p.in[I_WGATE] + (size_t)(layer * 4 + b) * 1024 * 1024; dst = wl + WING + (size_t)(INW + b * 1024) * 1024; K = 1024; N = 1024; }
        else if ((q -= 1024) < 512) { const int b = q >> 7; q &= 127; src = p.in[I_WBR] + (size_t)(layer * 4 + b) * 512 * 1024; dst = wl + WB + (size_t)b * 1024 * 512; K = 512; N = 1024; }
        else if ((q -= 512) < 256) { src = p.in[I_WOUT] + (size_t)layer * 1024 * 1024; dst = wl + WO; K = 1024; N = 1024; }
        else if ((q -= 256) < 1408) { src = p.in[I_WFI] + (size_t)layer * 1024 * 5632; dst = wl + WFI; K = 1024; N = 5632; }
        else if ((q -= 1408) < 704) { src = p.in[I_WFO] + (size_t)layer * DFF * 1024; dst = wl + WFO; K = DFF; N = 1024; }
        else { q -= 704; src = p.in[I_SWGLU] + (size_t)layer * 512 * 512; dst = wl + WGLU; K = 512; N = 512; }
        nn = N >> 6;
        const int tk = q / nn, tn = q % nn;
        int drow0 = tn * 64;
        if (N == 5632) drow0 = tn < 44 ? tn * 128 : (tn - 44) * 128 + 64;
        conv_tile(src, dst, K, N, tk, tn, drow0, tile);
    }
    const int gt = bidx() * 256 + tid, gn = gdim() * 256;
    float* cosA = (float*)(p.ws + OFF_COSA); float* sinA = (float*)(p.ws + OFF_SINA);
    float* cosD = (float*)(p.ws + OFF_COSD); float* sinD = (float*)(p.ws + OFF_SIND);
    for (int i = gt; i < SL * 32; i += gn) {
        const int t = i >> 5, j = i & 31;
        const float invA = exp2f(-(float)(j & 15) * (13.287712379549449f / 16.0f));
        const float angA = (j < 16 ? (float)(t >> 6) : (float)(t & 63)) * invA;
        cosA[i] = cosf(angA); sinA[i] = sinf(angA);
        const float invD = exp2f(-(float)j * (13.287712379549449f / 32.0f));
        const float angD = (float)t * invD;
        cosD[i] = cosf(angD); sinD[i] = sinf(angD);
    }
    float* bias = (float*)(p.ws + OFF_BIAS);
    for (int i = gt; i < 4 * 4096; i += gn) {
        const int h = i >> 12, r = i & 4095;
        float v = 0.f;
        if (r < 4095) v = p.in[I_REL][t5_bucket(r - 2047) * 4 + h] * LOG2E;
        bias[i] = v;
    }
    if (bidx() == 0) {
        if (tid < 4) {
            const float* lv = p.in[I_DLAM] + tid * 256;
            float s1 = 0.f, s2 = 0.f;
            for (int j = 0; j < 64; ++j) { s1 += lv[j] * lv[64 + j]; s2 += lv[128 + j] * lv[192 + j]; }
            const float li = 0.8f - 0.6f * expf(-0.3f * (float)tid);
            float* lam = (float*)(p.ws + OFF_LAM);
            lam[tid] = expf(s1) - expf(s2) + li; lam[4 + tid] = li;
        }
        if (tid < 64) ((int*)(p.ws + OFF_QCNT))[tid] = 0;
    }
}

DI const float* x_in_row(const Params& p, int grp, int row) {
    const int seq = grp * G + (row >> 11), t = row & 2047;
    return seq < 8 ? p.in[I_XP] + ((size_t)seq * SL + t) * DM : p.in[I_XS] + ((size_t)(seq - 8) * SL + t) * DM;
}
DI void phase_norm(const Params& p, int grp, const float* gain, int mode) {
    const int lane = tidx() & 63;
    const int gw = bidx() * 4 + (tidx() >> 6), nw = gdim() * 4;
    bf16_t* hb = (bf16_t*)(p.ws + OFF_H);
    f32x4 gv[4];
#pragma unroll
    for (int i = 0; i < 4; ++i) gv[i] = *(const f32x4*)(gain + lane * 4 + 256 * i);
    for (int row = gw; row < TG; row += nw) {
        float* xo = p.out + ((size_t)grp * TG + row) * DM;
        const float* x = mode == 0 ? x_in_row(p, grp, row) : xo;
        f32x4 v[4]; float ss = 0.f;
#pragma unroll
        for (int i = 0; i < 4; ++i) { v[i] = *(const f32x4*)(x + lane * 4 + 256 * i); ss += v[i][0] * v[i][0] + v[i][1] * v[i][1] + v[i][2] * v[i][2] + v[i][3] * v[i][3]; }
        ss = wave_sum(ss);
        const float rstd = rsqrtf(ss * (1.0f / 1024.0f) + EPS);
#pragma unroll
        for (int i = 0; i < 4; ++i) {
            const f32x4 y = v[i] * rstd * gv[i];
            if (mode == 2) *(f32x4*)(xo + lane * 4 + 256 * i) = y;
            else { u32x2 w; w[0] = pk2(y[0], y[1]); w[1] = pk2(y[2], y[3]); *(u32x2*)(hb + (size_t)row * DM + lane * 4 + 256 * i) = w; }
        }
    }
}

DI void phase_in(const Params& p, int layer, char* lds, bool probe = false) {
    const bf16_t* hb = (const bf16_t*)(p.ws + OFF_H);
    const bf16_t* W = wts(p, layer) + WING;
    bf16_t* ub = (bf16_t*)(p.ws + OFF_U);
    bf16_t* gb = (bf16_t*)(p.ws + OFF_GATE);
    constexpr int NT = NIN / 128;
    const int lane = tidx() & 63, w = tidx() >> 6, wr = w >> 1, wc = w & 1, r16 = lane & 15, q4 = lane >> 4;
    TileIter it; ti_init(it, TG / 128, NT, 8, 6);
    int tm, tn, ntm = 0, ntn = 0;
    bool have = ti_next(it, tm, tn);
    GemmR pre;
    if (have) prime_k0(hb + (size_t)tm * 128 * DM, DM, W + (size_t)(tn * 128) * DM, DM, pre);
    for (; have; tm = ntm, tn = ntn) {
        have = ti_next(it, ntm, ntn);
        const bf16_t* nAt = have ? hb + (size_t)ntm * 128 * DM : hb; const bf16_t* nBt = have ? W + (size_t)(ntn * 128) * DM : W;
        const int c0 = tn * 128;
        const bool isV = (c0 == 640) || (c0 >= 2304 && c0 < 2816) || (c0 >= 3328 && c0 < 3840);
        f32x4 acc[4][4]; zero_acc(acc);
        const int cb = c0 + wc * 64;
        if (isV) {
            gemm128pre<false>(hb + (size_t)tm * 128 * DM, DM, W + (size_t)c0 * DM, DM, DM, pre, acc, lds);
            prime_k0(nAt, DM, nBt, DM, pre);
            bf16_t* vt; int cl, DV, NH;
            if (cb < 768) { vt = (bf16_t*)(p.ws + OFF_VTA); cl = cb - 640; DV = 64; NH = 2; }
            else if (cb < 2816) { vt = (bf16_t*)(p.ws + OFF_VTC); cl = cb - 2304; DV = 128; NH = 4; }
            else { vt = (bf16_t*)(p.ws + OFF_VTD); cl = cb - 3328; DV = 128; NH = 4; }
#pragma unroll
            for (int m = 0; m < 4; ++m) {
                const int row0 = tm * 128 + wr * 64 + m * 16 + q4 * 4, seq = row0 >> 11, t0 = row0 & 2047;
#pragma unroll
                for (int n = 0; n < 4; ++n) {
                    const int col = cl + n * 16 + r16, head = col / DV, d = col % DV;
                    u32x2 wv; wv[0] = pk2(acc[m][n][0], acc[m][n][1]); wv[1] = pk2(acc[m][n][2], acc[m][n][3]);
                    *(u32x2*)(vt + ((size_t)(seq * NH + head) * DV + d) * SL + t0) = wv;
                }
            }
        } else {
            gemm128pre<true>(hb + (size_t)tm * 128 * DM, DM, W + (size_t)c0 * DM, DM, DM, pre, acc, lds);
            bool donorm = false, dosig = false; int rot = 0; float scale = 1.f; const float* gain = nullptr;
            bf16_t* dst = ub; int ld = INW, dcol = cb;
            if (cb < 512) { donorm = true; rot = 1; scale = 0.125f * LOG2E; gain = p.in[I_QG] + layer * 64; }
            else if (cb < 640) { donorm = true; rot = 1; gain = p.in[I_KG] + layer * 64; }
            else if (cb < 1280) { }
            else if (cb < 1792) { scale = 0.125f * LOG2E; }
            else if (cb < 2816) { }
            else if (cb < 3072) { rot = 2; scale = 0.125f; }
            else if (cb < 3328) { rot = 2; }
            else if (cb < INW) { }
            else { dosig = true; dst = gb; ld = 4096; dcol = cb - INW; }
            float gl[4][4];
            if (donorm) {
#pragma unroll
                for (int n = 0; n < 4; ++n) { const f32x4 g4 = *(const f32x4*)(gain + n * 16 + q4 * 4); gl[n][0] = g4[0]; gl[n][1] = g4[1]; gl[n][2] = g4[2]; gl[n][3] = g4[3]; }
            }
            const float* ct = (const float*)(p.ws + (rot == 2 ? OFF_COSD : OFF_COSA));
            const float* sn = (const float*)(p.ws + (rot == 2 ? OFF_SIND : OFF_SINA));
#pragma unroll
            for (int m = 0; m < 4; ++m) {
                asm volatile("" ::: "memory");
                const int row = tm * 128 + wr * 64 + m * 16 + r16, tpos = row & 2047;
                float v[4][4];
#pragma unroll
                for (int n = 0; n < 4; ++n)
#pragma unroll
                    for (int i = 0; i < 4; ++i) v[n][i] = acc[m][n][i];
                if (donorm) {
                    float ss = 0.f;
#pragma unroll
                    for (int n = 0; n < 4; ++n)
#pragma unroll
                        for (int i = 0; i < 4; ++i) ss += v[n][i] * v[n][i];
                    ss += __shfl_xor(ss, 16); ss += __shfl_xor(ss, 32);
                    const float rstd = rsqrtf(ss * (1.0f / 64.0f) + EPS);
#pragma unroll
                    for (int n = 0; n < 4; ++n)
#pragma unroll
                        for (int i = 0; i < 4; ++i) v[n][i] = v[n][i] * rstd * gl[n][i];
                }
                if (rot) {
#pragma unroll
                    for (int n = 0; n < 2; ++n) {
                        const f32x4 c4 = *(const f32x4*)(ct + tpos * 32 + n * 16 + q4 * 4), s4 = *(const f32x4*)(sn + tpos * 32 + n * 16 + q4 * 4);
#pragma unroll
                        for (int i = 0; i < 4; ++i) { const float x1 = v[n][i], x2 = v[n + 2][i]; v[n][i] = x1 * c4[i] - x2 * s4[i]; v[n + 2][i] = x2 * c4[i] + x1 * s4[i]; }
                    }
                }
#pragma unroll
                for (int n = 0; n < 4; ++n) {
                    float o0, o1, o2, o3;
                    if (dosig) { o0 = sigmoidf_(v[n][0]); o1 = sigmoidf_(v[n][1]); o2 = sigmoidf_(v[n][2]); o3 = sigmoidf_(v[n][3]); }
                    else { o0 = v[n][0] * scale; o1 = v[n][1] * scale; o2 = v[n][2] * scale; o3 = v[n][3] * scale; }
                    otile_put(lds, wr * 64 + m * 16 + r16, wc * 64 + n * 16 + q4 * 4, pk2(o0, o1), pk2(o2, o3));
                }
            }
            prime_k0(nAt, DM, nBt, DM, pre);
            otile_flush(lds, dst + (size_t)(tm * 128) * ld + (dcol - wc * 64), ld);
        }
    }
}

template <int DV, int MODE>
DI void attn_task(const Params& p, int task, char* lds) {
    constexpr int NDT = DV / 32;
    constexpr int STG = 64 * AROWB + DV * AROWB;
    const int tid = tidx(), lane = tid & 63, wave = tid >> 6, r = lane & 31, h = lane >> 5;
    const bf16_t* ub = (const bf16_t*)(p.ws + OFF_U);
    const int qt = task & 15; const int rest = task >> 4;
    int seq, head, map = 0, qcol, kcol; const bf16_t* vt;
    if (MODE == 0) { head = rest & 7; seq = rest >> 3; qcol = head * 64; kcol = 512 + (head >> 2) * 64; vt = (const bf16_t*)(p.ws + OFF_VTA) + (size_t)(seq * 2 + (head >> 2)) * 64 * SL; }
    else if (MODE == 1) { map = rest & 1; head = (rest >> 1) & 3; seq = rest >> 3; qcol = 1280 + head * 128 + map * 64; kcol = 1792 + head * 128 + map * 64; vt = (const bf16_t*)(p.ws + OFF_VTC) + (size_t)(seq * 4 + head) * 128 * SL; }
    else { head = rest & 3; seq = rest >> 2; qcol = 2816 + head * 64; kcol = 3072 + head * 64; vt = (const bf16_t*)(p.ws + OFF_VTD) + (size_t)(seq * 4 + head) * 128 * SL; }
    const int qpos = qt * 128 + wave * 32 + r;
    const bf16_t* qptr = ub + ((size_t)seq * SL + qpos) * INW + qcol;
    bf16x8 qf[4];
#pragma unroll
    for (int s = 0; s < 4; ++s) qf[s] = *(const bf16x8*)(qptr + 16 * s + 8 * h);
    const bf16_t* kbase = ub + (size_t)seq * SL * INW + kcol;
    float* sBias = (float*)(lds + 2 * STG);
    if (MODE == 1) { const float* bl = (const float*)(p.ws + OFF_BIAS) + head * 4096; for (int i = tid; i < 4096; i += 256) sBias[i] = bl[i]; }
    float lgam = 0.f;
    if (MODE == 2) lgam = log2f(1.0f - exp2f(-5.0f - (float)head));
    f32x16 o[NDT];
#pragma unroll
    for (int d = 0; d < NDT; ++d)
#pragma unroll
        for (int i = 0; i < 16; ++i) o[d][i] = 0.f;
    float lsum = 0.f;
    const int srow = tid >> 3, sc = tid & 7;
    const bf16_t* kg = kbase + (size_t)srow * INW + sc * 8;
    const bf16_t* vg = vt + (size_t)srow * SL + sc * 8;
    u32x4 rk[2], rv[NDT];
#pragma unroll
    for (int i = 0; i < 2; ++i) rk[i] = *(const u32x4*)(kg + (size_t)(32 * i) * INW);
#pragma unroll
    for (int i = 0; i < NDT; ++i) rv[i] = *(const u32x4*)(vg + (size_t)(32 * i) * SL);
    const int soff = srow * AROWB + sc * 16;
#pragma unroll
    for (int i = 0; i < 2; ++i) *(u32x4*)(lds + soff + 32 * i * AROWB) = rk[i];
#pragma unroll
    for (int i = 0; i < NDT; ++i) *(u32x4*)(lds + 64 * AROWB + soff + 32 * i * AROWB) = rv[i];
    __syncthreads();
    for (int kt = 0; kt < SL / 64; ++kt) {
        const char* cur = lds + (kt & 1) * STG;
        char* nxt = lds + ((kt + 1) & 1) * STG;
        const bool more = kt + 1 < SL / 64;
        const int kv0 = kt * 64;
        if (more) {
            kg += (size_t)64 * INW; vg += 64;
#pragma unroll
            for (int i = 0; i < 2; ++i) rk[i] = *(const u32x4*)(kg + (size_t)(32 * i) * INW);
#pragma unroll
            for (int i = 0; i < NDT; ++i) rv[i] = *(const u32x4*)(vg + (size_t)(32 * i) * SL);
        }
        f32x16 st[2];
#pragma unroll
        for (int kk = 0; kk < 2; ++kk) {
#pragma unroll
            for (int i = 0; i < 16; ++i) st[kk][i] = 0.f;
#pragma unroll
            for (int s = 0; s < 4; ++s) {
                const bf16x8 kf = *(const bf16x8*)(cur + (32 * kk + r) * AROWB + (16 * s + 8 * h) * 2);
                st[kk] = MFMA32(kf, qf[s], st[kk]);
            }
        }
        const int qw0 = qt * 128 + wave * 32;
        const bool farL = MODE == 1 && (kv0 + 63 - qw0) <= -128, farR = MODE == 1 && (kv0 - (qw0 + 31)) >= 128;
        if (MODE == 1 && (farL || farR)) {
            const float bc = farL ? sBias[0] : sBias[4094];
#pragma unroll
            for (int kk = 0; kk < 2; ++kk)
#pragma unroll
                for (int i = 0; i < 16; ++i) { const float pv = __builtin_amdgcn_exp2f(st[kk][i] + bc); lsum += pv; st[kk][i] = pv; }
        } else
#pragma unroll
        for (int kk = 0; kk < 2; ++kk)
#pragma unroll
            for (int i = 0; i < 16; ++i) {
                const int m = kv0 + 32 * kk + (i & 3) + 8 * (i >> 2) + 4 * h;
                float pv;
                if (MODE == 0) pv = __builtin_amdgcn_exp2f(st[kk][i]);
                else if (MODE == 1) pv = __builtin_amdgcn_exp2f(st[kk][i] + sBias[m - qpos + 2047]);
                else pv = st[kk][i] * __builtin_amdgcn_exp2f(lgam * fabsf((float)(qpos - m)));
                if (MODE != 2) lsum += pv;
                st[kk][i] = pv;
            }
        const char* sV = cur + 64 * AROWB;
#pragma unroll
        for (int kk = 0; kk < 2; ++kk)
#pragma unroll
            for (int s2 = 0; s2 < 2; ++s2) {
                u32x4 pw;
#pragma unroll
                for (int j = 0; j < 4; ++j) pw[j] = pk2(st[kk][8 * s2 + 2 * j], st[kk][8 * s2 + 2 * j + 1]);
                const bf16x8 pf = __builtin_bit_cast(bf16x8, pw);
#pragma unroll
                for (int d = 0; d < NDT; ++d) {
                    const char* va = sV + (32 * d + r) * AROWB + (32 * kk + 16 * s2 + 4 * h) * 2;
                    const s16x4 lo = *(const s16x4*)va, hi = *(const s16x4*)(va + 16);
                    const bf16x8 vf = __builtin_shufflevector(lo, hi, 0, 1, 2, 3, 4, 5, 6, 7);
                    o[d] = MFMA32(vf, pf, o[d]);
                }
            }
        if (more) {
#pragma unroll
            for (int i = 0; i < 2; ++i) *(u32x4*)(nxt + soff + 32 * i * AROWB) = rk[i];
#pragma unroll
            for (int i = 0; i < NDT; ++i) *(u32x4*)(nxt + 64 * AROWB + soff + 32 * i * AROWB) = rv[i];
        }
        __syncthreads();
    }
    const size_t tok = (size_t)seq * SL + qpos;
    if (MODE != 2) {
        const float ltot = lsum + __shfl_xor(lsum, 32);
        const float inv = __builtin_amdgcn_rcpf(ltot);
        bf16_t* dst = MODE == 0 ? (bf16_t*)(p.ws + OFF_O) + tok * 512 + head * 64
                                : (bf16_t*)(p.ws + OFF_DT) + ((size_t)map * TG + tok) * 512 + head * 128;
        if (DV == 128) {
#pragma unroll
            for (int d = 0; d < NDT; ++d)
#pragma unroll
                for (int a = 0; a < 4; ++a) otile_put(lds, wave * 32 + r, 32 * d + 8 * a + 4 * h, pk2(o[d][4 * a] * inv, o[d][4 * a + 1] * inv), pk2(o[d][4 * a + 2] * inv, o[d][4 * a + 3] * inv));
            otile_flush(lds, (bf16_t*)(p.ws + OFF_DT) + ((size_t)map * TG + (size_t)seq * SL + qt * 128) * 512 + head * 128, 512);
        } else {
#pragma unroll
        for (int d = 0; d < NDT; ++d)
#pragma unroll
            for (int a = 0; a < 4; ++a) {
                u32x2 wv; wv[0] = pk2(o[d][4 * a] * inv, o[d][4 * a + 1] * inv); wv[1] = pk2(o[d][4 * a + 2] * inv, o[d][4 * a + 3] * inv);
                *(u32x2*)(dst + 32 * d + 8 * a + 4 * h) = wv;
            }
        }
    } else {
        float s = 0.f;
#pragma unroll
        for (int d = 0; d < NDT; ++d)
#pragma unroll
            for (int i = 0; i < 16; ++i) s += o[d][i];
        s += __shfl_xor(s, 32);
        const float mu = s * (1.0f / 128.0f);
        float vs = 0.f;
#pragma unroll
        for (int d = 0; d < NDT; ++d)
#pragma unroll
            for (int i = 0; i < 16; ++i) { const float dd = o[d][i] - mu; vs += dd * dd; }
        vs += __shfl_xor(vs, 32);
        const float rstd = rsqrtf(vs * (1.0f / 128.0f) + EPS);
        const bf16_t* gp = ub + tok * INW + 3840 + head * 128;
        bf16_t* dst = (bf16_t*)(p.ws + OFF_O) + ((size_t)3 * TG + tok) * 512 + head * 128;
#pragma unroll
        for (int d = 0; d < NDT; ++d)
#pragma unroll
            for (int a = 0; a < 4; ++a) {
                asm volatile("" ::: "memory");
                const u32x2 gw = *(const u32x2*)(gp + 32 * d + 8 * a + 4 * h);
                const float g0 = bflo(gw[0]), g1 = bfhi(gw[0]), g2 = bflo(gw[1]), g3 = bfhi(gw[1]);
                const float y0 = (o[d][4 * a] - mu) * rstd * g0 * sigmoidf_(g0), y1 = (o[d][4 * a + 1] - mu) * rstd * g1 * sigmoidf_(g1);
                const float y2 = (o[d][4 * a + 2] - mu) * rstd * g2 * sigmoidf_(g2), y3 = (o[d][4 * a + 3] - mu) * rstd * g3 * sigmoidf_(g3);
                otile_put(lds, wave * 32 + r, 32 * d + 8 * a + 4 * h, pk2(y0, y1), pk2(y2, y3));
            }
        otile_flush(lds, (bf16_t*)(p.ws + OFF_O) + ((size_t)3 * TG + (size_t)seq * SL + qt * 128) * 512 + head * 128, 512);
    }
}

DI void attn_gqa2(const Params& p, int task, char* lds) {
    constexpr int DV = 64, NDT = 2;
    constexpr int STG = 64 * AROWB + DV * AROWB;
    const int tid = tidx(), lane = tid & 63, wave = tid >> 6, r = lane & 31, h = lane >> 5;
    const bf16_t* ub = (const bf16_t*)(p.ws + OFF_U);
    const int qt = task & 7, rest = task >> 3, head = rest & 7, seq = rest >> 3;
    const int qcol = head * 64, kcol = 512 + (head >> 2) * 64;
    const bf16_t* vt = (const bf16_t*)(p.ws + OFF_VTA) + (size_t)(seq * 2 + (head >> 2)) * 64 * SL;
    const int qpos0 = qt * 256 + wave * 64 + r;
    bf16x8 qf[2][4];
#pragma unroll
    for (int qs = 0; qs < 2; ++qs) {
        const bf16_t* qptr = ub + ((size_t)seq * SL + qpos0 + 32 * qs) * INW + qcol;
#pragma unroll
        for (int s = 0; s < 4; ++s) qf[qs][s] = *(const bf16x8*)(qptr + 16 * s + 8 * h);
    }
    const bf16_t* kbase = ub + (size_t)seq * SL * INW + kcol;
    f32x16 o[2][NDT];
#pragma unroll
    for (int qs = 0; qs < 2; ++qs)
#pragma unroll
        for (int d = 0; d < NDT; ++d)
#pragma unroll
            for (int i = 0; i < 16; ++i) o[qs][d][i] = 0.f;
    float lsum[2] = {0.f, 0.f};
    const int srow = tid >> 3, sc = tid & 7;
    const bf16_t* kg = kbase + (size_t)srow * INW + sc * 8;
    const bf16_t* vg = vt + (size_t)srow * SL + sc * 8;
    u32x4 rk[2], rv[NDT];
#pragma unroll
    for (int i = 0; i < 2; ++i) rk[i] = *(const u32x4*)(kg + (size_t)(32 * i) * INW);
#pragma unroll
    for (int i = 0; i < NDT; ++i) rv[i] = *(const u32x4*)(vg + (size_t)(32 * i) * SL);
    const int soff = srow * AROWB + sc * 16;
#pragma unroll
    for (int i = 0; i < 2; ++i) *(u32x4*)(lds + soff + 32 * i * AROWB) = rk[i];
#pragma unroll
    for (int i = 0; i < NDT; ++i) *(u32x4*)(lds + 64 * AROWB + soff + 32 * i * AROWB) = rv[i];
    __syncthreads();
    for (int kt = 0; kt < SL / 64; ++kt) {
        const char* cur = lds + (kt & 1) * STG;
        char* nxt = lds + ((kt + 1) & 1) * STG;
        const bool more = kt + 1 < SL / 64;
        if (more) {
            kg += (size_t)64 * INW; vg += 64;
#pragma unroll
            for (int i = 0; i < 2; ++i) rk[i] = *(const u32x4*)(kg + (size_t)(32 * i) * INW);
#pragma unroll
            for (int i = 0; i < NDT; ++i) rv[i] = *(const u32x4*)(vg + (size_t)(32 * i) * SL);
        }
        f32x16 st[2][2];
#pragma unroll
        for (int kk = 0; kk < 2; ++kk) {
#pragma unroll
            for (int i = 0; i < 16; ++i) { st[0][kk][i] = 0.f; st[1][kk][i] = 0.f; }
#pragma unroll
            for (int s = 0; s < 4; ++s) {
                const bf16x8 kf = *(const bf16x8*)(cur + (32 * kk + r) * AROWB + (16 * s + 8 * h) * 2);
                st[0][kk] = MFMA32(kf, qf[0][s], st[0][kk]);
                st[1][kk] = MFMA32(kf, qf[1][s], st[1][kk]);
            }
        }
#pragma unroll
        for (int qs = 0; qs < 2; ++qs)
#pragma unroll
            for (int kk = 0; kk < 2; ++kk)
#pragma unroll
                for (int i = 0; i < 16; ++i) { const float pv = __builtin_amdgcn_exp2f(st[qs][kk][i]); lsum[qs] += pv; st[qs][kk][i] = pv; }
        const char* sV = cur + 64 * AROWB;
#pragma unroll
        for (int kk = 0; kk < 2; ++kk)
#pragma unroll
            for (int s2 = 0; s2 < 2; ++s2) {
                bf16x8 pf[2];
#pragma unroll
                for (int qs = 0; qs < 2; ++qs) {
                    u32x4 pw;
#pragma unroll
                    for (int j = 0; j < 4; ++j) pw[j] = pk2(st[qs][kk][8 * s2 + 2 * j], st[qs][kk][8 * s2 + 2 * j + 1]);
                    pf[qs] = __builtin_bit_cast(bf16x8, pw);
                }
#pragma unroll
                for (int d = 0; d < NDT; ++d) {
                    const char* va = sV + (32 * d + r) * AROWB + (32 * kk + 16 * s2 + 4 * h) * 2;
                    const s16x4 lo = *(const s16x4*)va, hi = *(const s16x4*)(va + 16);
                    const bf16x8 vf = __builtin_shufflevector(lo, hi, 0, 1, 2, 3, 4, 5, 6, 7);
                    o[0][d] = MFMA32(vf, pf[0], o[0][d]);
                    o[1][d] = MFMA32(vf, pf[1], o[1][d]);
                }
            }
        if (more) {
#pragma unroll
            for (int i = 0; i < 2; ++i) *(u32x4*)(nxt + soff + 32 * i * AROWB) = rk[i];
#pragma unroll
            for (int i = 0; i < NDT; ++i) *(u32x4*)(nxt + 64 * AROWB + soff + 32 * i * AROWB) = rv[i];
        }
        __syncthreads();
    }
#pragma unroll
    for (int qs = 0; qs < 2; ++qs) {
        const size_t tok = (size_t)seq * SL + qpos0 + 32 * qs;
        const float ltot = lsum[qs] + __shfl_xor(lsum[qs], 32);
        const float inv = __builtin_amdgcn_rcpf(ltot);
        bf16_t* dst = (bf16_t*)(p.ws + OFF_O) + tok * 512 + head * 64;
#pragma unroll
        for (int d = 0; d < NDT; ++d)
#pragma unroll
            for (int a = 0; a < 4; ++a) {
                u32x2 wv; wv[0] = pk2(o[qs][d][4 * a] * inv, o[qs][d][4 * a + 1] * inv); wv[1] = pk2(o[qs][d][4 * a + 2] * inv, o[qs][d][4 * a + 3] * inv);
                *(u32x2*)(dst + 32 * d + 8 * a + 4 * h) = wv;
            }
    }
}

DI void tr_read8(unsigned a, s16x4 (&v)[8]) {
    asm volatile("ds_read_b64_tr_b16 %0, %8\n\tds_read_b64_tr_b16 %1, %8 offset:256\n\tds_read_b64_tr_b16 %2, %8 offset:1024\n\tds_read_b64_tr_b16 %3, %8 offset:1280\n\t"
                 "ds_read_b64_tr_b16 %4, %8 offset:2048\n\tds_read_b64_tr_b16 %5, %8 offset:2304\n\tds_read_b64_tr_b16 %6, %8 offset:3072\n\tds_read_b64_tr_b16 %7, %8 offset:3328\n\t"
                 "s_waitcnt lgkmcnt(0)"
                 : "=&v"(v[0]), "=&v"(v[1]), "=&v"(v[2]), "=&v"(v[3]), "=&v"(v[4]), "=&v"(v[5]), "=&v"(v[6]), "=&v"(v[7]) : "v"(a) : "memory");
}

DI void s5_wave_task(const Params& p, int layer, int wt, char* ldsw) {
    const int lane = tidx() & 63, r = lane & 31, h = lane >> 5;
    const int dir = wt & 1, g = (wt >> 1) & 31, pair = wt >> 6;
    const bf16_t* ub = (const bf16_t*)(p.ws + OFF_U);
    const int hp = (r >> 2) & 1, ia = 4 * (r >> 3) + (r & 3);
    const unsigned img = (unsigned)(size_t)ldsw;
    char* chunkbuf = ldsw + 8192;
    const int i16 = lane & 15, tq = i16 >> 2, tp = i16 & 3, blk = (lane >> 4) & 1;
    const unsigned trA = img + (8 * h + tq) * 64 + 8 * (4 * blk + tp);
    const float dsk = r < 16 ? p.in[I_SD][layer * 512 + g * 16 + r] : 0.f;
    bf16_t* yl = (bf16_t*)(p.ws + (dir ? OFF_YB : OFF_YF)) + ((size_t)(2 * pair + h) * 512 + g * 16 + (r & 15)) * SL;
    const int pb = (layer * 2 + dir) * 32 + g;
    const float dt = expf(p.in[I_SLDT][pb]);
    float abr[2], abi[2];
    bf16x8 bfrag[2][2], cfrag[2][2][2], dfrag;
    {
        u32x4 dw;
#pragma unroll
        for (int j = 0; j < 4; ++j) dw[j] = pk2((dir == 0 && r == 8 * h + 2 * j) ? dsk : 0.f, (dir == 0 && r == 8 * h + 2 * j + 1) ? dsk : 0.f);
        dfrag = __builtin_bit_cast(bf16x8, dw);
    }
#pragma unroll
    for (int st = 0; st < 2; ++st) {
        const int n = 32 * st + r;
        const float are = p.in[I_SARE][pb * 64 + n], aim = p.in[I_SAIM][pb * 64 + n];
        const float mag = expf(dt * are);
        abr[st] = mag * cosf(dt * aim); abi[st] = mag * sinf(dt * aim);
        const float den = are * are + aim * aim, nr = abr[st] - 1.0f;
        const float fre = (nr * are + abi[st] * aim) / den, fim = (abi[st] * are - nr * aim) / den;
        const float* bre = p.in[I_SBRE] + ((size_t)pb * 64 + n) * 16 + 8 * h;
        const float* bim = p.in[I_SBIM] + ((size_t)pb * 64 + n) * 16 + 8 * h;
        u32x4 wre, wim;
#pragma unroll
        for (int j = 0; j < 4; ++j) {
            const float br0 = bre[2 * j], bi0 = bim[2 * j], br1 = bre[2 * j + 1], bi1 = bim[2 * j + 1];
            wre[j] = pk2(fre * br0 - fim * bi0, fre * br1 - fim * bi1);
            wim[j] = pk2(fre * bi0 + fim * br0, fre * bi1 + fim * br1);
        }
        bfrag[st][0] = __builtin_bit_cast(bf16x8, wre); bfrag[st][1] = __builtin_bit_cast(bf16x8, wim);
#pragma unroll
        for (int s = 0; s < 2; ++s) {
            u32x4 cr = {0u, 0u, 0u, 0u}, ci = {0u, 0u, 0u, 0u};
            if (r < 16) {
                const float* cre = p.in[I_SCRE] + ((size_t)pb * 16 + r) * 64 + 32 * st + 16 * s + 8 * h;
                const float* cim = p.in[I_SCIM] + ((size_t)pb * 16 + r) * 64 + 32 * st + 16 * s + 8 * h;
#pragma unroll
                for (int j = 0; j < 4; ++j) { cr[j] = pk2(cre[2 * j], cre[2 * j + 1]); ci[j] = pk2(-cim[2 * j], -cim[2 * j + 1]); }
            }
            cfrag[st][s][0] = __builtin_bit_cast(bf16x8, cr); cfrag[st][s][1] = __builtin_bit_cast(bf16x8, ci);
        }
    }
    float sre[2] = {0.f, 0.f}, sim[2] = {0.f, 0.f};
    const bf16_t* gsrc[4]; int loff[4];
#pragma unroll
    for (int j = 0; j < 4; ++j) {
        const int c = lane + 64 * j, row = c >> 1, half = c & 1, ss = row >> 6, tau = row & 63;
        gsrc[j] = ub + ((size_t)(2 * pair + ss) * SL + (dir ? (SL - 1 - tau) : tau)) * INW + 768 + g * 16 + half * 8;
        loff[j] = row * 32 + half * 16;
    }
    const long cstep = dir ? -(long)64 * INW : (long)64 * INW;
    u32x4 crg[4];
#pragma unroll
    for (int j = 0; j < 4; ++j) crg[j] = *(const u32x4*)gsrc[j];
#pragma unroll
    for (int j = 0; j < 4; ++j) *(u32x4*)(chunkbuf + loff[j]) = crg[j];
    const int aoff = (hp * 64 + ia) * 32 + h * 16;
    for (int chunk = 0; chunk < SL / 64; ++chunk) {
        if (chunk + 1 < SL / 64) {
#pragma unroll
            for (int j = 0; j < 4; ++j) { gsrc[j] += cstep; crg[j] = *(const u32x4*)gsrc[j]; }
        }
        const char* cb = chunkbuf + (chunk & 1) * 4096;
#pragma unroll 1
        for (int tl = 0; tl < 4; ++tl) {
            const int s0 = chunk * 64 + tl * 16;
            const bf16x8 ua = *(const bf16x8*)(cb + aoff + tl * 512);
            f32x16 z;
#pragma unroll
            for (int i = 0; i < 16; ++i) z[i] = 0.f;
            f32x16 y0 = MFMA32(ua, dfrag, z);
            f32x16 y1 = z;
#pragma unroll
            for (int st = 0; st < 2; ++st) {
                f32x16 xr = MFMA32(ua, bfrag[st][0], z);
                f32x16 xi = MFMA32(ua, bfrag[st][1], z);
                float cr = sre[st], ci = sim[st];
#pragma unroll
                for (int i = 0; i < 16; ++i) {
                    const float nr = abr[st] * cr - abi[st] * ci + xr[i];
                    const float ni = abr[st] * ci + abi[st] * cr + xi[i];
                    cr = nr; ci = ni; xr[i] = nr; xi[i] = ni;
                }
                sre[st] = cr; sim[st] = ci;
#pragma unroll
                for (int a = 0; a < 4; ++a) {
                    u32x2 w0, w1; w0[0] = pk2(xr[4 * a], xr[4 * a + 1]); w0[1] = pk2(xr[4 * a + 2], xr[4 * a + 3]);
                    w1[0] = pk2(xi[4 * a], xi[4 * a + 1]); w1[1] = pk2(xi[4 * a + 2], xi[4 * a + 3]);
                    *(u32x2*)(ldsw + (st * 2 + 0) * 2048 + r * 64 + 8 * (2 * a + h)) = w0;
                    *(u32x2*)(ldsw + (st * 2 + 1) * 2048 + r * 64 + 8 * (2 * a + h)) = w1;
                }
            }
            asm volatile("s_waitcnt lgkmcnt(0)" ::: "memory");
            {
                s16x4 v[8];
                tr_read8(trA, v);
                y0 = MFMA32(__builtin_shufflevector(v[0], v[1], 0, 1, 2, 3, 4, 5, 6, 7), cfrag[0][0][0], y0);
                y0 = MFMA32(__builtin_shufflevector(v[2], v[3], 0, 1, 2, 3, 4, 5, 6, 7), cfrag[0][1][0], y0);
                y0 = MFMA32(__builtin_shufflevector(v[4], v[5], 0, 1, 2, 3, 4, 5, 6, 7), cfrag[0][0][1], y0);
                y0 = MFMA32(__builtin_shufflevector(v[6], v[7], 0, 1, 2, 3, 4, 5, 6, 7), cfrag[0][1][1], y0);
                s16x4 u[8];
                tr_read8(trA + 4096, u);
                y1 = MFMA32(__builtin_shufflevector(u[0], u[1], 0, 1, 2, 3, 4, 5, 6, 7), cfrag[1][0][0], y1);
                y1 = MFMA32(__builtin_shufflevector(u[2], u[3], 0, 1, 2, 3, 4, 5, 6, 7), cfrag[1][1][0], y1);
                y1 = MFMA32(__builtin_shufflevector(u[4], u[5], 0, 1, 2, 3, 4, 5, 6, 7), cfrag[1][0][1], y1);
                y1 = MFMA32(__builtin_shufflevector(u[6], u[7], 0, 1, 2, 3, 4, 5, 6, 7), cfrag[1][1][1], y1);
            }
            if (r < 16) {
                u32x4 o0, o1;
                if (dir == 0) {
#pragma unroll
                    for (int j = 0; j < 4; ++j) { o0[j] = pk2(y0[2 * j] + y1[2 * j], y0[2 * j + 1] + y1[2 * j + 1]); o1[j] = pk2(y0[8 + 2 * j] + y1[8 + 2 * j], y0[9 + 2 * j] + y1[9 + 2 * j]); }
                    *(u32x4*)(yl + s0) = o0; *(u32x4*)(yl + s0 + 8) = o1;
                } else {
#pragma unroll
                    for (int j = 0; j < 4; ++j) { o0[j] = pk2(y0[15 - 2 * j] + y1[15 - 2 * j], y0[14 - 2 * j] + y1[14 - 2 * j]); o1[j] = pk2(y0[7 - 2 * j] + y1[7 - 2 * j], y0[6 - 2 * j] + y1[6 - 2 * j]); }
                    *(u32x4*)(yl + (SL - 16 - s0)) = o0; *(u32x4*)(yl + (SL - 16 - s0) + 8) = o1;
                }
            }
        }
        if (chunk + 1 < SL / 64) {
#pragma unroll
            for (int j = 0; j < 4; ++j) *(u32x4*)(chunkbuf + ((chunk + 1) & 1) * 4096 + loff[j]) = crg[j];
        }
    }
}

DI void phase_mix(const Params& p, int layer, int qidx, char* lds, bool only_s5 = false) {
    __shared__ int s_task;
    int* qc = (int*)(p.ws + OFF_QCNT) + qidx;
    constexpr int N_S5 = (G / 2) * 32 * 2 / 4, N_DIFF = G * 4 * 2 * 16, N_RET = G * 4 * 16, N_GQA = G * 8 * 8;
    constexpr int NTOT = N_S5 + N_DIFF + N_RET + N_GQA;
    for (;;) {
        __syncthreads();
        if (tidx() == 0) s_task = atomicAdd(qc, 1);
        __syncthreads();
        int task = s_task;
        if (task >= (only_s5 ? N_S5 : NTOT)) break;
        if (task < N_S5) { const int wave = tidx() >> 6; s5_wave_task(p, layer, task * 4 + wave, lds + wave * 16384); }
        else if ((task -= N_S5) < N_DIFF) attn_task<128, 1>(p, task, lds);
        else if ((task -= N_DIFF) < N_RET) attn_task<128, 2>(p, task, lds);
        else attn_gqa2(p, task - N_RET, lds);
    }
}

DI float gelu_tanh(float v) { const float z2 = 1.5957691216057308f * (v + 0.044715f * v * v * v); return v * __builtin_amdgcn_rcpf(1.0f + __builtin_amdgcn_exp2f(-LOG2E * z2)); }

DI void glu_tile(const Params& p, int layer, int tm, int tn, char* lds) {
    const int tid = tidx(), lane = tid & 63, w = tid >> 6, wr = w >> 1, wc = w & 1, r16 = lane & 15, q4 = lane >> 4;
    const bf16_t* yf = (const bf16_t*)(p.ws + OFF_YF);
    const bf16_t* yb = (const bf16_t*)(p.ws + OFF_YB);
    const bf16_t* B = wts(p, layer) + WGLU + (size_t)tn * 128 * 512;
    const int seq = (tm * 128) >> 11, t0 = (tm * 128) & 2047;
    const int ach = tid & 63, aseg0 = tid >> 6;
    const bf16_t* fg = yf + ((size_t)seq * 512 + ach) * SL + t0;
    const bf16_t* bg2 = yb + ((size_t)seq * 512 + ach) * SL + t0;
    const int srow = tid >> 3, scol = tid & 7;
    const bf16_t* bg = B + (size_t)srow * 512 + scol * 8;
    const int soff = srow * ROWB + ((scol ^ ((srow >> 1) & 7)) << 4);
    u32x4 rf[4], rbk[4], rb[4];
    f32x4 acc[4][4]; zero_acc(acc);
    const int aoff = (wr * 64 + (lane & 15)) * ROWB;
    const int boff = GT_BYTES + (wc * 64 + (lane & 15)) * ROWB;
    const int sw = ((lane >> 4) ^ ((lane & 15) >> 1)) << 4;
    for (int kt = 0; kt < 8; ++kt) {
#pragma unroll
        for (int j = 0; j < 4; ++j) {
            rf[j] = *(const u32x4*)(fg + (size_t)kt * 64 * SL + (aseg0 + 4 * j) * 8);
            rbk[j] = *(const u32x4*)(bg2 + (size_t)kt * 64 * SL + (aseg0 + 4 * j) * 8);
            rb[j] = *(const u32x4*)(bg + (size_t)(32 * j) * 512 + kt * 64);
        }
#pragma unroll
        for (int j = 0; j < 4; ++j) {
            *(u32x4*)(lds + GT_BYTES + soff + 32 * j * ROWB) = rb[j];
            char* abase = lds + (aseg0 + 4 * j) * 8 * ROWB + (ach & 7) * 2;
#pragma unroll
            for (int e = 0; e < 4; ++e) {
                const float v0 = gelu_tanh(bflo(rf[j][e]) + bflo(rbk[j][e])), v1 = gelu_tanh(bfhi(rf[j][e]) + bfhi(rbk[j][e]));
                const unsigned pw = pk2(v0, v1);
                const int cs = (((ach >> 3) ^ ((4 * aseg0 + e) & 7)) << 4);
                *(bf16_t*)(abase + (2 * e) * ROWB + cs) = (bf16_t)(pw & 0xffffu);
                *(bf16_t*)(abase + (2 * e + 1) * ROWB + cs) = (bf16_t)(pw >> 16);
            }
        }
        __syncthreads();
        gemm_compute<false, 0>(lds, aoff, boff, sw, acc);
        __syncthreads();
    }
    bf16_t* ob = (bf16_t*)(p.ws + OFF_O) + (size_t)1 * TG * 512;
    const float* bgl = p.in[I_SBGLU] + layer * 512;
#pragma unroll
    for (int n = 0; n < 4; ++n) {
        const int ch = tn * 128 + wc * 64 + n * 16 + r16;
        const float bias = bgl[ch];
#pragma unroll
        for (int m = 0; m < 4; ++m) {
            const int tl = wr * 64 + m * 16 + q4 * 4;
            const u32x2 fw = *(const u32x2*)(yf + ((size_t)seq * 512 + ch) * SL + t0 + tl);
            const u32x2 bw = *(const u32x2*)(yb + ((size_t)seq * 512 + ch) * SL + t0 + tl);
            const float y0 = gelu_tanh(bflo(fw[0]) + bflo(bw[0])), y1 = gelu_tanh(bfhi(fw[0]) + bfhi(bw[0]));
            const float y2 = gelu_tanh(bflo(fw[1]) + bflo(bw[1])), y3 = gelu_tanh(bfhi(fw[1]) + bfhi(bw[1]));
            const unsigned w01 = pk2(y0 * sigmoidf_(acc[m][n][0] + bias), y1 * sigmoidf_(acc[m][n][1] + bias));
            const unsigned w23 = pk2(y2 * sigmoidf_(acc[m][n][2] + bias), y3 * sigmoidf_(acc[m][n][3] + bias));
            bf16_t* orow = ob + (size_t)(tm * 128 + tl) * 512 + ch;
            orow[0] = (bf16_t)(w01 & 0xffffu); orow[512] = (bf16_t)(w01 >> 16); orow[1024] = (bf16_t)(w23 & 0xffffu); orow[1536] = (bf16_t)(w23 >> 16);
        }
    }
}

DI void phase_glu(const Params& p, int layer, char* lds) {
    const int lane = tidx() & 63, w = tidx() >> 6;
    { TileIter it; ti_init(it, TG / 128, 4, 16, 4); int tm, tn; while (ti_next(it, tm, tn)) glu_tile(p, layer, tm, tn, lds); }
    const float lam = ((const float*)(p.ws + OFF_LAM))[layer], li = ((const float*)(p.ws + OFF_LAM))[4 + layer];
    const bf16_t* d0 = (const bf16_t*)(p.ws + OFF_DT); const bf16_t* d1 = d0 + (size_t)TG * 512;
    bf16_t* oc = (bf16_t*)(p.ws + OFF_O) + (size_t)2 * TG * 512;
    const f32x2 sg = *(const f32x2*)(p.in[I_DSUB] + layer * 128 + 2 * lane);
    const int gw = bidx() * 4 + w, nw = gdim() * 4;
    for (int it0 = gw; it0 < TG * 4; it0 += 8 * nw) {
        unsigned a[8], b[8];
#pragma unroll
        for (int j = 0; j < 8; ++j) {
            const int it = it0 + j * nw;
            const size_t off = (size_t)(it < TG * 4 ? it : gw) * 128 + 2 * lane;
            a[j] = *(const unsigned*)(d0 + off); b[j] = *(const unsigned*)(d1 + off);
        }
#pragma unroll
        for (int j = 0; j < 8; ++j) {
            const int it = it0 + j * nw;
            const float v0 = bflo(a[j]) - lam * bflo(b[j]), v1 = bfhi(a[j]) - lam * bfhi(b[j]);
            const float ss = wave_sum(v0 * v0 + v1 * v1);
            const float rs = rsqrtf(ss * (1.0f / 128.0f) + EPS) * (1.0f - li);
            if (it < TG * 4) *(unsigned*)(oc + (size_t)it * 128 + 2 * lane) = pk2(v0 * rs * sg[0], v1 * rs * sg[1]);
        }
    }
}

DI void phase_merge(const Params& p, int layer, char* lds) {
    const int lane = tidx() & 63, w = tidx() >> 6, wr = w >> 1, wc = w & 1, r16 = lane & 15, q4 = lane >> 4;
    const bf16_t* ob = (const bf16_t*)(p.ws + OFF_O);
    const bf16_t* gb = (const bf16_t*)(p.ws + OFF_GATE);
    const bf16_t* W = wts(p, layer) + WB;
    bf16_t* mb = (bf16_t*)(p.ws + OFF_M);
    TileIter it; ti_init(it, TG / 128, 8, 8, 8);
    int tm, tn;
    while (ti_next(it, tm, tn)) {
        f32x4 macc[4][4]; zero_acc(macc);
#pragma unroll 1
        for (int b = 0; b < 4; ++b) {
            f32x4 acc[4][4]; zero_acc(acc);
            gemm128<true, 0, false>(ob + ((size_t)b * TG + tm * 128) * 512, 512, W + ((size_t)b * 1024 + tn * 128) * 512, 512, 512, acc, lds);
#pragma unroll
            for (int m = 0; m < 4; ++m) {
                const int row = tm * 128 + wr * 64 + m * 16 + r16;
#pragma unroll
                for (int n = 0; n < 4; ++n) {
                    const int col = tn * 128 + wc * 64 + n * 16 + q4 * 4;
                    const u32x2 gw = *(const u32x2*)(gb + (size_t)row * 4096 + b * 1024 + col);
                    macc[m][n][0] += acc[m][n][0] * bflo(gw[0]); macc[m][n][1] += acc[m][n][1] * bfhi(gw[0]);
                    macc[m][n][2] += acc[m][n][2] * bflo(gw[1]); macc[m][n][3] += acc[m][n][3] * bfhi(gw[1]);
                }
            }
        }
#pragma unroll
        for (int m = 0; m < 4; ++m) {
            const int row = tm * 128 + wr * 64 + m * 16 + r16;
#pragma unroll
            for (int n = 0; n < 4; ++n) {
                const int col = tn * 128 + wc * 64 + n * 16 + q4 * 4;
                otile_put(lds, wr * 64 + m * 16 + r16, wc * 64 + n * 16 + q4 * 4, pk2(macc[m][n][0], macc[m][n][1]), pk2(macc[m][n][2], macc[m][n][3]));
            }
        }
        otile_flush(lds, mb + (size_t)(tm * 128) * DM + tn * 128, DM);
    }
}

DI void phase_resid(const Params& p, int grp, const bf16_t* A, int K, const bf16_t* Wt, bool first, char* lds) {
    const int lane = tidx() & 63, w = tidx() >> 6, wr = w >> 1, wc = w & 1, r16 = lane & 15, q4 = lane >> 4;
    TileIter it; ti_init(it, TG / 128, 8, 8, 8);
    int tm, tn, ntm = 0, ntn = 0;
    bool have = ti_next(it, tm, tn);
    GemmRegs g;
    if (have) gemm_prime(A + (size_t)tm * 128 * K, K, Wt + (size_t)tn * 128 * K, K, g);
    for (; have; tm = ntm, tn = ntn) {
        have = ti_next(it, ntm, ntn);
        const bf16_t* At = A + (size_t)tm * 128 * K; const bf16_t* Bt = Wt + (size_t)tn * 128 * K;
        const bf16_t* nAt = have ? A + (size_t)ntm * 128 * K : At; const bf16_t* nBt = have ? Wt + (size_t)ntn * 128 * K : Bt;
        f32x4 acc[4][4]; zero_acc(acc);
        gemm_stream<true>(At, Bt, nAt, nBt, K, K, K, g, acc, lds);
#pragma unroll
        for (int m = 0; m < 4; ++m)
#pragma unroll
            for (int n = 0; n < 4; ++n) *(f32x4*)(lds + (wr * 64 + m * 16 + r16) * OROWF + (wc * 64 + n * 16 + q4 * 4) * 4) = acc[m][n];
        __syncthreads();
        {
            const int tid = tidx();
#pragma unroll 4
            for (int i = 0; i < 16; ++i) {
                const int c = tid + 256 * i, rl = c >> 5, ch = c & 31, row = tm * 128 + rl;
                float* xo = p.out + ((size_t)grp * TG + row) * DM + tn * 128 + ch * 4;
                const float* xi = first ? x_in_row(p, grp, row) + tn * 128 + ch * 4 : xo;
                const f32x4 a = *(const f32x4*)(lds + rl * OROWF + ch * 16);
                const f32x4 xv = *(const f32x4*)xi;
                *(f32x4*)xo = xv + a;
            }
        }
        __syncthreads();
    }
}

DI void phase_ffn1(const Params& p, int layer, char* lds) {
    const int lane = tidx() & 63, w = tidx() >> 6, wr = w >> 1, wc = w & 1, r16 = lane & 15, q4 = lane >> 4;
    const bf16_t* hb = (const bf16_t*)(p.ws + OFF_H);
    const bf16_t* W = wts(p, layer) + WFI;
    bf16_t* fb = (bf16_t*)(p.ws + OFF_F);
    constexpr int NT = DFF / 64;
    TileIter it; ti_init(it, TG / 128, NT, 8, 4);
    int tm, tn, ntm = 0, ntn = 0;
    bool have = ti_next(it, tm, tn);
    GemmRegs g;
    if (have) gemm_prime(hb + (size_t)tm * 128 * DM, DM, W + (size_t)tn * 128 * DM, DM, g);
    for (; have; tm = ntm, tn = ntn) {
        have = ti_next(it, ntm, ntn);
        const bf16_t* At = hb + (size_t)tm * 128 * DM; const bf16_t* Bt = W + (size_t)tn * 128 * DM;
        const bf16_t* nAt = have ? hb + (size_t)ntm * 128 * DM : At; const bf16_t* nBt = have ? W + (size_t)ntn * 128 * DM : Bt;
        f32x4 acc[4][4]; zero_acc(acc);
        gemm_stream<true, 1>(At, Bt, nAt, nBt, DM, DM, DM, g, acc, lds);
#pragma unroll
        for (int m = 0; m < 4; ++m) {
            const int row = tm * 128 + wr * 64 + m * 16 + r16;
#pragma unroll
            for (int n = 0; n < 2; ++n) {
                const int col = tn * 64 + wc * 32 + n * 16 + q4 * 4;
                float f[4];
#pragma unroll
                for (int i = 0; i < 4; ++i) { const float gq = acc[m][n][i]; f[i] = gq * sigmoidf_(gq) * acc[m][n + 2][i]; }
                otile_put(lds, wr * 64 + m * 16 + r16, wc * 32 + n * 16 + q4 * 4, pk2(f[0], f[1]), pk2(f[2], f[3]));
            }
        }
        {
            const int tid = tidx();
            __syncthreads();
#pragma unroll
            for (int i = 0; i < 4; ++i) {
                const int c = tid + 256 * i, row = c >> 3, ch = c & 7;
                const u32x4 v = *(const u32x4*)(lds + row * OROW + ch * 16);
                *(u32x4*)(fb + (size_t)(tm * 128 + row) * DFF + tn * 64 + ch * 8) = v;
            }
            __syncthreads();
        }
    }
}

#define XB_TMO      128
#define XB_XCNT(j)  (256  + 64 * (j))
#define XB_XSUB(j)  (1280 + 64 * (j))
#define XB_XGEN(j)  (2304 + 64 * (j))
#define XB_TOP      3328
#define XB_TOPGEN   3392
#define XCD_BAR_WORDS 3456
#define XB_SPIN_CAP (1u << 18)
#define LAS __attribute__((address_space(3)))

__device__ __forceinline__ unsigned xb_ld(unsigned* p)              { return __hip_atomic_load(p, __ATOMIC_RELAXED, __HIP_MEMORY_SCOPE_AGENT); }
__device__ __forceinline__ unsigned xb_add(unsigned* p, unsigned v) { return __hip_atomic_fetch_add(p, v, __ATOMIC_RELAXED, __HIP_MEMORY_SCOPE_AGENT); }
__device__ __forceinline__ unsigned xb_xcc_id() { return (unsigned)__builtin_amdgcn_s_getreg((3 << 11) | 20) & 0xFu; }
#define XB_SPIN(cond, bar) do { unsigned _sp = 0; while (cond) { __builtin_amdgcn_s_sleep(1); \
    if ((++_sp & 255u) == 0u) { if (xb_ld(&(bar)[XB_TMO])) break; if (_sp > XB_SPIN_CAP) { atomicAdd(&(bar)[XB_TMO], 1u); break; } } } } while (0)

struct XcdBarrier {
    unsigned* bar; unsigned x;
    volatile LAS unsigned* st;
};

__device__ __forceinline__ XcdBarrier xcd_barrier_post(unsigned* bar, volatile LAS unsigned* st) {
    XcdBarrier b; b.bar = bar; b.x = xb_xcc_id(); b.st = st;
    if (threadIdx.x == 0) (void)xb_add(&bar[XB_XCNT(b.x)], 1u);
    return b;
}
__device__ __forceinline__ void xcd_barrier_complete(unsigned* bar, unsigned x, unsigned& nloc, unsigned& nx) {
    const unsigned G = gdim() * gridDim.y * gridDim.z;
    unsigned sum, cnt, mine, sp = 0u;
    for (;;) {
        sum = 0u; cnt = 0u; mine = 0u;
#pragma unroll
        for (unsigned j = 0; j < 16; ++j) { const unsigned c = xb_ld(&bar[XB_XCNT(j)]); sum += c; cnt += (c > 0u) ? 1u : 0u; mine = (j == x) ? c : mine; }
        if (sum == G) break;
        __builtin_amdgcn_s_sleep(1);
        if ((++sp & 255u) == 0u) { if (xb_ld(&bar[XB_TMO])) break; if (sp > XB_SPIN_CAP) { atomicAdd(&bar[XB_TMO], 1u); break; } }
    }
    nloc = mine > 0u ? mine : 1u; nx = cnt > 0u ? cnt : 1u;
}

__device__ __forceinline__ void xcd_barrier(const XcdBarrier& b) {
    asm volatile("s_waitcnt vmcnt(0)" ::: "memory");
    __syncthreads();
    if (threadIdx.x == 0) {
        unsigned* bar = b.bar;
        __builtin_amdgcn_s_waitcnt(0);
        unsigned nloc = b.st[0], nx = b.st[1];
        if (nloc == 0u) { xcd_barrier_complete(bar, b.x, nloc, nx); b.st[0] = nloc; b.st[1] = nx; }
        const unsigned old = xb_add(&bar[XB_XSUB(b.x)], 1u);
        const unsigned gen = old / nloc;
        if (old + 1u == (gen + 1u) * nloc) {
            __builtin_amdgcn_fence(__ATOMIC_RELEASE, "agent");
            asm volatile("s_waitcnt vmcnt(0)" ::: "memory");
            const unsigned og = xb_add(&bar[XB_TOP], 1u);
            const unsigned tg = og / nx;
            if (og + 1u == (tg + 1u) * nx) xb_add(&bar[XB_TOPGEN], 1u);
            else XB_SPIN(xb_ld(&bar[XB_TOPGEN]) == tg, bar);
            __builtin_amdgcn_fence(__ATOMIC_ACQUIRE, "agent");
            xb_add(&bar[XB_XGEN(b.x)], 1u);
            asm volatile("s_waitcnt vmcnt(0)" ::: "memory");
        } else {
            XB_SPIN(xb_ld(&bar[XB_XGEN(b.x)]) == gen, bar);
            __builtin_amdgcn_fence(__ATOMIC_ACQUIRE, "agent");
            asm volatile("s_waitcnt vmcnt(0)" ::: "memory");
        }
    }
    __syncthreads();
}


constexpr int PH_PER_GRP = 4 * 9 + 1;
constexpr int NPHASE = 1 + NGRP * PH_PER_GRP;

#ifndef PROBE_K
#define PROBE_K (-1)
#endif
DI void run_phase(const Params& p, int ph, char* lds, int rep = 0) {
    if (ph == 0) { phase_prologue(p, lds); return; }
    const int q = ph - 1, grp = q / PH_PER_GRP, r = q % PH_PER_GRP;
    if (r == 36) { phase_norm(p, grp, p.in[I_NFIN], 2); return; }
    const int layer = r / 9, k = r % 9;
    switch (k) {
        case 0: phase_norm(p, grp, p.in[I_NMIX] + layer * DM, layer == 0 ? 0 : 1); break;
        case 1: phase_in(p, layer, lds, rep == 1); break;
        case 2: phase_mix(p, layer, grp * 4 + layer + 20 * rep, lds, rep == 1); break;
        case 3: phase_glu(p, layer, lds); break;
        case 4: phase_merge(p, layer, lds); break;
        case 5: phase_resid(p, grp, (const bf16_t*)(p.ws + OFF_M), DM, wts(p, layer) + WO, layer == 0, lds); break;
        case 6: phase_norm(p, grp, p.in[I_NFFN] + layer * DM, 1); break;
        case 7: phase_ffn1(p, layer, lds); break;
        default: phase_resid(p, grp, (const bf16_t*)(p.ws + OFF_F), DFF, wts(p, layer) + WFO, false, lds); break;
    }
}

__global__ void __launch_bounds__(256, 2) mega(Params p, int only) {
    __shared__ __attribute__((aligned(16))) char lds[LDS_BYTES];
#if MULTI_LAUNCH
    if (only >= 0) { run_phase(p, only, lds); return; }
#endif
    cg::grid_group grid = cg::this_grid();
    __shared__ uint4 xb_words;
    if (threadIdx.x == 0) xb_words = make_uint4(0u, 0u, 0u, 0u);
    __syncthreads();
    XcdBarrier xb = xcd_barrier_post((unsigned*)(p.ws + OFF_BAR), (volatile LAS unsigned*)&xb_words);
    for (int ph = 0; ph < NPHASE; ++ph) {
        run_phase(p, ph, lds);
        if (ph + 1 < NPHASE) { if (ph == 0) grid.sync(); else xcd_barrier(xb); }
        if (PROBE_K == 100) xcd_barrier(xb);
        if (PROBE_K >= 0 && PROBE_K < 9 && ph > 0 && ((ph - 1) % PH_PER_GRP) < 36 && (((ph - 1) % PH_PER_GRP) % 9) == PROBE_K) { run_phase(p, ph, lds, 1); xcd_barrier(xb); }
    }
}

extern "C" void kernel_launch(void* const* d_in, const int* in_sizes, int n_in, void* d_out, int out_size, void* d_ws, size_t ws_size, hipStream_t stream) {
    (void)in_sizes; (void)n_in; (void)out_size;
    static int grid_blocks = 0;
    if (!grid_blocks) {
        int dev = 0, cus = 0, per_cu = 0;
        hipGetDevice(&dev);
        hipDeviceGetAttribute(&cus, hipDeviceAttributeMultiprocessorCount, dev);
        hipOccupancyMaxActiveBlocksPerMultiprocessor(&per_cu, mega, 256, 0);
        if (per_cu < 1) per_cu = 1;
        if (per_cu > 2) per_cu = 2;
        grid_blocks = cus * per_cu;
    }
    if (ws_size < WS_END) { fprintf(stderr, "workspace too small: %zu < %zu\n", ws_size, (size_t)WS_END); return; }
    Params p{};
    for (int i = 0; i < 26; ++i) p.in[i] = (const float*)d_in[i];
    p.out = (float*)d_out; p.ws = (char*)d_ws;
    hipMemsetAsync((char*)d_ws + OFF_BAR, 0, XCD_BAR_WORDS * sizeof(unsigned), stream);
#if MULTI_LAUNCH
    for (int ph = 0; ph < NPHASE; ++ph) mega<<<dim3(grid_blocks), dim3(256), 0, stream>>>(p, ph);
#else
    int only = -1;
    void* args[] = {&p, &only};
    hipError_t e = hipLaunchCooperativeKernel((void*)mega, dim3(grid_blocks), dim3(256), args, 0, stream);
    if (e != hipSuccess) fprintf(stderr, "cooperative launch failed: %s (grid %d)\n", hipGetErrorString(e), grid_blocks);
#endif
}
```

```cpp
#include <hip/hip_runtime.h>
#include <hip/hip_cooperative_groups.h>
#include <cstdio>
#include <cstdint>
namespace cg = cooperative_groups;

#ifndef MULTI_LAUNCH
#define MULTI_LAUNCH 0
#endif

#define DI __device__ __forceinline__
typedef unsigned short bf16_t;
typedef __bf16 bf16v2 __attribute__((ext_vector_type(2)));
typedef float f32x2 __attribute__((ext_vector_type(2)));
typedef short bf16x8 __attribute__((ext_vector_type(8)));
typedef short s16x4 __attribute__((ext_vector_type(4)));
typedef float f32x4 __attribute__((ext_vector_type(4)));
typedef float f32x16 __attribute__((ext_vector_type(16)));
typedef unsigned u32x4 __attribute__((ext_vector_type(4)));
typedef unsigned u32x2 __attribute__((ext_vector_type(2)));

constexpr int DM = 1024, SL = 2048, NSEQ = 40, G = 8, NGRP = NSEQ / G, TG = G * SL;
constexpr int INW = 4352, NIN = INW + 4096, DFF = 2816;
constexpr float EPS = 1e-6f;
constexpr float LOG2E = 1.4426950408889634f;

constexpr size_t WING = 0;
constexpr size_t WB = 8650752;
constexpr size_t WO = WB + 2097152;
constexpr size_t WFI = WO + 1048576;
constexpr size_t WFO = WFI + 5767168;
constexpr size_t WGLU = WFO + 2883584;
constexpr size_t LW = WGLU + 262144;

constexpr size_t OFF_W = 0;
constexpr size_t OFF_TAB = OFF_W + 4 * LW * 2;
constexpr size_t OFF_COSA = OFF_TAB, OFF_SINA = OFF_TAB + 262144, OFF_COSD = OFF_TAB + 2 * 262144, OFF_SIND = OFF_TAB + 3 * 262144;
constexpr size_t OFF_BIAS = OFF_TAB + 1048576;
constexpr size_t OFF_LAM = OFF_BIAS + 65536;
constexpr size_t OFF_QCNT = OFF_LAM + 256;
constexpr size_t OFF_BAR = OFF_TAB + 1048576 + 131072;
constexpr size_t OFF_H = OFF_TAB + 2097152;
constexpr size_t OFF_U = OFF_H + (size_t)TG * 1024 * 2;
constexpr size_t OFF_GATE = OFF_U + (size_t)TG * INW * 2;
constexpr size_t OFF_VTA = OFF_GATE + (size_t)TG * 4096 * 2;
constexpr size_t OFF_VTC = OFF_VTA + (size_t)TG * 128 * 2;
constexpr size_t OFF_VTD = OFF_VTC + (size_t)TG * 512 * 2;
constexpr size_t OFF_O = OFF_VTD + (size_t)TG * 512 * 2;
constexpr size_t OFF_YF = OFF_O + (size_t)4 * TG * 512 * 2;
constexpr size_t OFF_YB = OFF_YF + (size_t)TG * 512 * 2;
constexpr size_t OFF_DT = OFF_YB + (size_t)TG * 512 * 2;
constexpr size_t WS_END = OFF_DT + (size_t)2 * TG * 512 * 2;
constexpr size_t OFF_M = OFF_U;
constexpr size_t OFF_F = OFF_U;

struct Params { const float* in[26]; float* out; char* ws; };

enum { I_XP = 0, I_XS, I_NMIX, I_WIN, I_QG, I_KG, I_SARE, I_SAIM, I_SLDT, I_SBRE, I_SBIM, I_SCRE, I_SCIM, I_SD, I_SWGLU, I_SBGLU,
       I_DLAM, I_DSUB, I_REL, I_WGATE, I_WBR, I_WOUT, I_NFFN, I_WFI, I_WFO, I_NFIN };

constexpr int LDS_BYTES = 71680;
constexpr int AROWB = 144;
constexpr int ROWB = 128;
constexpr int GT_BYTES = 128 * ROWB;

DI int bidx() { int b = blockIdx.x; asm volatile("" : "+s"(b)); return b; }
DI int gdim() { int g = gridDim.x; asm volatile("" : "+s"(g)); return g; }
DI int tidx() { int t = threadIdx.x; asm volatile("" : "+v"(t)); return t; }
DI unsigned pk2(float a, float b) { f32x2 v = {a, b}; bf16v2 r = __builtin_convertvector(v, bf16v2); return __builtin_bit_cast(unsigned, r); }
DI float bf2f(bf16_t v) { return __uint_as_float(((unsigned)v) << 16); }
DI float bflo(unsigned w) { return __uint_as_float(w << 16); }
DI float bfhi(unsigned w) { return __uint_as_float(w & 0xffff0000u); }
DI float sigmoidf_(float x) { return __builtin_amdgcn_rcpf(1.0f + __builtin_amdgcn_exp2f(-LOG2E * x)); }
DI float wave_sum(float v) { v += __shfl_xor(v, 32); v += __shfl_xor(v, 16); v += __shfl_xor(v, 8); v += __shfl_xor(v, 4); v += __shfl_xor(v, 2); v += __shfl_xor(v, 1); return v; }
DI bf16_t* wts(const Params& p, int layer) { return (bf16_t*)(p.ws + OFF_W) + (size_t)layer * LW; }
#define MFMA16(a, b, c) __builtin_amdgcn_mfma_f32_16x16x32_bf16((a), (b), (c), 0, 0, 0)
#define MFMA32(a, b, c) __builtin_amdgcn_mfma_f32_32x32x16_bf16((a), (b), (c), 0, 0, 0)

template <bool SWAP, int BMAP>
DI void gemm_compute(const char* cur, int aoff, int boff, int sw, f32x4 (&acc)[4][4]) {
#pragma unroll
    for (int ks = 0; ks < 2; ++ks) {
        bf16x8 af[4], bfr[4];
        if (ks) asm volatile("" ::: "memory");
        const int so = sw ^ (ks * 64);
#pragma unroll
        for (int m = 0; m < 4; ++m) af[m] = *(const bf16x8*)(cur + aoff + m * 16 * ROWB + so);
#pragma unroll
        for (int n = 0; n < 4; ++n) bfr[n] = *(const bf16x8*)(cur + boff + (BMAP ? ((n >> 1) * 64 + (n & 1) * 16) : n * 16) * ROWB + so);
#pragma unroll
        for (int m = 0; m < 4; ++m)
#pragma unroll
            for (int n = 0; n < 4; ++n) acc[m][n] = SWAP ? MFMA16(bfr[n], af[m], acc[m][n]) : MFMA16(af[m], bfr[n], acc[m][n]);
    }
}
#define GLOAD(RA, RB, KT) { _Pragma("unroll") for (int i_ = 0; i_ < 4; ++i_) { \
    const char* ua_ = Ab + (size_t)(((32 * i_) * lda + (KT) * 64) * 2); const char* ub_ = Bb + (size_t)(((32 * i_) * ldb + (KT) * 64) * 2); \
    RA[i_] = *(const u32x4*)(ua_ + avoff); RB[i_] = *(const u32x4*)(ub_ + bvoff); } }
#define LSTORE(RA, RB, ST) { _Pragma("unroll") for (int i_ = 0; i_ < 4; ++i_) { *(u32x4*)(lds + (ST) * (2 * GT_BYTES) + soff + 32 * i_ * ROWB) = RA[i_]; *(u32x4*)(lds + (ST) * (2 * GT_BYTES) + GT_BYTES + soff + 32 * i_ * ROWB) = RB[i_]; } }
template <bool SWAP, int BMAP = 0, bool DEEP = true>
DI void gemm128(const bf16_t* __restrict__ A, int lda, const bf16_t* __restrict__ B, int ldb, int K, f32x4 (&acc)[4][4], char* lds) {
    const int tid = tidx(), lane = tid & 63, w = tid >> 6, wr = w >> 1, wc = w & 1;
    const int srow = tid >> 3, scol = tid & 7;
    const char* Ab = (const char*)A; const char* Bb = (const char*)B;
    const unsigned avoff = (unsigned)(srow * lda + scol * 8) * 2u, bvoff = (unsigned)(srow * ldb + scol * 8) * 2u;
    const int soff = srow * ROWB + ((scol ^ ((srow >> 1) & 7)) << 4);
    const int nk = K >> 6;
    const int aoff = (wr * 64 + (lane & 15)) * ROWB;
    const int boff = GT_BYTES + ((BMAP ? wc * 32 : wc * 64) + (lane & 15)) * ROWB;
    const int sw = ((lane >> 4) ^ ((lane & 15) >> 1)) << 4;
    u32x4 ra0[4], rb0[4];
    GLOAD(ra0, rb0, 0);
    LSTORE(ra0, rb0, 0);
    if (DEEP) {
        u32x4 ra1[4], rb1[4];
        GLOAD(ra1, rb1, 1);
        __syncthreads();
        for (int kt = 0; kt < nk; kt += 2) {
            { const int k2 = kt + 2 < nk ? kt + 2 : nk - 1; GLOAD(ra0, rb0, k2); }
            gemm_compute<SWAP, BMAP>(lds, aoff, boff, sw, acc);
            LSTORE(ra1, rb1, 1);
            __syncthreads();
            { const int k3 = kt + 3 < nk ? kt + 3 : nk - 1; GLOAD(ra1, rb1, k3); }
            gemm_compute<SWAP, BMAP>(lds + 2 * GT_BYTES, aoff, boff, sw, acc);
            LSTORE(ra0, rb0, 0);
            __syncthreads();
        }
    } else {
        __syncthreads();
        for (int kt = 0; kt < nk; ++kt) {
            const bool more = (kt + 1 < nk);
            if (more) GLOAD(ra0, rb0, kt + 1);
            gemm_compute<SWAP, BMAP>(lds + (kt & 1) * (2 * GT_BYTES), aoff, boff, sw, acc);
            if (more) { if (kt & 1) { LSTORE(ra0, rb0, 0); } else { LSTORE(ra0, rb0, 1); } }
            __syncthreads();
        }
    }
}

struct GemmR { u32x4 a[4], b[4]; };
DI void prime_k0(const bf16_t* A, int lda, const bf16_t* B, int ldb, GemmR& g) {
    const int tid = tidx(), srow = tid >> 3, scol = tid & 7;
    const char* Ab = (const char*)A; const char* Bb = (const char*)B;
    const unsigned avoff = (unsigned)(srow * lda + scol * 8) * 2u, bvoff = (unsigned)(srow * ldb + scol * 8) * 2u;
    GLOAD(g.a, g.b, 0);
}
template <bool SWAP, int BMAP = 0>
DI void gemm128pre(const bf16_t* __restrict__ A, int lda, const bf16_t* __restrict__ B, int ldb, int K, GemmR& pre, f32x4 (&acc)[4][4], char* lds) {
    const int tid = tidx(), lane = tid & 63, w = tid >> 6, wr = w >> 1, wc = w & 1;
    const int srow = tid >> 3, scol = tid & 7;
    const char* Ab = (const char*)A; const char* Bb = (const char*)B;
    const unsigned avoff = (unsigned)(srow * lda + scol * 8) * 2u, bvoff = (unsigned)(srow * ldb + scol * 8) * 2u;
    const int soff = srow * ROWB + ((scol ^ ((srow >> 1) & 7)) << 4);
    const int nk = K >> 6;
    const int aoff = (wr * 64 + (lane & 15)) * ROWB;
    const int boff = GT_BYTES + ((BMAP ? wc * 32 : wc * 64) + (lane & 15)) * ROWB;
    const int sw = ((lane >> 4) ^ ((lane & 15) >> 1)) << 4;
    u32x4 ra1[4], rb1[4];
    LSTORE(pre.a, pre.b, 0);
    GLOAD(ra1, rb1, 1);
    __syncthreads();
    for (int kt = 0; kt < nk; kt += 2) {
        { const int k2 = kt + 2 < nk ? kt + 2 : nk - 1; GLOAD(pre.a, pre.b, k2); }
        gemm_compute<SWAP, BMAP>(lds, aoff, boff, sw, acc);
        LSTORE(ra1, rb1, 1);
        __syncthreads();
        { const int k3 = kt + 3 < nk ? kt + 3 : nk - 1; GLOAD(ra1, rb1, k3); }
        gemm_compute<SWAP, BMAP>(lds + 2 * GT_BYTES, aoff, boff, sw, acc);
        LSTORE(pre.a, pre.b, 0);
        __syncthreads();
    }
}

struct TileIter { int per, SM, SN, nSn, sbase, len, q, nslot; };
DI void ti_init(TileIter& it, int NTm, int NTn, int SM, int SN) {
    const int x = bidx() & 7;
    it.nslot = (gdim() - x + 7) >> 3; it.per = SM * SN; it.SM = SM; it.SN = SN; it.nSn = NTn / SN;
    const int nS = (NTm / SM) * it.nSn;
    it.sbase = x * (nS >> 3); it.len = (nS >> 3) * it.per; it.q = bidx() >> 3;
}
DI bool ti_next(TileIter& it, int& tm, int& tn) {
    if (it.q >= it.len) return false;
    const int j = it.q / it.per, w = it.q % it.per, S = it.sbase + j, sm = S / it.nSn, sn = S % it.nSn;
    tm = sm * it.SM + (w % it.SM); tn = sn * it.SN + (w / it.SM);
    it.q += it.nslot;
    return true;
}

struct GemmRegs { u32x4 a0[4], b0[4], a1[4], b1[4]; };
typedef const __attribute__((address_space(1))) char* gptr_t;
typedef const __attribute__((address_space(1))) u32x4* gvec_t;
DI gptr_t uptr(const void* q) {
    const size_t v = (size_t)q;
    const unsigned lo = __builtin_amdgcn_readfirstlane((unsigned)v), hi = __builtin_amdgcn_readfirstlane((unsigned)(v >> 32));
    return (gptr_t)(((size_t)hi << 32) | lo);
}
#define GLOADP(RA, RB, PA, PB, KT) { _Pragma("unroll") for (int i_ = 0; i_ < 4; ++i_) { \
    gptr_t ua_ = (PA) + (size_t)(((32 * i_) * lda + (KT) * 64) * 2); gptr_t ub_ = (PB) + (size_t)(((32 * i_) * ldb + (KT) * 64) * 2); \
    RA[i_] = *(gvec_t)(ua_ + avoff); RB[i_] = *(gvec_t)(ub_ + bvoff); } }
DI void gemm_prime(const bf16_t* A, int lda, const bf16_t* B, int ldb, GemmRegs& g) {
    const int tid = tidx(), srow = tid >> 3, scol = tid & 7;
    const unsigned avoff = (unsigned)(srow * lda + scol * 8) * 2u, bvoff = (unsigned)(srow * ldb + scol * 8) * 2u;
    gptr_t Ab = uptr(A); gptr_t Bb = uptr(B);
    GLOADP(g.a0, g.b0, Ab, Bb, 0);
    GLOADP(g.a1, g.b1, Ab, Bb, 1);
}
template <bool SWAP, int BMAP = 0>
DI void gemm_stream(const bf16_t* A, const bf16_t* B, const bf16_t* nA, const bf16_t* nB, int lda, int ldb, int K, GemmRegs& g, f32x4 (&acc)[4][4], char* lds) {
    const int tid = tidx(), lane = tid & 63, w = tid >> 6, wr = w >> 1, wc = w & 1;
    const int srow = tid >> 3, scol = tid & 7;
    const unsigned avoff = (unsigned)(srow * lda + scol * 8) * 2u, bvoff = (unsigned)(srow * ldb + scol * 8) * 2u;
    gptr_t Ab = uptr(A); gptr_t Bb = uptr(B); gptr_t nAb = uptr(nA); gptr_t nBb = uptr(nB);
    const int soff = srow * ROWB + ((scol ^ ((srow >> 1) & 7)) << 4);
    const int nk = K >> 6;
    const int aoff = (wr * 64 + (lane & 15)) * ROWB;
    const int boff = GT_BYTES + ((BMAP ? wc * 32 : wc * 64) + (lane & 15)) * ROWB;
    const int sw = ((lane >> 4) ^ ((lane & 15) >> 1)) << 4;
    LSTORE(g.a0, g.b0, 0);
    __syncthreads();
    for (int kt = 0; kt < nk; kt += 2) {
        const bool last = kt + 2 >= nk;
        gptr_t pa = last ? nAb : Ab; gptr_t pb = last ? nBb : Bb;
        const int k2 = last ? 0 : kt + 2, k3 = last ? 1 : kt + 3;
        GLOADP(g.a0, g.b0, pa, pb, k2);
        gemm_compute<SWAP, BMAP>(lds, aoff, boff, sw, acc);
        LSTORE(g.a1, g.b1, 1);
        __syncthreads();
        GLOADP(g.a1, g.b1, pa, pb, k3);
        gemm_compute<SWAP, BMAP>(lds + 2 * GT_BYTES, aoff, boff, sw, acc);
        if (!last) LSTORE(g.a0, g.b0, 0);
        __syncthreads();
    }
}

DI void zero_acc(f32x4 (&acc)[4][4]) {
#pragma unroll
    for (int m = 0; m < 4; ++m)
#pragma unroll
        for (int n = 0; n < 4; ++n) acc[m][n] = (f32x4){0.f, 0.f, 0.f, 0.f};
}


constexpr int OROW = 272;
constexpr int OROWF = 528;
DI void otile_put(char* lds, int row, int col, unsigned w0, unsigned w1) { u32x2 w; w[0] = w0; w[1] = w1; *(u32x2*)(lds + row * OROW + col * 2) = w; }
DI void otile_flush(char* lds, bf16_t* dst, int ld) {
    const int tid = tidx();
    __syncthreads();
#pragma unroll
    for (int i = 0; i < 8; ++i) {
        const int c = tid + 256 * i, row = c >> 4, ch = c & 15;
        const u32x4 v = *(const u32x4*)(lds + row * OROW + ch * 16);
        *(u32x4*)(dst + (size_t)row * ld + ch * 8) = v;
    }
    __syncthreads();
}

DI void conv_tile(const float* __restrict__ src, bf16_t* __restrict__ dst, int K, int N, int tk, int tn, int drow0, float* tile) {
    const int tid = tidx(), ty = tid >> 4, tx = tid & 15;
#pragma unroll
    for (int i = 0; i < 4; ++i) {
        const int k = ty + 16 * i;
        const f32x4 v = *(const f32x4*)(src + (size_t)(tk * 64 + k) * N + tn * 64 + tx * 4);
        tile[k * 65 + tx * 4 + 0] = v[0]; tile[k * 65 + tx * 4 + 1] = v[1]; tile[k * 65 + tx * 4 + 2] = v[2]; tile[k * 65 + tx * 4 + 3] = v[3];
    }
    __syncthreads();
    const int n = tid >> 2, ks = (tid & 3) * 16;
    u32x4 w0, w1;
#pragma unroll
    for (int j = 0; j < 4; ++j) {
        w0[j] = pk2(tile[(ks + 2 * j) * 65 + n], tile[(ks + 2 * j + 1) * 65 + n]);
        w1[j] = pk2(tile[(ks + 8 + 2 * j) * 65 + n], tile[(ks + 8 + 2 * j + 1) * 65 + n]);
    }
    bf16_t* d = dst + (size_t)(drow0 + n) * K + tk * 64 + ks;
    *(u32x4*)d = w0; *(u32x4*)(d + 8) = w1;
    __syncthreads();
}

DI int t5_bucket(int rel) {
    const int base = rel > 0 ? 16 : 0;
    const int dist = rel < 0 ? -rel : rel;
    int b;
    if (dist < 8) b = dist;
    else {
        const float lr = logf((float)dist / 8.0f) / 2.772588722239781f;
        int lg = 8 + (int)(lr * 8.0f);
        b = lg < 15 ? lg : 15;
    }
    return base + b;
}

DI void phase_prologue(const Params& p, char* lds) {
    float* tile = (float*)lds;
    const int tid = tidx();
    for (int t = bidx(); t < 4 * 5056; t += gdim()) {
        const int layer = t / 5056; int q = t % 5056;
        bf16_t* wl = wts(p, layer);
        const float* src; bf16_t* dst; int K, N, nn;
        if (q < 1088) { src = p.in[I_WIN] + (size_t)layer * 1024 * INW; dst = wl + WING; K = 1024; N = INW; }
        else if ((q -= 1088) < 1024) { const int b = q >> 8; q &= 255; src = p.in[I_WGATE] + (size_t)(layer * 4 + b) * 1024 * 1024; dst = wl + WING + (size_t)(INW + b * 1024) * 1024; K = 1024; N = 1024; }
        else if ((q -= 1024) < 512) { const int b = q >> 7; q &= 127; src = p.in[I_WBR] + (size_t)(layer * 4 + b) * 512 * 1024; dst = wl + WB + (size_t)b * 1024 * 512; K = 512; N = 1024; }
        else if ((q -= 512) < 256) { src = p.in[I_WOUT] + (size_t)layer * 1024 * 1024; dst = wl + WO; K = 1024; N = 1024; }
        else if ((q -= 256) < 1408) { src = p.in[I_WFI] + (size_t)layer * 1024 * 5632; dst = wl + WFI; K = 1024; N = 5632; }
        else if ((q -= 1408) < 704) { src = p.in[I_WFO] + (size_t)layer * DFF * 1024; dst = wl + WFO; K = DFF; N = 1024; }
        else { q -= 704; src = p.in[I_SWGLU] + (size_t)layer * 512 * 512; dst = wl + WGLU; K = 512; N = 512; }
        nn = N >> 6;
        const int tk = q / nn, tn = q % nn;
        int drow0 = tn * 64;
        if (N == 5632) drow0 = tn < 44 ? tn * 128 : (tn - 44) * 128 + 64;
        conv_tile(src, dst, K, N, tk, tn, drow0, tile);
    }
    const int gt = bidx() * 256 + tid, gn = gdim() * 256;
    float* cosA = (float*)(p.ws + OFF_COSA); float* sinA = (float*)(p.ws + OFF_SINA);
    float* cosD = (float*)(p.ws + OFF_COSD); float* sinD = (float*)(p.ws + OFF_SIND);
    for (int i = gt; i < SL * 32; i += gn) {
        const int t = i >> 5, j = i & 31;
        const float invA = exp2f(-(float)(j & 15) * (13.287712379549449f / 16.0f));
        const float angA = (j < 16 ? (float)(t >> 6) : (float)(t & 63)) * invA;
        cosA[i] = cosf(angA); sinA[i] = sinf(angA);
        const float invD = exp2f(-(float)j * (13.287712379549449f / 32.0f));
        const float angD = (float)t * invD;
        cosD[i] = cosf(angD); sinD[i] = sinf(angD);
    }
    float* bias = (float*)(p.ws + OFF_BIAS);
    for (int i = gt; i < 4 * 4096; i += gn) {
        const int h = i >> 12, r = i & 4095;
        float v = 0.f;
        if (r < 4095) v = p.in[I_REL][t5_bucket(r - 2047) * 4 + h] * LOG2E;
        bias[i] = v;
    }
    if (bidx() == 0) {
        if (tid < 4) {
            const float* lv = p.in[I_DLAM] + tid * 256;
            float s1 = 0.f, s2 = 0.f;
            for (int j = 0; j < 64; ++j) { s1 += lv[j] * lv[64 + j]; s2 += lv[128 + j] * lv[192 + j]; }
            const float li = 0.8f - 0.6f * expf(-0.3f * (float)tid);
            float* lam = (float*)(p.ws + OFF_LAM);
            lam[tid] = expf(s1) - expf(s2) + li; lam[4 + tid] = li;
        }
        if (tid < 64) ((int*)(p.ws + OFF_QCNT))[tid] = 0;
    }
}

DI const float* x_in_row(const Params& p, int grp, int row) {
    const int seq = grp * G + (row >> 11), t = row & 2047;
    return seq < 8 ? p.in[I_XP] + ((size_t)seq * SL + t) * DM : p.in[I_XS] + ((size_t)(seq - 8) * SL + t) * DM;
}
DI void phase_norm(const Params& p, int grp, const float* gain, int mode) {
    const int lane = tidx() & 63;
    const int gw = bidx() * 4 + (tidx() >> 6), nw = gdim() * 4;
    bf16_t* hb = (bf16_t*)(p.ws + OFF_H);
    f32x4 gv[4];
#pragma unroll
    for (int i = 0; i < 4; ++i) gv[i] = *(const f32x4*)(gain + lane * 4 + 256 * i);
    for (int row = gw; row < TG; row += nw) {
        float* xo = p.out + ((size_t)grp * TG + row) * DM;
        const float* x = mode == 0 ? x_in_row(p, grp, row) : xo;
        f32x4 v[4]; float ss = 0.f;
#pragma unroll
        for (int i = 0; i < 4; ++i) { v[i] = *(const f32x4*)(x + lane * 4 + 256 * i); ss += v[i][0] * v[i][0] + v[i][1] * v[i][1] + v[i][2] * v[i][2] + v[i][3] * v[i][3]; }
        ss = wave_sum(ss);
        const float rstd = rsqrtf(ss * (1.0f / 1024.0f) + EPS);
#pragma unroll
        for (int i = 0; i < 4; ++i) {
            const f32x4 y = v[i] * rstd * gv[i];
            if (mode == 2) *(f32x4*)(xo + lane * 4 + 256 * i) = y;
            else { u32x2 w; w[0] = pk2(y[0], y[1]); w[1] = pk2(y[2], y[3]); *(u32x2*)(hb + (size_t)row * DM + lane * 4 + 256 * i) = w; }
        }
    }
}

DI void phase_in(const Params& p, int layer, char* lds, bool probe = false) {
    const bf16_t* hb = (const bf16_t*)(p.ws + OFF_H);
    const bf16_t* W = wts(p, layer) + WING;
    bf16_t* ub = (bf16_t*)(p.ws + OFF_U);
    bf16_t* gb = (bf16_t*)(p.ws + OFF_GATE);
    constexpr int NT = NIN / 128;
    const int lane = tidx() & 63, w = tidx() >> 6, wr = w >> 1, wc = w & 1, r16 = lane & 15, q4 = lane >> 4;
    TileIter it; ti_init(it, TG / 128, NT, 8, 6);
    int tm, tn, ntm = 0, ntn = 0;
    bool have = ti_next(it, tm, tn);
    GemmR pre;
    if (have) prime_k0(hb + (size_t)tm * 128 * DM, DM, W + (size_t)(tn * 128) * DM, DM, pre);
    for (; have; tm = ntm, tn = ntn) {
        have = ti_next(it, ntm, ntn);
        const bf16_t* nAt = have ? hb + (size_t)ntm * 128 * DM : hb; const bf16_t* nBt = have ? W + (size_t)(ntn * 128) * DM : W;
        const int c0 = tn * 128;
        const bool isV = (c0 == 640) || (c0 >= 2304 && c0 < 2816) || (c0 >= 3328 && c0 < 3840);
        f32x4 acc[4][4]; zero_acc(acc);
        const int cb = c0 + wc * 64;
        if (isV) {
            gemm128pre<false>(hb + (size_t)tm * 128 * DM, DM, W + (size_t)c0 * DM, DM, DM, pre, acc, lds);
            prime_k0(nAt, DM, nBt, DM, pre);
            bf16_t* vt; int cl, DV, NH;
            if (cb < 768) { vt = (bf16_t*)(p.ws + OFF_VTA); cl = cb - 640; DV = 64; NH = 2; }
            else if (cb < 2816) { vt = (bf16_t*)(p.ws + OFF_VTC); cl = cb - 2304; DV = 128; NH = 4; }
            else { vt = (bf16_t*)(p.ws + OFF_VTD); cl = cb - 3328; DV = 128; NH = 4; }
#pragma unroll
            for (int m = 0; m < 4; ++m)
#pragma unroll
                for (int n = 0; n < 4; ++n)
                    otile_put(lds, wc * 64 + n * 16 + r16, wr * 64 + m * 16 + q4 * 4, pk2(acc[m][n][0], acc[m][n][1]), pk2(acc[m][n][2], acc[m][n][3]));
            otile_flush(lds, vt + ((size_t)((tm * 128) >> 11) * NH * DV + (cl - wc * 64)) * SL + ((tm * 128) & 2047), SL);
        } else {
            gemm128pre<true>(hb + (size_t)tm * 128 * DM, DM, W + (size_t)c0 * DM, DM, DM, pre, acc, lds);
            bool donorm = false, dosig = false; int rot = 0; float scale = 1.f; const float* gain = nullptr;
            bf16_t* dst = ub; int ld = INW, dcol = cb;
            if (cb < 512) { donorm = true; rot = 1; scale = 0.125f * LOG2E; gain = p.in[I_QG] + layer * 64; }
            else if (cb < 640) { donorm = true; rot = 1; gain = p.in[I_KG] + layer * 64; }
            else if (cb < 1280) { }
            else if (cb < 1792) { scale = 0.125f * LOG2E; }
            else if (cb < 2816) { }
            else if (cb < 3072) { rot = 2; scale = 0.125f; }
            else if (cb < 3328) { rot = 2; }
            else if (cb < INW) { }
            else { dosig = true; dst = gb; ld = 4096; dcol = cb - INW; }
            float gl[4][4];
            if (donorm) {
#pragma unroll
                for (int n = 0; n < 4; ++n) { const f32x4 g4 = *(const f32x4*)(gain + n * 16 + q4 * 4); gl[n][0] = g4[0]; gl[n][1] = g4[1]; gl[n][2] = g4[2]; gl[n][3] = g4[3]; }
            }
            const float* ct = (const float*)(p.ws + (rot == 2 ? OFF_COSD : OFF_COSA));
            const float* sn = (const float*)(p.ws + (rot == 2 ? OFF_SIND : OFF_SINA));
#pragma unroll
            for (int m = 0; m < 4; ++m) {
                asm volatile("" ::: "memory");
                const int row = tm * 128 + wr * 64 + m * 16 + r16, tpos = row & 2047;
                float v[4][4];
#pragma unroll
                for (int n = 0; n < 4; ++n)
#pragma unroll
                    for (int i = 0; i < 4; ++i) v[n][i] = acc[m][n][i];
                if (donorm) {
                    float ss = 0.f;
#pragma unroll
                    for (int n = 0; n < 4; ++n)
#pragma unroll
                        for (int i = 0; i < 4; ++i) ss += v[n][i] * v[n][i];
                    ss += __shfl_xor(ss, 16); ss += __shfl_xor(ss, 32);
                    const float rstd = rsqrtf(ss * (1.0f / 64.0f) + EPS);
#pragma unroll
                    for (int n = 0; n < 4; ++n)
#pragma unroll
                        for (int i = 0; i < 4; ++i) v[n][i] = v[n][i] * rstd * gl[n][i];
                }
                if (rot) {
#pragma unroll
                    for (int n = 0; n < 2; ++n) {
                        const f32x4 c4 = *(const f32x4*)(ct + tpos * 32 + n * 16 + q4 * 4), s4 = *(const f32x4*)(sn + tpos * 32 + n * 16 + q4 * 4);
#pragma unroll
                        for (int i = 0; i < 4; ++i) { const float x1 = v[n][i], x2 = v[n + 2][i]; v[n][i] = x1 * c4[i] - x2 * s4[i]; v[n + 2][i] = x2 * c4[i] + x1 * s4[i]; }
                    }
                }
#pragma unroll
                for (int n = 0; n < 4; ++n) {
                    float o0, o1, o2, o3;
                    if (dosig) { o0 = sigmoidf_(v[n][0]); o1 = sigmoidf_(v[n][1]); o2 = sigmoidf_(v[n][2]); o3 = sigmoidf_(v[n][3]); }
                    else { o0 = v[n][0] * scale; o1 = v[n][1] * scale; o2 = v[n][2] * scale; o3 = v[n][3] * scale; }
                    otile_put(lds, wr * 64 + m * 16 + r16, wc * 64 + n * 16 + q4 * 4, pk2(o0, o1), pk2(o2, o3));
                }
            }
            prime_k0(nAt, DM, nBt, DM, pre);
            otile_flush(lds, dst + (size_t)(tm * 128) * ld + (dcol - wc * 64), ld);
        }
    }
}

template <int DV, int MODE>
DI void attn_task(const Params& p, int task, char* lds) {
    constexpr int NDT = DV / 32;
    constexpr int STG = 64 * AROWB + DV * AROWB;
    const int tid = tidx(), lane = tid & 63, wave = tid >> 6, r = lane & 31, h = lane >> 5;
    const bf16_t* ub = (const bf16_t*)(p.ws + OFF_U);
    const int qt = task & 15; const int rest = task >> 4;
    int seq, head, map = 0, qcol, kcol; const bf16_t* vt;
    if (MODE == 0) { head = rest & 7; seq = rest >> 3; qcol = head * 64; kcol = 512 + (head >> 2) * 64; vt = (const bf16_t*)(p.ws + OFF_VTA) + (size_t)(seq * 2 + (head >> 2)) * 64 * SL; }
    else if (MODE == 1) { map = rest & 1; head = (rest >> 1) & 3; seq = rest >> 3; qcol = 1280 + head * 128 + map * 64; kcol = 1792 + head * 128 + map * 64; vt = (const bf16_t*)(p.ws + OFF_VTC) + (size_t)(seq * 4 + head) * 128 * SL; }
    else { head = rest & 3; seq = rest >> 2; qcol = 2816 + head * 64; kcol = 3072 + head * 64; vt = (const bf16_t*)(p.ws + OFF_VTD) + (size_t)(seq * 4 + head) * 128 * SL; }
    const int qpos = qt * 128 + wave * 32 + r;
    const bf16_t* qptr = ub + ((size_t)seq * SL + qpos) * INW + qcol;
    bf16x8 qf[4];
#pragma unroll
    for (int s = 0; s < 4; ++s) qf[s] = *(const bf16x8*)(qptr + 16 * s + 8 * h);
    const bf16_t* kbase = ub + (size_t)seq * SL * INW + kcol;
    float* sBias = (float*)(lds + 2 * STG);
    if (MODE == 1) { const float* bl = (const float*)(p.ws + OFF_BIAS) + head * 4096; for (int i = tid; i < 4096; i += 256) sBias[i] = bl[i]; }
    float lgam = 0.f;
    if (MODE == 2) lgam = log2f(1.0f - exp2f(-5.0f - (float)head));
    f32x16 o[NDT];
#pragma unroll
    for (int d = 0; d < NDT; ++d)
#pragma unroll
        for (int i = 0; i < 16; ++i) o[d][i] = 0.f;
    float lsum = 0.f;
    const int srow = tid >> 3, sc = tid & 7;
    const bf16_t* kg = kbase + (size_t)srow * INW + sc * 8;
    const bf16_t* vg = vt + (size_t)srow * SL + sc * 8;
    u32x4 rk[2], rv[NDT];
#pragma unroll
    for (int i = 0; i < 2; ++i) rk[i] = *(const u32x4*)(kg + (size_t)(32 * i) * INW);
#pragma unroll
    for (int i = 0; i < NDT; ++i) rv[i] = *(const u32x4*)(vg + (size_t)(32 * i) * SL);
    const int soff = srow * AROWB + sc * 16;
#pragma unroll
    for (int i = 0; i < 2; ++i) *(u32x4*)(lds + soff + 32 * i * AROWB) = rk[i];
#pragma unroll
    for (int i = 0; i < NDT; ++i) *(u32x4*)(lds + 64 * AROWB + soff + 32 * i * AROWB) = rv[i];
    __syncthreads();
    for (int kt = 0; kt < SL / 64; ++kt) {
        const char* cur = lds + (kt & 1) * STG;
        char* nxt = lds + ((kt + 1) & 1) * STG;
        const bool more = kt + 1 < SL / 64;
        const int kv0 = kt * 64;
        if (more) {
            kg += (size_t)64 * INW; vg += 64;
#pragma unroll
            for (int i = 0; i < 2; ++i) rk[i] = *(const u32x4*)(kg + (size_t)(32 * i) * INW);
#pragma unroll
            for (int i = 0; i < NDT; ++i) rv[i] = *(const u32x4*)(vg + (size_t)(32 * i) * SL);
        }
        f32x16 st[2];
#pragma unroll
        for (int kk = 0; kk < 2; ++kk) {
#pragma unroll
            for (int i = 0; i < 16; ++i) st[kk][i] = 0.f;
#pragma unroll
            for (int s = 0; s < 4; ++s) {
                const bf16x8 kf = *(const bf16x8*)(cur + (32 * kk + r) * AROWB + (16 * s + 8 * h) * 2);
                st[kk] = MFMA32(kf, qf[s], st[kk]);
            }
        }
        const int qw0 = qt * 128 + wave * 32;
        const bool farL = MODE == 1 && (kv0 + 63 - qw0) <= -128, farR = MODE == 1 && (kv0 - (qw0 + 31)) >= 128;
        if (MODE == 1 && (farL || farR)) {
            const float bc = farL ? sBias[0] : sBias[4094];
#pragma unroll
            for (int kk = 0; kk < 2; ++kk)
#pragma unroll
                for (int i = 0; i < 16; ++i) { const float pv = __builtin_amdgcn_exp2f(st[kk][i] + bc); lsum += pv; st[kk][i] = pv; }
        } else
#pragma unroll
        for (int kk = 0; kk < 2; ++kk)
#pragma unroll
            for (int i = 0; i < 16; ++i) {
                const int m = kv0 + 32 * kk + (i & 3) + 8 * (i >> 2) + 4 * h;
                float pv;
                if (MODE == 0) pv = __builtin_amdgcn_exp2f(st[kk][i]);
                else if (MODE == 1) pv = __builtin_amdgcn_exp2f(st[kk][i] + sBias[m - qpos + 2047]);
                else pv = st[kk][i] * __builtin_amdgcn_exp2f(lgam * fabsf((float)(qpos - m)));
                if (MODE != 2) lsum += pv;
                st[kk][i] = pv;
            }
        const char* sV = cur + 64 * AROWB;
#pragma unroll
        for (int kk = 0; kk < 2; ++kk)
#pragma unroll
            for (int s2 = 0; s2 < 2; ++s2) {
                u32x4 pw;
#pragma unroll
                for (int j = 0; j < 4; ++j) pw[j] = pk2(st[kk][8 * s2 + 2 * j], st[kk][8 * s2 + 2 * j + 1]);
                const bf16x8 pf = __builtin_bit_cast(bf16x8, pw);
#pragma unroll
                for (int d = 0; d < NDT; ++d) {
                    const char* va = sV + (32 * d + r) * AROWB + (32 * kk + 16 * s2 + 4 * h) * 2;
                    const s16x4 lo = *(const s16x4*)va, hi = *(const s16x4*)(va + 16);
                    const bf16x8 vf = __builtin_shufflevector(lo, hi, 0, 1, 2, 3, 4, 5, 6, 7);
                    o[d] = MFMA32(vf, pf, o[d]);
                }
            }
        if (more) {
#pragma unroll
            for (int i = 0; i < 2; ++i) *(u32x4*)(nxt + soff + 32 * i * AROWB) = rk[i];
#pragma unroll
            for (int i = 0; i < NDT; ++i) *(u32x4*)(nxt + 64 * AROWB + soff + 32 * i * AROWB) = rv[i];
        }
        __syncthreads();
    }
    const size_t tok = (size_t)seq * SL + qpos;
    if (MODE != 2) {
        const float ltot = lsum + __shfl_xor(lsum, 32);
        const float inv = __builtin_amdgcn_rcpf(ltot);
        bf16_t* dst = MODE == 0 ? (bf16_t*)(p.ws + OFF_O) + tok * 512 + head * 64
                                : (bf16_t*)(p.ws + OFF_DT) + ((size_t)map * TG + tok) * 512 + head * 128;
        if (DV == 128) {
#pragma unroll
            for (int d = 0; d < NDT; ++d)
#pragma unroll
                for (int a = 0; a < 4; ++a) otile_put(lds, wave * 32 + r, 32 * d + 8 * a + 4 * h, pk2(o[d][4 * a] * inv, o[d][4 * a + 1] * inv), pk2(o[d][4 * a + 2] * inv, o[d][4 * a + 3] * inv));
            otile_flush(lds, (bf16_t*)(p.ws + OFF_DT) + ((size_t)map * TG + (size_t)seq * SL + qt * 128) * 512 + head * 128, 512);
        } else {
#pragma unroll
        for (int d = 0; d < NDT; ++d)
#pragma unroll
            for (int a = 0; a < 4; ++a) {
                u32x2 wv; wv[0] = pk2(o[d][4 * a] * inv, o[d][4 * a + 1] * inv); wv[1] = pk2(o[d][4 * a + 2] * inv, o[d][4 * a + 3] * inv);
                *(u32x2*)(dst + 32 * d + 8 * a + 4 * h) = wv;
            }
        }
    } else {
        float s = 0.f;
#pragma unroll
        for (int d = 0; d < NDT; ++d)
#pragma unroll
            for (int i = 0; i < 16; ++i) s += o[d][i];
        s += __shfl_xor(s, 32);
        const float mu = s * (1.0f / 128.0f);
        float vs = 0.f;
#pragma unroll
        for (int d = 0; d < NDT; ++d)
#pragma unroll
            for (int i = 0; i < 16; ++i) { const float dd = o[d][i] - mu; vs += dd * dd; }
        vs += __shfl_xor(vs, 32);
        const float rstd = rsqrtf(vs * (1.0f / 128.0f) + EPS);
        const bf16_t* gp = ub + tok * INW + 3840 + head * 128;
        bf16_t* dst = (bf16_t*)(p.ws + OFF_O) + ((size_t)3 * TG + tok) * 512 + head * 128;
#pragma unroll
        for (int d = 0; d < NDT; ++d)
#pragma unroll
            for (int a = 0; a < 4; ++a) {
                asm volatile("" ::: "memory");
                const u32x2 gw = *(const u32x2*)(gp + 32 * d + 8 * a + 4 * h);
                const float g0 = bflo(gw[0]), g1 = bfhi(gw[0]), g2 = bflo(gw[1]), g3 = bfhi(gw[1]);
                const float y0 = (o[d][4 * a] - mu) * rstd * g0 * sigmoidf_(g0), y1 = (o[d][4 * a + 1] - mu) * rstd * g1 * sigmoidf_(g1);
                const float y2 = (o[d][4 * a + 2] - mu) * rstd * g2 * sigmoidf_(g2), y3 = (o[d][4 * a + 3] - mu) * rstd * g3 * sigmoidf_(g3);
                otile_put(lds, wave * 32 + r, 32 * d + 8 * a + 4 * h, pk2(y0, y1), pk2(y2, y3));
            }
        otile_flush(lds, (bf16_t*)(p.ws + OFF_O) + ((size_t)3 * TG + (size_t)seq * SL + qt * 128) * 512 + head * 128, 512);
    }
}

DI void attn_gqa2(const Params& p, int task, char* lds) {
    constexpr int DV = 64, NDT = 2;
    constexpr int STG = 64 * AROWB + DV * AROWB;
    const int tid = tidx(), lane = tid & 63, wave = tid >> 6, r = lane & 31, h = lane >> 5;
    const bf16_t* ub = (const bf16_t*)(p.ws + OFF_U);
    const int qt = task & 7, rest = task >> 3, head = rest & 7, seq = rest >> 3;
    const int qcol = head * 64, kcol = 512 + (head >> 2) * 64;
    const bf16_t* vt = (const bf16_t*)(p.ws + OFF_VTA) + (size_t)(seq * 2 + (head >> 2)) * 64 * SL;
    const int qpos0 = qt * 256 + wave * 64 + r;
    bf16x8 qf[2][4];
#pragma unroll
    for (int qs = 0; qs < 2; ++qs) {
        const bf16_t* qptr = ub + ((size_t)seq * SL + qpos0 + 32 * qs) * INW + qcol;
#pragma unroll
        for (int s = 0; s < 4; ++s) qf[qs][s] = *(const bf16x8*)(qptr + 16 * s + 8 * h);
    }
    const bf16_t* kbase = ub + (size_t)seq * SL * INW + kcol;
    f32x16 o[2][NDT];
#pragma unroll
    for (int qs = 0; qs < 2; ++qs)
#pragma unroll
        for (int d = 0; d < NDT; ++d)
#pragma unroll
            for (int i = 0; i < 16; ++i) o[qs][d][i] = 0.f;
    float lsum[2] = {0.f, 0.f};
    const int srow = tid >> 3, sc = tid & 7;
    const bf16_t* kg = kbase + (size_t)srow * INW + sc * 8;
    const bf16_t* vg = vt + (size_t)srow * SL + sc * 8;
    u32x4 rk[2], rv[NDT];
#pragma unroll
    for (int i = 0; i < 2; ++i) rk[i] = *(const u32x4*)(kg + (size_t)(32 * i) * INW);
#pragma unroll
    for (int i = 0; i < NDT; ++i) rv[i] = *(const u32x4*)(vg + (size_t)(32 * i) * SL);
    const int soff = srow * AROWB + sc * 16;
#pragma unroll
    for (int i = 0; i < 2; ++i) *(u32x4*)(lds + soff + 32 * i * AROWB) = rk[i];
#pragma unroll
    for (int i = 0; i < NDT; ++i) *(u32x4*)(lds + 64 * AROWB + soff + 32 * i * AROWB) = rv[i];
    __syncthreads();
    for (int kt = 0; kt < SL / 64; ++kt) {
        const char* cur = lds + (kt & 1) * STG;
        char* nxt = lds + ((kt + 1) & 1) * STG;
        const bool more = kt + 1 < SL / 64;
        if (more) {
            kg += (size_t)64 * INW; vg += 64;
#pragma unroll
            for (int i = 0; i < 2; ++i) rk[i] = *(const u32x4*)(kg + (size_t)(32 * i) * INW);
#pragma unroll
            for (int i = 0; i < NDT; ++i) rv[i] = *(const u32x4*)(vg + (size_t)(32 * i) * SL);
        }
        f32x16 st[2][2];
#pragma unroll
        for (int kk = 0; kk < 2; ++kk) {
#pragma unroll
            for (int i = 0; i < 16; ++i) { st[0][kk][i] = 0.f; st[1][kk][i] = 0.f; }
#pragma unroll
            for (int s = 0; s < 4; ++s) {
                const bf16x8 kf = *(const bf16x8*)(cur + (32 * kk + r) * AROWB + (16 * s + 8 * h) * 2);
                st[0][kk] = MFMA32(kf, qf[0][s], st[0][kk]);
                st[1][kk] = MFMA32(kf, qf[1][s], st[1][kk]);
            }
        }
#pragma unroll
        for (int qs = 0; qs < 2; ++qs)
#pragma unroll
            for (int kk = 0; kk < 2; ++kk)
#pragma unroll
                for (int i = 0; i < 16; ++i) { const float pv = __builtin_amdgcn_exp2f(st[qs][kk][i]); lsum[qs] += pv; st[qs][kk][i] = pv; }
        const char* sV = cur + 64 * AROWB;
#pragma unroll
        for (int kk = 0; kk < 2; ++kk)
#pragma unroll
            for (int s2 = 0; s2 < 2; ++s2) {
                bf16x8 pf[2];
#pragma unroll
                for (int qs = 0; qs < 2; ++qs) {
                    u32x4 pw;
#pragma unroll
                    for (int j = 0; j < 4; ++j) pw[j] = pk2(st[qs][kk][8 * s2 + 2 * j], st[qs][kk][8 * s2 + 2 * j + 1]);
                    pf[qs] = __builtin_bit_cast(bf16x8, pw);
                }
#pragma unroll
                for (int d = 0; d < NDT; ++d) {
                    const char* va = sV + (32 * d + r) * AROWB + (32 * kk + 16 * s2 + 4 * h) * 2;
                    const s16x4 lo = *(const s16x4*)va, hi = *(const s16x4*)(va + 16);
                    const bf16x8 vf = __builtin_shufflevector(lo, hi, 0, 1, 2, 3, 4, 5, 6, 7);
                    o[0][d] = MFMA32(vf, pf[0], o[0][d]);
                    o[1][d] = MFMA32(vf, pf[1], o[1][d]);
                }
            }
        if (more) {
#pragma unroll
            for (int i = 0; i < 2; ++i) *(u32x4*)(nxt + soff + 32 * i * AROWB) = rk[i];
#pragma unroll
            for (int i = 0; i < NDT; ++i) *(u32x4*)(nxt + 64 * AROWB + soff + 32 * i * AROWB) = rv[i];
        }
        __syncthreads();
    }
#pragma unroll
    for (int qs = 0; qs < 2; ++qs) {
        const size_t tok = (size_t)seq * SL + qpos0 + 32 * qs;
        const float ltot = lsum[qs] + __shfl_xor(lsum[qs], 32);
        const float inv = __builtin_amdgcn_rcpf(ltot);
        bf16_t* dst = (bf16_t*)(p.ws + OFF_O) + tok * 512 + head * 64;
#pragma unroll
        for (int d = 0; d < NDT; ++d)
#pragma unroll
            for (int a = 0; a < 4; ++a) {
                u32x2 wv; wv[0] = pk2(o[qs][d][4 * a] * inv, o[qs][d][4 * a + 1] * inv); wv[1] = pk2(o[qs][d][4 * a + 2] * inv, o[qs][d][4 * a + 3] * inv);
                *(u32x2*)(dst + 32 * d + 8 * a + 4 * h) = wv;
            }
    }
}

DI void tr_read8(unsigned a, s16x4 (&v)[8]) {
    asm volatile("ds_read_b64_tr_b16 %0, %8\n\tds_read_b64_tr_b16 %1, %8 offset:256\n\tds_read_b64_tr_b16 %2, %8 offset:1024\n\tds_read_b64_tr_b16 %3, %8 offset:1280\n\t"
                 "ds_read_b64_tr_b16 %4, %8 offset:2048\n\tds_read_b64_tr_b16 %5, %8 offset:2304\n\tds_read_b64_tr_b16 %6, %8 offset:3072\n\tds_read_b64_tr_b16 %7, %8 offset:3328\n\t"
                 "s_waitcnt lgkmcnt(0)"
                 : "=&v"(v[0]), "=&v"(v[1]), "=&v"(v[2]), "=&v"(v[3]), "=&v"(v[4]), "=&v"(v[5]), "=&v"(v[6]), "=&v"(v[7]) : "v"(a) : "memory");
}

DI void s5_wave_task(const Params& p, int layer, int wt, char* ldsw) {
    const int lane = tidx() & 63, r = lane & 31, h = lane >> 5;
    const int dir = wt & 1, g = (wt >> 1) & 31, pair = wt >> 6;
    const bf16_t* ub = (const bf16_t*)(p.ws + OFF_U);
    const int hp = (r >> 2) & 1, ia = 4 * (r >> 3) + (r & 3);
    const unsigned img = (unsigned)(size_t)ldsw;
    char* chunkbuf = ldsw + 8192;
    const int i16 = lane & 15, tq = i16 >> 2, tp = i16 & 3, blk = (lane >> 4) & 1;
    const unsigned trA = img + (8 * h + tq) * 64 + 8 * (4 * blk + tp);
    const float dsk = r < 16 ? p.in[I_SD][layer * 512 + g * 16 + r] : 0.f;
    bf16_t* yl = (bf16_t*)(p.ws + (dir ? OFF_YB : OFF_YF)) + ((size_t)(2 * pair + h) * 512 + g * 16 + (r & 15)) * SL;
    const int pb = (layer * 2 + dir) * 32 + g;
    const float dt = expf(p.in[I_SLDT][pb]);
    float abr[2], abi[2];
    bf16x8 bfrag[2][2], cfrag[2][2][2], dfrag;
    {
        u32x4 dw;
#pragma unroll
        for (int j = 0; j < 4; ++j) dw[j] = pk2((dir == 0 && r == 8 * h + 2 * j) ? dsk : 0.f, (dir == 0 && r == 8 * h + 2 * j + 1) ? dsk : 0.f);
        dfrag = __builtin_bit_cast(bf16x8, dw);
    }
#pragma unroll
    for (int st = 0; st < 2; ++st) {
        const int n = 32 * st + r;
        const float are = p.in[I_SARE][pb * 64 + n], aim = p.in[I_SAIM][pb * 64 + n];
        const float mag = expf(dt * are);
        abr[st] = mag * cosf(dt * aim); abi[st] = mag * sinf(dt * aim);
        const float den = are * are + aim * aim, nr = abr[st] - 1.0f;
        const float fre = (nr * are + abi[st] * aim) / den, fim = (abi[st] * are - nr * aim) / den;
        const float* bre = p.in[I_SBRE] + ((size_t)pb * 64 + n) * 16 + 8 * h;
        const float* bim = p.in[I_SBIM] + ((size_t)pb * 64 + n) * 16 + 8 * h;
        u32x4 wre, wim;
#pragma unroll
        for (int j = 0; j < 4; ++j) {
            const float br0 = bre[2 * j], bi0 = bim[2 * j], br1 = bre[2 * j + 1], bi1 = bim[2 * j + 1];
            wre[j] = pk2(fre * br0 - fim * bi0, fre * br1 - fim * bi1);
            wim[j] = pk2(fre * bi0 + fim * br0, fre * bi1 + fim * br1);
        }
        bfrag[st][0] = __builtin_bit_cast(bf16x8, wre); bfrag[st][1] = __builtin_bit_cast(bf16x8, wim);
#pragma unroll
        for (int s = 0; s < 2; ++s) {
            u32x4 cr = {0u, 0u, 0u, 0u}, ci = {0u, 0u, 0u, 0u};
            if (r < 16) {
                const float* cre = p.in[I_SCRE] + ((size_t)pb * 16 + r) * 64 + 32 * st + 16 * s + 8 * h;
                const float* cim = p.in[I_SCIM] + ((size_t)pb * 16 + r) * 64 + 32 * st + 16 * s + 8 * h;
#pragma unroll
                for (int j = 0; j < 4; ++j) { cr[j] = pk2(cre[2 * j], cre[2 * j + 1]); ci[j] = pk2(-cim[2 * j], -cim[2 * j + 1]); }
            }
            cfrag[st][s][0] = __builtin_bit_cast(bf16x8, cr); cfrag[st][s][1] = __builtin_bit_cast(bf16x8, ci);
        }
    }
    float sre[2] = {0.f, 0.f}, sim[2] = {0.f, 0.f};
    const bf16_t* gsrc[4]; int loff[4];
#pragma unroll
    for (int j = 0; j < 4; ++j) {
        const int c = lane + 64 * j, row = c >> 1, half = c & 1, ss = row >> 6, tau = row & 63;
        gsrc[j] = ub + ((size_t)(2 * pair + ss) * SL + (dir ? (SL - 1 - tau) : tau)) * INW + 768 + g * 16 + half * 8;
        loff[j] = row * 32 + half * 16;
    }
    const long cstep = dir ? -(long)64 * INW : (long)64 * INW;
    u32x4 crg[4];
#pragma unroll
    for (int j = 0; j < 4; ++j) crg[j] = *(const u32x4*)gsrc[j];
#pragma unroll
    for (int j = 0; j < 4; ++j) *(u32x4*)(chunkbuf + loff[j]) = crg[j];
    const int aoff = (hp * 64 + ia) * 32 + h * 16;
    for (int chunk = 0; chunk < SL / 64; ++chunk) {
        if (chunk + 1 < SL / 64) {
#pragma unroll
            for (int j = 0; j < 4; ++j) { gsrc[j] += cstep; crg[j] = *(const u32x4*)gsrc[j]; }
        }
        const char* cb = chunkbuf + (chunk & 1) * 4096;
#pragma unroll 1
        for (int tl = 0; tl < 4; ++tl) {
            const int s0 = chunk * 64 + tl * 16;
            const bf16x8 ua = *(const bf16x8*)(cb + aoff + tl * 512);
            f32x16 z;
#pragma unroll
            for (int i = 0; i < 16; ++i) z[i] = 0.f;
            f32x16 y0 = MFMA32(ua, dfrag, z);
            f32x16 y1 = z;
#pragma unroll
            for (int st = 0; st < 2; ++st) {
                f32x16 xr = MFMA32(ua, bfrag[st][0], z);
                f32x16 xi = MFMA32(ua, bfrag[st][1], z);
                float cr = sre[st], ci = sim[st];
#pragma unroll
                for (int i = 0; i < 16; ++i) {
                    const float nr = abr[st] * cr - abi[st] * ci + xr[i];
                    const float ni = abr[st] * ci + abi[st] * cr + xi[i];
                    cr = nr; ci = ni; xr[i] = nr; xi[i] = ni;
                }
                sre[st] = cr; sim[st] = ci;
#pragma unroll
                for (int a = 0; a < 4; ++a) {
                    u32x2 w0, w1; w0[0] = pk2(xr[4 * a], xr[4 * a + 1]); w0[1] = pk2(xr[4 * a + 2], xr[4 * a + 3]);
                    w1[0] = pk2(xi[4 * a], xi[4 * a + 1]); w1[1] = pk2(xi[4 * a + 2], xi[4 * a + 3]);
                    *(u32x2*)(ldsw + (st * 2 + 0) * 2048 + r * 64 + 8 * (2 * a + h)) = w0;
                    *(u32x2*)(ldsw + (st * 2 + 1) * 2048 + r * 64 + 8 * (2 * a + h)) = w1;
                }
            }
            asm volatile("s_waitcnt lgkmcnt(0)" ::: "memory");
            {
                s16x4 v[8];
                tr_read8(trA, v);
                y0 = MFMA32(__builtin_shufflevector(v[0], v[1], 0, 1, 2, 3, 4, 5, 6, 7), cfrag[0][0][0], y0);
                y0 = MFMA32(__builtin_shufflevector(v[2], v[3], 0, 1, 2, 3, 4, 5, 6, 7), cfrag[0][1][0], y0);
                y0 = MFMA32(__builtin_shufflevector(v[4], v[5], 0, 1, 2, 3, 4, 5, 6, 7), cfrag[0][0][1], y0);
                y0 = MFMA32(__builtin_shufflevector(v[6], v[7], 0, 1, 2, 3, 4, 5, 6, 7), cfrag[0][1][1], y0);
                s16x4 u[8];
                tr_read8(trA + 4096, u);
                y1 = MFMA32(__builtin_shufflevector(u[0], u[1], 0, 1, 2, 3, 4, 5, 6, 7), cfrag[1][0][0], y1);
                y1 = MFMA32(__builtin_shufflevector(u[2], u[3], 0, 1, 2, 3, 4, 5, 6, 7), cfrag[1][1][0], y1);
                y1 = MFMA32(__builtin_shufflevector(u[4], u[5], 0, 1, 2, 3, 4, 5, 6, 7), cfrag[1][0][1], y1);
                y1 = MFMA32(__builtin_shufflevector(u[6], u[7], 0, 1, 2, 3, 4, 5, 6, 7), cfrag[1][1][1], y1);
            }
            if (r < 16) {
                u32x4 o0, o1;
                if (dir == 0) {
#pragma unroll
                    for (int j = 0; j < 4; ++j) { o0[j] = pk2(y0[2 * j] + y1[2 * j], y0[2 * j + 1] + y1[2 * j + 1]); o1[j] = pk2(y0[8 + 2 * j] + y1[8 + 2 * j], y0[9 + 2 * j] + y1[9 + 2 * j]); }
                    *(u32x4*)(yl + s0) = o0; *(u32x4*)(yl + s0 + 8) = o1;
                } else {
#pragma unroll
                    for (int j = 0; j < 4; ++j) { o0[j] = pk2(y0[15 - 2 * j] + y1[15 - 2 * j], y0[14 - 2 * j] + y1[14 - 2 * j]); o1[j] = pk2(y0[7 - 2 * j] + y1[7 - 2 * j], y0[6 - 2 * j] + y1[6 - 2 * j]); }
                    *(u32x4*)(yl + (SL - 16 - s0)) = o0; *(u32x4*)(yl + (SL - 16 - s0) + 8) = o1;
                }
            }
        }
        if (chunk + 1 < SL / 64) {
#pragma unroll
            for (int j = 0; j < 4; ++j) *(u32x4*)(chunkbuf + ((chunk + 1) & 1) * 4096 + loff[j]) = crg[j];
        }
    }
}

DI void phase_mix(const Params& p, int layer, int qidx, char* lds, bool only_s5 = false) {
    __shared__ int s_task;
    int* qc = (int*)(p.ws + OFF_QCNT) + qidx;
    constexpr int N_S5 = (G / 2) * 32 * 2 / 4, N_DIFF = G * 4 * 2 * 16, N_RET = G * 4 * 16, N_GQA = G * 8 * 8;
    constexpr int NTOT = N_S5 + N_DIFF + N_RET + N_GQA;
    for (;;) {
        __syncthreads();
        if (tidx() == 0) s_task = atomicAdd(qc, 1);
        __syncthreads();
        int task = s_task;
        if (task >= (only_s5 ? N_S5 : NTOT)) break;
        if (task < N_S5) { const int wave = tidx() >> 6; s5_wave_task(p, layer, task * 4 + wave, lds + wave * 16384); }
        else if ((task -= N_S5) < N_DIFF) attn_task<128, 1>(p, task, lds);
        else if ((task -= N_DIFF) < N_RET) attn_task<128, 2>(p, task, lds);
        else attn_gqa2(p, task - N_RET, lds);
    }
}

DI float gelu_tanh(float v) { const float z2 = 1.5957691216057308f * (v + 0.044715f * v * v * v); return v * __builtin_amdgcn_rcpf(1.0f + __builtin_amdgcn_exp2f(-LOG2E * z2)); }

DI void glu_tile(const Params& p, int layer, int tm, int tn, char* lds) {
    const int tid = tidx(), lane = tid & 63, w = tid >> 6, wr = w >> 1, wc = w & 1, r16 = lane & 15, q4 = lane >> 4;
    const bf16_t* yf = (const bf16_t*)(p.ws + OFF_YF);
    const bf16_t* yb = (const bf16_t*)(p.ws + OFF_YB);
    const bf16_t* B = wts(p, layer) + WGLU + (size_t)tn * 128 * 512;
    const int seq = (tm * 128) >> 11, t0 = (tm * 128) & 2047;
    const int ach = tid & 63, aseg0 = tid >> 6;
    const bf16_t* fg = yf + ((size_t)seq * 512 + ach) * SL + t0;
    const bf16_t* bg2 = yb + ((size_t)seq * 512 + ach) * SL + t0;
    const int srow = tid >> 3, scol = tid & 7;
    const bf16_t* bg = B + (size_t)srow * 512 + scol * 8;
    const int soff = srow * ROWB + ((scol ^ ((srow >> 1) & 7)) << 4);
    u32x4 rf[4], rbk[4], rb[4];
    f32x4 acc[4][4]; zero_acc(acc);
    const int aoff = (wr * 64 + (lane & 15)) * ROWB;
    const int boff = GT_BYTES + (wc * 64 + (lane & 15)) * ROWB;
    const int sw = ((lane >> 4) ^ ((lane & 15) >> 1)) << 4;
    for (int kt = 0; kt < 8; ++kt) {
#pragma unroll
        for (int j = 0; j < 4; ++j) {
            rf[j] = *(const u32x4*)(fg + (size_t)kt * 64 * SL + (aseg0 + 4 * j) * 8);
            rbk[j] = *(const u32x4*)(bg2 + (size_t)kt * 64 * SL + (aseg0 + 4 * j) * 8);
            rb[j] = *(const u32x4*)(bg + (size_t)(32 * j) * 512 + kt * 64);
        }
#pragma unroll
        for (int j = 0; j < 4; ++j) {
            *(u32x4*)(lds + GT_BYTES + soff + 32 * j * ROWB) = rb[j];
            char* abase = lds + (aseg0 + 4 * j) * 8 * ROWB + (ach & 7) * 2;
#pragma unroll
            for (int e = 0; e < 4; ++e) {
                const float v0 = gelu_tanh(bflo(rf[j][e]) + bflo(rbk[j][e])), v1 = gelu_tanh(bfhi(rf[j][e]) + bfhi(rbk[j][e]));
                const unsigned pw = pk2(v0, v1);
                const int cs = (((ach >> 3) ^ ((4 * aseg0 + e) & 7)) << 4);
                *(bf16_t*)(abase + (2 * e) * ROWB + cs) = (bf16_t)(pw & 0xffffu);
                *(bf16_t*)(abase + (2 * e + 1) * ROWB + cs) = (bf16_t)(pw >> 16);
            }
        }
        __syncthreads();
        gemm_compute<false, 0>(lds, aoff, boff, sw, acc);
        __syncthreads();
    }
    bf16_t* ob = (bf16_t*)(p.ws + OFF_O) + (size_t)1 * TG * 512;
    const float* bgl = p.in[I_SBGLU] + layer * 512;
#pragma unroll
    for (int n = 0; n < 4; ++n) {
        const int ch = tn * 128 + wc * 64 + n * 16 + r16;
        const float bias = bgl[ch];
#pragma unroll
        for (int m = 0; m < 4; ++m) {
            const int tl = wr * 64 + m * 16 + q4 * 4;
            const u32x2 fw = *(const u32x2*)(yf + ((size_t)seq * 512 + ch) * SL + t0 + tl);
            const u32x2 bw = *(const u32x2*)(yb + ((size_t)seq * 512 + ch) * SL + t0 + tl);
            const float y0 = gelu_tanh(bflo(fw[0]) + bflo(bw[0])), y1 = gelu_tanh(bfhi(fw[0]) + bfhi(bw[0]));
            const float y2 = gelu_tanh(bflo(fw[1]) + bflo(bw[1])), y3 = gelu_tanh(bfhi(fw[1]) + bfhi(bw[1]));
            const unsigned w01 = pk2(y0 * sigmoidf_(acc[m][n][0] + bias), y1 * sigmoidf_(acc[m][n][1] + bias));
            const unsigned w23 = pk2(y2 * sigmoidf_(acc[m][n][2] + bias), y3 * sigmoidf_(acc[m][n][3] + bias));
            bf16_t* orow = ob + (size_t)(tm * 128 + tl) * 512 + ch;
            orow[0] = (bf16_t)(w01 & 0xffffu); orow[512] = (bf16_t)(w01 >> 16); orow[1024] = (bf16_t)(w23 & 0xffffu); orow[1536] = (bf16_t)(w23 >> 16);
        }
    }
}

DI void phase_glu(const Params& p, int layer, char* lds) {
    const int lane = tidx() & 63, w = tidx() >> 6;
    { TileIter it; ti_init(it, TG / 128, 4, 16, 4); int tm, tn; while (ti_next(it, tm, tn)) glu_tile(p, layer, tm, tn, lds); }
    const float lam = ((const float*)(p.ws + OFF_LAM))[layer], li = ((const float*)(p.ws + OFF_LAM))[4 + layer];
    const bf16_t* d0 = (const bf16_t*)(p.ws + OFF_DT); const bf16_t* d1 = d0 + (size_t)TG * 512;
    bf16_t* oc = (bf16_t*)(p.ws + OFF_O) + (size_t)2 * TG * 512;
    const f32x2 sg = *(const f32x2*)(p.in[I_DSUB] + layer * 128 + 2 * lane);
    const int gw = bidx() * 4 + w, nw = gdim() * 4;
    for (int it0 = gw; it0 < TG * 4; it0 += 8 * nw) {
        unsigned a[8], b[8];
#pragma unroll
        for (int j = 0; j < 8; ++j) {
            const int it = it0 + j * nw;
            const size_t off = (size_t)(it < TG * 4 ? it : gw) * 128 + 2 * lane;
            a[j] = *(const unsigned*)(d0 + off); b[j] = *(const unsigned*)(d1 + off);
        }
#pragma unroll
        for (int j = 0; j < 8; ++j) {
            const int it = it0 + j * nw;
            const float v0 = bflo(a[j]) - lam * bflo(b[j]), v1 = bfhi(a[j]) - lam * bfhi(b[j]);
            const float ss = wave_sum(v0 * v0 + v1 * v1);
            const float rs = rsqrtf(ss * (1.0f / 128.0f) + EPS) * (1.0f - li);
            if (it < TG * 4) *(unsigned*)(oc + (size_t)it * 128 + 2 * lane) = pk2(v0 * rs * sg[0], v1 * rs * sg[1]);
        }
    }
}

DI void phase_merge(const Params& p, int layer, char* lds) {
    const int lane = tidx() & 63, w = tidx() >> 6, wr = w >> 1, wc = w & 1, r16 = lane & 15, q4 = lane >> 4;
    const bf16_t* ob = (const bf16_t*)(p.ws + OFF_O);
    const bf16_t* gb = (const bf16_t*)(p.ws + OFF_GATE);
    const bf16_t* W = wts(p, layer) + WB;
    bf16_t* mb = (bf16_t*)(p.ws + OFF_M);
    TileIter it; ti_init(it, TG / 128, 8, 8, 8);
    int tm, tn;
    while (ti_next(it, tm, tn)) {
        f32x4 macc[4][4]; zero_acc(macc);
#pragma unroll 1
        for (int b = 0; b < 4; ++b) {
            f32x4 acc[4][4]; zero_acc(acc);
            gemm128<true, 0, false>(ob + ((size_t)b * TG + tm * 128) * 512, 512, W + ((size_t)b * 1024 + tn * 128) * 512, 512, 512, acc, lds);
#pragma unroll
            for (int m = 0; m < 4; ++m) {
                const int row = tm * 128 + wr * 64 + m * 16 + r16;
#pragma unroll
                for (int n = 0; n < 4; ++n) {
                    const int col = tn * 128 + wc * 64 + n * 16 + q4 * 4;
                    const u32x2 gw = *(const u32x2*)(gb + (size_t)row * 4096 + b * 1024 + col);
                    macc[m][n][0] += acc[m][n][0] * bflo(gw[0]); macc[m][n][1] += acc[m][n][1] * bfhi(gw[0]);
                    macc[m][n][2] += acc[m][n][2] * bflo(gw[1]); macc[m][n][3] += acc[m][n][3] * bfhi(gw[1]);
                }
            }
        }
#pragma unroll
        for (int m = 0; m < 4; ++m) {
            const int row = tm * 128 + wr * 64 + m * 16 + r16;
#pragma unroll
            for (int n = 0; n < 4; ++n) {
                const int col = tn * 128 + wc * 64 + n * 16 + q4 * 4;
                otile_put(lds, wr * 64 + m * 16 + r16, wc * 64 + n * 16 + q4 * 4, pk2(macc[m][n][0], macc[m][n][1]), pk2(macc[m][n][2], macc[m][n][3]));
            }
        }
        otile_flush(lds, mb + (size_t)(tm * 128) * DM + tn * 128, DM);
    }
}

DI void phase_resid(const Params& p, int grp, const bf16_t* A, int K, const bf16_t* Wt, bool first, char* lds) {
    const int lane = tidx() & 63, w = tidx() >> 6, wr = w >> 1, wc = w & 1, r16 = lane & 15, q4 = lane >> 4;
    TileIter it; ti_init(it, TG / 128, 8, 8, 8);
    int tm, tn, ntm = 0, ntn = 0;
    bool have = ti_next(it, tm, tn);
    GemmRegs g;
    if (have) gemm_prime(A + (size_t)tm * 128 * K, K, Wt + (size_t)tn * 128 * K, K, g);
    for (; have; tm = ntm, tn = ntn) {
        have = ti_next(it, ntm, ntn);
        const bf16_t* At = A + (size_t)tm * 128 * K; const bf16_t* Bt = Wt + (size_t)tn * 128 * K;
        const bf16_t* nAt = have ? A + (size_t)ntm * 128 * K : At; const bf16_t* nBt = have ? Wt + (size_t)ntn * 128 * K : Bt;
        f32x4 acc[4][4]; zero_acc(acc);
        gemm_stream<true>(At, Bt, nAt, nBt, K, K, K, g, acc, lds);
#pragma unroll
        for (int m = 0; m < 4; ++m)
#pragma unroll
            for (int n = 0; n < 4; ++n) *(f32x4*)(lds + (wr * 64 + m * 16 + r16) * OROWF + (wc * 64 + n * 16 + q4 * 4) * 4) = acc[m][n];
        __syncthreads();
        {
            const int tid = tidx();
#pragma unroll 4
            for (int i = 0; i < 16; ++i) {
                const int c = tid + 256 * i, rl = c >> 5, ch = c & 31, row = tm * 128 + rl;
                float* xo = p.out + ((size_t)grp * TG + row) * DM + tn * 128 + ch * 4;
                const float* xi = first ? x_in_row(p, grp, row) + tn * 128 + ch * 4 : xo;
                const f32x4 a = *(const f32x4*)(lds + rl * OROWF + ch * 16);
                const f32x4 xv = *(const f32x4*)xi;
                *(f32x4*)xo = xv + a;
            }
        }
        __syncthreads();
    }
}

DI void phase_ffn1(const Params& p, int layer, char* lds) {
    const int lane = tidx() & 63, w = tidx() >> 6, wr = w >> 1, wc = w & 1, r16 = lane & 15, q4 = lane >> 4;
    const bf16_t* hb = (const bf16_t*)(p.ws + OFF_H);
    const bf16_t* W = wts(p, layer) + WFI;
    bf16_t* fb = (bf16_t*)(p.ws + OFF_F);
    constexpr int NT = DFF / 64;
    TileIter it; ti_init(it, TG / 128, NT, 8, 4);
    int tm, tn, ntm = 0, ntn = 0;
    bool have = ti_next(it, tm, tn);
    GemmRegs g;
    if (have) gemm_prime(hb + (size_t)tm * 128 * DM, DM, W + (size_t)tn * 128 * DM, DM, g);
    for (; have; tm = ntm, tn = ntn) {
        have = ti_next(it, ntm, ntn);
        const bf16_t* At = hb + (size_t)tm * 128 * DM; const bf16_t* Bt = W + (size_t)tn * 128 * DM;
        const bf16_t* nAt = have ? hb + (size_t)ntm * 128 * DM : At; const bf16_t* nBt = have ? W + (size_t)ntn * 128 * DM : Bt;
        f32x4 acc[4][4]; zero_acc(acc);
        gemm_stream<true, 1>(At, Bt, nAt, nBt, DM, DM, DM, g, acc, lds);
#pragma unroll
        for (int m = 0; m < 4; ++m) {
            const int row = tm * 128 + wr * 64 + m * 16 + r16;
#pragma unroll
            for (int n = 0; n < 2; ++n) {
                const int col = tn * 64 + wc * 32 + n * 16 + q4 * 4;
                float f[4];
#pragma unroll
                for (int i = 0; i < 4; ++i) { const float gq = acc[m][n][i]; f[i] = gq * sigmoidf_(gq) * acc[m][n + 2][i]; }
                otile_put(lds, wr * 64 + m * 16 + r16, wc * 32 + n * 16 + q4 * 4, pk2(f[0], f[1]), pk2(f[2], f[3]));
            }
        }
        {
            const int tid = tidx();
            __syncthreads();
#pragma unroll
            for (int i = 0; i < 4; ++i) {
                const int c = tid + 256 * i, row = c >> 3, ch = c & 7;
                const u32x4 v = *(const u32x4*)(lds + row * OROW + ch * 16);
                *(u32x4*)(fb + (size_t)(tm * 128 + row) * DFF + tn * 64 + ch * 8) = v;
            }
            __syncthreads();
        }
    }
}

#define XB_TMO      128
#define XB_XCNT(j)  (256  + 64 * (j))
#define XB_XSUB(j)  (1280 + 64 * (j))
#define XB_XGEN(j)  (2304 + 64 * (j))
#define XB_TOP      3328
#define XB_TOPGEN   3392
#define XCD_BAR_WORDS 3456
#define XB_SPIN_CAP (1u << 18)
#define LAS __attribute__((address_space(3)))

__device__ __forceinline__ unsigned xb_ld(unsigned* p)              { return __hip_atomic_load(p, __ATOMIC_RELAXED, __HIP_MEMORY_SCOPE_AGENT); }
__device__ __forceinline__ unsigned xb_add(unsigned* p, unsigned v) { return __hip_atomic_fetch_add(p, v, __ATOMIC_RELAXED, __HIP_MEMORY_SCOPE_AGENT); }
__device__ __forceinline__ unsigned xb_xcc_id() { return (unsigned)__builtin_amdgcn_s_getreg((3 << 11) | 20) & 0xFu; }
#define XB_SPIN(cond, bar) do { unsigned _sp = 0; while (cond) { __builtin_amdgcn_s_sleep(1); \
    if ((++_sp & 255u) == 0u) { if (xb_ld(&(bar)[XB_TMO])) break; if (_sp > XB_SPIN_CAP) { atomicAdd(&(bar)[XB_TMO], 1u); break; } } } } while (0)

struct XcdBarrier {
    unsigned* bar; unsigned x;
    volatile LAS unsigned* st;
};

__device__ __forceinline__ XcdBarrier xcd_barrier_post(unsigned* bar, volatile LAS unsigned* st) {
    XcdBarrier b; b.bar = bar; b.x = xb_xcc_id(); b.st = st;
    if (threadIdx.x == 0) (void)xb_add(&bar[XB_XCNT(b.x)], 1u);
    return b;
}
__device__ __forceinline__ void xcd_barrier_complete(unsigned* bar, unsigned x, unsigned& nloc, unsigned& nx) {
    const unsigned G = gdim() * gridDim.y * gridDim.z;
    unsigned sum, cnt, mine, sp = 0u;
    for (;;) {
        sum = 0u; cnt = 0u; mine = 0u;
#pragma unroll
        for (unsigned j = 0; j < 16; ++j) { const unsigned c = xb_ld(&bar[XB_XCNT(j)]); sum += c; cnt += (c > 0u) ? 1u : 0u; mine = (j == x) ? c : mine; }
        if (sum == G) break;
        __builtin_amdgcn_s_sleep(1);
        if ((++sp & 255u) == 0u) { if (xb_ld(&bar[XB_TMO])) break; if (sp > XB_SPIN_CAP) { atomicAdd(&bar[XB_TMO], 1u); break; } }
    }
    nloc = mine > 0u ? mine : 1u; nx = cnt > 0u ? cnt : 1u;
}

__device__ __forceinline__ void xcd_barrier(const XcdBarrier& b) {
    asm volatile("s_waitcnt vmcnt(0)" ::: "memory");
    __syncthreads();
    if (threadIdx.x == 0) {
        unsigned* bar = b.bar;
        __builtin_amdgcn_s_waitcnt(0);
        unsigned nloc = b.st[0], nx = b.st[1];
        if (nloc == 0u) { xcd_barrier_complete(bar, b.x, nloc, nx); b.st[0] = nloc; b.st[1] = nx; }
        const unsigned old = xb_add(&bar[XB_XSUB(b.x)], 1u);
        const unsigned gen = old / nloc;
        if (old + 1u == (gen + 1u) * nloc) {
            __builtin_amdgcn_fence(__ATOMIC_RELEASE, "agent");
            asm volatile("s_waitcnt vmcnt(0)" ::: "memory");
            const unsigned og = xb_add(&bar[XB_TOP], 1u);
            const unsigned tg = og / nx;
            if (og + 1u == (tg + 1u) * nx) xb_add(&bar[XB_TOPGEN], 1u);
            else XB_SPIN(xb_ld(&bar[XB_TOPGEN]) == tg, bar);
            __builtin_amdgcn_fence(__ATOMIC_ACQUIRE, "agent");
            xb_add(&bar[XB_XGEN(b.x)], 1u);
            asm volatile("s_waitcnt vmcnt(0)" ::: "memory");
        } else {
            XB_SPIN(xb_ld(&bar[XB_XGEN(b.x)]) == gen, bar);
            __builtin_amdgcn_fence(__ATOMIC_ACQUIRE, "agent");
            asm volatile("s_waitcnt vmcnt(0)" ::: "memory");
        }
    }
    __syncthreads();
}


constexpr int PH_PER_GRP = 4 * 9 + 1;
constexpr int NPHASE = 1 + NGRP * PH_PER_GRP;

#ifndef PROBE_K
#define PROBE_K (-1)
#endif
DI void run_phase(const Params& p, int ph, char* lds, int rep = 0) {
    if (ph == 0) { phase_prologue(p, lds); return; }
    const int q = ph - 1, grp = q / PH_PER_GRP, r = q % PH_PER_GRP;
    if (r == 36) { phase_norm(p, grp, p.in[I_NFIN], 2); return; }
    const int layer = r / 9, k = r % 9;
    switch (k) {
        case 0: phase_norm(p, grp, p.in[I_NMIX] + layer * DM, layer == 0 ? 0 : 1); break;
        case 1: phase_in(p, layer, lds, rep == 1); break;
        case 2: phase_mix(p, layer, grp * 4 + layer + 20 * rep, lds, rep == 1); break;
        case 3: phase_glu(p, layer, lds); break;
        case 4: phase_merge(p, layer, lds); break;
        case 5: phase_resid(p, grp, (const bf16_t*)(p.ws + OFF_M), DM, wts(p, layer) + WO, layer == 0, lds); break;
        case 6: phase_norm(p, grp, p.in[I_NFFN] + layer * DM, 1); break;
        case 7: phase_ffn1(p, layer, lds); break;
        default: phase_resid(p, grp, (const bf16_t*)(p.ws + OFF_F), DFF, wts(p, layer) + WFO, false, lds); break;
    }
}

__global__ void __launch_bounds__(256, 2) mega(Params p, int only) {
    __shared__ __attribute__((aligned(16))) char lds[LDS_BYTES];
#if MULTI_LAUNCH
    if (only >= 0) { run_phase(p, only, lds); return; }
#endif
    cg::grid_group grid = cg::this_grid();
    __shared__ uint4 xb_words;
    if (threadIdx.x == 0) xb_words = make_uint4(0u, 0u, 0u, 0u);
    __syncthreads();
    XcdBarrier xb = xcd_barrier_post((unsigned*)(p.ws + OFF_BAR), (volatile LAS unsigned*)&xb_words);
    for (int ph = 0; ph < NPHASE; ++ph) {
        run_phase(p, ph, lds);
        if (ph + 1 < NPHASE) { if (ph == 0) grid.sync(); else xcd_barrier(xb); }
        if (PROBE_K == 100) xcd_barrier(xb);
        if (PROBE_K >= 0 && PROBE_K < 9 && ph > 0 && ((ph - 1) % PH_PER_GRP) < 36 && (((ph - 1) % PH_PER_GRP) % 9) == PROBE_K) { run_phase(p, ph, lds, 1); xcd_barrier(xb); }
    }
}

extern "C" void kernel_launch(void* const* d_in, const int* in_sizes, int n_in, void* d_out, int out_size, void* d_ws, size_t ws_size, hipStream_t stream) {
    (void)in_sizes; (void)n_in; (void)out_size;
    static int grid_blocks = 0;
    if (!grid_blocks) {
        int dev = 0, cus = 0, per_cu = 0;
        hipGetDevice(&dev);
        hipDeviceGetAttribute(&cus, hipDeviceAttributeMultiprocessorCount, dev);
        hipOccupancyMaxActiveBlocksPerMultiprocessor(&per_cu, mega, 256, 0);
        if (per_cu < 1) per_cu = 1;
        if (per_cu > 2) per_cu = 2;
        grid_blocks = cus * per_cu;
    }
    if (ws_size < WS_END) { fprintf(stderr, "workspace too small: %zu < %zu\n", ws_size, (size_t)WS_END); return; }
    Params p{};
    for (int i = 0; i < 26; ++i) p.in[i] = (const float*)d_in[i];
    p.out = (float*)d_out; p.ws = (char*)d_ws;
    hipMemsetAsync((char*)d_ws + OFF_BAR, 0, XCD_BAR_WORDS * sizeof(unsigned), stream);
#if MULTI_LAUNCH
    for (int ph = 0; ph < NPHASE; ++ph) mega<<<dim3(grid_blocks), dim3(256), 0, stream>>>(p, ph);
#else
    int only = -1;
    void* args[] = {&p, &only};
    hipError_t e = hipLaunchCooperativeKernel((void*)mega, dim3(grid_blocks), dim3(256), args, 0, stream);
    if (e != hipSuccess) fprintf(stderr, "cooperative launch failed: %s (grid %d)\n", hipGetErrorString(e), grid_blocks);
#endif
}
```

```cpp
#include <hip/hip_runtime.h>
#include <hip/hip_cooperative_groups.h>
#include <cstdio>
#include <cstdint>
namespace cg = cooperative_groups;

#ifndef MULTI_LAUNCH
#define MULTI_LAUNCH 0
#endif

#define DI __device__ __forceinline__
typedef unsigned short bf16_t;
typedef __bf16 bf16v2 __attribute__((ext_vector_type(2)));
typedef float f32x2 __attribute__((ext_vector_type(2)));
typedef short bf16x8 __attribute__((ext_vector_type(8)));
typedef short s16x4 __attribute__((ext_vector_type(4)));
typedef float f32x4 __attribute__((ext_vector_type(4)));
typedef float f32x16 __attribute__((ext_vector_type(16)));
typedef unsigned u32x4 __attribute__((ext_vector_type(4)));
typedef unsigned u32x2 __attribute__((ext_vector_type(2)));

constexpr int DM = 1024, SL = 2048, NSEQ = 40, G = 8, NGRP = NSEQ / G, TG = G * SL;
constexpr int INW = 4352, NIN = INW + 4096, DFF = 2816;
constexpr float EPS = 1e-6f;
constexpr float LOG2E = 1.4426950408889634f;

constexpr size_t WING = 0;
constexpr size_t WB = 8650752;
constexpr size_t WO = WB + 2097152;
constexpr size_t WFI = WO + 1048576;
constexpr size_t WFO = WFI + 5767168;
constexpr size_t WGLU = WFO + 2883584;
constexpr size_t LW = WGLU + 262144;

constexpr size_t OFF_W = 0;
constexpr size_t OFF_TAB = OFF_W + 4 * LW * 2;
constexpr size_t OFF_COSA = OFF_TAB, OFF_SINA = OFF_TAB + 262144, OFF_COSD = OFF_TAB + 2 * 262144, OFF_SIND = OFF_TAB + 3 * 262144;
constexpr size_t OFF_BIAS = OFF_TAB + 1048576;
constexpr size_t OFF_LAM = OFF_BIAS + 65536;
constexpr size_t OFF_QCNT = OFF_LAM + 256;
constexpr size_t OFF_BAR = OFF_TAB + 1048576 + 131072;
constexpr size_t OFF_H = OFF_TAB + 2097152;
constexpr size_t OFF_U = OFF_H + (size_t)TG * 1024 * 2;
constexpr size_t OFF_GATE = OFF_U + (size_t)TG * INW * 2;
constexpr size_t OFF_VTA = OFF_GATE + (size_t)TG * 4096 * 2;
constexpr size_t OFF_VTC = OFF_VTA + (size_t)TG * 128 * 2;
constexpr size_t OFF_VTD = OFF_VTC + (size_t)TG * 512 * 2;
constexpr size_t OFF_O = OFF_VTD + (size_t)TG * 512 * 2;
constexpr size_t OFF_YF = OFF_O + (size_t)4 * TG * 512 * 2;
constexpr size_t OFF_YB = OFF_YF + (size_t)TG * 512 * 2;
constexpr size_t OFF_DT = OFF_YB + (size_t)TG * 512 * 2;
constexpr size_t WS_END = OFF_DT + (size_t)2 * TG * 512 * 2;
constexpr size_t OFF_M = OFF_U;
constexpr size_t OFF_F = OFF_U;

struct Params { const float* in[26]; float* out; char* ws; };

enum { I_XP = 0, I_XS, I_NMIX, I_WIN, I_QG, I_KG, I_SARE, I_SAIM, I_SLDT, I_SBRE, I_SBIM, I_SCRE, I_SCIM, I_SD, I_SWGLU, I_SBGLU,
       I_DLAM, I_DSUB, I_REL, I_WGATE, I_WBR, I_WOUT, I_NFFN, I_WFI, I_WFO, I_NFIN };

constexpr int LDS_BYTES = 71680;
constexpr int AROWB = 144;
constexpr int ROWB = 128;
constexpr int GT_BYTES = 128 * ROWB;

DI int bidx() { int b = blockIdx.x; asm volatile("" : "+s"(b)); return b; }
DI int gdim() { int g = gridDim.x; asm volatile("" : "+s"(g)); return g; }
DI int tidx() { int t = threadIdx.x; asm volatile("" : "+v"(t)); return t; }
DI unsigned pk2(float a, float b) { f32x2 v = {a, b}; bf16v2 r = __builtin_convertvector(v, bf16v2); return __builtin_bit_cast(unsigned, r); }
DI float bf2f(bf16_t v) { return __uint_as_float(((unsigned)v) << 16); }
DI float bflo(unsigned w) { return __uint_as_float(w << 16); }
DI float bfhi(unsigned w) { return __uint_as_float(w & 0xffff0000u); }
DI float sigmoidf_(float x) { return __builtin_amdgcn_rcpf(1.0f + __builtin_amdgcn_exp2f(-LOG2E * x)); }
DI float wave_sum(float v) { v += __shfl_xor(v, 32); v += __shfl_xor(v, 16); v += __shfl_xor(v, 8); v += __shfl_xor(v, 4); v += __shfl_xor(v, 2); v += __shfl_xor(v, 1); return v; }
DI bf16_t* wts(const Params& p, int layer) { return (bf16_t*)(p.ws + OFF_W) + (size_t)layer * LW; }
#define MFMA16(a, b, c) __builtin_amdgcn_mfma_f32_16x16x32_bf16((a), (b), (c), 0, 0, 0)
#define MFMA32(a, b, c) __builtin_amdgcn_mfma_f32_32x32x16_bf16((a), (b), (c), 0, 0, 0)

template <bool SWAP, int BMAP>
DI void gemm_compute(const char* cur, int aoff, int boff, int sw, f32x4 (&acc)[4][4]) {
#pragma unroll
    for (int ks = 0; ks < 2; ++ks) {
        bf16x8 af[4], bfr[4];
        const int so = sw ^ (ks * 64);
#pragma unroll
        for (int m = 0; m < 4; ++m) af[m] = *(const bf16x8*)(cur + aoff + m * 16 * ROWB + so);
#pragma unroll
        for (int n = 0; n < 4; ++n) bfr[n] = *(const bf16x8*)(cur + boff + (BMAP ? ((n >> 1) * 64 + (n & 1) * 16) : n * 16) * ROWB + so);
#pragma unroll
        for (int m = 0; m < 4; ++m)
#pragma unroll
            for (int n = 0; n < 4; ++n) acc[m][n] = SWAP ? MFMA16(bfr[n], af[m], acc[m][n]) : MFMA16(af[m], bfr[n], acc[m][n]);
    }
}
#define GLOAD(RA, RB, KT) { _Pragma("unroll") for (int i_ = 0; i_ < 4; ++i_) { \
    const char* ua_ = Ab + (size_t)(((32 * i_) * lda + (KT) * 64) * 2); const char* ub_ = Bb + (size_t)(((32 * i_) * ldb + (KT) * 64) * 2); \
    RA[i_] = *(const u32x4*)(ua_ + avoff); RB[i_] = *(const u32x4*)(ub_ + bvoff); } }
#define LSTORE(RA, RB, ST) { _Pragma("unroll") for (int i_ = 0; i_ < 4; ++i_) { *(u32x4*)(lds + (ST) * (2 * GT_BYTES) + soff + 32 * i_ * ROWB) = RA[i_]; *(u32x4*)(lds + (ST) * (2 * GT_BYTES) + GT_BYTES + soff + 32 * i_ * ROWB) = RB[i_]; } }
template <bool SWAP, int BMAP = 0, bool DEEP = true>
DI void gemm128(const bf16_t* __restrict__ A, int lda, const bf16_t* __restrict__ B, int ldb, int K, f32x4 (&acc)[4][4], char* lds) {
    const int tid = tidx(), lane = tid & 63, w = tid >> 6, wr = w >> 1, wc = w & 1;
    const int srow = tid >> 3, scol = tid & 7;
    const char* Ab = (const char*)A; const char* Bb = (const char*)B;
    const unsigned avoff = (unsigned)(srow * lda + scol * 8) * 2u, bvoff = (unsigned)(srow * ldb + scol * 8) * 2u;
    const int soff = srow * ROWB + ((scol ^ ((srow >> 1) & 7)) << 4);
    const int nk = K >> 6;
    const int aoff = (wr * 64 + (lane & 15)) * ROWB;
    const int boff = GT_BYTES + ((BMAP ? wc * 32 : wc * 64) + (lane & 15)) * ROWB;
    const int sw = ((lane >> 4) ^ ((lane & 15) >> 1)) << 4;
    u32x4 ra0[4], rb0[4];
    GLOAD(ra0, rb0, 0);
    LSTORE(ra0, rb0, 0);
    if (DEEP) {
        u32x4 ra1[4], rb1[4];
        GLOAD(ra1, rb1, 1);
        __syncthreads();
        for (int kt = 0; kt < nk; kt += 2) {
            { const int k2 = kt + 2 < nk ? kt + 2 : nk - 1; GLOAD(ra0, rb0, k2); }
            gemm_compute<SWAP, BMAP>(lds, aoff, boff, sw, acc);
            LSTORE(ra1, rb1, 1);
            __syncthreads();
            { const int k3 = kt + 3 < nk ? kt + 3 : nk - 1; GLOAD(ra1, rb1, k3); }
            gemm_compute<SWAP, BMAP>(lds + 2 * GT_BYTES, aoff, boff, sw, acc);
            LSTORE(ra0, rb0, 0);
            __syncthreads();
        }
    } else {
        __syncthreads();
        for (int kt = 0; kt < nk; ++kt) {
            const bool more = (kt + 1 < nk);
            if (more) GLOAD(ra0, rb0, kt + 1);
            gemm_compute<SWAP, BMAP>(lds + (kt & 1) * (2 * GT_BYTES), aoff, boff, sw, acc);
            if (more) { if (kt & 1) { LSTORE(ra0, rb0, 0); } else { LSTORE(ra0, rb0, 1); } }
            __syncthreads();
        }
    }
}

struct GemmR { u32x4 a[4], b[4]; };
DI void prime_k0(const bf16_t* A, int lda, const bf16_t* B, int ldb, GemmR& g) {
    const int tid = tidx(), srow = tid >> 3, scol = tid & 7;
    const char* Ab = (const char*)A; const char* Bb = (const char*)B;
    const unsigned avoff = (unsigned)(srow * lda + scol * 8) * 2u, bvoff = (unsigned)(srow * ldb + scol * 8) * 2u;
    GLOAD(g.a, g.b, 0);
}
template <bool SWAP, int BMAP = 0>
DI void gemm128pre(const bf16_t* __restrict__ A, int lda, const bf16_t* __restrict__ B, int ldb, int K, GemmR& pre, f32x4 (&acc)[4][4], char* lds) {
    const int tid = tidx(), lane = tid & 63, w = tid >> 6, wr = w >> 1, wc = w & 1;
    const int srow = tid >> 3, scol = tid & 7;
    const char* Ab = (const char*)A; const char* Bb = (const char*)B;
    const unsigned avoff = (unsigned)(srow * lda + scol * 8) * 2u, bvoff = (unsigned)(srow * ldb + scol * 8) * 2u;
    const int soff = srow * ROWB + ((scol ^ ((srow >> 1) & 7)) << 4);
    const int nk = K >> 6;
    const int aoff = (wr * 64 + (lane & 15)) * ROWB;
    const int boff = GT_BYTES + ((BMAP ? wc * 32 : wc * 64) + (lane & 15)) * ROWB;
    const int sw = ((lane >> 4) ^ ((lane & 15) >> 1)) << 4;
    u32x4 ra1[4], rb1[4];
    LSTORE(pre.a, pre.b, 0);
    GLOAD(ra1, rb1, 1);
    __syncthreads();
    for (int kt = 0; kt < nk; kt += 2) {
        { const int k2 = kt + 2 < nk ? kt + 2 : nk - 1; GLOAD(pre.a, pre.b, k2); }
        gemm_compute<SWAP, BMAP>(lds, aoff, boff, sw, acc);
        LSTORE(ra1, rb1, 1);
        __syncthreads();
        { const int k3 = kt + 3 < nk ? kt + 3 : nk - 1; GLOAD(ra1, rb1, k3); }
        gemm_compute<SWAP, BMAP>(lds + 2 * GT_BYTES, aoff, boff, sw, acc);
        LSTORE(pre.a, pre.b, 0);
        __syncthreads();
    }
}

struct TileIter { int per, SM, SN, nSn, sbase, len, q, nslot; };
DI void ti_init(TileIter& it, int NTm, int NTn, int SM, int SN) {
    const int x = bidx() & 7;
    it.nslot = (gdim() - x + 7) >> 3; it.per = SM * SN; it.SM = SM; it.SN = SN; it.nSn = NTn / SN;
    const int nS = (NTm / SM) * it.nSn;
    it.sbase = x * (nS >> 3); it.len = (nS >> 3) * it.per; it.q = bidx() >> 3;
}
DI bool ti_next(TileIter& it, int& tm, int& tn) {
    if (it.q >= it.len) return false;
    const int j = it.q / it.per, w = it.q % it.per, S = it.sbase + j, sm = S / it.nSn, sn = S % it.nSn;
    tm = sm * it.SM + (w % it.SM); tn = sn * it.SN + (w / it.SM);
    it.q += it.nslot;
    return true;
}

struct GemmRegs { u32x4 a0[4], b0[4], a1[4], b1[4]; };
typedef const __attribute__((address_space(1))) char* gptr_t;
typedef const __attribute__((address_space(1))) u32x4* gvec_t;
DI gptr_t uptr(const void* q) {
    const size_t v = (size_t)q;
    const unsigned lo = __builtin_amdgcn_readfirstlane((unsigned)v), hi = __builtin_amdgcn_readfirstlane((unsigned)(v >> 32));
    return (gptr_t)(((size_t)hi << 32) | lo);
}
#define GLOADP(RA, RB, PA, PB, KT) { _Pragma("unroll") for (int i_ = 0; i_ < 4; ++i_) { \
    gptr_t ua_ = (PA) + (size_t)(((32 * i_) * lda + (KT) * 64) * 2); gptr_t ub_ = (PB) + (size_t)(((32 * i_) * ldb + (KT) * 64) * 2); \
    RA[i_] = *(gvec_t)(ua_ + avoff); RB[i_] = *(gvec_t)(ub_ + bvoff); } }
DI void gemm_prime(const bf16_t* A, int lda, const bf16_t* B, int ldb, GemmRegs& g) {
    const int tid = tidx(), srow = tid >> 3, scol = tid & 7;
    const unsigned avoff = (unsigned)(srow * lda + scol * 8) * 2u, bvoff = (unsigned)(srow * ldb + scol * 8) * 2u;
    gptr_t Ab = uptr(A); gptr_t Bb = uptr(B);
    GLOADP(g.a0, g.b0, Ab, Bb, 0);
    GLOADP(g.a1, g.b1, Ab, Bb, 1);
}
template <bool SWAP, int BMAP = 0>
DI void gemm_stream(const bf16_t* A, const bf16_t* B, const bf16_t* nA, const bf16_t* nB, int lda, int ldb, int K, GemmRegs& g, f32x4 (&acc)[4][4], char* lds) {
    const int tid = tidx(), lane = tid & 63, w = tid >> 6, wr = w >> 1, wc = w & 1;
    const int srow = tid >> 3, scol = tid & 7;
    const unsigned avoff = (unsigned)(srow * lda + scol * 8) * 2u, bvoff = (unsigned)(srow * ldb + scol * 8) * 2u;
    gptr_t Ab = uptr(A); gptr_t Bb = uptr(B); gptr_t nAb = uptr(nA); gptr_t nBb = uptr(nB);
    const int soff = srow * ROWB + ((scol ^ ((srow >> 1) & 7)) << 4);
    const int nk = K >> 6;
    const int aoff = (wr * 64 + (lane & 15)) * ROWB;
    const int boff = GT_BYTES + ((BMAP ? wc * 32 : wc * 64) + (lane & 15)) * ROWB;
    const int sw = ((lane >> 4) ^ ((lane & 15) >> 1)) << 4;
    LSTORE(g.a0, g.b0, 0);
    __syncthreads();
    for (int kt = 0; kt < nk; kt += 2) {
        const bool last = kt + 2 >= nk;
        gptr_t pa = last ? nAb : Ab; gptr_t pb = last ? nBb : Bb;
        const int k2 = last ? 0 : kt + 2, k3 = last ? 1 : kt + 3;
        GLOADP(g.a0, g.b0, pa, pb, k2);
        gemm_compute<SWAP, BMAP>(lds, aoff, boff, sw, acc);
        LSTORE(g.a1, g.b1, 1);
        __syncthreads();
        GLOADP(g.a1, g.b1, pa, pb, k3);
        gemm_compute<SWAP, BMAP>(lds + 2 * GT_BYTES, aoff, boff, sw, acc);
        if (!last) LSTORE(g.a0, g.b0, 0);
        __syncthreads();
    }
}

DI void zero_acc(f32x4 (&acc)[4][4]) {
#pragma unroll
    for (int m = 0; m < 4; ++m)
#pragma unroll
        for (int n = 0; n < 4; ++n) acc[m][n] = (f32x4){0.f, 0.f, 0.f, 0.f};
}


constexpr int OROW = 272;
constexpr int OROWF = 528;
DI void otile_put(char* lds, int row, int col, unsigned w0, unsigned w1) { u32x2 w; w[0] = w0; w[1] = w1; *(u32x2*)(lds + row * OROW + col * 2) = w; }
DI void otile_flush(char* lds, bf16_t* dst, int ld) {
    const int tid = tidx();
    __syncthreads();
#pragma unroll
    for (int i = 0; i < 8; ++i) {
        const int c = tid + 256 * i, row = c >> 4, ch = c & 15;
        const u32x4 v = *(const u32x4*)(lds + row * OROW + ch * 16);
        *(u32x4*)(dst + (size_t)row * ld + ch * 8) = v;
    }
    __syncthreads();
}

DI void conv_tile(const float* __restrict__ src, bf16_t* __restrict__ dst, int K, int N, int tk, int tn, int drow0, float* tile) {
    const int tid = tidx(), ty = tid >> 4, tx = tid & 15;
#pragma unroll
    for (int i = 0; i < 4; ++i) {
        const int k = ty + 16 * i;
        const f32x4 v = *(const f32x4*)(src + (size_t)(tk * 64 + k) * N + tn * 64 + tx * 4);
        tile[k * 65 + tx * 4 + 0] = v[0]; tile[k * 65 + tx * 4 + 1] = v[1]; tile[k * 65 + tx * 4 + 2] = v[2]; tile[k * 65 + tx * 4 + 3] = v[3];
    }
    __syncthreads();
    const int n = tid >> 2, ks = (tid & 3) * 16;
    u32x4 w0, w1;
#pragma unroll
    for (int j = 0; j < 4; ++j) {
        w0[j] = pk2(tile[(ks + 2 * j) * 65 + n], tile[(ks + 2 * j + 1) * 65 + n]);
        w1[j] = pk2(tile[(ks + 8 + 2 * j) * 65 + n], tile[(ks + 8 + 2 * j + 1) * 65 + n]);
    }
    bf16_t* d = dst + (size_t)(drow0 + n) * K + tk * 64 + ks;
    *(u32x4*)d = w0; *(u32x4*)(d + 8) = w1;
    __syncthreads();
}

DI int t5_bucket(int rel) {
    const int base = rel > 0 ? 16 : 0;
    const int dist = rel < 0 ? -rel : rel;
    int b;
    if (dist < 8) b = dist;
    else {
        const float lr = logf((float)dist / 8.0f) / 2.772588722239781f;
        int lg = 8 + (int)(lr * 8.0f);
        b = lg < 15 ? lg : 15;
    }
    return base + b;
}

DI void phase_prologue(const Params& p, char* lds) {
    float* tile = (float*)lds;
    const int tid = tidx();
    for (int t = bidx(); t < 4 * 5056; t += gdim()) {
        const int layer = t / 5056; int q = t % 5056;
        bf16_t* wl = wts(p, layer);
        const float* src; bf16_t* dst; int K, N, nn;
        if (q < 1088) { src = p.in[I_WIN] + (size_t)layer * 1024 * INW; dst = wl + WING; K = 1024; N = INW; }
        else if ((q -= 1088) < 1024) { const int b = q >> 8; q &= 255; src = p.in[I_WGATE] + (size_t)(layer * 4 + b) * 1024 * 1024; dst = wl + WING + (size_t)(INW + b * 1024) * 1024; K = 1024; N = 1024; }
        else if ((q -= 1024) < 512) { const int b = q >> 7; q &= 127; src = p.in[I_WBR] + (size_t)(layer * 4 + b) * 512 * 1024; dst = wl + WB + (size_t)b * 1024 * 512; K = 512; N = 1024; }
        else if ((q -= 512) < 256) { src = p.in[I_WOUT] + (size_t)layer * 1024 * 1024; dst = wl + WO; K = 1024; N = 1024; }
        else if ((q -= 256) < 1408) { src = p.in[I_WFI] + (size_t)layer * 1024 * 5632; dst = wl + WFI; K = 1024; N = 5632; }
        else if ((q -= 1408) < 704) { src = p.in[I_WFO] + (size_t)layer * DFF * 1024; dst = wl + WFO; K = DFF; N = 1024; }
        else { q -= 704; src = p.in[I_SWGLU] + (size_t)layer * 512 * 512; dst = wl + WGLU; K = 512; N = 512; }
        nn = N >> 6;
        const int tk = q / nn, tn = q % nn;
        int drow0 = tn * 64;
        if (N == 5632) drow0 = tn < 44 ? tn * 128 : (tn - 44) * 128 + 64;
        conv_tile(src, dst, K, N, tk, tn, drow0, tile);
    }
    const int gt = bidx() * 256 + tid, gn = gdim() * 256;
    float* cosA = (float*)(p.ws + OFF_COSA); float* sinA = (float*)(p.ws + OFF_SINA);
    float* cosD = (float*)(p.ws + OFF_COSD); float* sinD = (float*)(p.ws + OFF_SIND);
    for (int i = gt; i < SL * 32; i += gn) {
        const int t = i >> 5, j = i & 31;
        const float invA = exp2f(-(float)(j & 15) * (13.287712379549449f / 16.0f));
        const float angA = (j < 16 ? (float)(t >> 6) : (float)(t & 63)) * invA;
        cosA[i] = cosf(angA); sinA[i] = sinf(angA);
        const float invD = exp2f(-(float)j * (13.287712379549449f / 32.0f));
        const float angD = (float)t * invD;
        cosD[i] = cosf(angD); sinD[i] = sinf(angD);
    }
    float* bias = (float*)(p.ws + OFF_BIAS);
    for (int i = gt; i < 4 * 4096; i += gn) {
        const int h = i >> 12, r = i & 4095;
        float v = 0.f;
        if (r < 4095) v = p.in[I_REL][t5_bucket(r - 2047) * 4 + h] * LOG2E;
        bias[i] = v;
    }
    if (bidx() == 0) {
        if (tid < 4) {
            const float* lv = p.in[I_DLAM] + tid * 256;
            float s1 = 0.f, s2 = 0.f;
            for (int j = 0; j < 64; ++j) { s1 += lv[j] * lv[64 + j]; s2 += lv[128 + j] * lv[192 + j]; }
            const float li = 0.8f - 0.6f * expf(-0.3f * (float)tid);
            float* lam = (float*)(p.ws + OFF_LAM);
            lam[tid] = expf(s1) - expf(s2) + li; lam[4 + tid] = li;
        }
        if (tid < 64) ((int*)(p.ws + OFF_QCNT))[tid] = 0;
    }
}

DI const float* x_in_row(const Params& p, int grp, int row) {
    const int seq = grp * G + (row >> 11), t = row & 2047;
    return seq < 8 ? p.in[I_XP] + ((size_t)seq * SL + t) * DM : p.in[I_XS] + ((size_t)(seq - 8) * SL + t) * DM;
}
DI void phase_norm(const Params& p, int grp, const float* gain, int mode) {
    const int lane = tidx() & 63;
    const int gw = bidx() * 4 + (tidx() >> 6), nw = gdim() * 4;
    bf16_t* hb = (bf16_t*)(p.ws + OFF_H);
    f32x4 gv[4];
#pragma unroll
    for (int i = 0; i < 4; ++i) gv[i] = *(const f32x4*)(gain + lane * 4 + 256 * i);
    for (int row = gw; row < TG; row += nw) {
        float* xo = p.out + ((size_t)grp * TG + row) * DM;
        const float* x = mode == 0 ? x_in_row(p, grp, row) : xo;
        f32x4 v[4]; float ss = 0.f;
#pragma unroll
        for (int i = 0; i < 4; ++i) { v[i] = *(const f32x4*)(x + lane * 4 + 256 * i); ss += v[i][0] * v[i][0] + v[i][1] * v[i][1] + v[i][2] * v[i][2] + v[i][3] * v[i][3]; }
        ss = wave_sum(ss);
        const float rstd = rsqrtf(ss * (1.0f / 1024.0f) + EPS);
#pragma unroll
        for (int i = 0; i < 4; ++i) {
            const f32x4 y = v[i] * rstd * gv[i];
            if (mode == 2) *(f32x4*)(xo + lane * 4 + 256 * i) = y;
            else { u32x2 w; w[0] = pk2(y[0], y[1]); w[1] = pk2(y[2], y[3]); *(u32x2*)(hb + (size_t)row * DM + lane * 4 + 256 * i) = w; }
        }
    }
}

DI void phase_in(const Params& p, int layer, char* lds, bool probe = false) {
    const bf16_t* hb = (const bf16_t*)(p.ws + OFF_H);
    const bf16_t* W = wts(p, layer) + WING;
    bf16_t* ub = (bf16_t*)(p.ws + OFF_U);
    bf16_t* gb = (bf16_t*)(p.ws + OFF_GATE);
    constexpr int NT = NIN / 128;
    const int lane = tidx() & 63, w = tidx() >> 6, wr = w >> 1, wc = w & 1, r16 = lane & 15, q4 = lane >> 4;
    TileIter it; ti_init(it, TG / 128, NT, 8, 6);
    int tm, tn, ntm = 0, ntn = 0;
    bool have = ti_next(it, tm, tn);
    GemmR pre;
    if (have) prime_k0(hb + (size_t)tm * 128 * DM, DM, W + (size_t)(tn * 128) * DM, DM, pre);
    for (; have; tm = ntm, tn = ntn) {
        have = ti_next(it, ntm, ntn);
        const bf16_t* nAt = have ? hb + (size_t)ntm * 128 * DM : hb; const bf16_t* nBt = have ? W + (size_t)(ntn * 128) * DM : W;
        const int c0 = tn * 128;
        const bool isV = (c0 == 640) || (c0 >= 2304 && c0 < 2816) || (c0 >= 3328 && c0 < 3840);
        f32x4 acc[4][4]; zero_acc(acc);
        const int cb = c0 + wc * 64;
        if (isV) {
            gemm128pre<false>(hb + (size_t)tm * 128 * DM, DM, W + (size_t)c0 * DM, DM, DM, pre, acc, lds);
            prime_k0(nAt, DM, nBt, DM, pre);
            bf16_t* vt; int cl, DV, NH;
            if (cb < 768) { vt = (bf16_t*)(p.ws + OFF_VTA); cl = cb - 640; DV = 64; NH = 2; }
            else if (cb < 2816) { vt = (bf16_t*)(p.ws + OFF_VTC); cl = cb - 2304; DV = 128; NH = 4; }
            else { vt = (bf16_t*)(p.ws + OFF_VTD); cl = cb - 3328; DV = 128; NH = 4; }
#pragma unroll
            for (int m = 0; m < 4; ++m)
#pragma unroll
                for (int n = 0; n < 4; ++n)
                    otile_put(lds, wc * 64 + n * 16 + r16, wr * 64 + m * 16 + q4 * 4, pk2(acc[m][n][0], acc[m][n][1]), pk2(acc[m][n][2], acc[m][n][3]));
            otile_flush(lds, vt + ((size_t)((tm * 128) >> 11) * NH * DV + (cl - wc * 64)) * SL + ((tm * 128) & 2047), SL);
        } else {
            gemm128pre<true>(hb + (size_t)tm * 128 * DM, DM, W + (size_t)c0 * DM, DM, DM, pre, acc, lds);
            bool donorm = false, dosig = false; int rot = 0; float scale = 1.f; const float* gain = nullptr;
            bf16_t* dst = ub; int ld = INW, dcol = cb;
            if (cb < 512) { donorm = true; rot = 1; scale = 0.125f * LOG2E; gain = p.in[I_QG] + layer * 64; }
            else if (cb < 640) { donorm = true; rot = 1; gain = p.in[I_KG] + layer * 64; }
            else if (cb < 1280) { }
            else if (cb < 1792) { scale = 0.125f * LOG2E; }
            else if (cb < 2816) { }
            else if (cb < 3072) { rot = 2; scale = 0.125f; }
            else if (cb < 3328) { rot = 2; }
            else if (cb < INW) { }
            else { dosig = true; dst = gb; ld = 4096; dcol = cb - INW; }
            float gl[4][4];
            if (donorm) {
#pragma unroll
                for (int n = 0; n < 4; ++n) { const f32x4 g4 = *(const f32x4*)(gain + n * 16 + q4 * 4); gl[n][0] = g4[0]; gl[n][1] = g4[1]; gl[n][2] = g4[2]; gl[n][3] = g4[3]; }
            }
            const float* ct = (const float*)(p.ws + (rot == 2 ? OFF_COSD : OFF_COSA));
            const float* sn = (const float*)(p.ws + (rot == 2 ? OFF_SIND : OFF_SINA));
#pragma unroll
            for (int m = 0; m < 4; ++m) {
                asm volatile("" ::: "memory");
                const int row = tm * 128 + wr * 64 + m * 16 + r16, tpos = row & 2047;
                float v[4][4];
#pragma unroll
                for (int n = 0; n < 4; ++n)
#pragma unroll
                    for (int i = 0; i < 4; ++i) v[n][i] = acc[m][n][i];
                if (donorm) {
                    float ss = 0.f;
#pragma unroll
                    for (int n = 0; n < 4; ++n)
#pragma unroll
                        for (int i = 0; i < 4; ++i) ss += v[n][i] * v[n][i];
                    ss += __shfl_xor(ss, 16); ss += __shfl_xor(ss, 32);
                    const float rstd = rsqrtf(ss * (1.0f / 64.0f) + EPS);
#pragma unroll
                    for (int n = 0; n < 4; ++n)
#pragma unroll
                        for (int i = 0; i < 4; ++i) v[n][i] = v[n][i] * rstd * gl[n][i];
                }
                if (rot) {
#pragma unroll
                    for (int n = 0; n < 2; ++n) {
                        const f32x4 c4 = *(const f32x4*)(ct + tpos * 32 + n * 16 + q4 * 4), s4 = *(const f32x4*)(sn + tpos * 32 + n * 16 + q4 * 4);
#pragma unroll
                        for (int i = 0; i < 4; ++i) { const float x1 = v[n][i], x2 = v[n + 2][i]; v[n][i] = x1 * c4[i] - x2 * s4[i]; v[n + 2][i] = x2 * c4[i] + x1 * s4[i]; }
                    }
                }
#pragma unroll
                for (int n = 0; n < 4; ++n) {
                    float o0, o1, o2, o3;
                    if (dosig) { o0 = sigmoidf_(v[n][0]); o1 = sigmoidf_(v[n][1]); o2 = sigmoidf_(v[n][2]); o3 = sigmoidf_(v[n][3]); }
                    else { o0 = v[n][0] * scale; o1 = v[n][1] * scale; o2 = v[n][2] * scale; o3 = v[n][3] * scale; }
                    otile_put(lds, wr * 64 + m * 16 + r16, wc * 64 + n * 16 + q4 * 4, pk2(o0, o1), pk2(o2, o3));
                }
            }
            prime_k0(nAt, DM, nBt, DM, pre);
            otile_flush(lds, dst + (size_t)(tm * 128) * ld + (dcol - wc * 64), ld);
        }
    }
}

template <int DV, int MODE>
DI void attn_task(const Params& p, int task, char* lds) {
    constexpr int NDT = DV / 32;
    constexpr int STG = 64 * AROWB + DV * AROWB;
    const int tid = tidx(), lane = tid & 63, wave = tid >> 6, r = lane & 31, h = lane >> 5;
    const bf16_t* ub = (const bf16_t*)(p.ws + OFF_U);
    const int qt = task & 15; const int rest = task >> 4;
    int seq, head, map = 0, qcol, kcol; const bf16_t* vt;
    if (MODE == 0) { head = rest & 7; seq = rest >> 3; qcol = head * 64; kcol = 512 + (head >> 2) * 64; vt = (const bf16_t*)(p.ws + OFF_VTA) + (size_t)(seq * 2 + (head >> 2)) * 64 * SL; }
    else if (MODE == 1) { map = rest & 1; head = (rest >> 1) & 3; seq = rest >> 3; qcol = 1280 + head * 128 + map * 64; kcol = 1792 + head * 128 + map * 64; vt = (const bf16_t*)(p.ws + OFF_VTC) + (size_t)(seq * 4 + head) * 128 * SL; }
    else { head = rest & 3; seq = rest >> 2; qcol = 2816 + head * 64; kcol = 3072 + head * 64; vt = (const bf16_t*)(p.ws + OFF_VTD) + (size_t)(seq * 4 + head) * 128 * SL; }
    const int qpos = qt * 128 + wave * 32 + r;
    const bf16_t* qptr = ub + ((size_t)seq * SL + qpos) * INW + qcol;
    bf16x8 qf[4];
#pragma unroll
    for (int s = 0; s < 4; ++s) qf[s] = *(const bf16x8*)(qptr + 16 * s + 8 * h);
    const bf16_t* kbase = ub + (size_t)seq * SL * INW + kcol;
    float* sBias = (float*)(lds + 2 * STG);
    if (MODE == 1) { const float* bl = (const float*)(p.ws + OFF_BIAS) + head * 4096; for (int i = tid; i < 4096; i += 256) sBias[i] = bl[i]; }
    float lgam = 0.f;
    if (MODE == 2) lgam = log2f(1.0f - exp2f(-5.0f - (float)head));
    f32x16 o[NDT];
#pragma unroll
    for (int d = 0; d < NDT; ++d)
#pragma unroll
        for (int i = 0; i < 16; ++i) o[d][i] = 0.f;
    float lsum = 0.f;
    const int srow = tid >> 3, sc = tid & 7;
    const bf16_t* kg = kbase + (size_t)srow * INW + sc * 8;
    const bf16_t* vg = vt + (size_t)srow * SL + sc * 8;
    u32x4 rk[2], rv[NDT];
#pragma unroll
    for (int i = 0; i < 2; ++i) rk[i] = *(const u32x4*)(kg + (size_t)(32 * i) * INW);
#pragma unroll
    for (int i = 0; i < NDT; ++i) rv[i] = *(const u32x4*)(vg + (size_t)(32 * i) * SL);
    const int soff = srow * AROWB + sc * 16;
#pragma unroll
    for (int i = 0; i < 2; ++i) *(u32x4*)(lds + soff + 32 * i * AROWB) = rk[i];
#pragma unroll
    for (int i = 0; i < NDT; ++i) *(u32x4*)(lds + 64 * AROWB + soff + 32 * i * AROWB) = rv[i];
    __syncthreads();
    for (int kt = 0; kt < SL / 64; ++kt) {
        const char* cur = lds + (kt & 1) * STG;
        char* nxt = lds + ((kt + 1) & 1) * STG;
        const bool more = kt + 1 < SL / 64;
        const int kv0 = kt * 64;
        if (more) {
            kg += (size_t)64 * INW; vg += 64;
#pragma unroll
            for (int i = 0; i < 2; ++i) rk[i] = *(const u32x4*)(kg + (size_t)(32 * i) * INW);
#pragma unroll
            for (int i = 0; i < NDT; ++i) rv[i] = *(const u32x4*)(vg + (size_t)(32 * i) * SL);
        }
        f32x16 st[2];
#pragma unroll
        for (int kk = 0; kk < 2; ++kk) {
#pragma unroll
            for (int i = 0; i < 16; ++i) st[kk][i] = 0.f;
#pragma unroll
            for (int s = 0; s < 4; ++s) {
                const bf16x8 kf = *(const bf16x8*)(cur + (32 * kk + r) * AROWB + (16 * s + 8 * h) * 2);
                st[kk] = MFMA32(kf, qf[s], st[kk]);
            }
        }
        const int qw0 = qt * 128 + wave * 32;
        const bool farL = MODE == 1 && (kv0 + 63 - qw0) <= -128, farR = MODE == 1 && (kv0 - (qw0 + 31)) >= 128;
        if (MODE == 1 && (farL || farR)) {
            const float bc = farL ? sBias[0] : sBias[4094];
#pragma unroll
            for (int kk = 0; kk < 2; ++kk)
#pragma unroll
                for (int i = 0; i < 16; ++i) { const float pv = __builtin_amdgcn_exp2f(st[kk][i] + bc); lsum += pv; st[kk][i] = pv; }
        } else
#pragma unroll
        for (int kk = 0; kk < 2; ++kk)
#pragma unroll
            for (int i = 0; i < 16; ++i) {
                const int m = kv0 + 32 * kk + (i & 3) + 8 * (i >> 2) + 4 * h;
                float pv;
                if (MODE == 0) pv = __builtin_amdgcn_exp2f(st[kk][i]);
                else if (MODE == 1) pv = __builtin_amdgcn_exp2f(st[kk][i] + sBias[m - qpos + 2047]);
                else pv = st[kk][i] * __builtin_amdgcn_exp2f(lgam * fabsf((float)(qpos - m)));
                if (MODE != 2) lsum += pv;
                st[kk][i] = pv;
            }
        const char* sV = cur + 64 * AROWB;
#pragma unroll
        for (int kk = 0; kk < 2; ++kk)
#pragma unroll
            for (int s2 = 0; s2 < 2; ++s2) {
                u32x4 pw;
#pragma unroll
                for (int j = 0; j < 4; ++j) pw[j] = pk2(st[kk][8 * s2 + 2 * j], st[kk][8 * s2 + 2 * j + 1]);
                const bf16x8 pf = __builtin_bit_cast(bf16x8, pw);
#pragma unroll
                for (int d = 0; d < NDT; ++d) {
                    const char* va = sV + (32 * d + r) * AROWB + (32 * kk + 16 * s2 + 4 * h) * 2;
                    const s16x4 lo = *(const s16x4*)va, hi = *(const s16x4*)(va + 16);
                    const bf16x8 vf = __builtin_shufflevector(lo, hi, 0, 1, 2, 3, 4, 5, 6, 7);
                    o[d] = MFMA32(vf, pf, o[d]);
                }
            }
        if (more) {
#pragma unroll
            for (int i = 0; i < 2; ++i) *(u32x4*)(nxt + soff + 32 * i * AROWB) = rk[i];
#pragma unroll
            for (int i = 0; i < NDT; ++i) *(u32x4*)(nxt + 64 * AROWB + soff + 32 * i * AROWB) = rv[i];
        }
        __syncthreads();
    }
    const size_t tok = (size_t)seq * SL + qpos;
    if (MODE != 2) {
        const float ltot = lsum + __shfl_xor(lsum, 32);
        const float inv = __builtin_amdgcn_rcpf(ltot);
        bf16_t* dst = MODE == 0 ? (bf16_t*)(p.ws + OFF_O) + tok * 512 + head * 64
                                : (bf16_t*)(p.ws + OFF_DT) + ((size_t)map * TG + tok) * 512 + head * 128;
        if (DV == 128) {
#pragma unroll
            for (int d = 0; d < NDT; ++d)
#pragma unroll
                for (int a = 0; a < 4; ++a) otile_put(lds, wave * 32 + r, 32 * d + 8 * a + 4 * h, pk2(o[d][4 * a] * inv, o[d][4 * a + 1] * inv), pk2(o[d][4 * a + 2] * inv, o[d][4 * a + 3] * inv));
            otile_flush(lds, (bf16_t*)(p.ws + OFF_DT) + ((size_t)map * TG + (size_t)seq * SL + qt * 128) * 512 + head * 128, 512);
        } else {
#pragma unroll
        for (int d = 0; d < NDT; ++d)
#pragma unroll
            for (int a = 0; a < 4; ++a) {
                u32x2 wv; wv[0] = pk2(o[d][4 * a] * inv, o[d][4 * a + 1] * inv); wv[1] = pk2(o[d][4 * a + 2] * inv, o[d][4 * a + 3] * inv);
                *(u32x2*)(dst + 32 * d + 8 * a + 4 * h) = wv;
            }
        }
    } else {
        float s = 0.f;
#pragma unroll
        for (int d = 0; d < NDT; ++d)
#pragma unroll
            for (int i = 0; i < 16; ++i) s += o[d][i];
        s += __shfl_xor(s, 32);
        const float mu = s * (1.0f / 128.0f);
        float vs = 0.f;
#pragma unroll
        for (int d = 0; d < NDT; ++d)
#pragma unroll
            for (int i = 0; i < 16; ++i) { const float dd = o[d][i] - mu; vs += dd * dd; }
        vs += __shfl_xor(vs, 32);
        const float rstd = rsqrtf(vs * (1.0f / 128.0f) + EPS);
        const bf16_t* gp = ub + tok * INW + 3840 + head * 128;
        bf16_t* dst = (bf16_t*)(p.ws + OFF_O) + ((size_t)3 * TG + tok) * 512 + head * 128;
#pragma unroll
        for (int d = 0; d < NDT; ++d)
#pragma unroll
            for (int a = 0; a < 4; ++a) {
                asm volatile("" ::: "memory");
                const u32x2 gw = *(const u32x2*)(gp + 32 * d + 8 * a + 4 * h);
                const float g0 = bflo(gw[0]), g1 = bfhi(gw[0]), g2 = bflo(gw[1]), g3 = bfhi(gw[1]);
                const float y0 = (o[d][4 * a] - mu) * rstd * g0 * sigmoidf_(g0), y1 = (o[d][4 * a + 1] - mu) * rstd * g1 * sigmoidf_(g1);
                const float y2 = (o[d][4 * a + 2] - mu) * rstd * g2 * sigmoidf_(g2), y3 = (o[d][4 * a + 3] - mu) * rstd * g3 * sigmoidf_(g3);
                otile_put(lds, wave * 32 + r, 32 * d + 8 * a + 4 * h, pk2(y0, y1), pk2(y2, y3));
            }
        otile_flush(lds, (bf16_t*)(p.ws + OFF_O) + ((size_t)3 * TG + (size_t)seq * SL + qt * 128) * 512 + head * 128, 512);
    }
}

DI void attn_gqa2(const Params& p, int task, char* lds) {
    constexpr int DV = 64, NDT = 2;
    constexpr int STG = 64 * AROWB + DV * AROWB;
    const int tid = tidx(), lane = tid & 63, wave = tid >> 6, r = lane & 31, h = lane >> 5;
    const bf16_t* ub = (const bf16_t*)(p.ws + OFF_U);
    const int qt = task & 7, rest = task >> 3, head = rest & 7, seq = rest >> 3;
    const int qcol = head * 64, kcol = 512 + (head >> 2) * 64;
    const bf16_t* vt = (const bf16_t*)(p.ws + OFF_VTA) + (size_t)(seq * 2 + (head >> 2)) * 64 * SL;
    const int qpos0 = qt * 256 + wave * 64 + r;
    bf16x8 qf[2][4];
#pragma unroll
    for (int qs = 0; qs < 2; ++qs) {
        const bf16_t* qptr = ub + ((size_t)seq * SL + qpos0 + 32 * qs) * INW + qcol;
#pragma unroll
        for (int s = 0; s < 4; ++s) qf[qs][s] = *(const bf16x8*)(qptr + 16 * s + 8 * h);
    }
    const bf16_t* kbase = ub + (size_t)seq * SL * INW + kcol;
    f32x16 o[2][NDT];
#pragma unroll
    for (int qs = 0; qs < 2; ++qs)
#pragma unroll
        for (int d = 0; d < NDT; ++d)
#pragma unroll
            for (int i = 0; i < 16; ++i) o[qs][d][i] = 0.f;
    float lsum[2] = {0.f, 0.f};
    const int srow = tid >> 3, sc = tid & 7;
    const bf16_t* kg = kbase + (size_t)srow * INW + sc * 8;
    const bf16_t* vg = vt + (size_t)srow * SL + sc * 8;
    u32x4 rk[2], rv[NDT];
#pragma unroll
    for (int i = 0; i < 2; ++i) rk[i] = *(const u32x4*)(kg + (size_t)(32 * i) * INW);
#pragma unroll
    for (int i = 0; i < NDT; ++i) rv[i] = *(const u32x4*)(vg + (size_t)(32 * i) * SL);
    const int soff = srow * AROWB + sc * 16;
#pragma unroll
    for (int i = 0; i < 2; ++i) *(u32x4*)(lds + soff + 32 * i * AROWB) = rk[i];
#pragma unroll
    for (int i = 0; i < NDT; ++i) *(u32x4*)(lds + 64 * AROWB + soff + 32 * i * AROWB) = rv[i];
    __syncthreads();
    for (int kt = 0; kt < SL / 64; ++kt) {
        const char* cur = lds + (kt & 1) * STG;
        char* nxt = lds + ((kt + 1) & 1) * STG;
        const bool more = kt + 1 < SL / 64;
        if (more) {
            kg += (size_t)64 * INW; vg += 64;
#pragma unroll
            for (int i = 0; i < 2; ++i) rk[i] = *(const u32x4*)(kg + (size_t)(32 * i) * INW);
#pragma unroll
            for (int i = 0; i < NDT; ++i) rv[i] = *(const u32x4*)(vg + (size_t)(32 * i) * SL);
        }
        f32x16 st[2][2];
#pragma unroll
        for (int kk = 0; kk < 2; ++kk) {
#pragma unroll
            for (int i = 0; i < 16; ++i) { st[0][kk][i] = 0.f; st[1][kk][i] = 0.f; }
#pragma unroll
            for (int s = 0; s < 4; ++s) {
                const bf16x8 kf = *(const bf16x8*)(cur + (32 * kk + r) * AROWB + (16 * s + 8 * h) * 2);
                st[0][kk] = MFMA32(kf, qf[0][s], st[0][kk]);
                st[1][kk] = MFMA32(kf, qf[1][s], st[1][kk]);
            }
        }
#pragma unroll
        for (int qs = 0; qs < 2; ++qs)
#pragma unroll
            for (int kk = 0; kk < 2; ++kk)
#pragma unroll
                for (int i = 0; i < 16; ++i) { const float pv = __builtin_amdgcn_exp2f(st[qs][kk][i]); lsum[qs] += pv; st[qs][kk][i] = pv; }
        const char* sV = cur + 64 * AROWB;
#pragma unroll
        for (int kk = 0; kk < 2; ++kk)
#pragma unroll
            for (int s2 = 0; s2 < 2; ++s2) {
                bf16x8 pf[2];
#pragma unroll
                for (int qs = 0; qs < 2; ++qs) {
                    u32x4 pw;
#pragma unroll
                    for (int j = 0; j < 4; ++j) pw[j] = pk2(st[qs][kk][8 * s2 + 2 * j], st[qs][kk][8 * s2 + 2 * j + 1]);
                    pf[qs] = __builtin_bit_cast(bf16x8, pw);
                }
#pragma unroll
                for (int d = 0; d < NDT; ++d) {
                    const char* va = sV + (32 * d + r) * AROWB + (32 * kk + 16 * s2 + 4 * h) * 2;
                    const s16x4 lo = *(const s16x4*)va, hi = *(const s16x4*)(va + 16);
                    const bf16x8 vf = __builtin_shufflevector(lo, hi, 0, 1, 2, 3, 4, 5, 6, 7);
                    o[0][d] = MFMA32(vf, pf[0], o[0][d]);
                    o[1][d] = MFMA32(vf, pf[1], o[1][d]);
                }
            }
        if (more) {
#pragma unroll
            for (int i = 0; i < 2; ++i) *(u32x4*)(nxt + soff + 32 * i * AROWB) = rk[i];
#pragma unroll
            for (int i = 0; i < NDT; ++i) *(u32x4*)(nxt + 64 * AROWB + soff + 32 * i * AROWB) = rv[i];
        }
        __syncthreads();
    }
#pragma unroll
    for (int qs = 0; qs < 2; ++qs) {
        const size_t tok = (size_t)seq * SL + qpos0 + 32 * qs;
        const float ltot = lsum[qs] + __shfl_xor(lsum[qs], 32);
        const float inv = __builtin_amdgcn_rcpf(ltot);
        bf16_t* dst = (bf16_t*)(p.ws + OFF_O) + tok * 512 + head * 64;
#pragma unroll
        for (int d = 0; d < NDT; ++d)
#pragma unroll
            for (int a = 0; a < 4; ++a) {
                u32x2 wv; wv[0] = pk2(o[qs][d][4 * a] * inv, o[qs][d][4 * a + 1] * inv); wv[1] = pk2(o[qs][d][4 * a + 2] * inv, o[qs][d][4 * a + 3] * inv);
                *(u32x2*)(dst + 32 * d + 8 * a + 4 * h) = wv;
            }
    }
}

DI void tr_read8(unsigned a, s16x4 (&v)[8]) {
    asm volatile("ds_read_b64_tr_b16 %0, %8\n\tds_read_b64_tr_b16 %1, %8 offset:256\n\tds_read_b64_tr_b16 %2, %8 offset:1024\n\tds_read_b64_tr_b16 %3, %8 offset:1280\n\t"
                 "ds_read_b64_tr_b16 %4, %8 offset:2048\n\tds_read_b64_tr_b16 %5, %8 offset:2304\n\tds_read_b64_tr_b16 %6, %8 offset:3072\n\tds_read_b64_tr_b16 %7, %8 offset:3328\n\t"
                 "s_waitcnt lgkmcnt(0)"
                 : "=&v"(v[0]), "=&v"(v[1]), "=&v"(v[2]), "=&v"(v[3]), "=&v"(v[4]), "=&v"(v[5]), "=&v"(v[6]), "=&v"(v[7]) : "v"(a) : "memory");
}

DI void s5_wave_task(const Params& p, int layer, int wt, char* ldsw) {
    const int lane = tidx() & 63, r = lane & 31, h = lane >> 5;
    const int dir = wt & 1, g = (wt >> 1) & 31, pair = wt >> 6;
    const bf16_t* ub = (const bf16_t*)(p.ws + OFF_U);
    const int hp = (r >> 2) & 1, ia = 4 * (r >> 3) + (r & 3);
    const unsigned img = (unsigned)(size_t)ldsw;
    char* chunkbuf = ldsw + 8192;
    const int i16 = lane & 15, tq = i16 >> 2, tp = i16 & 3, blk = (lane >> 4) & 1;
    const unsigned trA = img + (8 * h + tq) * 64 + 8 * (4 * blk + tp);
    const float dsk = r < 16 ? p.in[I_SD][layer * 512 + g * 16 + r] : 0.f;
    bf16_t* yl = (bf16_t*)(p.ws + (dir ? OFF_YB : OFF_YF)) + ((size_t)(2 * pair + h) * 512 + g * 16 + (r & 15)) * SL;
    const int pb = (layer * 2 + dir) * 32 + g;
    const float dt = expf(p.in[I_SLDT][pb]);
    float abr[2], abi[2];
    bf16x8 bfrag[2][2], cfrag[2][2][2], dfrag;
    {
        u32x4 dw;
#pragma unroll
        for (int j = 0; j < 4; ++j) dw[j] = pk2((dir == 0 && r == 8 * h + 2 * j) ? dsk : 0.f, (dir == 0 && r == 8 * h + 2 * j + 1) ? dsk : 0.f);
        dfrag = __builtin_bit_cast(bf16x8, dw);
    }
#pragma unroll
    for (int st = 0; st < 2; ++st) {
        const int n = 32 * st + r;
        const float are = p.in[I_SARE][pb * 64 + n], aim = p.in[I_SAIM][pb * 64 + n];
        const float mag = expf(dt * are);
        abr[st] = mag * cosf(dt * aim); abi[st] = mag * sinf(dt * aim);
        const float den = are * are + aim * aim, nr = abr[st] - 1.0f;
        const float fre = (nr * are + abi[st] * aim) / den, fim = (abi[st] * are - nr * aim) / den;
        const float* bre = p.in[I_SBRE] + ((size_t)pb * 64 + n) * 16 + 8 * h;
        const float* bim = p.in[I_SBIM] + ((size_t)pb * 64 + n) * 16 + 8 * h;
        u32x4 wre, wim;
#pragma unroll
        for (int j = 0; j < 4; ++j) {
            const float br0 = bre[2 * j], bi0 = bim[2 * j], br1 = bre[2 * j + 1], bi1 = bim[2 * j + 1];
            wre[j] = pk2(fre * br0 - fim * bi0, fre * br1 - fim * bi1);
            wim[j] = pk2(fre * bi0 + fim * br0, fre * bi1 + fim * br1);
        }
        bfrag[st][0] = __builtin_bit_cast(bf16x8, wre); bfrag[st][1] = __builtin_bit_cast(bf16x8, wim);
#pragma unroll
        for (int s = 0; s < 2; ++s) {
            u32x4 cr = {0u, 0u, 0u, 0u}, ci = {0u, 0u, 0u, 0u};
            if (r < 16) {
                const float* cre = p.in[I_SCRE] + ((size_t)pb * 16 + r) * 64 + 32 * st + 16 * s + 8 * h;
                const float* cim = p.in[I_SCIM] + ((size_t)pb * 16 + r) * 64 + 32 * st + 16 * s + 8 * h;
#pragma unroll
                for (int j = 0; j < 4; ++j) { cr[j] = pk2(cre[2 * j], cre[2 * j + 1]); ci[j] = pk2(-cim[2 * j], -cim[2 * j + 1]); }
            }
            cfrag[st][s][0] = __builtin_bit_cast(bf16x8, cr); cfrag[st][s][1] = __builtin_bit_cast(bf16x8, ci);
        }
    }
    float sre[2] = {0.f, 0.f}, sim[2] = {0.f, 0.f};
    const bf16_t* gsrc[4]; int loff[4];
#pragma unroll
    for (int j = 0; j < 4; ++j) {
        const int c = lane + 64 * j, row = c >> 1, half = c & 1, ss = row >> 6, tau = row & 63;
        gsrc[j] = ub + ((size_t)(2 * pair + ss) * SL + (dir ? (SL - 1 - tau) : tau)) * INW + 768 + g * 16 + half * 8;
        loff[j] = row * 32 + half * 16;
    }
    const long cstep = dir ? -(long)64 * INW : (long)64 * INW;
    u32x4 crg[4];
#pragma unroll
    for (int j = 0; j < 4; ++j) crg[j] = *(const u32x4*)gsrc[j];
#pragma unroll
    for (int j = 0; j < 4; ++j) *(u32x4*)(chunkbuf + loff[j]) = crg[j];
    const int aoff = (hp * 64 + ia) * 32 + h * 16;
    for (int chunk = 0; chunk < SL / 64; ++chunk) {
        if (chunk + 1 < SL / 64) {
#pragma unroll
            for (int j = 0; j < 4; ++j) { gsrc[j] += cstep; crg[j] = *(const u32x4*)gsrc[j]; }
        }
        const char* cb = chunkbuf + (chunk & 1) * 4096;
#pragma unroll 1
        for (int tl = 0; tl < 4; ++tl) {
            const int s0 = chunk * 64 + tl * 16;
            const bf16x8 ua = *(const bf16x8*)(cb + aoff + tl * 512);
            f32x16 z;
#pragma unroll
            for (int i = 0; i < 16; ++i) z[i] = 0.f;
            f32x16 y0 = MFMA32(ua, dfrag, z);
            f32x16 y1 = z;
#pragma unroll
            for (int st = 0; st < 2; ++st) {
                f32x16 xr = MFMA32(ua, bfrag[st][0], z);
                f32x16 xi = MFMA32(ua, bfrag[st][1], z);
                float cr = sre[st], ci = sim[st];
#pragma unroll
                for (int i = 0; i < 16; ++i) {
                    const float nr = abr[st] * cr - abi[st] * ci + xr[i];
                    const float ni = abr[st] * ci + abi[st] * cr + xi[i];
                    cr = nr; ci = ni; xr[i] = nr; xi[i] = ni;
                }
                sre[st] = cr; sim[st] = ci;
#pragma unroll
                for (int a = 0; a < 4; ++a) {
                    u32x2 w0, w1; w0[0] = pk2(xr[4 * a], xr[4 * a + 1]); w0[1] = pk2(xr[4 * a + 2], xr[4 * a + 3]);
                    w1[0] = pk2(xi[4 * a], xi[4 * a + 1]); w1[1] = pk2(xi[4 * a + 2], xi[4 * a + 3]);
                    *(u32x2*)(ldsw + (st * 2 + 0) * 2048 + r * 64 + 8 * (2 * a + h)) = w0;
                    *(u32x2*)(ldsw + (st * 2 + 1) * 2048 + r * 64 + 8 * (2 * a + h)) = w1;
                }
            }
            asm volatile("s_waitcnt lgkmcnt(0)" ::: "memory");
            {
                s16x4 v[8];
                tr_read8(trA, v);
                y0 = MFMA32(__builtin_shufflevector(v[0], v[1], 0, 1, 2, 3, 4, 5, 6, 7), cfrag[0][0][0], y0);
                y0 = MFMA32(__builtin_shufflevector(v[2], v[3], 0, 1, 2, 3, 4, 5, 6, 7), cfrag[0][1][0], y0);
                y0 = MFMA32(__builtin_shufflevector(v[4], v[5], 0, 1, 2, 3, 4, 5, 6, 7), cfrag[0][0][1], y0);
                y0 = MFMA32(__builtin_shufflevector(v[6], v[7], 0, 1, 2, 3, 4, 5, 6, 7), cfrag[0][1][1], y0);
                s16x4 u[8];
                tr_read8(trA + 4096, u);
                y1 = MFMA32(__builtin_shufflevector(u[0], u[1], 0, 1, 2, 3, 4, 5, 6, 7), cfrag[1][0][0], y1);
                y1 = MFMA32(__builtin_shufflevector(u[2], u[3], 0, 1, 2, 3, 4, 5, 6, 7), cfrag[1][1][0], y1);
                y1 = MFMA32(__builtin_shufflevector(u[4], u[5], 0, 1, 2, 3, 4, 5, 6, 7), cfrag[1][0][1], y1);
                y1 = MFMA32(__builtin_shufflevector(u[6], u[7], 0, 1, 2, 3, 4, 5, 6, 7), cfrag[1][1][1], y1);
            }
            if (r < 16) {
                u32x4 o0, o1;
                if (dir == 0) {
#pragma unroll
                    for (int j = 0; j < 4; ++j) { o0[j] = pk2(y0[2 * j] + y1[2 * j], y0[2 * j + 1] + y1[2 * j + 1]); o1[j] = pk2(y0[8 + 2 * j] + y1[8 + 2 * j], y0[9 + 2 * j] + y1[9 + 2 * j]); }
                    *(u32x4*)(yl + s0) = o0; *(u32x4*)(yl + s0 + 8) = o1;
                } else {
#pragma unroll
                    for (int j = 0; j < 4; ++j) { o0[j] = pk2(y0[15 - 2 * j] + y1[15 - 2 * j], y0[14 - 2 * j] + y1[14 - 2 * j]); o1[j] = pk2(y0[7 - 2 * j] + y1[7 - 2 * j], y0[6 - 2 * j] + y1[6 - 2 * j]); }
                    *(u32x4*)(yl + (SL - 16 - s0)) = o0; *(u32x4*)(yl + (SL - 16 - s0) + 8) = o1;
                }
            }
        }
        if (chunk + 1 < SL / 64) {
#pragma unroll
            for (int j = 0; j < 4; ++j) *(u32x4*)(chunkbuf + ((chunk + 1) & 1) * 4096 + loff[j]) = crg[j];
        }
    }
}

DI void phase_mix(const Params& p, int layer, int qidx, char* lds, bool only_s5 = false) {
    __shared__ int s_task;
    int* qc = (int*)(p.ws + OFF_QCNT) + qidx;
    constexpr int N_S5 = (G / 2) * 32 * 2 / 4, N_DIFF = G * 4 * 2 * 16, N_RET = G * 4 * 16, N_GQA = G * 8 * 8;
    constexpr int NTOT = N_S5 + N_DIFF + N_RET + N_GQA;
    for (;;) {
        __syncthreads();
        if (tidx() == 0) s_task = atomicAdd(qc, 1);
        __syncthreads();
        int task = s_task;
        if (task >= (only_s5 ? N_S5 : NTOT)) break;
        if (task < N_S5) { const int wave = tidx() >> 6; s5_wave_task(p, layer, task * 4 + wave, lds + wave * 16384); }
        else if ((task -= N_S5) < N_DIFF) attn_task<128, 1>(p, task, lds);
        else if ((task -= N_DIFF) < N_RET) attn_task<128, 2>(p, task, lds);
        else attn_gqa2(p, task - N_RET, lds);
    }
}

DI float gelu_tanh(float v) { const float z2 = 1.5957691216057308f * (v + 0.044715f * v * v * v); return v * __builtin_amdgcn_rcpf(1.0f + __builtin_amdgcn_exp2f(-LOG2E * z2)); }

DI void glu_tile(const Params& p, int layer, int tm, int tn, char* lds) {
    const int tid = tidx(), lane = tid & 63, w = tid >> 6, wr = w >> 1, wc = w & 1, r16 = lane & 15, q4 = lane >> 4;
    const bf16_t* yf = (const bf16_t*)(p.ws + OFF_YF);
    const bf16_t* yb = (const bf16_t*)(p.ws + OFF_YB);
    const bf16_t* B = wts(p, layer) + WGLU + (size_t)tn * 128 * 512;
    const int seq = (tm * 128) >> 11, t0 = (tm * 128) & 2047;
    const int ach = tid & 63, aseg0 = tid >> 6;
    const bf16_t* fg = yf + ((size_t)seq * 512 + ach) * SL + t0;
    const bf16_t* bg2 = yb + ((size_t)seq * 512 + ach) * SL + t0;
    const int srow = tid >> 3, scol = tid & 7;
    const bf16_t* bg = B + (size_t)srow * 512 + scol * 8;
    const int soff = srow * ROWB + ((scol ^ ((srow >> 1) & 7)) << 4);
    u32x4 rf[4], rbk[4], rb[4];
    f32x4 acc[4][4]; zero_acc(acc);
    const int aoff = (wr * 64 + (lane & 15)) * ROWB;
    const int boff = GT_BYTES + (wc * 64 + (lane & 15)) * ROWB;
    const int sw = ((lane >> 4) ^ ((lane & 15) >> 1)) << 4;
    for (int kt = 0; kt < 8; ++kt) {
#pragma unroll
        for (int j = 0; j < 4; ++j) {
            rf[j] = *(const u32x4*)(fg + (size_t)kt * 64 * SL + (aseg0 + 4 * j) * 8);
            rbk[j] = *(const u32x4*)(bg2 + (size_t)kt * 64 * SL + (aseg0 + 4 * j) * 8);
            rb[j] = *(const u32x4*)(bg + (size_t)(32 * j) * 512 + kt * 64);
        }
#pragma unroll
        for (int j = 0; j < 4; ++j) {
            *(u32x4*)(lds + GT_BYTES + soff + 32 * j * ROWB) = rb[j];
            char* abase = lds + (aseg0 + 4 * j) * 8 * ROWB + (ach & 7) * 2;
#pragma unroll
            for (int e = 0; e < 4; ++e) {
                const float v0 = gelu_tanh(bflo(rf[j][e]) + bflo(rbk[j][e])), v1 = gelu_tanh(bfhi(rf[j][e]) + bfhi(rbk[j][e]));
                const unsigned pw = pk2(v0, v1);
                const int cs = (((ach >> 3) ^ ((4 * aseg0 + e) & 7)) << 4);
                *(bf16_t*)(abase + (2 * e) * ROWB + cs) = (bf16_t)(pw & 0xffffu);
                *(bf16_t*)(abase + (2 * e + 1) * ROWB + cs) = (bf16_t)(pw >> 16);
            }
        }
        __syncthreads();
        gemm_compute<false, 0>(lds, aoff, boff, sw, acc);
        __syncthreads();
    }
    bf16_t* ob = (bf16_t*)(p.ws + OFF_O) + (size_t)1 * TG * 512;
    const float* bgl = p.in[I_SBGLU] + layer * 512;
#pragma unroll
    for (int n = 0; n < 4; ++n) {
        const int ch = tn * 128 + wc * 64 + n * 16 + r16;
        const float bias = bgl[ch];
#pragma unroll
        for (int m = 0; m < 4; ++m) {
            const int tl = wr * 64 + m * 16 + q4 * 4;
            const u32x2 fw = *(const u32x2*)(yf + ((size_t)seq * 512 + ch) * SL + t0 + tl);
            const u32x2 bw = *(const u32x2*)(yb + ((size_t)seq * 512 + ch) * SL + t0 + tl);
            const float y0 = gelu_tanh(bflo(fw[0]) + bflo(bw[0])), y1 = gelu_tanh(bfhi(fw[0]) + bfhi(bw[0]));
            const float y2 = gelu_tanh(bflo(fw[1]) + bflo(bw[1])), y3 = gelu_tanh(bfhi(fw[1]) + bfhi(bw[1]));
            const unsigned w01 = pk2(y0 * sigmoidf_(acc[m][n][0] + bias), y1 * sigmoidf_(acc[m][n][1] + bias));
            const unsigned w23 = pk2(y2 * sigmoidf_(acc[m][n][2] + bias), y3 * sigmoidf_(acc[m][n][3] + bias));
            bf16_t* orow = ob + (size_t)(tm * 128 + tl) * 512 + ch;
            orow[0] = (bf16_t)(w01 & 0xffffu); orow[512] = (bf16_t)(w01 >> 16); orow[1024] = (bf16_t)(w23 & 0xffffu); orow[1536] = (bf16_t)(w23 >> 16);
        }
    }
}

DI void phase_glu(const Params& p, int layer, char* lds) {
    const int lane = tidx() & 63, w = tidx() >> 6;
    { TileIter it; ti_init(it, TG / 128, 4, 16, 4); int tm, tn; while (ti_next(it, tm, tn)) glu_tile(p, layer, tm, tn, lds); }
    const float lam = ((const float*)(p.ws + OFF_LAM))[layer], li = ((const float*)(p.ws + OFF_LAM))[4 + layer];
    const bf16_t* d0 = (const bf16_t*)(p.ws + OFF_DT); const bf16_t* d1 = d0 + (size_t)TG * 512;
    bf16_t* oc = (bf16_t*)(p.ws + OFF_O) + (size_t)2 * TG * 512;
    const f32x2 sg = *(const f32x2*)(p.in[I_DSUB] + layer * 128 + 2 * lane);
    const int gw = bidx() * 4 + w, nw = gdim() * 4;
    for (int it0 = gw; it0 < TG * 4; it0 += 8 * nw) {
        unsigned a[8], b[8];
#pragma unroll
        for (int j = 0; j < 8; ++j) {
            const int it = it0 + j * nw;
            const size_t off = (size_t)(it < TG * 4 ? it : gw) * 128 + 2 * lane;
            a[j] = *(const unsigned*)(d0 + off); b[j] = *(const unsigned*)(d1 + off);
        }
#pragma unroll
        for (int j = 0; j < 8; ++j) {
            const int it = it0 + j * nw;
            const float v0 = bflo(a[j]) - lam * bflo(b[j]), v1 = bfhi(a[j]) - lam * bfhi(b[j]);
            const float ss = wave_sum(v0 * v0 + v1 * v1);
            const float rs = rsqrtf(ss * (1.0f / 128.0f) + EPS) * (1.0f - li);
            if (it < TG * 4) *(unsigned*)(oc + (size_t)it * 128 + 2 * lane) = pk2(v0 * rs * sg[0], v1 * rs * sg[1]);
        }
    }
}

DI void phase_merge(const Params& p, int layer, char* lds) {
    const int lane = tidx() & 63, w = tidx() >> 6, wr = w >> 1, wc = w & 1, r16 = lane & 15, q4 = lane >> 4;
    const bf16_t* ob = (const bf16_t*)(p.ws + OFF_O);
    const bf16_t* gb = (const bf16_t*)(p.ws + OFF_GATE);
    const bf16_t* W = wts(p, layer) + WB;
    bf16_t* mb = (bf16_t*)(p.ws + OFF_M);
    TileIter it; ti_init(it, TG / 128, 8, 8, 8);
    int tm, tn;
    while (ti_next(it, tm, tn)) {
        f32x4 macc[4][4]; zero_acc(macc);
#pragma unroll 1
        for (int b = 0; b < 4; ++b) {
            f32x4 acc[4][4]; zero_acc(acc);
            gemm128<true, 0, false>(ob + ((size_t)b * TG + tm * 128) * 512, 512, W + ((size_t)b * 1024 + tn * 128) * 512, 512, 512, acc, lds);
#pragma unroll
            for (int m = 0; m < 4; ++m) {
                const int row = tm * 128 + wr * 64 + m * 16 + r16;
#pragma unroll
                for (int n = 0; n < 4; ++n) {
                    const int col = tn * 128 + wc * 64 + n * 16 + q4 * 4;
                    const u32x2 gw = *(const u32x2*)(gb + (size_t)row * 4096 + b * 1024 + col);
                    macc[m][n][0] += acc[m][n][0] * bflo(gw[0]); macc[m][n][1] += acc[m][n][1] * bfhi(gw[0]);
                    macc[m][n][2] += acc[m][n][2] * bflo(gw[1]); macc[m][n][3] += acc[m][n][3] * bfhi(gw[1]);
                }
            }
        }
#pragma unroll
        for (int m = 0; m < 4; ++m) {
            const int row = tm * 128 + wr * 64 + m * 16 + r16;
#pragma unroll
            for (int n = 0; n < 4; ++n) {
                const int col = tn * 128 + wc * 64 + n * 16 + q4 * 4;
                otile_put(lds, wr * 64 + m * 16 + r16, wc * 64 + n * 16 + q4 * 4, pk2(macc[m][n][0], macc[m][n][1]), pk2(macc[m][n][2], macc[m][n][3]));
            }
        }
        otile_flush(lds, mb + (size_t)(tm * 128) * DM + tn * 128, DM);
    }
}

DI void phase_resid(const Params& p, int grp, const bf16_t* A, int K, const bf16_t* Wt, bool first, char* lds) {
    const int lane = tidx() & 63, w = tidx() >> 6, wr = w >> 1, wc = w & 1, r16 = lane & 15, q4 = lane >> 4;
    TileIter it; ti_init(it, TG / 128, 8, 8, 8);
    int tm, tn, ntm = 0, ntn = 0;
    bool have = ti_next(it, tm, tn);
    GemmRegs g;
    if (have) gemm_prime(A + (size_t)tm * 128 * K, K, Wt + (size_t)tn * 128 * K, K, g);
    for (; have; tm = ntm, tn = ntn) {
        have = ti_next(it, ntm, ntn);
        const bf16_t* At = A + (size_t)tm * 128 * K; const bf16_t* Bt = Wt + (size_t)tn * 128 * K;
        const bf16_t* nAt = have ? A + (size_t)ntm * 128 * K : At; const bf16_t* nBt = have ? Wt + (size_t)ntn * 128 * K : Bt;
        f32x4 acc[4][4]; zero_acc(acc);
        gemm_stream<true>(At, Bt, nAt, nBt, K, K, K, g, acc, lds);
#pragma unroll
        for (int m = 0; m < 4; ++m)
#pragma unroll
            for (int n = 0; n < 4; ++n) *(f32x4*)(lds + (wr * 64 + m * 16 + r16) * OROWF + (wc * 64 + n * 16 + q4 * 4) * 4) = acc[m][n];
        __syncthreads();
        {
            const int tid = tidx();
#pragma unroll 4
            for (int i = 0; i < 16; ++i) {
                const int c = tid + 256 * i, rl = c >> 5, ch = c & 31, row = tm * 128 + rl;
                float* xo = p.out + ((size_t)grp * TG + row) * DM + tn * 128 + ch * 4;
                const float* xi = first ? x_in_row(p, grp, row) + tn * 128 + ch * 4 : xo;
                const f32x4 a = *(const f32x4*)(lds + rl * OROWF + ch * 16);
                const f32x4 xv = *(const f32x4*)xi;
                *(f32x4*)xo = xv + a;
            }
        }
        __syncthreads();
    }
}

DI void phase_ffn1(const Params& p, int layer, char* lds) {
    const int lane = tidx() & 63, w = tidx() >> 6, wr = w >> 1, wc = w & 1, r16 = lane & 15, q4 = lane >> 4;
    const bf16_t* hb = (const bf16_t*)(p.ws + OFF_H);
    const bf16_t* W = wts(p, layer) + WFI;
    bf16_t* fb = (bf16_t*)(p.ws + OFF_F);
    constexpr int NT = DFF / 64;
    TileIter it; ti_init(it, TG / 128, NT, 8, 4);
    int tm, tn, ntm = 0, ntn = 0;
    bool have = ti_next(it, tm, tn);
    GemmRegs g;
    if (have) gemm_prime(hb + (size_t)tm * 128 * DM, DM, W + (size_t)tn * 128 * DM, DM, g);
    for (; have; tm = ntm, tn = ntn) {
        have = ti_next(it, ntm, ntn);
        const bf16_t* At = hb + (size_t)tm * 128 * DM; const bf16_t* Bt = W + (size_t)tn * 128 * DM;
        const bf16_t* nAt = have ? hb + (size_t)ntm * 128 * DM : At; const bf16_t* nBt = have ? W + (size_t)ntn * 128 * DM : Bt;
        f32x4 acc[4][4]; zero_acc(acc);
        gemm_stream<true, 1>(At, Bt, nAt, nBt, DM, DM, DM, g, acc, lds);
#pragma unroll
        for (int m = 0; m < 4; ++m) {
            const int row = tm * 128 + wr * 64 + m * 16 + r16;
#pragma unroll
            for (int n = 0; n < 2; ++n) {
                const int col = tn * 64 + wc * 32 + n * 16 + q4 * 4;
                float f[4];
#pragma unroll
                for (int i = 0; i < 4; ++i) { const float gq = acc[m][n][i]; f[i] = gq * sigmoidf_(gq) * acc[m][n + 2][i]; }
                otile_put(lds, wr * 64 + m * 16 + r16, wc * 32 + n * 16 + q4 * 4, pk2(f[0], f[1]), pk2(f[2], f[3]));
            }
        }
        {
            const int tid = tidx();
            __syncthreads();
#pragma unroll
            for (int i = 0; i < 4; ++i) {
                const int c = tid + 256 * i, row = c >> 3, ch = c & 7;
                const u32x4 v = *(const u32x4*)(lds + row * OROW + ch * 16);
                *(u32x4*)(fb + (size_t)(tm * 128 + row) * DFF + tn * 64 + ch * 8) = v;
            }
            __syncthreads();
        }
    }
}

#define XB_TMO      128
#define XB_XCNT(j)  (256  + 64 * (j))
#define XB_XSUB(j)  (1280 + 64 * (j))
#define XB_XGEN(j)  (2304 + 64 * (j))
#define XB_TOP      3328
#define XB_TOPGEN   3392
#define XCD_BAR_WORDS 3456
#define XB_SPIN_CAP (1u << 18)
#define LAS __attribute__((address_space(3)))

__device__ __forceinline__ unsigned xb_ld(unsigned* p)              { return __hip_atomic_load(p, __ATOMIC_RELAXED, __HIP_MEMORY_SCOPE_AGENT); }
__device__ __forceinline__ unsigned xb_add(unsigned* p, unsigned v) { return __hip_atomic_fetch_add(p, v, __ATOMIC_RELAXED, __HIP_MEMORY_SCOPE_AGENT); }
__device__ __forceinline__ unsigned xb_xcc_id() { return (unsigned)__builtin_amdgcn_s_getreg((3 << 11) | 20) & 0xFu; }
#define XB_SPIN(cond, bar) do { unsigned _sp = 0; while (cond) { __builtin_amdgcn_s_sleep(1); \
    if ((++_sp & 255u) == 0u) { if (xb_ld(&(bar)[XB_TMO])) break; if (_sp > XB_SPIN_CAP) { atomicAdd(&(bar)[XB_TMO], 1u); break; } } } } while (0)

struct XcdBarrier {
    unsigned* bar; unsigned x;
    volatile LAS unsigned* st;
};

__device__ __forceinline__ XcdBarrier xcd_barrier_post(unsigned* bar, volatile LAS unsigned* st) {
    XcdBarrier b; b.bar = bar; b.x = xb_xcc_id(); b.st = st;
    if (threadIdx.x == 0) (void)xb_add(&bar[XB_XCNT(b.x)], 1u);
    return b;
}
__device__ __forceinline__ void xcd_barrier_complete(unsigned* bar, unsigned x, unsigned& nloc, unsigned& nx) {
    const unsigned G = gdim() * gridDim.y * gridDim.z;
    unsigned sum, cnt, mine, sp = 0u;
    for (;;) {
        sum = 0u; cnt = 0u; mine = 0u;
#pragma unroll
        for (unsigned j = 0; j < 16; ++j) { const unsigned c = xb_ld(&bar[XB_XCNT(j)]); sum += c; cnt += (c > 0u) ? 1u : 0u; mine = (j == x) ? c : mine; }
        if (sum == G) break;
        __builtin_amdgcn_s_sleep(1);
        if ((++sp & 255u) == 0u) { if (xb_ld(&bar[XB_TMO])) break; if (sp > XB_SPIN_CAP) { atomicAdd(&bar[XB_TMO], 1u); break; } }
    }
    nloc = mine > 0u ? mine : 1u; nx = cnt > 0u ? cnt : 1u;
}

__device__ __forceinline__ void xcd_barrier(const XcdBarrier& b) {
    asm volatile("s_waitcnt vmcnt(0)" ::: "memory");
    __syncthreads();
    if (threadIdx.x == 0) {
        unsigned* bar = b.bar;
        __builtin_amdgcn_s_waitcnt(0);
        unsigned nloc = b.st[0], nx = b.st[1];
        if (nloc == 0u) { xcd_barrier_complete(bar, b.x, nloc, nx); b.st[0] = nloc; b.st[1] = nx; }
        const unsigned old = xb_add(&bar[XB_XSUB(b.x)], 1u);
        const unsigned gen = old / nloc;
        if (old + 1u == (gen + 1u) * nloc) {
            __builtin_amdgcn_fence(__ATOMIC_RELEASE, "agent");
            asm volatile("s_waitcnt vmcnt(0)" ::: "memory");
            const unsigned og = xb_add(&bar[XB_TOP], 1u);
            const unsigned tg = og / nx;
            if (og + 1u == (tg + 1u) * nx) xb_add(&bar[XB_TOPGEN], 1u);
            else XB_SPIN(xb_ld(&bar[XB_TOPGEN]) == tg, bar);
            __builtin_amdgcn_fence(__ATOMIC_ACQUIRE, "agent");
            xb_add(&bar[XB_XGEN(b.x)], 1u);
            asm volatile("s_waitcnt vmcnt(0)" ::: "memory");
        } else {
            XB_SPIN(xb_ld(&bar[XB_XGEN(b.x)]) == gen, bar);
            __builtin_amdgcn_fence(__ATOMIC_ACQUIRE, "agent");
            asm volatile("s_waitcnt vmcnt(0)" ::: "memory");
        }
    }
    __syncthreads();
}


constexpr int PH_PER_GRP = 4 * 9 + 1;
constexpr int NPHASE = 1 + NGRP * PH_PER_GRP;

#ifndef PROBE_K
#define PROBE_K (-1)
#endif
DI void run_phase(const Params& p, int ph, char* lds, int rep = 0) {
    if (ph == 0) { phase_prologue(p, lds); return; }
    const int q = ph - 1, grp = q / PH_PER_GRP, r = q % PH_PER_GRP;
    if (r == 36) { phase_norm(p, grp, p.in[I_NFIN], 2); return; }
    const int layer = r / 9, k = r % 9;
    switch (k) {
        case 0: phase_norm(p, grp, p.in[I_NMIX] + layer * DM, layer == 0 ? 0 : 1); break;
        case 1: phase_in(p, layer, lds, rep == 1); break;
        case 2: phase_mix(p, layer, grp * 4 + layer + 20 * rep, lds, rep == 1); break;
        case 3: phase_glu(p, layer, lds); break;
        case 4: phase_merge(p, layer, lds); break;
        case 5: phase_resid(p, grp, (const bf16_t*)(p.ws + OFF_M), DM, wts(p, layer) + WO, layer == 0, lds); break;
        case 6: phase_norm(p, grp, p.in[I_NFFN] + layer * DM, 1); break;
        case 7: phase_ffn1(p, layer, lds); break;
        default: phase_resid(p, grp, (const bf16_t*)(p.ws + OFF_F), DFF, wts(p, layer) + WFO, false, lds); break;
    }
}

__global__ void __launch_bounds__(256, 2) mega(Params p, int only) {
    __shared__ __attribute__((aligned(16))) char lds[LDS_BYTES];
#if MULTI_LAUNCH
    if (only >= 0) { run_phase(p, only, lds); return; }
#endif
    cg::grid_group grid = cg::this_grid();
    __shared__ uint4 xb_words;
    if (threadIdx.x == 0) xb_words = make_uint4(0u, 0u, 0u, 0u);
    __syncthreads();
    XcdBarrier xb = xcd_barrier_post((unsigned*)(p.ws + OFF_BAR), (volatile LAS unsigned*)&xb_words);
    for (int ph = 0; ph < NPHASE; ++ph) {
        run_phase(p, ph, lds);
        if (ph + 1 < NPHASE) { if (ph == 0) grid.sync(); else xcd_barrier(xb); }
        if (PROBE_K == 100) xcd_barrier(xb);
        if (PROBE_K >= 0 && PROBE_K < 9 && ph > 0 && ((ph - 1) % PH_PER_GRP) < 36 && (((ph - 1) % PH_PER_GRP) % 9) == PROBE_K) { run_phase(p, ph, lds, 1); xcd_barrier(xb); }
    }
}

extern "C" void kernel_launch(void* const* d_in, const int* in_sizes, int n_in, void* d_out, int out_size, void* d_ws, size_t ws_size, hipStream_t stream) {
    (void)in_sizes; (void)n_in; (void)out_size;
    static int grid_blocks = 0;
    if (!grid_blocks) {
        int dev = 0, cus = 0, per_cu = 0;
        hipGetDevice(&dev);
        hipDeviceGetAttribute(&cus, hipDeviceAttributeMultiprocessorCount, dev);
        hipOccupancyMaxActiveBlocksPerMultiprocessor(&per_cu, mega, 256, 0);
        if (per_cu < 1) per_cu = 1;
        if (per_cu > 2) per_cu = 2;
        grid_blocks = cus * per_cu;
    }
    if (ws_size < WS_END) { fprintf(stderr, "workspace too small: %zu < %zu\n", ws_size, (size_t)WS_END); return; }
    Params p{};
    for (int i = 0; i < 26; ++i) p.in[i] = (const float*)d_in[i];
    p.out = (float*)d_out; p.ws = (char*)d_ws;
    hipMemsetAsync((char*)d_ws + OFF_BAR, 0, XCD_BAR_WORDS * sizeof(unsigned), stream);
#if MULTI_LAUNCH
    for (int ph = 0; ph < NPHASE; ++ph) mega<<<dim3(grid_blocks), dim3(256), 0, stream>>>(p, ph);
#else
    int only = -1;
    void* args[] = {&p, &only};
    hipError_t e = hipLaunchCooperativeKernel((void*)mega, dim3(grid_blocks), dim3(256), args, 0, stream);
    if (e != hipSuccess) fprintf(stderr, "cooperative launch failed: %s (grid %d)\n", hipGetErrorString(e), grid_blocks);
#endif
}
```

```cpp
#include <hip/hip_runtime.h>
#include <hip/hip_cooperative_groups.h>
#include <cstdio>
#include <cstdint>
namespace cg = cooperative_groups;

#ifndef MULTI_LAUNCH
#define MULTI_LAUNCH 0
#endif

#define DI __device__ __forceinline__
typedef unsigned short bf16_t;
typedef __bf16 bf16v2 __attribute__((ext_vector_type(2)));
typedef float f32x2 __attribute__((ext_vector_type(2)));
typedef short bf16x8 __attribute__((ext_vector_type(8)));
typedef short s16x4 __attribute__((ext_vector_type(4)));
typedef float f32x4 __attribute__((ext_vector_type(4)));
typedef float f32x16 __attribute__((ext_vector_type(16)));
typedef unsigned u32x4 __attribute__((ext_vector_type(4)));
typedef unsigned u32x2 __attribute__((ext_vector_type(2)));

constexpr int DM = 1024, SL = 2048, NSEQ = 40, G = 8, NGRP = NSEQ / G, TG = G * SL;
constexpr int INW = 4352, NIN = INW + 4096, DFF = 2816;
constexpr float EPS = 1e-6f;
constexpr float LOG2E = 1.4426950408889634f;

constexpr size_t WING = 0;
constexpr size_t WB = 8650752;
constexpr size_t WO = WB + 2097152;
constexpr size_t WFI = WO + 1048576;
constexpr size_t WFO = WFI + 5767168;
constexpr size_t WGLU = WFO + 2883584;
constexpr size_t LW = WGLU + 262144;

constexpr size_t OFF_W = 0;
constexpr size_t OFF_TAB = OFF_W + 4 * LW * 2;
constexpr size_t OFF_COSA = OFF_TAB, OFF_SINA = OFF_TAB + 262144, OFF_COSD = OFF_TAB + 2 * 262144, OFF_SIND = OFF_TAB + 3 * 262144;
constexpr size_t OFF_BIAS = OFF_TAB + 1048576;
constexpr size_t OFF_LAM = OFF_BIAS + 65536;
constexpr size_t OFF_QCNT = OFF_LAM + 256;
constexpr size_t OFF_BAR = OFF_TAB + 1048576 + 131072;
constexpr size_t OFF_H = OFF_TAB + 2097152;
constexpr size_t OFF_U = OFF_H + (size_t)TG * 1024 * 2;
constexpr size_t OFF_GATE = OFF_U + (size_t)TG * INW * 2;
constexpr size_t OFF_VTA = OFF_GATE + (size_t)TG * 4096 * 2;
constexpr size_t OFF_VTC = OFF_VTA + (size_t)TG * 128 * 2;
constexpr size_t OFF_VTD = OFF_VTC + (size_t)TG * 512 * 2;
constexpr size_t OFF_O = OFF_VTD + (size_t)TG * 512 * 2;
constexpr size_t OFF_YF = OFF_O + (size_t)4 * TG * 512 * 2;
constexpr size_t OFF_YB = OFF_YF + (size_t)TG * 512 * 2;
constexpr size_t OFF_DT = OFF_YB + (size_t)TG * 512 * 2;
constexpr size_t WS_END = OFF_DT + (size_t)2 * TG * 512 * 2;
constexpr size_t OFF_M = OFF_U;
constexpr size_t OFF_F = OFF_U;

struct Params { const float* in[26]; float* out; char* ws; };

enum { I_XP = 0, I_XS, I_NMIX, I_WIN, I_QG, I_KG, I_SARE, I_SAIM, I_SLDT, I_SBRE, I_SBIM, I_SCRE, I_SCIM, I_SD, I_SWGLU, I_SBGLU,
       I_DLAM, I_DSUB, I_REL, I_WGATE, I_WBR, I_WOUT, I_NFFN, I_WFI, I_WFO, I_NFIN };

constexpr int LDS_BYTES = 71680;
constexpr int AROWB = 144;
constexpr int ROWB = 128;
constexpr int GT_BYTES = 128 * ROWB;

DI int bidx() { int b = blockIdx.x; asm volatile("" : "+s"(b)); return b; }
DI int gdim() { int g = gridDim.x; asm volatile("" : "+s"(g)); return g; }
DI int tidx() { int t = threadIdx.x; asm volatile("" : "+v"(t)); return t; }
DI unsigned pk2(float a, float b) { f32x2 v = {a, b}; bf16v2 r = __builtin_convertvector(v, bf16v2); return __builtin_bit_cast(unsigned, r); }
DI float bf2f(bf16_t v) { return __uint_as_float(((unsigned)v) << 16); }
DI float bflo(unsigned w) { return __uint_as_float(w << 16); }
DI float bfhi(unsigned w) { return __uint_as_float(w & 0xffff0000u); }
DI float sigmoidf_(float x) { return __builtin_amdgcn_rcpf(1.0f + __builtin_amdgcn_exp2f(-LOG2E * x)); }
DI float wave_sum(float v) { v += __shfl_xor(v, 32); v += __shfl_xor(v, 16); v += __shfl_xor(v, 8); v += __shfl_xor(v, 4); v += __shfl_xor(v, 2); v += __shfl_xor(v, 1); return v; }
DI bf16_t* wts(const Params& p, int layer) { return (bf16_t*)(p.ws + OFF_W) + (size_t)layer * LW; }
#define MFMA16(a, b, c) __builtin_amdgcn_mfma_f32_16x16x32_bf16((a), (b), (c), 0, 0, 0)
#define MFMA32(a, b, c) __builtin_amdgcn_mfma_f32_32x32x16_bf16((a), (b), (c), 0, 0, 0)

template <bool SWAP, int BMAP>
DI void gemm_compute(const char* cur, int aoff, int boff, int sw, f32x4 (&acc)[4][4]) {
#pragma unroll
    for (int ks = 0; ks < 2; ++ks) {
        bf16x8 af[4], bfr[4];
        const int so = sw ^ (ks * 64);
#pragma unroll
        for (int m = 0; m < 4; ++m) af[m] = *(const bf16x8*)(cur + aoff + m * 16 * ROWB + so);
#pragma unroll
        for (int n = 0; n < 4; ++n) bfr[n] = *(const bf16x8*)(cur + boff + (BMAP ? ((n >> 1) * 64 + (n & 1) * 16) : n * 16) * ROWB + so);
#pragma unroll
        for (int m = 0; m < 4; ++m)
#pragma unroll
            for (int n = 0; n < 4; ++n) acc[m][n] = SWAP ? MFMA16(bfr[n], af[m], acc[m][n]) : MFMA16(af[m], bfr[n], acc[m][n]);
    }
}
#define GLOAD(RA, RB, KT) { _Pragma("unroll") for (int i_ = 0; i_ < 4; ++i_) { \
    const char* ua_ = Ab + (size_t)(((32 * i_) * lda + (KT) * 64) * 2); const char* ub_ = Bb + (size_t)(((32 * i_) * ldb + (KT) * 64) * 2); \
    RA[i_] = *(const u32x4*)(ua_ + avoff); RB[i_] = *(const u32x4*)(ub_ + bvoff); } }
#define LSTORE(RA, RB, ST) { _Pragma("unroll") for (int i_ = 0; i_ < 4; ++i_) { *(u32x4*)(lds + (ST) * (2 * GT_BYTES) + soff + 32 * i_ * ROWB) = RA[i_]; *(u32x4*)(lds + (ST) * (2 * GT_BYTES) + GT_BYTES + soff + 32 * i_ * ROWB) = RB[i_]; } }
template <bool SWAP, int BMAP = 0, bool DEEP = true>
DI void gemm128(const bf16_t* __restrict__ A, int lda, const bf16_t* __restrict__ B, int ldb, int K, f32x4 (&acc)[4][4], char* lds) {
    const int tid = tidx(), lane = tid & 63, w = tid >> 6, wr = w >> 1, wc = w & 1;
    const int srow = tid >> 3, scol = tid & 7;
    const char* Ab = (const char*)A; const char* Bb = (const char*)B;
    const unsigned avoff = (unsigned)(srow * lda + scol * 8) * 2u, bvoff = (unsigned)(srow * ldb + scol * 8) * 2u;
    const int soff = srow * ROWB + ((scol ^ ((srow >> 1) & 7)) << 4);
    const int nk = K >> 6;
    const int aoff = (wr * 64 + (lane & 15)) * ROWB;
    const int boff = GT_BYTES + ((BMAP ? wc * 32 : wc * 64) + (lane & 15)) * ROWB;
    const int sw = ((lane >> 4) ^ ((lane & 15) >> 1)) << 4;
    u32x4 ra0[4], rb0[4];
    GLOAD(ra0, rb0, 0);
    LSTORE(ra0, rb0, 0);
    if (DEEP) {
        u32x4 ra1[4], rb1[4];
        GLOAD(ra1, rb1, 1);
        __syncthreads();
        for (int kt = 0; kt < nk; kt += 2) {
            { const int k2 = kt + 2 < nk ? kt + 2 : nk - 1; GLOAD(ra0, rb0, k2); }
            gemm_compute<SWAP, BMAP>(lds, aoff, boff, sw, acc);
            LSTORE(ra1, rb1, 1);
            __syncthreads();
            { const int k3 = kt + 3 < nk ? kt + 3 : nk - 1; GLOAD(ra1, rb1, k3); }
            gemm_compute<SWAP, BMAP>(lds + 2 * GT_BYTES, aoff, boff, sw, acc);
            LSTORE(ra0, rb0, 0);
            __syncthreads();
        }
    } else {
        __syncthreads();
        for (int kt = 0; kt < nk; ++kt) {
            const bool more = (kt + 1 < nk);
            if (more) GLOAD(ra0, rb0, kt + 1);
            gemm_compute<SWAP, BMAP>(lds + (kt & 1) * (2 * GT_BYTES), aoff, boff, sw, acc);
            if (more) { if (kt & 1) { LSTORE(ra0, rb0, 0); } else { LSTORE(ra0, rb0, 1); } }
            __syncthreads();
        }
    }
}

struct GemmR { u32x4 a[4], b[4]; };
DI void prime_k0(const bf16_t* A, int lda, const bf16_t* B, int ldb, GemmR& g) {
    const int tid = tidx(), srow = tid >> 3, scol = tid & 7;
    const char* Ab = (const char*)A; const char* Bb = (const char*)B;
    const unsigned avoff = (unsigned)(srow * lda + scol * 8) * 2u, bvoff = (unsigned)(srow * ldb + scol * 8) * 2u;
    GLOAD(g.a, g.b, 0);
}
template <bool SWAP, int BMAP = 0>
DI void gemm128pre(const bf16_t* __restrict__ A, int lda, const bf16_t* __restrict__ B, int ldb, int K, GemmR& pre, f32x4 (&acc)[4][4], char* lds) {
    const int tid = tidx(), lane = tid & 63, w = tid >> 6, wr = w >> 1, wc = w & 1;
    const int srow = tid >> 3, scol = tid & 7;
    const char* Ab = (const char*)A; const char* Bb = (const char*)B;
    const unsigned avoff = (unsigned)(srow * lda + scol * 8) * 2u, bvoff = (unsigned)(srow * ldb + scol * 8) * 2u;
    const int soff = srow * ROWB + ((scol ^ ((srow >> 1) & 7)) << 4);
    const int nk = K >> 6;
    const int aoff = (wr * 64 + (lane & 15)) * ROWB;
    const int boff = GT_BYTES + ((BMAP ? wc * 32 : wc * 64) + (lane & 15)) * ROWB;
    const int sw = ((lane >> 4) ^ ((lane & 15) >> 1)) << 4;
    u32x4 ra1[4], rb1[4];
    LSTORE(pre.a, pre.b, 0);
    GLOAD(ra1, rb1, 1);
    __syncthreads();
    for (int kt = 0; kt < nk; kt += 2) {
        { const int k2 = kt + 2 < nk ? kt + 2 : nk - 1; GLOAD(pre.a, pre.b, k2); }
        gemm_compute<SWAP, BMAP>(lds, aoff, boff, sw, acc);
        LSTORE(ra1, rb1, 1);
        __syncthreads();
        { const int k3 = kt + 3 < nk ? kt + 3 : nk - 1; GLOAD(ra1, rb1, k3); }
        gemm_compute<SWAP, BMAP>(lds + 2 * GT_BYTES, aoff, boff, sw, acc);
        LSTORE(pre.a, pre.b, 0);
        __syncthreads();
    }
}

struct TileIter { int per, SM, SN, nSn, sbase, len, q, nslot; };
DI void ti_init(TileIter& it, int NTm, int NTn, int SM, int SN) {
    const int x = bidx() & 7;
    it.nslot = (gdim() - x + 7) >> 3; it.per = SM * SN; it.SM = SM; it.SN = SN; it.nSn = NTn / SN;
    const int nS = (NTm / SM) * it.nSn;
    it.sbase = x * (nS >> 3); it.len = (nS >> 3) * it.per; it.q = bidx() >> 3;
}
DI bool ti_next(TileIter& it, int& tm, int& tn) {
    if (it.q >= it.len) return false;
    const int j = it.q / it.per, w = it.q % it.per, S = it.sbase + j, sm = S / it.nSn, sn = S % it.nSn;
    tm = sm * it.SM + (w % it.SM); tn = sn * it.SN + (w / it.SM);
    it.q += it.nslot;
    return true;
}

struct GemmRegs { u32x4 a0[4], b0[4], a1[4], b1[4]; };
typedef const __attribute__((address_space(1))) char* gptr_t;
typedef const __attribute__((address_space(1))) u32x4* gvec_t;
DI gptr_t uptr(const void* q) {
    const size_t v = (size_t)q;
    const unsigned lo = __builtin_amdgcn_readfirstlane((unsigned)v), hi = __builtin_amdgcn_readfirstlane((unsigned)(v >> 32));
    return (gptr_t)(((size_t)hi << 32) | lo);
}
#define GLOADP(RA, RB, PA, PB, KT) { _Pragma("unroll") for (int i_ = 0; i_ < 4; ++i_) { \
    gptr_t ua_ = (PA) + (size_t)(((32 * i_) * lda + (KT) * 64) * 2); gptr_t ub_ = (PB) + (size_t)(((32 * i_) * ldb + (KT) * 64) * 2); \
    RA[i_] = *(gvec_t)(ua_ + avoff); RB[i_] = *(gvec_t)(ub_ + bvoff); } }
DI void gemm_prime(const bf16_t* A, int lda, const bf16_t* B, int ldb, GemmRegs& g) {
    const int tid = tidx(), srow = tid >> 3, scol = tid & 7;
    const unsigned avoff = (unsigned)(srow * lda + scol * 8) * 2u, bvoff = (unsigned)(srow * ldb + scol * 8) * 2u;
    gptr_t Ab = uptr(A); gptr_t Bb = uptr(B);
    GLOADP(g.a0, g.b0, Ab, Bb, 0);
    GLOADP(g.a1, g.b1, Ab, Bb, 1);
}
template <bool SWAP, int BMAP = 0>
DI void gemm_stream(const bf16_t* A, const bf16_t* B, const bf16_t* nA, const bf16_t* nB, int lda, int ldb, int K, GemmRegs& g, f32x4 (&acc)[4][4], char* lds) {
    const int tid = tidx(), lane = tid & 63, w = tid >> 6, wr = w >> 1, wc = w & 1;
    const int srow = tid >> 3, scol = tid & 7;
    const unsigned avoff = (unsigned)(srow * lda + scol * 8) * 2u, bvoff = (unsigned)(srow * ldb + scol * 8) * 2u;
    gptr_t Ab = uptr(A); gptr_t Bb = uptr(B); gptr_t nAb = uptr(nA); gptr_t nBb = uptr(nB);
    const int soff = srow * ROWB + ((scol ^ ((srow >> 1) & 7)) << 4);
    const int nk = K >> 6;
    const int aoff = (wr * 64 + (lane & 15)) * ROWB;
    const int boff = GT_BYTES + ((BMAP ? wc * 32 : wc * 64) + (lane & 15)) * ROWB;
    const int sw = ((lane >> 4) ^ ((lane & 15) >> 1)) << 4;
    LSTORE(g.a0, g.b0, 0);
    __syncthreads();
    for (int kt = 0; kt < nk; kt += 2) {
        const bool last = kt + 2 >= nk;
        gptr_t pa = last ? nAb : Ab; gptr_t pb = last ? nBb : Bb;
        const int k2 = last ? 0 : kt + 2, k3 = last ? 1 : kt + 3;
        GLOADP(g.a0, g.b0, pa, pb, k2);
        gemm_compute<SWAP, BMAP>(lds, aoff, boff, sw, acc);
        LSTORE(g.a1, g.b1, 1);
        __syncthreads();
        GLOADP(g.a1, g.b1, pa, pb, k3);
        gemm_compute<SWAP, BMAP>(lds + 2 * GT_BYTES, aoff, boff, sw, acc);
        if (!last) LSTORE(g.a0, g.b0, 0);
        __syncthreads();
    }
}

DI void zero_acc(f32x4 (&acc)[4][4]) {
#pragma unroll
    for (int m = 0; m < 4; ++m)
#pragma unroll
        for (int n = 0; n < 4; ++n) acc[m][n] = (f32x4){0.f, 0.f, 0.f, 0.f};
}


constexpr int OROW = 272;
constexpr int OROWF = 528;
DI void otile_put(char* lds, int row, int col, unsigned w0, unsigned w1) { u32x2 w; w[0] = w0; w[1] = w1; *(u32x2*)(lds + row * OROW + col * 2) = w; }
DI void otile_flush(char* lds, bf16_t* dst, int ld) {
    const int tid = tidx();
    __syncthreads();
#pragma unroll
    for (int i = 0; i < 8; ++i) {
        const int c = tid + 256 * i, row = c >> 4, ch = c & 15;
        const u32x4 v = *(const u32x4*)(lds + row * OROW + ch * 16);
        *(u32x4*)(dst + (size_t)row * ld + ch * 8) = v;
    }
    __syncthreads();
}

DI void conv_tile(const float* __restrict__ src, bf16_t* __restrict__ dst, int K, int N, int tk, int tn, int drow0, float* tile) {
    const int tid = tidx(), ty = tid >> 4, tx = tid & 15;
#pragma unroll
    for (int i = 0; i < 4; ++i) {
        const int k = ty + 16 * i;
        const f32x4 v = *(const f32x4*)(src + (size_t)(tk * 64 + k) * N + tn * 64 + tx * 4);
        tile[k * 65 + tx * 4 + 0] = v[0]; tile[k * 65 + tx * 4 + 1] = v[1]; tile[k * 65 + tx * 4 + 2] = v[2]; tile[k * 65 + tx * 4 + 3] = v[3];
    }
    __syncthreads();
    const int n = tid >> 2, ks = (tid & 3) * 16;
    u32x4 w0, w1;
#pragma unroll
    for (int j = 0; j < 4; ++j) {
        w0[j] = pk2(tile[(ks + 2 * j) * 65 + n], tile[(ks + 2 * j + 1) * 65 + n]);
        w1[j] = pk2(tile[(ks + 8 + 2 * j) * 65 + n], tile[(ks + 8 + 2 * j + 1) * 65 + n]);
    }
    bf16_t* d = dst + (size_t)(drow0 + n) * K + tk * 64 + ks;
    *(u32x4*)d = w0; *(u32x4*)(d + 8) = w1;
    __syncthreads();
}

DI int t5_bucket(int rel) {
    const int base = rel > 0 ? 16 : 0;
    const int dist = rel < 0 ? -rel : rel;
    int b;
    if (dist < 8) b = dist;
    else {
        const float lr = logf((float)dist / 8.0f) / 2.772588722239781f;
        int lg = 8 + (int)(lr * 8.0f);
        b = lg < 15 ? lg : 15;
    }
    return base + b;
}

DI void phase_prologue(const Params& p, char* lds) {
    float* tile = (float*)lds;
    const int tid = tidx();
    for (int t = bidx(); t < 4 * 5056; t += gdim()) {
        const int layer = t / 5056; int q = t % 5056;
        bf16_t* wl = wts(p, layer);
        const float* src; bf16_t* dst; int K, N, nn;
        if (q < 1088) { src = p.in[I_WIN] + (size_t)layer * 1024 * INW; dst = wl + WING; K = 1024; N = INW; }
        else if ((q -= 1088) < 1024) { const int b = q >> 8; q &= 255; src = p.in[I_WGATE] + (size_t)(layer * 4 + b) * 1024 * 1024; dst = wl + WING + (size_t)(INW + b * 1024) * 1024; K = 1024; N = 1024; }
        else if ((q -= 1024) < 512) { const int b = q >> 7; q &= 127; src = p.in[I_WBR] + (size_t)(layer * 4 + b) * 512 * 1024; dst = wl + WB + (size_t)b * 1024 * 512; K = 512; N = 1024; }
        else if ((q -= 512) < 256) { src = p.in[I_WOUT] + (size_t)layer * 1024 * 1024; dst = wl + WO; K = 1024; N = 1024; }
        else if ((q -= 256) < 1408) { src = p.in[I_WFI] + (size_t)layer * 1024 * 5632; dst = wl + WFI; K = 1024; N = 5632; }
        else if ((q -= 1408) < 704) { src = p.in[I_WFO] + (size_t)layer * DFF * 1024; dst = wl + WFO; K = DFF; N = 1024; }
        else { q -= 704; src = p.in[I_SWGLU] + (size_t)layer * 512 * 512; dst = wl + WGLU; K = 512; N = 512; }
        nn = N >> 6;
        const int tk = q / nn, tn = q % nn;
        int drow0 = tn * 64;
        if (N == 5632) drow0 = tn < 44 ? tn * 128 : (tn - 44) * 128 + 64;
        conv_tile(src, dst, K, N, tk, tn, drow0, tile);
    }
    const int gt = bidx() * 256 + tid, gn = gdim() * 256;
    float* cosA = (float*)(p.ws + OFF_COSA); float* sinA = (float*)(p.ws + OFF_SINA);
    float* cosD = (float*)(p.ws + OFF_COSD); float* sinD = (float*)(p.ws + OFF_SIND);
    for (int i = gt; i < SL * 32; i += gn) {
        const int t = i >> 5, j = i & 31;
        const float invA = exp2f(-(float)(j & 15) * (13.287712379549449f / 16.0f));
        const float angA = (j < 16 ? (float)(t >> 6) : (float)(t & 63)) * invA;
        cosA[i] = cosf(angA); sinA[i] = sinf(angA);
        const float invD = exp2f(-(float)j * (13.287712379549449f / 32.0f));
        const float angD = (float)t * invD;
        cosD[i] = cosf(angD); sinD[i] = sinf(angD);
    }
    float* bias = (float*)(p.ws + OFF_BIAS);
    for (int i = gt; i < 4 * 4096; i += gn) {
        const int h = i >> 12, r = i & 4095;
        float v = 0.f;
        if (r < 4095) v = p.in[I_REL][t5_bucket(r - 2047) * 4 + h] * LOG2E;
        bias[i] = v;
    }
    if (bidx() == 0) {
        if (tid < 4) {
            const float* lv = p.in[I_DLAM] + tid * 256;
            float s1 = 0.f, s2 = 0.f;
            for (int j = 0; j < 64; ++j) { s1 += lv[j] * lv[64 + j]; s2 += lv[128 + j] * lv[192 + j]; }
            const float li = 0.8f - 0.6f * expf(-0.3f * (float)tid);
            float* lam = (float*)(p.ws + OFF_LAM);
            lam[tid] = expf(s1) - expf(s2) + li; lam[4 + tid] = li;
        }
        if (tid < 64) ((int*)(p.ws + OFF_QCNT))[tid] = 0;
    }
}

DI const float* x_in_row(const Params& p, int grp, int row) {
    const int seq = grp * G + (row >> 11), t = row & 2047;
    return seq < 8 ? p.in[I_XP] + ((size_t)seq * SL + t) * DM : p.in[I_XS] + ((size_t)(seq - 8) * SL + t) * DM;
}
DI void phase_norm(const Params& p, int grp, const float* gain, int mode) {
    const int lane = tidx() & 63;
    const int gw = bidx() * 4 + (tidx() >> 6), nw = gdim() * 4;
    bf16_t* hb = (bf16_t*)(p.ws + OFF_H);
    f32x4 gv[4];
#pragma unroll
    for (int i = 0; i < 4; ++i) gv[i] = *(const f32x4*)(gain + lane * 4 + 256 * i);
    for (int row = gw; row < TG; row += nw) {
        float* xo = p.out + ((size_t)grp * TG + row) * DM;
        const float* x = mode == 0 ? x_in_row(p, grp, row) : xo;
        f32x4 v[4]; float ss = 0.f;
#pragma unroll
        for (int i = 0; i < 4; ++i) { v[i] = *(const f32x4*)(x + lane * 4 + 256 * i); ss += v[i][0] * v[i][0] + v[i][1] * v[i][1] + v[i][2] * v[i][2] + v[i][3] * v[i][3]; }
        ss = wave_sum(ss);
        const float rstd = rsqrtf(ss * (1.0f / 1024.0f) + EPS);
#pragma unroll
        for (int i = 0; i < 4; ++i) {
            const f32x4 y = v[i] * rstd * gv[i];
            if (mode == 2) *(f32x4*)(xo + lane * 4 + 256 * i) = y;
            else { u32x2 w; w[0] = pk2(y[0], y[1]); w[1] = pk2(y[2], y[3]); *(u32x2*)(hb + (size_t)row * DM + lane * 4 + 256 * i) = w; }
        }
    }
}

DI void phase_in(const Params& p, int layer, char* lds, bool probe = false) {
    const bf16_t* hb = (const bf16_t*)(p.ws + OFF_H);
    const bf16_t* W = wts(p, layer) + WING;
    bf16_t* ub = (bf16_t*)(p.ws + OFF_U);
    bf16_t* gb = (bf16_t*)(p.ws + OFF_GATE);
    constexpr int NT = NIN / 128;
    const int lane = tidx() & 63, w = tidx() >> 6, wr = w >> 1, wc = w & 1, r16 = lane & 15, q4 = lane >> 4;
    TileIter it; ti_init(it, TG / 128, NT, 8, 6);
    int tm, tn, ntm = 0, ntn = 0;
    bool have = ti_next(it, tm, tn);
    GemmR pre;
    if (have) prime_k0(hb + (size_t)tm * 128 * DM, DM, W + (size_t)(tn * 128) * DM, DM, pre);
    for (; have; tm = ntm, tn = ntn) {
        have = ti_next(it, ntm, ntn);
        const bf16_t* nAt = have ? hb + (size_t)ntm * 128 * DM : hb; const bf16_t* nBt = have ? W + (size_t)(ntn * 128) * DM : W;
        const int c0 = tn * 128;
        const bool isV = (c0 == 640) || (c0 >= 2304 && c0 < 2816) || (c0 >= 3328 && c0 < 3840);
        f32x4 acc[4][4]; zero_acc(acc);
        const int cb = c0 + wc * 64;
        if (isV) {
            gemm128pre<false>(hb + (size_t)tm * 128 * DM, DM, W + (size_t)c0 * DM, DM, DM, pre, acc, lds);
            prime_k0(nAt, DM, nBt, DM, pre);
            bf16_t* vt; int cl, DV, NH;
            if (cb < 768) { vt = (bf16_t*)(p.ws + OFF_VTA); cl = cb - 640; DV = 64; NH = 2; }
            else if (cb < 2816) { vt = (bf16_t*)(p.ws + OFF_VTC); cl = cb - 2304; DV = 128; NH = 4; }
            else { vt = (bf16_t*)(p.ws + OFF_VTD); cl = cb - 3328; DV = 128; NH = 4; }
#pragma unroll
            for (int m = 0; m < 4; ++m)
#pragma unroll
                for (int n = 0; n < 4; ++n)
                    otile_put(lds, wc * 64 + n * 16 + r16, wr * 64 + m * 16 + q4 * 4, pk2(acc[m][n][0], acc[m][n][1]), pk2(acc[m][n][2], acc[m][n][3]));
            otile_flush(lds, vt + ((size_t)((tm * 128) >> 11) * NH * DV + (cl - wc * 64)) * SL + ((tm * 128) & 2047), SL);
        } else {
            gemm128pre<true>(hb + (size_t)tm * 128 * DM, DM, W + (size_t)c0 * DM, DM, DM, pre, acc, lds);
            bool donorm = false, dosig = false; int rot = 0; float scale = 1.f; const float* gain = nullptr;
            bf16_t* dst = ub; int ld = INW, dcol = cb;
            if (cb < 512) { donorm = true; rot = 1; scale = 0.125f * LOG2E; gain = p.in[I_QG] + layer * 64; }
            else if (cb < 640) { donorm = true; rot = 1; gain = p.in[I_KG] + layer * 64; }
            else if (cb < 1280) { }
            else if (cb < 1792) { scale = 0.125f * LOG2E; }
            else if (cb < 2816) { }
            else if (cb < 3072) { rot = 2; scale = 0.125f; }
            else if (cb < 3328) { rot = 2; }
            else if (cb < INW) { }
            else { dosig = true; dst = gb; ld = 4096; dcol = cb - INW; }
            float gl[4][4];
            if (donorm) {
#pragma unroll
                for (int n = 0; n < 4; ++n) { const f32x4 g4 = *(const f32x4*)(gain + n * 16 + q4 * 4); gl[n][0] = g4[0]; gl[n][1] = g4[1]; gl[n][2] = g4[2]; gl[n][3] = g4[3]; }
            }
            const float* ct = (const float*)(p.ws + (rot == 2 ? OFF_COSD : OFF_COSA));
            const float* sn = (const float*)(p.ws + (rot == 2 ? OFF_SIND : OFF_SINA));
#pragma unroll
            for (int m = 0; m < 4; ++m) {
                asm volatile("" ::: "memory");
                const int row = tm * 128 + wr * 64 + m * 16 + r16, tpos = row & 2047;
                float v[4][4];
#pragma unroll
                for (int n = 0; n < 4; ++n)
#pragma unroll
                    for (int i = 0; i < 4; ++i) v[n][i] = acc[m][n][i];
                if (donorm) {
                    float ss = 0.f;
#pragma unroll
                    for (int n = 0; n < 4; ++n)
#pragma unroll
                        for (int i = 0; i < 4; ++i) ss += v[n][i] * v[n][i];
                    ss += __shfl_xor(ss, 16); ss += __shfl_xor(ss, 32);
                    const float rstd = rsqrtf(ss * (1.0f / 64.0f) + EPS);
#pragma unroll
                    for (int n = 0; n < 4; ++n)
#pragma unroll
                        for (int i = 0; i < 4; ++i) v[n][i] = v[n][i] * rstd * gl[n][i];
                }
                if (rot) {
#pragma unroll
                    for (int n = 0; n < 2; ++n) {
                        const f32x4 c4 = *(const f32x4*)(ct + tpos * 32 + n * 16 + q4 * 4), s4 = *(const f32x4*)(sn + tpos * 32 + n * 16 + q4 * 4);
#pragma unroll
                        for (int i = 0; i < 4; ++i) { const float x1 = v[n][i], x2 = v[n + 2][i]; v[n][i] = x1 * c4[i] - x2 * s4[i]; v[n + 2][i] = x2 * c4[i] + x1 * s4[i]; }
                    }
                }
#pragma unroll
                for (int n = 0; n < 4; ++n) {
                    float o0, o1, o2, o3;
                    if (dosig) { o0 = sigmoidf_(v[n][0]); o1 = sigmoidf_(v[n][1]); o2 = sigmoidf_(v[n][2]); o3 = sigmoidf_(v[n][3]); }
                    else { o0 = v[n][0] * scale; o1 = v[n][1] * scale; o2 = v[n][2] * scale; o3 = v[n][3] * scale; }
                    otile_put(lds, wr * 64 + m * 16 + r16, wc * 64 + n * 16 + q4 * 4, pk2(o0, o1), pk2(o2, o3));
                }
            }
            prime_k0(nAt, DM, nBt, DM, pre);
            otile_flush(lds, dst + (size_t)(tm * 128) * ld + (dcol - wc * 64), ld);
        }
    }
}

template <int DV, int MODE>
DI void attn_task(const Params& p, int task, char* lds) {
    constexpr int NDT = DV / 32;
    constexpr int STG = 64 * AROWB + DV * AROWB;
    const int tid = tidx(), lane = tid & 63, wave = tid >> 6, r = lane & 31, h = lane >> 5;
    const bf16_t* ub = (const bf16_t*)(p.ws + OFF_U);
    const int qt = task & 15; const int rest = task >> 4;
    int seq, head, map = 0, qcol, kcol; const bf16_t* vt;
    if (MODE == 0) { head = rest & 7; seq = rest >> 3; qcol = head * 64; kcol = 512 + (head >> 2) * 64; vt = (const bf16_t*)(p.ws + OFF_VTA) + (size_t)(seq * 2 + (head >> 2)) * 64 * SL; }
    else if (MODE == 1) { map = rest & 1; head = (rest >> 1) & 3; seq = rest >> 3; qcol = 1280 + head * 128 + map * 64; kcol = 1792 + head * 128 + map * 64; vt = (const bf16_t*)(p.ws + OFF_VTC) + (size_t)(seq * 4 + head) * 128 * SL; }
    else { head = rest & 3; seq = rest >> 2; qcol = 2816 + head * 64; kcol = 3072 + head * 64; vt = (const bf16_t*)(p.ws + OFF_VTD) + (size_t)(seq * 4 + head) * 128 * SL; }
    const int qpos = qt * 128 + wave * 32 + r;
    const bf16_t* qptr = ub + ((size_t)seq * SL + qpos) * INW + qcol;
    bf16x8 qf[4];
#pragma unroll
    for (int s = 0; s < 4; ++s) qf[s] = *(const bf16x8*)(qptr + 16 * s + 8 * h);
    const bf16_t* kbase = ub + (size_t)seq * SL * INW + kcol;
    float* sBias = (float*)(lds + 2 * STG);
    if (MODE == 1) { const float* bl = (const float*)(p.ws + OFF_BIAS) + head * 4096; for (int i = tid; i < 4096; i += 256) sBias[i] = bl[i]; }
    float lgam = 0.f;
    if (MODE == 2) lgam = log2f(1.0f - exp2f(-5.0f - (float)head));
    f32x16 o[NDT];
#pragma unroll
    for (int d = 0; d < NDT; ++d)
#pragma unroll
        for (int i = 0; i < 16; ++i) o[d][i] = 0.f;
    float lsum = 0.f;
    const int srow = tid >> 3, sc = tid & 7;
    const bf16_t* kg = kbase + (size_t)srow * INW + sc * 8;
    const bf16_t* vg = vt + (size_t)srow * SL + sc * 8;
    u32x4 rk[2], rv[NDT];
#pragma unroll
    for (int i = 0; i < 2; ++i) rk[i] = *(const u32x4*)(kg + (size_t)(32 * i) * INW);
#pragma unroll
    for (int i = 0; i < NDT; ++i) rv[i] = *(const u32x4*)(vg + (size_t)(32 * i) * SL);
    const int soff = srow * AROWB + sc * 16;
#pragma unroll
    for (int i = 0; i < 2; ++i) *(u32x4*)(lds + soff + 32 * i * AROWB) = rk[i];
#pragma unroll
    for (int i = 0; i < NDT; ++i) *(u32x4*)(lds + 64 * AROWB + soff + 32 * i * AROWB) = rv[i];
    __syncthreads();
    for (int kt = 0; kt < SL / 64; ++kt) {
        const char* cur = lds + (kt & 1) * STG;
        char* nxt = lds + ((kt + 1) & 1) * STG;
        const bool more = kt + 1 < SL / 64;
        const int kv0 = kt * 64;
        if (more) {
            kg += (size_t)64 * INW; vg += 64;
#pragma unroll
            for (int i = 0; i < 2; ++i) rk[i] = *(const u32x4*)(kg + (size_t)(32 * i) * INW);
#pragma unroll
            for (int i = 0; i < NDT; ++i) rv[i] = *(const u32x4*)(vg + (size_t)(32 * i) * SL);
        }
        f32x16 st[2];
#pragma unroll
        for (int kk = 0; kk < 2; ++kk) {
#pragma unroll
            for (int i = 0; i < 16; ++i) st[kk][i] = 0.f;
#pragma unroll
            for (int s = 0; s < 4; ++s) {
                const bf16x8 kf = *(const bf16x8*)(cur + (32 * kk + r) * AROWB + (16 * s + 8 * h) * 2);
                st[kk] = MFMA32(kf, qf[s], st[kk]);
            }
        }
        const int qw0 = qt * 128 + wave * 32;
        const bool farL = MODE == 1 && (kv0 + 63 - qw0) <= -128, farR = MODE == 1 && (kv0 - (qw0 + 31)) >= 128;
        if (MODE == 1 && (farL || farR)) {
            const float bc = farL ? sBias[0] : sBias[4094];
#pragma unroll
            for (int kk = 0; kk < 2; ++kk)
#pragma unroll
                for (int i = 0; i < 16; ++i) { const float pv = __builtin_amdgcn_exp2f(st[kk][i] + bc); lsum += pv; st[kk][i] = pv; }
        } else
#pragma unroll
        for (int kk = 0; kk < 2; ++kk)
#pragma unroll
            for (int i = 0; i < 16; ++i) {
                const int m = kv0 + 32 * kk + (i & 3) + 8 * (i >> 2) + 4 * h;
                float pv;
                if (MODE == 0) pv = __builtin_amdgcn_exp2f(st[kk][i]);
                else if (MODE == 1) pv = __builtin_amdgcn_exp2f(st[kk][i] + sBias[m - qpos + 2047]);
                else pv = st[kk][i] * __builtin_amdgcn_exp2f(lgam * fabsf((float)(qpos - m)));
                if (MODE != 2) lsum += pv;
                st[kk][i] = pv;
            }
        const char* sV = cur + 64 * AROWB;
#pragma unroll
        for (int kk = 0; kk < 2; ++kk)
#pragma unroll
            for (int s2 = 0; s2 < 2; ++s2) {
                u32x4 pw;
#pragma unroll
                for (int j = 0; j < 4; ++j) pw[j] = pk2(st[kk][8 * s2 + 2 * j], st[kk][8 * s2 + 2 * j + 1]);
                const bf16x8 pf = __builtin_bit_cast(bf16x8, pw);
#pragma unroll
                for (int d = 0; d < NDT; ++d) {
                    const char* va = sV + (32 * d + r) * AROWB + (32 * kk + 16 * s2 + 4 * h) * 2;
                    const s16x4 lo = *(const s16x4*)va, hi = *(const s16x4*)(va + 16);
                    const bf16x8 vf = __builtin_shufflevector(lo, hi, 0, 1, 2, 3, 4, 5, 6, 7);
                    o[d] = MFMA32(vf, pf, o[d]);
                }
            }
        if (more) {
#pragma unroll
            for (int i = 0; i < 2; ++i) *(u32x4*)(nxt + soff + 32 * i * AROWB) = rk[i];
#pragma unroll
            for (int i = 0; i < NDT; ++i) *(u32x4*)(nxt + 64 * AROWB + soff + 32 * i * AROWB) = rv[i];
        }
        __syncthreads();
    }
    const size_t tok = (size_t)seq * SL + qpos;
    if (MODE != 2) {
        const float ltot = lsum + __shfl_xor(lsum, 32);
        const float inv = __builtin_amdgcn_rcpf(ltot);
        bf16_t* dst = MODE == 0 ? (bf16_t*)(p.ws + OFF_O) + tok * 512 + head * 64
                                : (bf16_t*)(p.ws + OFF_DT) + ((size_t)map * TG + tok) * 512 + head * 128;
        if (DV == 128) {
#pragma unroll
            for (int d = 0; d < NDT; ++d)
#pragma unroll
                for (int a = 0; a < 4; ++a) otile_put(lds, wave * 32 + r, 32 * d + 8 * a + 4 * h, pk2(o[d][4 * a] * inv, o[d][4 * a + 1] * inv), pk2(o[d][4 * a + 2] * inv, o[d][4 * a + 3] * inv));
            otile_flush(lds, (bf16_t*)(p.ws + OFF_DT) + ((size_t)map * TG + (size_t)seq * SL + qt * 128) * 512 + head * 128, 512);
        } else {
#pragma unroll
        for (int d = 0; d < NDT; ++d)
#pragma unroll
            for (int a = 0; a < 4; ++a) {
                u32x2 wv; wv[0] = pk2(o[d][4 * a] * inv, o[d][4 * a + 1] * inv); wv[1] = pk2(o[d][4 * a + 2] * inv, o[d][4 * a + 3] * inv);
                *(u32x2*)(dst + 32 * d + 8 * a + 4 * h) = wv;
            }
        }
    } else {
        float s = 0.f;
#pragma unroll
        for (int d = 0; d < NDT; ++d)
#pragma unroll
            for (int i = 0; i < 16; ++i) s += o[d][i];
        s += __shfl_xor(s, 32);
        const float mu = s * (1.0f / 128.0f);
        float vs = 0.f;
#pragma unroll
        for (int d = 0; d < NDT; ++d)
#pragma unroll
            for (int i = 0; i < 16; ++i) { const float dd = o[d][i] - mu; vs += dd * dd; }
        vs += __shfl_xor(vs, 32);
        const float rstd = rsqrtf(vs * (1.0f / 128.0f) + EPS);
        const bf16_t* gp = ub + tok * INW + 3840 + head * 128;
        bf16_t* dst = (bf16_t*)(p.ws + OFF_O) + ((size_t)3 * TG + tok) * 512 + head * 128;
        u32x2 gwv[NDT][4];
#pragma unroll
        for (int d = 0; d < NDT; ++d)
#pragma unroll
            for (int a = 0; a < 4; ++a) gwv[d][a] = *(const u32x2*)(gp + 32 * d + 8 * a + 4 * h);
#pragma unroll
        for (int d = 0; d < NDT; ++d)
#pragma unroll
            for (int a = 0; a < 4; ++a) {
                const u32x2 gw = gwv[d][a];
                const float g0 = bflo(gw[0]), g1 = bfhi(gw[0]), g2 = bflo(gw[1]), g3 = bfhi(gw[1]);
                const float y0 = (o[d][4 * a] - mu) * rstd * g0 * sigmoidf_(g0), y1 = (o[d][4 * a + 1] - mu) * rstd * g1 * sigmoidf_(g1);
                const float y2 = (o[d][4 * a + 2] - mu) * rstd * g2 * sigmoidf_(g2), y3 = (o[d][4 * a + 3] - mu) * rstd * g3 * sigmoidf_(g3);
                otile_put(lds, wave * 32 + r, 32 * d + 8 * a + 4 * h, pk2(y0, y1), pk2(y2, y3));
            }
        otile_flush(lds, (bf16_t*)(p.ws + OFF_O) + ((size_t)3 * TG + (size_t)seq * SL + qt * 128) * 512 + head * 128, 512);
    }
}

DI void attn_gqa2(const Params& p, int task, char* lds) {
    constexpr int DV = 64, NDT = 2;
    constexpr int STG = 64 * AROWB + DV * AROWB;
    const int tid = tidx(), lane = tid & 63, wave = tid >> 6, r = lane & 31, h = lane >> 5;
    const bf16_t* ub = (const bf16_t*)(p.ws + OFF_U);
    const int qt = task & 7, rest = task >> 3, head = rest & 7, seq = rest >> 3;
    const int qcol = head * 64, kcol = 512 + (head >> 2) * 64;
    const bf16_t* vt = (const bf16_t*)(p.ws + OFF_VTA) + (size_t)(seq * 2 + (head >> 2)) * 64 * SL;
    const int qpos0 = qt * 256 + wave * 64 + r;
    bf16x8 qf[2][4];
#pragma unroll
    for (int qs = 0; qs < 2; ++qs) {
        const bf16_t* qptr = ub + ((size_t)seq * SL + qpos0 + 32 * qs) * INW + qcol;
#pragma unroll
        for (int s = 0; s < 4; ++s) qf[qs][s] = *(const bf16x8*)(qptr + 16 * s + 8 * h);
    }
    const bf16_t* kbase = ub + (size_t)seq * SL * INW + kcol;
    f32x16 o[2][NDT];
#pragma unroll
    for (int qs = 0; qs < 2; ++qs)
#pragma unroll
        for (int d = 0; d < NDT; ++d)
#pragma unroll
            for (int i = 0; i < 16; ++i) o[qs][d][i] = 0.f;
    float lsum[2] = {0.f, 0.f};
    const int srow = tid >> 3, sc = tid & 7;
    const bf16_t* kg = kbase + (size_t)srow * INW + sc * 8;
    const bf16_t* vg = vt + (size_t)srow * SL + sc * 8;
    u32x4 rk[2], rv[NDT];
#pragma unroll
    for (int i = 0; i < 2; ++i) rk[i] = *(const u32x4*)(kg + (size_t)(32 * i) * INW);
#pragma unroll
    for (int i = 0; i < NDT; ++i) rv[i] = *(const u32x4*)(vg + (size_t)(32 * i) * SL);
    const int soff = srow * AROWB + sc * 16;
#pragma unroll
    for (int i = 0; i < 2; ++i) *(u32x4*)(lds + soff + 32 * i * AROWB) = rk[i];
#pragma unroll
    for (int i = 0; i < NDT; ++i) *(u32x4*)(lds + 64 * AROWB + soff + 32 * i * AROWB) = rv[i];
    __syncthreads();
    for (int kt = 0; kt < SL / 64; ++kt) {
        const char* cur = lds + (kt & 1) * STG;
        char* nxt = lds + ((kt + 1) & 1) * STG;
        const bool more = kt + 1 < SL / 64;
        if (more) {
            kg += (size_t)64 * INW; vg += 64;
#pragma unroll
            for (int i = 0; i < 2; ++i) rk[i] = *(const u32x4*)(kg + (size_t)(32 * i) * INW);
#pragma unroll
            for (int i = 0; i < NDT; ++i) rv[i] = *(const u32x4*)(vg + (size_t)(32 * i) * SL);
        }
        f32x16 st[2][2];
#pragma unroll
        for (int kk = 0; kk < 2; ++kk) {
#pragma unroll
            for (int i = 0; i < 16; ++i) { st[0][kk][i] = 0.f; st[1][kk][i] = 0.f; }
#pragma unroll
            for (int s = 0; s < 4; ++s) {
                const bf16x8 kf = *(const bf16x8*)(cur + (32 * kk + r) * AROWB + (16 * s + 8 * h) * 2);
                st[0][kk] = MFMA32(kf, qf[0][s], st[0][kk]);
                st[1][kk] = MFMA32(kf, qf[1][s], st[1][kk]);
            }
        }
#pragma unroll
        for (int qs = 0; qs < 2; ++qs)
#pragma unroll
            for (int kk = 0; kk < 2; ++kk)
#pragma unroll
                for (int i = 0; i < 16; ++i) { const float pv = __builtin_amdgcn_exp2f(st[qs][kk][i]); lsum[qs] += pv; st[qs][kk][i] = pv; }
        const char* sV = cur + 64 * AROWB;
#pragma unroll
        for (int kk = 0; kk < 2; ++kk)
#pragma unroll
            for (int s2 = 0; s2 < 2; ++s2) {
                bf16x8 pf[2];
#pragma unroll
                for (int qs = 0; qs < 2; ++qs) {
                    u32x4 pw;
#pragma unroll
                    for (int j = 0; j < 4; ++j) pw[j] = pk2(st[qs][kk][8 * s2 + 2 * j], st[qs][kk][8 * s2 + 2 * j + 1]);
                    pf[qs] = __builtin_bit_cast(bf16x8, pw);
                }
#pragma unroll
                for (int d = 0; d < NDT; ++d) {
                    const char* va = sV + (32 * d + r) * AROWB + (32 * kk + 16 * s2 + 4 * h) * 2;
                    const s16x4 lo = *(const s16x4*)va, hi = *(const s16x4*)(va + 16);
                    const bf16x8 vf = __builtin_shufflevector(lo, hi, 0, 1, 2, 3, 4, 5, 6, 7);
                    o[0][d] = MFMA32(vf, pf[0], o[0][d]);
                    o[1][d] = MFMA32(vf, pf[1], o[1][d]);
                }
            }
        if (more) {
#pragma unroll
            for (int i = 0; i < 2; ++i) *(u32x4*)(nxt + soff + 32 * i * AROWB) = rk[i];
#pragma unroll
            for (int i = 0; i < NDT; ++i) *(u32x4*)(nxt + 64 * AROWB + soff + 32 * i * AROWB) = rv[i];
        }
        __syncthreads();
    }
#pragma unroll
    for (int qs = 0; qs < 2; ++qs) {
        const size_t tok = (size_t)seq * SL + qpos0 + 32 * qs;
        const float ltot = lsum[qs] + __shfl_xor(lsum[qs], 32);
        const float inv = __builtin_amdgcn_rcpf(ltot);
        bf16_t* dst = (bf16_t*)(p.ws + OFF_O) + tok * 512 + head * 64;
#pragma unroll
        for (int d = 0; d < NDT; ++d)
#pragma unroll
            for (int a = 0; a < 4; ++a) {
                u32x2 wv; wv[0] = pk2(o[qs][d][4 * a] * inv, o[qs][d][4 * a + 1] * inv); wv[1] = pk2(o[qs][d][4 * a + 2] * inv, o[qs][d][4 * a + 3] * inv);
                *(u32x2*)(dst + 32 * d + 8 * a + 4 * h) = wv;
            }
    }
}

DI void tr_read8(unsigned a, s16x4 (&v)[8]) {
    asm volatile("ds_read_b64_tr_b16 %0, %8\n\tds_read_b64_tr_b16 %1, %8 offset:256\n\tds_read_b64_tr_b16 %2, %8 offset:1024\n\tds_read_b64_tr_b16 %3, %8 offset:1280\n\t"
                 "ds_read_b64_tr_b16 %4, %8 offset:2048\n\tds_read_b64_tr_b16 %5, %8 offset:2304\n\tds_read_b64_tr_b16 %6, %8 offset:3072\n\tds_read_b64_tr_b16 %7, %8 offset:3328\n\t"
                 "s_waitcnt lgkmcnt(0)"
                 : "=&v"(v[0]), "=&v"(v[1]), "=&v"(v[2]), "=&v"(v[3]), "=&v"(v[4]), "=&v"(v[5]), "=&v"(v[6]), "=&v"(v[7]) : "v"(a) : "memory");
}

DI void s5_wave_task(const Params& p, int layer, int wt, char* ldsw) {
    const int lane = tidx() & 63, r = lane & 31, h = lane >> 5;
    const int dir = wt & 1, g = (wt >> 1) & 31, pair = wt >> 6;
    const bf16_t* ub = (const bf16_t*)(p.ws + OFF_U);
    const int hp = (r >> 2) & 1, ia = 4 * (r >> 3) + (r & 3);
    const unsigned img = (unsigned)(size_t)ldsw;
    char* chunkbuf = ldsw + 8192;
    const int i16 = lane & 15, tq = i16 >> 2, tp = i16 & 3, blk = (lane >> 4) & 1;
    const unsigned trA = img + (8 * h + tq) * 64 + 8 * (4 * blk + tp);
    const float dsk = r < 16 ? p.in[I_SD][layer * 512 + g * 16 + r] : 0.f;
    bf16_t* yl = (bf16_t*)(p.ws + (dir ? OFF_YB : OFF_YF)) + ((size_t)(2 * pair + h) * 512 + g * 16 + (r & 15)) * SL;
    const int pb = (layer * 2 + dir) * 32 + g;
    const float dt = expf(p.in[I_SLDT][pb]);
    float abr[2], abi[2];
    bf16x8 bfrag[2][2], cfrag[2][2][2], dfrag;
    {
        u32x4 dw;
#pragma unroll
        for (int j = 0; j < 4; ++j) dw[j] = pk2((dir == 0 && r == 8 * h + 2 * j) ? dsk : 0.f, (dir == 0 && r == 8 * h + 2 * j + 1) ? dsk : 0.f);
        dfrag = __builtin_bit_cast(bf16x8, dw);
    }
#pragma unroll
    for (int st = 0; st < 2; ++st) {
        const int n = 32 * st + r;
        const float are = p.in[I_SARE][pb * 64 + n], aim = p.in[I_SAIM][pb * 64 + n];
        const float mag = expf(dt * are);
        abr[st] = mag * cosf(dt * aim); abi[st] = mag * sinf(dt * aim);
        const float den = are * are + aim * aim, nr = abr[st] - 1.0f;
        const float fre = (nr * are + abi[st] * aim) / den, fim = (abi[st] * are - nr * aim) / den;
        const float* bre = p.in[I_SBRE] + ((size_t)pb * 64 + n) * 16 + 8 * h;
        const float* bim = p.in[I_SBIM] + ((size_t)pb * 64 + n) * 16 + 8 * h;
        u32x4 wre, wim;
#pragma unroll
        for (int j = 0; j < 4; ++j) {
            const float br0 = bre[2 * j], bi0 = bim[2 * j], br1 = bre[2 * j + 1], bi1 = bim[2 * j + 1];
            wre[j] = pk2(fre * br0 - fim * bi0, fre * br1 - fim * bi1);
            wim[j] = pk2(fre * bi0 + fim * br0, fre * bi1 + fim * br1);
        }
        bfrag[st][0] = __builtin_bit_cast(bf16x8, wre); bfrag[st][1] = __builtin_bit_cast(bf16x8, wim);
#pragma unroll
        for (int s = 0; s < 2; ++s) {
            u32x4 cr = {0u, 0u, 0u, 0u}, ci = {0u, 0u, 0u, 0u};
            if (r < 16) {
                const float* cre = p.in[I_SCRE] + ((size_t)pb * 16 + r) * 64 + 32 * st + 16 * s + 8 * h;
                const float* cim = p.in[I_SCIM] + ((size_t)pb * 16 + r) * 64 + 32 * st + 16 * s + 8 * h;
#pragma unroll
                for (int j = 0; j < 4; ++j) { cr[j] = pk2(cre[2 * j], cre[2 * j + 1]); ci[j] = pk2(-cim[2 * j], -cim[2 * j + 1]); }
            }
            cfrag[st][s][0] = __builtin_bit_cast(bf16x8, cr); cfrag[st][s][1] = __builtin_bit_cast(bf16x8, ci);
        }
    }
    float sre[2] = {0.f, 0.f}, sim[2] = {0.f, 0.f};
    const bf16_t* gsrc[4]; int loff[4];
#pragma unroll
    for (int j = 0; j < 4; ++j) {
        const int c = lane + 64 * j, row = c >> 1, half = c & 1, ss = row >> 6, tau = row & 63;
        gsrc[j] = ub + ((size_t)(2 * pair + ss) * SL + (dir ? (SL - 1 - tau) : tau)) * INW + 768 + g * 16 + half * 8;
        loff[j] = row * 32 + half * 16;
    }
    const long cstep = dir ? -(long)64 * INW : (long)64 * INW;
    u32x4 crg[4];
#pragma unroll
    for (int j = 0; j < 4; ++j) crg[j] = *(const u32x4*)gsrc[j];
#pragma unroll
    for (int j = 0; j < 4; ++j) *(u32x4*)(chunkbuf + loff[j]) = crg[j];
    const int aoff = (hp * 64 + ia) * 32 + h * 16;
    for (int chunk = 0; chunk < SL / 64; ++chunk) {
        if (chunk + 1 < SL / 64) {
#pragma unroll
            for (int j = 0; j < 4; ++j) { gsrc[j] += cstep; crg[j] = *(const u32x4*)gsrc[j]; }
        }
        const char* cb = chunkbuf + (chunk & 1) * 4096;
#pragma unroll 1
        for (int tl = 0; tl < 4; ++tl) {
            const int s0 = chunk * 64 + tl * 16;
            const bf16x8 ua = *(const bf16x8*)(cb + aoff + tl * 512);
            f32x16 z;
#pragma unroll
            for (int i = 0; i < 16; ++i) z[i] = 0.f;
            f32x16 y0 = MFMA32(ua, dfrag, z);
            f32x16 y1 = z;
#pragma unroll
            for (int st = 0; st < 2; ++st) {
                f32x16 xr = MFMA32(ua, bfrag[st][0], z);
                f32x16 xi = MFMA32(ua, bfrag[st][1], z);
                float cr = sre[st], ci = sim[st];
#pragma unroll
                for (int i = 0; i < 16; ++i) {
                    const float nr = abr[st] * cr - abi[st] * ci + xr[i];
                    const float ni = abr[st] * ci + abi[st] * cr + xi[i];
                    cr = nr; ci = ni; xr[i] = nr; xi[i] = ni;
                }
                sre[st] = cr; sim[st] = ci;
#pragma unroll
                for (int a = 0; a < 4; ++a) {
                    u32x2 w0, w1; w0[0] = pk2(xr[4 * a], xr[4 * a + 1]); w0[1] = pk2(xr[4 * a + 2], xr[4 * a + 3]);
                    w1[0] = pk2(xi[4 * a], xi[4 * a + 1]); w1[1] = pk2(xi[4 * a + 2], xi[4 * a + 3]);
                    *(u32x2*)(ldsw + (st * 2 + 0) * 2048 + r * 64 + 8 * (2 * a + h)) = w0;
                    *(u32x2*)(ldsw + (st * 2 + 1) * 2048 + r * 64 + 8 * (2 * a + h)) = w1;
                }
            }
            asm volatile("s_waitcnt lgkmcnt(0)" ::: "memory");
            {
                s16x4 v[8];
                tr_read8(trA, v);
                y0 = MFMA32(__builtin_shufflevector(v[0], v[1], 0, 1, 2, 3, 4, 5, 6, 7), cfrag[0][0][0], y0);
                y0 = MFMA32(__builtin_shufflevector(v[2], v[3], 0, 1, 2, 3, 4, 5, 6, 7), cfrag[0][1][0], y0);
                y0 = MFMA32(__builtin_shufflevector(v[4], v[5], 0, 1, 2, 3, 4, 5, 6, 7), cfrag[0][0][1], y0);
                y0 = MFMA32(__builtin_shufflevector(v[6], v[7], 0, 1, 2, 3, 4, 5, 6, 7), cfrag[0][1][1], y0);
                s16x4 u[8];
                tr_read8(trA + 4096, u);
                y1 = MFMA32(__builtin_shufflevector(u[0], u[1], 0, 1, 2, 3, 4, 5, 6, 7), cfrag[1][0][0], y1);
                y1 = MFMA32(__builtin_shufflevector(u[2], u[3], 0, 1, 2, 3, 4, 5, 6, 7), cfrag[1][1][0], y1);
                y1 = MFMA32(__builtin_shufflevector(u[4], u[5], 0, 1, 2, 3, 4, 5, 6, 7), cfrag[1][0][1], y1);
                y1 = MFMA32(__builtin_shufflevector(u[6], u[7], 0, 1, 2, 3, 4, 5, 6, 7), cfrag[1][1][1], y1);
            }
            if (r < 16) {
                u32x4 o0, o1;
                if (dir == 0) {
#pragma unroll
                    for (int j = 0; j < 4; ++j) { o0[j] = pk2(y0[2 * j] + y1[2 * j], y0[2 * j + 1] + y1[2 * j + 1]); o1[j] = pk2(y0[8 + 2 * j] + y1[8 + 2 * j], y0[9 + 2 * j] + y1[9 + 2 * j]); }
                    *(u32x4*)(yl + s0) = o0; *(u32x4*)(yl + s0 + 8) = o1;
                } else {
#pragma unroll
                    for (int j = 0; j < 4; ++j) { o0[j] = pk2(y0[15 - 2 * j] + y1[15 - 2 * j], y0[14 - 2 * j] + y1[14 - 2 * j]); o1[j] = pk2(y0[7 - 2 * j] + y1[7 - 2 * j], y0[6 - 2 * j] + y1[6 - 2 * j]); }
                    *(u32x4*)(yl + (SL - 16 - s0)) = o0; *(u32x4*)(yl + (SL - 16 - s0) + 8) = o1;
                }
            }
        }
        if (chunk + 1 < SL / 64) {
#pragma unroll
            for (int j = 0; j < 4; ++j) *(u32x4*)(chunkbuf + ((chunk + 1) & 1) * 4096 + loff[j]) = crg[j];
        }
    }
}

DI void phase_mix(const Params& p, int layer, int qidx, char* lds, bool only_s5 = false) {
    __shared__ int s_task;
    int* qc = (int*)(p.ws + OFF_QCNT) + qidx;
    constexpr int N_S5 = (G / 2) * 32 * 2 / 4, N_DIFF = G * 4 * 2 * 16, N_RET = G * 4 * 16, N_GQA = G * 8 * 8;
    constexpr int NTOT = N_S5 + N_DIFF + N_RET + N_GQA;
    for (;;) {
        __syncthreads();
        if (tidx() == 0) s_task = atomicAdd(qc, 1);
        __syncthreads();
        int task = s_task;
        if (task >= (only_s5 ? N_S5 : NTOT)) break;
        if (task < N_S5) { const int wave = tidx() >> 6; s5_wave_task(p, layer, task * 4 + wave, lds + wave * 16384); }
        else if ((task -= N_S5) < N_DIFF) attn_task<128, 1>(p, task, lds);
        else if ((task -= N_DIFF) < N_RET) attn_task<128, 2>(p, task, lds);
        else attn_gqa2(p, task - N_RET, lds);
    }
}

DI float gelu_tanh(float v) { const float z2 = 1.5957691216057308f * (v + 0.044715f * v * v * v); return v * __builtin_amdgcn_rcpf(1.0f + __builtin_amdgcn_exp2f(-LOG2E * z2)); }

DI void glu_tile(const Params& p, int layer, int tm, int tn, char* lds) {
    const int tid = tidx(), lane = tid & 63, w = tid >> 6, wr = w >> 1, wc = w & 1, r16 = lane & 15, q4 = lane >> 4;
    const bf16_t* yf = (const bf16_t*)(p.ws + OFF_YF);
    const bf16_t* yb = (const bf16_t*)(p.ws + OFF_YB);
    const bf16_t* B = wts(p, layer) + WGLU + (size_t)tn * 128 * 512;
    const int seq = (tm * 128) >> 11, t0 = (tm * 128) & 2047;
    const int ach = tid & 63, aseg0 = tid >> 6;
    const bf16_t* fg = yf + ((size_t)seq * 512 + ach) * SL + t0;
    const bf16_t* bg2 = yb + ((size_t)seq * 512 + ach) * SL + t0;
    const int srow = tid >> 3, scol = tid & 7;
    const bf16_t* bg = B + (size_t)srow * 512 + scol * 8;
    const int soff = srow * ROWB + ((scol ^ ((srow >> 1) & 7)) << 4);
    u32x4 rf[4], rbk[4], rb[4];
    f32x4 acc[4][4]; zero_acc(acc);
    const int aoff = (wr * 64 + (lane & 15)) * ROWB;
    const int boff = GT_BYTES + (wc * 64 + (lane & 15)) * ROWB;
    const int sw = ((lane >> 4) ^ ((lane & 15) >> 1)) << 4;
    for (int kt = 0; kt < 8; ++kt) {
#pragma unroll
        for (int j = 0; j < 4; ++j) {
            rf[j] = *(const u32x4*)(fg + (size_t)kt * 64 * SL + (aseg0 + 4 * j) * 8);
            rbk[j] = *(const u32x4*)(bg2 + (size_t)kt * 64 * SL + (aseg0 + 4 * j) * 8);
            rb[j] = *(const u32x4*)(bg + (size_t)(32 * j) * 512 + kt * 64);
        }
#pragma unroll
        for (int j = 0; j < 4; ++j) {
            *(u32x4*)(lds + GT_BYTES + soff + 32 * j * ROWB) = rb[j];
            char* abase = lds + (aseg0 + 4 * j) * 8 * ROWB + (ach & 7) * 2;
#pragma unroll
            for (int e = 0; e < 4; ++e) {
                const float v0 = gelu_tanh(bflo(rf[j][e]) + bflo(rbk[j][e])), v1 = gelu_tanh(bfhi(rf[j][e]) + bfhi(rbk[j][e]));
                const unsigned pw = pk2(v0, v1);
                const int cs = (((ach >> 3) ^ ((4 * aseg0 + e) & 7)) << 4);
                *(bf16_t*)(abase + (2 * e) * ROWB + cs) = (bf16_t)(pw & 0xffffu);
                *(bf16_t*)(abase + (2 * e + 1) * ROWB + cs) = (bf16_t)(pw >> 16);
            }
        }
        __syncthreads();
        gemm_compute<false, 0>(lds, aoff, boff, sw, acc);
        __syncthreads();
    }
    bf16_t* ob = (bf16_t*)(p.ws + OFF_O) + (size_t)1 * TG * 512;
    const float* bgl = p.in[I_SBGLU] + layer * 512;
#pragma unroll
    for (int n = 0; n < 4; ++n) {
        const int ch = tn * 128 + wc * 64 + n * 16 + r16;
        const float bias = bgl[ch];
#pragma unroll
        for (int m = 0; m < 4; ++m) {
            const int tl = wr * 64 + m * 16 + q4 * 4;
            const u32x2 fw = *(const u32x2*)(yf + ((size_t)seq * 512 + ch) * SL + t0 + tl);
            const u32x2 bw = *(const u32x2*)(yb + ((size_t)seq * 512 + ch) * SL + t0 + tl);
            const float y0 = gelu_tanh(bflo(fw[0]) + bflo(bw[0])), y1 = gelu_tanh(bfhi(fw[0]) + bfhi(bw[0]));
            const float y2 = gelu_tanh(bflo(fw[1]) + bflo(bw[1])), y3 = gelu_tanh(bfhi(fw[1]) + bfhi(bw[1]));
            const unsigned w01 = pk2(y0 * sigmoidf_(acc[m][n][0] + bias), y1 * sigmoidf_(acc[m][n][1] + bias));
            const unsigned w23 = pk2(y2 * sigmoidf_(acc[m][n][2] + bias), y3 * sigmoidf_(acc[m][n][3] + bias));
            bf16_t* orow = ob + (size_t)(tm * 128 + tl) * 512 + ch;
            orow[0] = (bf16_t)(w01 & 0xffffu); orow[512] = (bf16_t)(w01 >> 16); orow[1024] = (bf16_t)(w23 & 0xffffu); orow[1536] = (bf16_t)(w23 >> 16);
        }
    }
}

DI void phase_glu(const Params& p, int layer, char* lds) {
    const int lane = tidx() & 63, w = tidx() >> 6;
    { TileIter it; ti_init(it, TG / 128, 4, 16, 4); int tm, tn; while (ti_next(it, tm, tn)) glu_tile(p, layer, tm, tn, lds); }
    const float lam = ((const float*)(p.ws + OFF_LAM))[layer], li = ((const float*)(p.ws + OFF_LAM))[4 + layer];
    const bf16_t* d0 = (const bf16_t*)(p.ws + OFF_DT); const bf16_t* d1 = d0 + (size_t)TG * 512;
    bf16_t* oc = (bf16_t*)(p.ws + OFF_O) + (size_t)2 * TG * 512;
    const f32x2 sg = *(const f32x2*)(p.in[I_DSUB] + layer * 128 + 2 * lane);
    const int gw = bidx() * 4 + w, nw = gdim() * 4;
    for (int it0 = gw; it0 < TG * 4; it0 += 8 * nw) {
        unsigned a[8], b[8];
#pragma unroll
        for (int j = 0; j < 8; ++j) {
            const int it = it0 + j * nw;
            const size_t off = (size_t)(it < TG * 4 ? it : gw) * 128 + 2 * lane;
            a[j] = *(const unsigned*)(d0 + off); b[j] = *(const unsigned*)(d1 + off);
        }
#pragma unroll
        for (int j = 0; j < 8; ++j) {
            const int it = it0 + j * nw;
            const float v0 = bflo(a[j]) - lam * bflo(b[j]), v1 = bfhi(a[j]) - lam * bfhi(b[j]);
            const float ss = wave_sum(v0 * v0 + v1 * v1);
            const float rs = rsqrtf(ss * (1.0f / 128.0f) + EPS) * (1.0f - li);
            if (it < TG * 4) *(unsigned*)(oc + (size_t)it * 128 + 2 * lane) = pk2(v0 * rs * sg[0], v1 * rs * sg[1]);
        }
    }
}

DI void phase_merge(const Params& p, int layer, char* lds) {
    const int lane = tidx() & 63, w = tidx() >> 6, wr = w >> 1, wc = w & 1, r16 = lane & 15, q4 = lane >> 4;
    const bf16_t* ob = (const bf16_t*)(p.ws + OFF_O);
    const bf16_t* gb = (const bf16_t*)(p.ws + OFF_GATE);
    const bf16_t* W = wts(p, layer) + WB;
    bf16_t* mb = (bf16_t*)(p.ws + OFF_M);
    TileIter it; ti_init(it, TG / 128, 8, 8, 8);
    int tm, tn;
    while (ti_next(it, tm, tn)) {
        f32x4 macc[4][4]; zero_acc(macc);
#pragma unroll 1
        for (int b = 0; b < 4; ++b) {
            f32x4 acc[4][4]; zero_acc(acc);
            gemm128<true, 0, false>(ob + ((size_t)b * TG + tm * 128) * 512, 512, W + ((size_t)b * 1024 + tn * 128) * 512, 512, 512, acc, lds);
#pragma unroll
            for (int m = 0; m < 4; ++m) {
                const int row = tm * 128 + wr * 64 + m * 16 + r16;
#pragma unroll
                for (int n = 0; n < 4; ++n) {
                    const int col = tn * 128 + wc * 64 + n * 16 + q4 * 4;
                    const u32x2 gw = *(const u32x2*)(gb + (size_t)row * 4096 + b * 1024 + col);
                    macc[m][n][0] += acc[m][n][0] * bflo(gw[0]); macc[m][n][1] += acc[m][n][1] * bfhi(gw[0]);
                    macc[m][n][2] += acc[m][n][2] * bflo(gw[1]); macc[m][n][3] += acc[m][n][3] * bfhi(gw[1]);
                }
            }
        }
#pragma unroll
        for (int m = 0; m < 4; ++m) {
            const int row = tm * 128 + wr * 64 + m * 16 + r16;
#pragma unroll
            for (int n = 0; n < 4; ++n) {
                const int col = tn * 128 + wc * 64 + n * 16 + q4 * 4;
                otile_put(lds, wr * 64 + m * 16 + r16, wc * 64 + n * 16 + q4 * 4, pk2(macc[m][n][0], macc[m][n][1]), pk2(macc[m][n][2], macc[m][n][3]));
            }
        }
        otile_flush(lds, mb + (size_t)(tm * 128) * DM + tn * 128, DM);
    }
}

DI void phase_resid(const Params& p, int grp, const bf16_t* A, int K, const bf16_t* Wt, bool first, char* lds) {
    const int lane = tidx() & 63, w = tidx() >> 6, wr = w >> 1, wc = w & 1, r16 = lane & 15, q4 = lane >> 4;
    TileIter it; ti_init(it, TG / 128, 8, 8, 8);
    int tm, tn, ntm = 0, ntn = 0;
    bool have = ti_next(it, tm, tn);
    GemmRegs g;
    if (have) gemm_prime(A + (size_t)tm * 128 * K, K, Wt + (size_t)tn * 128 * K, K, g);
    for (; have; tm = ntm, tn = ntn) {
        have = ti_next(it, ntm, ntn);
        const bf16_t* At = A + (size_t)tm * 128 * K; const bf16_t* Bt = Wt + (size_t)tn * 128 * K;
        const bf16_t* nAt = have ? A + (size_t)ntm * 128 * K : At; const bf16_t* nBt = have ? Wt + (size_t)ntn * 128 * K : Bt;
        f32x4 acc[4][4]; zero_acc(acc);
        gemm_stream<true>(At, Bt, nAt, nBt, K, K, K, g, acc, lds);
#pragma unroll
        for (int m = 0; m < 4; ++m)
#pragma unroll
            for (int n = 0; n < 4; ++n) *(f32x4*)(lds + (wr * 64 + m * 16 + r16) * OROWF + (wc * 64 + n * 16 + q4 * 4) * 4) = acc[m][n];
        __syncthreads();
        {
            const int tid = tidx();
#pragma unroll 4
            for (int i = 0; i < 16; ++i) {
                const int c = tid + 256 * i, rl = c >> 5, ch = c & 31, row = tm * 128 + rl;
                float* xo = p.out + ((size_t)grp * TG + row) * DM + tn * 128 + ch * 4;
                const float* xi = first ? x_in_row(p, grp, row) + tn * 128 + ch * 4 : xo;
                const f32x4 a = *(const f32x4*)(lds + rl * OROWF + ch * 16);
                const f32x4 xv = *(const f32x4*)xi;
                *(f32x4*)xo = xv + a;
            }
        }
        __syncthreads();
    }
}

DI void phase_ffn1(const Params& p, int layer, char* lds) {
    const int lane = tidx() & 63, w = tidx() >> 6, wr = w >> 1, wc = w & 1, r16 = lane & 15, q4 = lane >> 4;
    const bf16_t* hb = (const bf16_t*)(p.ws + OFF_H);
    const bf16_t* W = wts(p, layer) + WFI;
    bf16_t* fb = (bf16_t*)(p.ws + OFF_F);
    constexpr int NT = DFF / 64;
    TileIter it; ti_init(it, TG / 128, NT, 8, 4);
    int tm, tn, ntm = 0, ntn = 0;
    bool have = ti_next(it, tm, tn);
    GemmRegs g;
    if (have) gemm_prime(hb + (size_t)tm * 128 * DM, DM, W + (size_t)tn * 128 * DM, DM, g);
    for (; have; tm = ntm, tn = ntn) {
        have = ti_next(it, ntm, ntn);
        const bf16_t* At = hb + (size_t)tm * 128 * DM; const bf16_t* Bt = W + (size_t)tn * 128 * DM;
        const bf16_t* nAt = have ? hb + (size_t)ntm * 128 * DM : At; const bf16_t* nBt = have ? W + (size_t)ntn * 128 * DM : Bt;
        f32x4 acc[4][4]; zero_acc(acc);
        gemm_stream<true, 1>(At, Bt, nAt, nBt, DM, DM, DM, g, acc, lds);
#pragma unroll
        for (int m = 0; m < 4; ++m) {
            const int row = tm * 128 + wr * 64 + m * 16 + r16;
#pragma unroll
            for (int n = 0; n < 2; ++n) {
                const int col = tn * 64 + wc * 32 + n * 16 + q4 * 4;
                float f[4];
#pragma unroll
                for (int i = 0; i < 4; ++i) { const float gq = acc[m][n][i]; f[i] = gq * sigmoidf_(gq) * acc[m][n + 2][i]; }
                otile_put(lds, wr * 64 + m * 16 + r16, wc * 32 + n * 16 + q4 * 4, pk2(f[0], f[1]), pk2(f[2], f[3]));
            }
        }
        {
            const int tid = tidx();
            __syncthreads();
#pragma unroll
            for (int i = 0; i < 4; ++i) {
                const int c = tid + 256 * i, row = c >> 3, ch = c & 7;
                const u32x4 v = *(const u32x4*)(lds + row * OROW + ch * 16);
                *(u32x4*)(fb + (size_t)(tm * 128 + row) * DFF + tn * 64 + ch * 8) = v;
            }
            __syncthreads();
        }
    }
}

#define XB_TMO      128
#define XB_XCNT(j)  (256  + 64 * (j))
#define XB_XSUB(j)  (1280 + 64 * (j))
#define XB_XGEN(j)  (2304 + 64 * (j))
#define XB_TOP      3328
#define XB_TOPGEN   3392
#define XCD_BAR_WORDS 3456
#define XB_SPIN_CAP (1u << 18)
#define LAS __attribute__((address_space(3)))

__device__ __forceinline__ unsigned xb_ld(unsigned* p)              { return __hip_atomic_load(p, __ATOMIC_RELAXED, __HIP_MEMORY_SCOPE_AGENT); }
__device__ __forceinline__ unsigned xb_add(unsigned* p, unsigned v) { return __hip_atomic_fetch_add(p, v, __ATOMIC_RELAXED, __HIP_MEMORY_SCOPE_AGENT); }
__device__ __forceinline__ unsigned xb_xcc_id() { return (unsigned)__builtin_amdgcn_s_getreg((3 << 11) | 20) & 0xFu; }
#define XB_SPIN(cond, bar) do { unsigned _sp = 0; while (cond) { __builtin_amdgcn_s_sleep(1); \
    if ((++_sp & 255u) == 0u) { if (xb_ld(&(bar)[XB_TMO])) break; if (_sp > XB_SPIN_CAP) { atomicAdd(&(bar)[XB_TMO], 1u); break; } } } } while (0)

struct XcdBarrier {
    unsigned* bar; unsigned x;
    volatile LAS unsigned* st;
};

__device__ __forceinline__ XcdBarrier xcd_barrier_post(unsigned* bar, volatile LAS unsigned* st) {
    XcdBarrier b; b.bar = bar; b.x = xb_xcc_id(); b.st = st;
    if (threadIdx.x == 0) (void)xb_add(&bar[XB_XCNT(b.x)], 1u);
    return b;
}
__device__ __forceinline__ void xcd_barrier_complete(unsigned* bar, unsigned x, unsigned& nloc, unsigned& nx) {
    const unsigned G = gdim() * gridDim.y * gridDim.z;
    unsigned sum, cnt, mine, sp = 0u;
    for (;;) {
        sum = 0u; cnt = 0u; mine = 0u;
#pragma unroll
        for (unsigned j = 0; j < 16; ++j) { const unsigned c = xb_ld(&bar[XB_XCNT(j)]); sum += c; cnt += (c > 0u) ? 1u : 0u; mine = (j == x) ? c : mine; }
        if (sum == G) break;
        __builtin_amdgcn_s_sleep(1);
        if ((++sp & 255u) == 0u) { if (xb_ld(&bar[XB_TMO])) break; if (sp > XB_SPIN_CAP) { atomicAdd(&bar[XB_TMO], 1u); break; } }
    }
    nloc = mine > 0u ? mine : 1u; nx = cnt > 0u ? cnt : 1u;
}

__device__ __forceinline__ void xcd_barrier(const XcdBarrier& b) {
    asm volatile("s_waitcnt vmcnt(0)" ::: "memory");
    __syncthreads();
    if (threadIdx.x == 0) {
        unsigned* bar = b.bar;
        __builtin_amdgcn_s_waitcnt(0);
        unsigned nloc = b.st[0], nx = b.st[1];
        if (nloc == 0u) { xcd_barrier_complete(bar, b.x, nloc, nx); b.st[0] = nloc; b.st[1] = nx; }
        const unsigned old = xb_add(&bar[XB_XSUB(b.x)], 1u);
        const unsigned gen = old / nloc;
        if (old + 1u == (gen + 1u) * nloc) {
            __builtin_amdgcn_fence(__ATOMIC_RELEASE, "agent");
            asm volatile("s_waitcnt vmcnt(0)" ::: "memory");
            const unsigned og = xb_add(&bar[XB_TOP], 1u);
            const unsigned tg = og / nx;
            if (og + 1u == (tg + 1u) * nx) xb_add(&bar[XB_TOPGEN], 1u);
            else XB_SPIN(xb_ld(&bar[XB_TOPGEN]) == tg, bar);
            __builtin_amdgcn_fence(__ATOMIC_ACQUIRE, "agent");
            xb_add(&bar[XB_XGEN(b.x)], 1u);
            asm volatile("s_waitcnt vmcnt(0)" ::: "memory");
        } else {
            XB_SPIN(xb_ld(&bar[XB_XGEN(b.x)]) == gen, bar);
            __builtin_amdgcn_fence(__ATOMIC_ACQUIRE, "agent");
            asm volatile("s_waitcnt vmcnt(0)" ::: "memory");
        }
    }
    __syncthreads();
}


constexpr int PH_PER_GRP = 4 * 9 + 1;
constexpr int NPHASE = 1 + NGRP * PH_PER_GRP;

#ifndef PROBE_K
#define PROBE_K (-1)
#endif
DI void run_phase(const Params& p, int ph, char* lds, int rep = 0) {
    if (ph == 0) { phase_prologue(p, lds); return; }
    const int q = ph - 1, grp = q / PH_PER_GRP, r = q % PH_PER_GRP;
    if (r == 36) { phase_norm(p, grp, p.in[I_NFIN], 2); return; }
    const int layer = r / 9, k = r % 9;
    switch (k) {
        case 0: phase_norm(p, grp, p.in[I_NMIX] + layer * DM, layer == 0 ? 0 : 1); break;
        case 1: phase_in(p, layer, lds, rep == 1); break;
        case 2: phase_mix(p, layer, grp * 4 + layer + 20 * rep, lds, rep == 1); break;
        case 3: phase_glu(p, layer, lds); break;
        case 4: phase_merge(p, layer, lds); break;
        case 5: phase_resid(p, grp, (const bf16_t*)(p.ws + OFF_M), DM, wts(p, layer) + WO, layer == 0, lds); break;
        case 6: phase_norm(p, grp, p.in[I_NFFN] + layer * DM, 1); break;
        case 7: phase_ffn1(p, layer, lds); break;
        default: phase_resid(p, grp, (const bf16_t*)(p.ws + OFF_F), DFF, wts(p, layer) + WFO, false, lds); break;
    }
}

__global__ void __launch_bounds__(256, 2) mega(Params p, int only) {
    __shared__ __attribute__((aligned(16))) char lds[LDS_BYTES];
#if MULTI_LAUNCH
    if (only >= 0) { run_phase(p, only, lds); return; }
#endif
    cg::grid_group grid = cg::this_grid();
    __shared__ uint4 xb_words;
    if (threadIdx.x == 0) xb_words = make_uint4(0u, 0u, 0u, 0u);
    __syncthreads();
    XcdBarrier xb = xcd_barrier_post((unsigned*)(p.ws + OFF_BAR), (volatile LAS unsigned*)&xb_words);
    for (int ph = 0; ph < NPHASE; ++ph) {
        run_phase(p, ph, lds);
        if (ph + 1 < NPHASE) { if (ph == 0) grid.sync(); else xcd_barrier(xb); }
        if (PROBE_K == 100) xcd_barrier(xb);
        if (PROBE_K >= 0 && PROBE_K < 9 && ph > 0 && ((ph - 1) % PH_PER_GRP) < 36 && (((ph - 1) % PH_PER_GRP) % 9) == PROBE_K) { run_phase(p, ph, lds, 1); xcd_barrier(xb); }
    }
}

extern "C" void kernel_launch(void* const* d_in, const int* in_sizes, int n_in, void* d_out, int out_size, void* d_ws, size_t ws_size, hipStream_t stream) {
    (void)in_sizes; (void)n_in; (void)out_size;
    static int grid_blocks = 0;
    if (!grid_blocks) {
        int dev = 0, cus = 0, per_cu = 0;
        hipGetDevice(&dev);
        hipDeviceGetAttribute(&cus, hipDeviceAttributeMultiprocessorCount, dev);
        hipOccupancyMaxActiveBlocksPerMultiprocessor(&per_cu, mega, 256, 0);
        if (per_cu < 1) per_cu = 1;
        if (per_cu > 2) per_cu = 2;
        grid_blocks = cus * per_cu;
    }
    if (ws_size < WS_END) { fprintf(stderr, "workspace too small: %zu < %zu\n", ws_size, (size_t)WS_END); return; }
    Params p{};
    for (int i = 0; i < 26; ++i) p.in[i] = (const float*)d_in[i];
    p.out = (float*)d_out; p.ws = (char*)d_ws;
    hipMemsetAsync((char*)d_ws + OFF_BAR, 0, XCD_BAR_WORDS * sizeof(unsigned), stream);
#if MULTI_LAUNCH
    for (int ph = 0; ph < NPHASE; ++ph) mega<<<dim3(grid_blocks), dim3(256), 0, stream>>>(p, ph);
#else
    int only = -1;
    void* args[] = {&p, &only};
    hipError_t e = hipLaunchCooperativeKernel((void*)mega, dim3(grid_blocks), dim3(256), args, 0, stream);
    if (e != hipSuccess) fprintf(stderr, "cooperative launch failed: %s (grid %d)\n", hipGetErrorString(e), grid_blocks);
#endif
}
```

```cpp
#include <hip/hip_runtime.h>
#include <hip/hip_cooperative_groups.h>
#include <cstdio>
#include <cstdint>
namespace cg = cooperative_groups;

#ifndef MULTI_LAUNCH
#define MULTI_LAUNCH 0
#endif

#define DI __device__ __forceinline__
typedef unsigned short bf16_t;
typedef __bf16 bf16v2 __attribute__((ext_vector_type(2)));
typedef float f32x2 __attribute__((ext_vector_type(2)));
typedef short bf16x8 __attribute__((ext_vector_type(8)));
typedef short s16x4 __attribute__((ext_vector_type(4)));
typedef float f32x4 __attribute__((ext_vector_type(4)));
typedef float f32x16 __attribute__((ext_vector_type(16)));
typedef unsigned u32x4 __attribute__((ext_vector_type(4)));
typedef unsigned u32x2 __attribute__((ext_vector_type(2)));

constexpr int DM = 1024, SL = 2048, NSEQ = 40, G = 8, NGRP = NSEQ / G, TG = G * SL;
constexpr int INW = 4352, NIN = INW + 4096, DFF = 2816;
constexpr float EPS = 1e-6f;
constexpr float LOG2E = 1.4426950408889634f;

constexpr size_t WING = 0;
constexpr size_t WB = 8650752;
constexpr size_t WO = WB + 2097152;
constexpr size_t WFI = WO + 1048576;
constexpr size_t WFO = WFI + 5767168;
constexpr size_t WGLU = WFO + 2883584;
constexpr size_t LW = WGLU + 262144;

constexpr size_t OFF_W = 0;
constexpr size_t OFF_TAB = OFF_W + 4 * LW * 2;
constexpr size_t OFF_COSA = OFF_TAB, OFF_SINA = OFF_TAB + 262144, OFF_COSD = OFF_TAB + 2 * 262144, OFF_SIND = OFF_TAB + 3 * 262144;
constexpr size_t OFF_BIAS = OFF_TAB + 1048576;
constexpr size_t OFF_LAM = OFF_BIAS + 65536;
constexpr size_t OFF_QCNT = OFF_LAM + 256;
constexpr size_t OFF_BAR = OFF_TAB + 1048576 + 131072;
constexpr size_t OFF_H = OFF_TAB + 2097152;
constexpr size_t OFF_U = OFF_H + (size_t)TG * 1024 * 2;
constexpr size_t OFF_GATE = OFF_U + (size_t)TG * INW * 2;
constexpr size_t OFF_VTA = OFF_GATE + (size_t)TG * 4096 * 2;
constexpr size_t OFF_VTC = OFF_VTA + (size_t)TG * 128 * 2;
constexpr size_t OFF_VTD = OFF_VTC + (size_t)TG * 512 * 2;
constexpr size_t OFF_O = OFF_VTD + (size_t)TG * 512 * 2;
constexpr size_t OFF_YF = OFF_O + (size_t)4 * TG * 512 * 2;
constexpr size_t OFF_YB = OFF_YF + (size_t)TG * 512 * 2;
constexpr size_t OFF_DT = OFF_YB + (size_t)TG * 512 * 2;
constexpr size_t WS_END = OFF_DT + (size_t)2 * TG * 512 * 2;
constexpr size_t OFF_M = OFF_U;
constexpr size_t OFF_F = OFF_U;

struct Params { const float* in[26]; float* out; char* ws; };

enum { I_XP = 0, I_XS, I_NMIX, I_WIN, I_QG, I_KG, I_SARE, I_SAIM, I_SLDT, I_SBRE, I_SBIM, I_SCRE, I_SCIM, I_SD, I_SWGLU, I_SBGLU,
       I_DLAM, I_DSUB, I_REL, I_WGATE, I_WBR, I_WOUT, I_NFFN, I_WFI, I_WFO, I_NFIN };

constexpr int LDS_BYTES = 71680;
constexpr int AROWB = 144;
constexpr int ROWB = 128;
constexpr int GT_BYTES = 128 * ROWB;

DI int bidx() { int b = blockIdx.x; asm volatile("" : "+s"(b)); return b; }
DI int gdim() { int g = gridDim.x; asm volatile("" : "+s"(g)); return g; }
DI int tidx() { int t = threadIdx.x; asm volatile("" : "+v"(t)); return t; }
DI unsigned pk2(float a, float b) { f32x2 v = {a, b}; bf16v2 r = __builtin_convertvector(v, bf16v2); return __builtin_bit_cast(unsigned, r); }
DI float bf2f(bf16_t v) { return __uint_as_float(((unsigned)v) << 16); }
DI float bflo(unsigned w) { return __uint_as_float(w << 16); }
DI float bfhi(unsigned w) { return __uint_as_float(w & 0xffff0000u); }
DI float sigmoidf_(float x) { return __builtin_amdgcn_rcpf(1.0f + __builtin_amdgcn_exp2f(-LOG2E * x)); }
DI float wave_sum(float v) { v += __shfl_xor(v, 32); v += __shfl_xor(v, 16); v += __shfl_xor(v, 8); v += __shfl_xor(v, 4); v += __shfl_xor(v, 2); v += __shfl_xor(v, 1); return v; }
DI bf16_t* wts(const Params& p, int layer) { return (bf16_t*)(p.ws + OFF_W) + (size_t)layer * LW; }
#define MFMA16(a, b, c) __builtin_amdgcn_mfma_f32_16x16x32_bf16((a), (b), (c), 0, 0, 0)
#define MFMA32(a, b, c) __builtin_amdgcn_mfma_f32_32x32x16_bf16((a), (b), (c), 0, 0, 0)

template <bool SWAP, int BMAP>
DI void gemm_compute(const char* cur, int aoff, int boff, int sw, f32x4 (&acc)[4][4]) {
#pragma unroll
    for (int ks = 0; ks < 2; ++ks) {
        bf16x8 af[4], bfr[4];
        const int so = sw ^ (ks * 64);
#pragma unroll
        for (int m = 0; m < 4; ++m) af[m] = *(const bf16x8*)(cur + aoff + m * 16 * ROWB + so);
#pragma unroll
        for (int n = 0; n < 4; ++n) bfr[n] = *(const bf16x8*)(cur + boff + (BMAP ? ((n >> 1) * 64 + (n & 1) * 16) : n * 16) * ROWB + so);
#pragma unroll
        for (int m = 0; m < 4; ++m)
#pragma unroll
            for (int n = 0; n < 4; ++n) acc[m][n] = SWAP ? MFMA16(bfr[n], af[m], acc[m][n]) : MFMA16(af[m], bfr[n], acc[m][n]);
    }
}
#define GLOAD(RA, RB, KT) { _Pragma("unroll") for (int i_ = 0; i_ < 4; ++i_) { \
    const char* ua_ = Ab + (size_t)(((32 * i_) * lda + (KT) * 64) * 2); const char* ub_ = Bb + (size_t)(((32 * i_) * ldb + (KT) * 64) * 2); \
    RA[i_] = *(const u32x4*)(ua_ + avoff); RB[i_] = *(const u32x4*)(ub_ + bvoff); } }
#define LSTORE(RA, RB, ST) { _Pragma("unroll") for (int i_ = 0; i_ < 4; ++i_) { *(u32x4*)(lds + (ST) * (2 * GT_BYTES) + soff + 32 * i_ * ROWB) = RA[i_]; *(u32x4*)(lds + (ST) * (2 * GT_BYTES) + GT_BYTES + soff + 32 * i_ * ROWB) = RB[i_]; } }
template <bool SWAP, int BMAP = 0, bool DEEP = true>
DI void gemm128(const bf16_t* __restrict__ A, int lda, const bf16_t* __restrict__ B, int ldb, int K, f32x4 (&acc)[4][4], char* lds) {
    const int tid = tidx(), lane = tid & 63, w = tid >> 6, wr = w >> 1, wc = w & 1;
    const int srow = tid >> 3, scol = tid & 7;
    const char* Ab = (const char*)A; const char* Bb = (const char*)B;
    const unsigned avoff = (unsigned)(srow * lda + scol * 8) * 2u, bvoff = (unsigned)(srow * ldb + scol * 8) * 2u;
    const int soff = srow * ROWB + ((scol ^ ((srow >> 1) & 7)) << 4);
    const int nk = K >> 6;
    const int aoff = (wr * 64 + (lane & 15)) * ROWB;
    const int boff = GT_BYTES + ((BMAP ? wc * 32 : wc * 64) + (lane & 15)) * ROWB;
    const int sw = ((lane >> 4) ^ ((lane & 15) >> 1)) << 4;
    u32x4 ra0[4], rb0[4];
    GLOAD(ra0, rb0, 0);
    LSTORE(ra0, rb0, 0);
    if (DEEP) {
        u32x4 ra1[4], rb1[4];
        GLOAD(ra1, rb1, 1);
        __syncthreads();
        for (int kt = 0; kt < nk; kt += 2) {
            { const int k2 = kt + 2 < nk ? kt + 2 : nk - 1; GLOAD(ra0, rb0, k2); }
            gemm_compute<SWAP, BMAP>(lds, aoff, boff, sw, acc);
            LSTORE(ra1, rb1, 1);
            __syncthreads();
            { const int k3 = kt + 3 < nk ? kt + 3 : nk - 1; GLOAD(ra1, rb1, k3); }
            gemm_compute<SWAP, BMAP>(lds + 2 * GT_BYTES, aoff, boff, sw, acc);
            LSTORE(ra0, rb0, 0);
            __syncthreads();
        }
    } else {
        __syncthreads();
        for (int kt = 0; kt < nk; ++kt) {
            const bool more = (kt + 1 < nk);
            if (more) GLOAD(ra0, rb0, kt + 1);
            gemm_compute<SWAP, BMAP>(lds + (kt & 1) * (2 * GT_BYTES), aoff, boff, sw, acc);
            if (more) { if (kt & 1) { LSTORE(ra0, rb0, 0); } else { LSTORE(ra0, rb0, 1); } }
            __syncthreads();
        }
    }
}

struct GemmR { u32x4 a[4], b[4]; };
DI void prime_k0(const bf16_t* A, int lda, const bf16_t* B, int ldb, GemmR& g) {
    const int tid = tidx(), srow = tid >> 3, scol = tid & 7;
    const char* Ab = (const char*)A; const char* Bb = (const char*)B;
    const unsigned avoff = (unsigned)(srow * lda + scol * 8) * 2u, bvoff = (unsigned)(srow * ldb + scol * 8) * 2u;
    GLOAD(g.a, g.b, 0);
}
template <bool SWAP, int BMAP = 0>
DI void gemm128pre(const bf16_t* __restrict__ A, int lda, const bf16_t* __restrict__ B, int ldb, int K, GemmR& pre, f32x4 (&acc)[4][4], char* lds) {
    const int tid = tidx(), lane = tid & 63, w = tid >> 6, wr = w >> 1, wc = w & 1;
    const int srow = tid >> 3, scol = tid & 7;
    const char* Ab = (const char*)A; const char* Bb = (const char*)B;
    const unsigned avoff = (unsigned)(srow * lda + scol * 8) * 2u, bvoff = (unsigned)(srow * ldb + scol * 8) * 2u;
    const int soff = srow * ROWB + ((scol ^ ((srow >> 1) & 7)) << 4);
    const int nk = K >> 6;
    const int aoff = (wr * 64 + (lane & 15)) * ROWB;
    const int boff = GT_BYTES + ((BMAP ? wc * 32 : wc * 64) + (lane & 15)) * ROWB;
    const int sw = ((lane >> 4) ^ ((lane & 15) >> 1)) << 4;
    u32x4 ra1[4], rb1[4];
    LSTORE(pre.a, pre.b, 0);
    GLOAD(ra1, rb1, 1);
    __syncthreads();
    for (int kt = 0; kt < nk; kt += 2) {
        { const int k2 = kt + 2 < nk ? kt + 2 : nk - 1; GLOAD(pre.a, pre.b, k2); }
        gemm_compute<SWAP, BMAP>(lds, aoff, boff, sw, acc);
        LSTORE(ra1, rb1, 1);
        __syncthreads();
        { const int k3 = kt + 3 < nk ? kt + 3 : nk - 1; GLOAD(ra1, rb1, k3); }
        gemm_compute<SWAP, BMAP>(lds + 2 * GT_BYTES, aoff, boff, sw, acc);
        LSTORE(pre.a, pre.b, 0);
        __syncthreads();
    }
}

struct TileIter { int per, SM, SN, nSn, sbase, len, q, nslot; };
DI void ti_init(TileIter& it, int NTm, int NTn, int SM, int SN) {
    const int x = bidx() & 7;
    it.nslot = (gdim() - x + 7) >> 3; it.per = SM * SN; it.SM = SM; it.SN = SN; it.nSn = NTn / SN;
    const int nS = (NTm / SM) * it.nSn;
    it.sbase = x * (nS >> 3); it.len = (nS >> 3) * it.per; it.q = bidx() >> 3;
}
DI bool ti_next(TileIter& it, int& tm, int& tn) {
    if (it.q >= it.len) return false;
    const int j = it.q / it.per, w = it.q % it.per, S = it.sbase + j, sm = S / it.nSn, sn = S % it.nSn;
    tm = sm * it.SM + (w % it.SM); tn = sn * it.SN + (w / it.SM);
    it.q += it.nslot;
    return true;
}

struct GemmRegs { u32x4 a0[4], b0[4], a1[4], b1[4]; };
typedef const __attribute__((address_space(1))) char* gptr_t;
typedef const __attribute__((address_space(1))) u32x4* gvec_t;
DI gptr_t uptr(const void* q) {
    const size_t v = (size_t)q;
    const unsigned lo = __builtin_amdgcn_readfirstlane((unsigned)v), hi = __builtin_amdgcn_readfirstlane((unsigned)(v >> 32));
    return (gptr_t)(((size_t)hi << 32) | lo);
}
#define GLOADP(RA, RB, PA, PB, KT) { _Pragma("unroll") for (int i_ = 0; i_ < 4; ++i_) { \
    gptr_t ua_ = (PA) + (size_t)(((32 * i_) * lda + (KT) * 64) * 2); gptr_t ub_ = (PB) + (size_t)(((32 * i_) * ldb + (KT) * 64) * 2); \
    RA[i_] = *(gvec_t)(ua_ + avoff); RB[i_] = *(gvec_t)(ub_ + bvoff); } }
DI void gemm_prime(const bf16_t* A, int lda, const bf16_t* B, int ldb, GemmRegs& g) {
    const int tid = tidx(), srow = tid >> 3, scol = tid & 7;
    const unsigned avoff = (unsigned)(srow * lda + scol * 8) * 2u, bvoff = (unsigned)(srow * ldb + scol * 8) * 2u;
    gptr_t Ab = uptr(A); gptr_t Bb = uptr(B);
    GLOADP(g.a0, g.b0, Ab, Bb, 0);
    GLOADP(g.a1, g.b1, Ab, Bb, 1);
}
template <bool SWAP, int BMAP = 0>
DI void gemm_stream(const bf16_t* A, const bf16_t* B, const bf16_t* nA, const bf16_t* nB, int lda, int ldb, int K, GemmRegs& g, f32x4 (&acc)[4][4], char* lds) {
    const int tid = tidx(), lane = tid & 63, w = tid >> 6, wr = w >> 1, wc = w & 1;
    const int srow = tid >> 3, scol = tid & 7;
    const unsigned avoff = (unsigned)(srow * lda + scol * 8) * 2u, bvoff = (unsigned)(srow * ldb + scol * 8) * 2u;
    gptr_t Ab = uptr(A); gptr_t Bb = uptr(B); gptr_t nAb = uptr(nA); gptr_t nBb = uptr(nB);
    const int soff = srow * ROWB + ((scol ^ ((srow >> 1) & 7)) << 4);
    const int nk = K >> 6;
    const int aoff = (wr * 64 + (lane & 15)) * ROWB;
    const int boff = GT_BYTES + ((BMAP ? wc * 32 : wc * 64) + (lane & 15)) * ROWB;
    const int sw = ((lane >> 4) ^ ((lane & 15) >> 1)) << 4;
    LSTORE(g.a0, g.b0, 0);
    __syncthreads();
    for (int kt = 0; kt < nk; kt += 2) {
        const bool last = kt + 2 >= nk;
        gptr_t pa = last ? nAb : Ab; gptr_t pb = last ? nBb : Bb;
        const int k2 = last ? 0 : kt + 2, k3 = last ? 1 : kt + 3;
        GLOADP(g.a0, g.b0, pa, pb, k2);
        gemm_compute<SWAP, BMAP>(lds, aoff, boff, sw, acc);
        LSTORE(g.a1, g.b1, 1);
        __syncthreads();
        GLOADP(g.a1, g.b1, pa, pb, k3);
        gemm_compute<SWAP, BMAP>(lds + 2 * GT_BYTES, aoff, boff, sw, acc);
        if (!last) LSTORE(g.a0, g.b0, 0);
        __syncthreads();
    }
}

DI void zero_acc(f32x4 (&acc)[4][4]) {
#pragma unroll
    for (int m = 0; m < 4; ++m)
#pragma unroll
        for (int n = 0; n < 4; ++n) acc[m][n] = (f32x4){0.f, 0.f, 0.f, 0.f};
}


constexpr int OROW = 272;
constexpr int OROWF = 528;
DI void otile_put(char* lds, int row, int col, unsigned w0, unsigned w1) { u32x2 w; w[0] = w0; w[1] = w1; *(u32x2*)(lds + row * OROW + col * 2) = w; }
DI void otile_flush(char* lds, bf16_t* dst, int ld) {
    const int tid = tidx();
    __syncthreads();
#pragma unroll
    for (int i = 0; i < 8; ++i) {
        const int c = tid + 256 * i, row = c >> 4, ch = c & 15;
        const u32x4 v = *(const u32x4*)(lds + row * OROW + ch * 16);
        *(u32x4*)(dst + (size_t)row * ld + ch * 8) = v;
    }
    __syncthreads();
}

DI void conv_tile(const float* __restrict__ src, bf16_t* __restrict__ dst, int K, int N, int tk, int tn, int drow0, float* tile) {
    const int tid = tidx(), ty = tid >> 4, tx = tid & 15;
#pragma unroll
    for (int i = 0; i < 4; ++i) {
        const int k = ty + 16 * i;
        const f32x4 v = *(const f32x4*)(src + (size_t)(tk * 64 + k) * N + tn * 64 + tx * 4);
        tile[k * 65 + tx * 4 + 0] = v[0]; tile[k * 65 + tx * 4 + 1] = v[1]; tile[k * 65 + tx * 4 + 2] = v[2]; tile[k * 65 + tx * 4 + 3] = v[3];
    }
    __syncthreads();
    const int n = tid >> 2, ks = (tid & 3) * 16;
    u32x4 w0, w1;
#pragma unroll
    for (int j = 0; j < 4; ++j) {
        w0[j] = pk2(tile[(ks + 2 * j) * 65 + n], tile[(ks + 2 * j + 1) * 65 + n]);
        w1[j] = pk2(tile[(ks + 8 + 2 * j) * 65 + n], tile[(ks + 8 + 2 * j + 1) * 65 + n]);
    }
    bf16_t* d = dst + (size_t)(drow0 + n) * K + tk * 64 + ks;
    *(u32x4*)d = w0; *(u32x4*)(d + 8) = w1;
    __syncthreads();
}

DI int t5_bucket(int rel) {
    const int base = rel > 0 ? 16 : 0;
    const int dist = rel < 0 ? -rel : rel;
    int b;
    if (dist < 8) b = dist;
    else {
        const float lr = logf((float)dist / 8.0f) / 2.772588722239781f;
        int lg = 8 + (int)(lr * 8.0f);
        b = lg < 15 ? lg : 15;
    }
    return base + b;
}

DI void phase_prologue(const Params& p, char* lds) {
    float* tile = (float*)lds;
    const int tid = tidx();
    for (int t = bidx(); t < 4 * 5056; t += gdim()) {
        const int layer = t / 5056; int q = t % 5056;
        bf16_t* wl = wts(p, layer);
        const float* src; bf16_t* dst; int K, N, nn;
        if (q < 1088) { src = p.in[I_WIN] + (size_t)layer * 1024 * INW; dst = wl + WING; K = 1024; N = INW; }
        else if ((q -= 1088) < 1024) { const int b = q >> 8; q &= 255; src = p.in[I_WGATE] + (size_t)(layer * 4 + b) * 1024 * 1024; dst = wl + WING + (size_t)(INW + b * 1024) * 1024; K = 1024; N = 1024; }
        else if ((q -= 1024) < 512) { const int b = q >> 7; q &= 127; src = p.in[I_WBR] + (size_t)(layer * 4 + b) * 512 * 1024; dst = wl + WB + (size_t)b * 1024 * 512; K = 512; N = 1024; }
        else if ((q -= 512) < 256) { src = p.in[I_WOUT] + (size_t)layer * 1024 * 1024; dst = wl + WO; K = 1024; N = 1024; }
        else if ((q -= 256) < 1408) { src = p.in[I_WFI] + (size_t)layer * 1024 * 5632; dst = wl + WFI; K = 1024; N = 5632; }
        else if ((q -= 1408) < 704) { src = p.in[I_WFO] + (size_t)layer * DFF * 1024; dst = wl + WFO; K = DFF; N = 1024; }
        else { q -= 704; src = p.in[I_SWGLU] + (size_t)layer * 512 * 512; dst = wl + WGLU; K = 512; N = 512; }
        nn = N >> 6;
        const int tk = q / nn, tn = q % nn;
        int drow0 = tn * 64;
        if (N == 5632) drow0 = tn < 44 ? tn * 128 : (tn - 44) * 128 + 64;
        conv_tile(src, dst, K, N, tk, tn, drow0, tile);
    }
    const int gt = bidx() * 256 + tid, gn = gdim() * 256;
    float* cosA = (float*)(p.ws + OFF_COSA); float* sinA = (float*)(p.ws + OFF_SINA);
    float* cosD = (float*)(p.ws + OFF_COSD); float* sinD = (float*)(p.ws + OFF_SIND);
    for (int i = gt; i < SL * 32; i += gn) {
        const int t = i >> 5, j = i & 31;
        const float invA = exp2f(-(float)(j & 15) * (13.287712379549449f / 16.0f));
        const float angA = (j < 16 ? (float)(t >> 6) : (float)(t & 63)) * invA;
        cosA[i] = cosf(angA); sinA[i] = sinf(angA);
        const float invD = exp2f(-(float)j * (13.287712379549449f / 32.0f));
        const float angD = (float)t * invD;
        cosD[i] = cosf(angD); sinD[i] = sinf(angD);
    }
    float* bias = (float*)(p.ws + OFF_BIAS);
    for (int i = gt; i < 4 * 4096; i += gn) {
        const int h = i >> 12, r = i & 4095;
        float v = 0.f;
        if (r < 4095) v = p.in[I_REL][t5_bucket(r - 2047) * 4 + h] * LOG2E;
        bias[i] = v;
    }
    if (bidx() == 0) {
        if (tid < 4) {
            const float* lv = p.in[I_DLAM] + tid * 256;
            float s1 = 0.f, s2 = 0.f;
            for (int j = 0; j < 64; ++j) { s1 += lv[j] * lv[64 + j]; s2 += lv[128 + j] * lv[192 + j]; }
            const float li = 0.8f - 0.6f * expf(-0.3f * (float)tid);
            float* lam = (float*)(p.ws + OFF_LAM);
            lam[tid] = expf(s1) - expf(s2) + li; lam[4 + tid] = li;
        }
        if (tid < 64) ((int*)(p.ws + OFF_QCNT))[tid] = 0;
    }
}

DI const float* x_in_row(const Params& p, int grp, int row) {
    const int seq = grp * G + (row >> 11), t = row & 2047;
    return seq < 8 ? p.in[I_XP] + ((size_t)seq * SL + t) * DM : p.in[I_XS] + ((size_t)(seq - 8) * SL + t) * DM;
}
DI void phase_norm(const Params& p, int grp, const float* gain, int mode) {
    const int lane = tidx() & 63;
    const int gw = bidx() * 4 + (tidx() >> 6), nw = gdim() * 4;
    bf16_t* hb = (bf16_t*)(p.ws + OFF_H);
    f32x4 gv[4];
#pragma unroll
    for (int i = 0; i < 4; ++i) gv[i] = *(const f32x4*)(gain + lane * 4 + 256 * i);
    for (int row = gw; row < TG; row += nw) {
        float* xo = p.out + ((size_t)grp * TG + row) * DM;
        const float* x = mode == 0 ? x_in_row(p, grp, row) : xo;
        f32x4 v[4]; float ss = 0.f;
#pragma unroll
        for (int i = 0; i < 4; ++i) { v[i] = *(const f32x4*)(x + lane * 4 + 256 * i); ss += v[i][0] * v[i][0] + v[i][1] * v[i][1] + v[i][2] * v[i][2] + v[i][3] * v[i][3]; }
        ss = wave_sum(ss);
        const float rstd = rsqrtf(ss * (1.0f / 1024.0f) + EPS);
#pragma unroll
        for (int i = 0; i < 4; ++i) {
            const f32x4 y = v[i] * rstd * gv[i];
            if (mode == 2) *(f32x4*)(xo + lane * 4 + 256 * i) = y;
            else { u32x2 w; w[0] = pk2(y[0], y[1]); w[1] = pk2(y[2], y[3]); *(u32x2*)(hb + (size_t)row * DM + lane * 4 + 256 * i) = w; }
        }
    }
}

DI void phase_in(const Params& p, int layer, char* lds, bool probe = false) {
    const bf16_t* hb = (const bf16_t*)(p.ws + OFF_H);
    const bf16_t* W = wts(p, layer) + WING;
    bf16_t* ub = (bf16_t*)(p.ws + OFF_U);
    bf16_t* gb = (bf16_t*)(p.ws + OFF_GATE);
    constexpr int NT = NIN / 128;
    const int lane = tidx() & 63, w = tidx() >> 6, wr = w >> 1, wc = w & 1, r16 = lane & 15, q4 = lane >> 4;
    TileIter it; ti_init(it, TG / 128, NT, 8, 6);
    int tm, tn, ntm = 0, ntn = 0;
    bool have = ti_next(it, tm, tn);
    GemmR pre;
    if (have) prime_k0(hb + (size_t)tm * 128 * DM, DM, W + (size_t)(tn * 128) * DM, DM, pre);
    for (; have; tm = ntm, tn = ntn) {
        have = ti_next(it, ntm, ntn);
        const bf16_t* nAt = have ? hb + (size_t)ntm * 128 * DM : hb; const bf16_t* nBt = have ? W + (size_t)(ntn * 128) * DM : W;
        const int c0 = tn * 128;
        const bool isV = (c0 == 640) || (c0 >= 2304 && c0 < 2816) || (c0 >= 3328 && c0 < 3840);
        f32x4 acc[4][4]; zero_acc(acc);
        const int cb = c0 + wc * 64;
        if (isV) {
            gemm128pre<false>(hb + (size_t)tm * 128 * DM, DM, W + (size_t)c0 * DM, DM, DM, pre, acc, lds);
            prime_k0(nAt, DM, nBt, DM, pre);
            bf16_t* vt; int cl, DV, NH;
            if (cb < 768) { vt = (bf16_t*)(p.ws + OFF_VTA); cl = cb - 640; DV = 64; NH = 2; }
            else if (cb < 2816) { vt = (bf16_t*)(p.ws + OFF_VTC); cl = cb - 2304; DV = 128; NH = 4; }
            else { vt = (bf16_t*)(p.ws + OFF_VTD); cl = cb - 3328; DV = 128; NH = 4; }
#pragma unroll
            for (int m = 0; m < 4; ++m)
#pragma unroll
                for (int n = 0; n < 4; ++n)
                    otile_put(lds, wc * 64 + n * 16 + r16, wr * 64 + m * 16 + q4 * 4, pk2(acc[m][n][0], acc[m][n][1]), pk2(acc[m][n][2], acc[m][n][3]));
            otile_flush(lds, vt + ((size_t)((tm * 128) >> 11) * NH * DV + (cl - wc * 64)) * SL + ((tm * 128) & 2047), SL);
        } else {
            gemm128pre<true>(hb + (size_t)tm * 128 * DM, DM, W + (size_t)c0 * DM, DM, DM, pre, acc, lds);
            bool donorm = false, dosig = false; int rot = 0; float scale = 1.f; const float* gain = nullptr;
            bf16_t* dst = ub; int ld = INW, dcol = cb;
            if (cb < 512) { donorm = true; rot = 1; scale = 0.125f * LOG2E; gain = p.in[I_QG] + layer * 64; }
            else if (cb < 640) { donorm = true; rot = 1; gain = p.in[I_KG] + layer * 64; }
            else if (cb < 1280) { }
            else if (cb < 1792) { scale = 0.125f * LOG2E; }
            else if (cb < 2816) { }
            else if (cb < 3072) { rot = 2; scale = 0.125f; }
            else if (cb < 3328) { rot = 2; }
            else if (cb < INW) { }
            else { dosig = true; dst = gb; ld = 4096; dcol = cb - INW; }
            float gl[4][4];
            if (donorm) {
#pragma unroll
                for (int n = 0; n < 4; ++n) { const f32x4 g4 = *(const f32x4*)(gain + n * 16 + q4 * 4); gl[n][0] = g4[0]; gl[n][1] = g4[1]; gl[n][2] = g4[2]; gl[n][3] = g4[3]; }
            }
            const float* ct = (const float*)(p.ws + (rot == 2 ? OFF_COSD : OFF_COSA));
            const float* sn = (const float*)(p.ws + (rot == 2 ? OFF_SIND : OFF_SINA));
#pragma unroll
            for (int m = 0; m < 4; ++m) {
                asm volatile("" ::: "memory");
                const int row = tm * 128 + wr * 64 + m * 16 + r16, tpos = row & 2047;
                float v[4][4];
#pragma unroll
                for (int n = 0; n < 4; ++n)
#pragma unroll
                    for (int i = 0; i < 4; ++i) v[n][i] = acc[m][n][i];
                if (donorm) {
                    float ss = 0.f;
#pragma unroll
                    for (int n = 0; n < 4; ++n)
#pragma unroll
                        for (int i = 0; i < 4; ++i) ss += v[n][i] * v[n][i];
                    ss += __shfl_xor(ss, 16); ss += __shfl_xor(ss, 32);
                    const float rstd = rsqrtf(ss * (1.0f / 64.0f) + EPS);
#pragma unroll
                    for (int n = 0; n < 4; ++n)
#pragma unroll
                        for (int i = 0; i < 4; ++i) v[n][i] = v[n][i] * rstd * gl[n][i];
                }
                if (rot) {
#pragma unroll
                    for (int n = 0; n < 2; ++n) {
                        const f32x4 c4 = *(const f32x4*)(ct + tpos * 32 + n * 16 + q4 * 4), s4 = *(const f32x4*)(sn + tpos * 32 + n * 16 + q4 * 4);
#pragma unroll
                        for (int i = 0; i < 4; ++i) { const float x1 = v[n][i], x2 = v[n + 2][i]; v[n][i] = x1 * c4[i] - x2 * s4[i]; v[n + 2][i] = x2 * c4[i] + x1 * s4[i]; }
                    }
                }
#pragma unroll
                for (int n = 0; n < 4; ++n) {
                    float o0, o1, o2, o3;
                    if (dosig) { o0 = sigmoidf_(v[n][0]); o1 = sigmoidf_(v[n][1]); o2 = sigmoidf_(v[n][2]); o3 = sigmoidf_(v[n][3]); }
                    else { o0 = v[n][0] * scale; o1 = v[n][1] * scale; o2 = v[n][2] * scale; o3 = v[n][3] * scale; }
                    otile_put(lds, wr * 64 + m * 16 + r16, wc * 64 + n * 16 + q4 * 4, pk2(o0, o1), pk2(o2, o3));
                }
            }
            prime_k0(nAt, DM, nBt, DM, pre);
            otile_flush(lds, dst + (size_t)(tm * 128) * ld + (dcol - wc * 64), ld);
        }
    }
}

template <int DV, int MODE>
DI void attn_task(const Params& p, int task, char* lds) {
    constexpr int NDT = DV / 32;
    constexpr int STG = 64 * AROWB + DV * AROWB;
    const int tid = tidx(), lane = tid & 63, wave = tid >> 6, r = lane & 31, h = lane >> 5;
    const bf16_t* ub = (const bf16_t*)(p.ws + OFF_U);
    const int qt = task & 15; const int rest = task >> 4;
    int seq, head, map = 0, qcol, kcol; const bf16_t* vt;
    if (MODE == 0) { head = rest & 7; seq = rest >> 3; qcol = head * 64; kcol = 512 + (head >> 2) * 64; vt = (const bf16_t*)(p.ws + OFF_VTA) + (size_t)(seq * 2 + (head >> 2)) * 64 * SL; }
    else if (MODE == 1) { map = rest & 1; head = (rest >> 1) & 3; seq = rest >> 3; qcol = 1280 + head * 128 + map * 64; kcol = 1792 + head * 128 + map * 64; vt = (const bf16_t*)(p.ws + OFF_VTC) + (size_t)(seq * 4 + head) * 128 * SL; }
    else { head = rest & 3; seq = rest >> 2; qcol = 2816 + head * 64; kcol = 3072 + head * 64; vt = (const bf16_t*)(p.ws + OFF_VTD) + (size_t)(seq * 4 + head) * 128 * SL; }
    const int qpos = qt * 128 + wave * 32 + r;
    const bf16_t* qptr = ub + ((size_t)seq * SL + qpos) * INW + qcol;
    bf16x8 qf[4];
#pragma unroll
    for (int s = 0; s < 4; ++s) qf[s] = *(const bf16x8*)(qptr + 16 * s + 8 * h);
    const bf16_t* kbase = ub + (size_t)seq * SL * INW + kcol;
    float* sBias = (float*)(lds + 2 * STG);
    if (MODE == 1) { const float* bl = (const float*)(p.ws + OFF_BIAS) + head * 4096; for (int i = tid; i < 4096; i += 256) sBias[i] = bl[i]; }
    float lgam = 0.f;
    if (MODE == 2) lgam = log2f(1.0f - exp2f(-5.0f - (float)head));
    f32x16 o[NDT];
#pragma unroll
    for (int d = 0; d < NDT; ++d)
#pragma unroll
        for (int i = 0; i < 16; ++i) o[d][i] = 0.f;
    float lsum = 0.f;
    const int srow = tid >> 3, sc = tid & 7;
    const bf16_t* kg = kbase + (size_t)srow * INW + sc * 8;
    const bf16_t* vg = vt + (size_t)srow * SL + sc * 8;
    u32x4 rk[2], rv[NDT];
#pragma unroll
    for (int i = 0; i < 2; ++i) rk[i] = *(const u32x4*)(kg + (size_t)(32 * i) * INW);
#pragma unroll
    for (int i = 0; i < NDT; ++i) rv[i] = *(const u32x4*)(vg + (size_t)(32 * i) * SL);
    const int soff = srow * AROWB + sc * 16;
#pragma unroll
    for (int i = 0; i < 2; ++i) *(u32x4*)(lds + soff + 32 * i * AROWB) = rk[i];
#pragma unroll
    for (int i = 0; i < NDT; ++i) *(u32x4*)(lds + 64 * AROWB + soff + 32 * i * AROWB) = rv[i];
    __syncthreads();
    for (int kt = 0; kt < SL / 64; ++kt) {
        const char* cur = lds + (kt & 1) * STG;
        char* nxt = lds + ((kt + 1) & 1) * STG;
        const bool more = kt + 1 < SL / 64;
        const int kv0 = kt * 64;
        if (more) {
            kg += (size_t)64 * INW; vg += 64;
#pragma unroll
            for (int i = 0; i < 2; ++i) rk[i] = *(const u32x4*)(kg + (size_t)(32 * i) * INW);
#pragma unroll
            for (int i = 0; i < NDT; ++i) rv[i] = *(const u32x4*)(vg + (size_t)(32 * i) * SL);
        }
        f32x16 st[2];
#pragma unroll
        for (int kk = 0; kk < 2; ++kk) {
#pragma unroll
            for (int i = 0; i < 16; ++i) st[kk][i] = 0.f;
#pragma unroll
            for (int s = 0; s < 4; ++s) {
                const bf16x8 kf = *(const bf16x8*)(cur + (32 * kk + r) * AROWB + (16 * s + 8 * h) * 2);
                st[kk] = MFMA32(kf, qf[s], st[kk]);
            }
        }
        const int qw0 = qt * 128 + wave * 32;
        const bool farL = MODE == 1 && (kv0 + 63 - qw0) <= -128, farR = MODE == 1 && (kv0 - (qw0 + 31)) >= 128;
        if (MODE == 1 && (farL || farR)) {
            const float bc = farL ? sBias[0] : sBias[4094];
#pragma unroll
            for (int kk = 0; kk < 2; ++kk)
#pragma unroll
                for (int i = 0; i < 16; ++i) { const float pv = __builtin_amdgcn_exp2f(st[kk][i] + bc); lsum += pv; st[kk][i] = pv; }
        } else
#pragma unroll
        for (int kk = 0; kk < 2; ++kk)
#pragma unroll
            for (int i = 0; i < 16; ++i) {
                const int m = kv0 + 32 * kk + (i & 3) + 8 * (i >> 2) + 4 * h;
                float pv;
                if (MODE == 0) pv = __builtin_amdgcn_exp2f(st[kk][i]);
                else if (MODE == 1) pv = __builtin_amdgcn_exp2f(st[kk][i] + sBias[m - qpos + 2047]);
                else pv = st[kk][i] * __builtin_amdgcn_exp2f(lgam * fabsf((float)(qpos - m)));
                if (MODE != 2) lsum += pv;
                st[kk][i] = pv;
            }
        const char* sV = cur + 64 * AROWB;
#pragma unroll
        for (int kk = 0; kk < 2; ++kk)
#pragma unroll
            for (int s2 = 0; s2 < 2; ++s2) {
                u32x4 pw;
#pragma unroll
                for (int j = 0; j < 4; ++j) pw[j] = pk2(st[kk][8 * s2 + 2 * j], st[kk][8 * s2 + 2 * j + 1]);
                const bf16x8 pf = __builtin_bit_cast(bf16x8, pw);
#pragma unroll
                for (int d = 0; d < NDT; ++d) {
                    const char* va = sV + (32 * d + r) * AROWB + (32 * kk + 16 * s2 + 4 * h) * 2;
                    const s16x4 lo = *(const s16x4*)va, hi = *(const s16x4*)(va + 16);
                    const bf16x8 vf = __builtin_shufflevector(lo, hi, 0, 1, 2, 3, 4, 5, 6, 7);
                    o[d] = MFMA32(vf, pf, o[d]);
                }
            }
        if (more) {
#pragma unroll
            for (int i = 0; i < 2; ++i) *(u32x4*)(nxt + soff + 32 * i * AROWB) = rk[i];
#pragma unroll
            for (int i = 0; i < NDT; ++i) *(u32x4*)(nxt + 64 * AROWB + soff + 32 * i * AROWB) = rv[i];
        }
        __syncthreads();
    }
    const size_t tok = (size_t)seq * SL + qpos;
    if (MODE != 2) {
        const float ltot = lsum + __shfl_xor(lsum, 32);
        const float inv = __builtin_amdgcn_rcpf(ltot);
        bf16_t* dst = MODE == 0 ? (bf16_t*)(p.ws + OFF_O) + tok * 512 + head * 64
                                : (bf16_t*)(p.ws + OFF_DT) + ((size_t)map * TG + tok) * 512 + head * 128;
        if (DV == 128) {
#pragma unroll
            for (int d = 0; d < NDT; ++d)
#pragma unroll
                for (int a = 0; a < 4; ++a) otile_put(lds, wave * 32 + r, 32 * d + 8 * a + 4 * h, pk2(o[d][4 * a] * inv, o[d][4 * a + 1] * inv), pk2(o[d][4 * a + 2] * inv, o[d][4 * a + 3] * inv));
            otile_flush(lds, (bf16_t*)(p.ws + OFF_DT) + ((size_t)map * TG + (size_t)seq * SL + qt * 128) * 512 + head * 128, 512);
        } else {
#pragma unroll
        for (int d = 0; d < NDT; ++d)
#pragma unroll
            for (int a = 0; a < 4; ++a) {
                u32x2 wv; wv[0] = pk2(o[d][4 * a] * inv, o[d][4 * a + 1] * inv); wv[1] = pk2(o[d][4 * a + 2] * inv, o[d][4 * a + 3] * inv);
                *(u32x2*)(dst + 32 * d + 8 * a + 4 * h) = wv;
            }
        }
    } else {
        float s = 0.f;
#pragma unroll
        for (int d = 0; d < NDT; ++d)
#pragma unroll
            for (int i = 0; i < 16; ++i) s += o[d][i];
        s += __shfl_xor(s, 32);
        const float mu = s * (1.0f / 128.0f);
        float vs = 0.f;
#pragma unroll
        for (int d = 0; d < NDT; ++d)
#pragma unroll
            for (int i = 0; i < 16; ++i) { const float dd = o[d][i] - mu; vs += dd * dd; }
        vs += __shfl_xor(vs, 32);
        const float rstd = rsqrtf(vs * (1.0f / 128.0f) + EPS);
        const bf16_t* gp = ub + tok * INW + 3840 + head * 128;
        bf16_t* dst = (bf16_t*)(p.ws + OFF_O) + ((size_t)3 * TG + tok) * 512 + head * 128;
        u32x2 gwv[NDT][4];
#pragma unroll
        for (int d = 0; d < NDT; ++d)
#pragma unroll
            for (int a = 0; a < 4; ++a) gwv[d][a] = *(const u32x2*)(gp + 32 * d + 8 * a + 4 * h);
#pragma unroll
        for (int d = 0; d < NDT; ++d)
#pragma unroll
            for (int a = 0; a < 4; ++a) {
                const u32x2 gw = gwv[d][a];
                const float g0 = bflo(gw[0]), g1 = bfhi(gw[0]), g2 = bflo(gw[1]), g3 = bfhi(gw[1]);
                const float y0 = (o[d][4 * a] - mu) * rstd * g0 * sigmoidf_(g0), y1 = (o[d][4 * a + 1] - mu) * rstd * g1 * sigmoidf_(g1);
                const float y2 = (o[d][4 * a + 2] - mu) * rstd * g2 * sigmoidf_(g2), y3 = (o[d][4 * a + 3] - mu) * rstd * g3 * sigmoidf_(g3);
                otile_put(lds, wave * 32 + r, 32 * d + 8 * a + 4 * h, pk2(y0, y1), pk2(y2, y3));
            }
        otile_flush(lds, (bf16_t*)(p.ws + OFF_O) + ((size_t)3 * TG + (size_t)seq * SL + qt * 128) * 512 + head * 128, 512);
    }
}

DI void attn_gqa2(const Params& p, int task, char* lds) {
    constexpr int DV = 64, NDT = 2;
    constexpr int STG = 64 * AROWB + DV * AROWB;
    const int tid = tidx(), lane = tid & 63, wave = tid >> 6, r = lane & 31, h = lane >> 5;
    const bf16_t* ub = (const bf16_t*)(p.ws + OFF_U);
    const int qt = task & 7, rest = task >> 3, head = rest & 7, seq = rest >> 3;
    const int qcol = head * 64, kcol = 512 + (head >> 2) * 64;
    const bf16_t* vt = (const bf16_t*)(p.ws + OFF_VTA) + (size_t)(seq * 2 + (head >> 2)) * 64 * SL;
    const int qpos0 = qt * 256 + wave * 64 + r;
    bf16x8 qf[2][4];
#pragma unroll
    for (int qs = 0; qs < 2; ++qs) {
        const bf16_t* qptr = ub + ((size_t)seq * SL + qpos0 + 32 * qs) * INW + qcol;
#pragma unroll
        for (int s = 0; s < 4; ++s) qf[qs][s] = *(const bf16x8*)(qptr + 16 * s + 8 * h);
    }
    const bf16_t* kbase = ub + (size_t)seq * SL * INW + kcol;
    f32x16 o[2][NDT];
#pragma unroll
    for (int qs = 0; qs < 2; ++qs)
#pragma unroll
        for (int d = 0; d < NDT; ++d)
#pragma unroll
            for (int i = 0; i < 16; ++i) o[qs][d][i] = 0.f;
    float lsum[2] = {0.f, 0.f};
    const int srow = tid >> 3, sc = tid & 7;
    const bf16_t* kg = kbase + (size_t)srow * INW + sc * 8;
    const bf16_t* vg = vt + (size_t)srow * SL + sc * 8;
    u32x4 rk[2], rv[NDT];
#pragma unroll
    for (int i = 0; i < 2; ++i) rk[i] = *(const u32x4*)(kg + (size_t)(32 * i) * INW);
#pragma unroll
    for (int i = 0; i < NDT; ++i) rv[i] = *(const u32x4*)(vg + (size_t)(32 * i) * SL);
    const int soff = srow * AROWB + sc * 16;
#pragma unroll
    for (int i = 0; i < 2; ++i) *(u32x4*)(lds + soff + 32 * i * AROWB) = rk[i];
#pragma unroll
    for (int i = 0; i < NDT; ++i) *(u32x4*)(lds + 64 * AROWB + soff + 32 * i * AROWB) = rv[i];
    __syncthreads();
    for (int kt = 0; kt < SL / 64; ++kt) {
        const char* cur = lds + (kt & 1) * STG;
        char* nxt = lds + ((kt + 1) & 1) * STG;
        const bool more = kt + 1 < SL / 64;
        if (more) {
            kg += (size_t)64 * INW; vg += 64;
#pragma unroll
            for (int i = 0; i < 2; ++i) rk[i] = *(const u32x4*)(kg + (size_t)(32 * i) * INW);
#pragma unroll
            for (int i = 0; i < NDT; ++i) rv[i] = *(const u32x4*)(vg + (size_t)(32 * i) * SL);
        }
        f32x16 st[2][2];
#pragma unroll
        for (int kk = 0; kk < 2; ++kk) {
#pragma unroll
            for (int i = 0; i < 16; ++i) { st[0][kk][i] = 0.f; st[1][kk][i] = 0.f; }
#pragma unroll
            for (int s = 0; s < 4; ++s) {
                const bf16x8 kf = *(const bf16x8*)(cur + (32 * kk + r) * AROWB + (16 * s + 8 * h) * 2);
                st[0][kk] = MFMA32(kf, qf[0][s], st[0][kk]);
                st[1][kk] = MFMA32(kf, qf[1][s], st[1][kk]);
            }
        }
#pragma unroll
        for (int qs = 0; qs < 2; ++qs)
#pragma unroll
            for (int kk = 0; kk < 2; ++kk)
#pragma unroll
                for (int i = 0; i < 16; ++i) { const float pv = __builtin_amdgcn_exp2f(st[qs][kk][i]); lsum[qs] += pv; st[qs][kk][i] = pv; }
        const char* sV = cur + 64 * AROWB;
#pragma unroll
        for (int kk = 0; kk < 2; ++kk)
#pragma unroll
            for (int s2 = 0; s2 < 2; ++s2) {
                bf16x8 pf[2];
#pragma unroll
                for (int qs = 0; qs < 2; ++qs) {
                    u32x4 pw;
#pragma unroll
                    for (int j = 0; j < 4; ++j) pw[j] = pk2(st[qs][kk][8 * s2 + 2 * j], st[qs][kk][8 * s2 + 2 * j + 1]);
                    pf[qs] = __builtin_bit_cast(bf16x8, pw);
                }
#pragma unroll
                for (int d = 0; d < NDT; ++d) {
                    const char* va = sV + (32 * d + r) * AROWB + (32 * kk + 16 * s2 + 4 * h) * 2;
                    const s16x4 lo = *(const s16x4*)va, hi = *(const s16x4*)(va + 16);
                    const bf16x8 vf = __builtin_shufflevector(lo, hi, 0, 1, 2, 3, 4, 5, 6, 7);
                    o[0][d] = MFMA32(vf, pf[0], o[0][d]);
                    o[1][d] = MFMA32(vf, pf[1], o[1][d]);
                }
            }
        if (more) {
#pragma unroll
            for (int i = 0; i < 2; ++i) *(u32x4*)(nxt + soff + 32 * i * AROWB) = rk[i];
#pragma unroll
            for (int i = 0; i < NDT; ++i) *(u32x4*)(nxt + 64 * AROWB + soff + 32 * i * AROWB) = rv[i];
        }
        __syncthreads();
    }
#pragma unroll
    for (int qs = 0; qs < 2; ++qs) {
        const size_t tok = (size_t)seq * SL + qpos0 + 32 * qs;
        const float ltot = lsum[qs] + __shfl_xor(lsum[qs], 32);
        const float inv = __builtin_amdgcn_rcpf(ltot);
        bf16_t* dst = (bf16_t*)(p.ws + OFF_O) + tok * 512 + head * 64;
#pragma unroll
        for (int d = 0; d < NDT; ++d)
#pragma unroll
            for (int a = 0; a < 4; ++a) {
                u32x2 wv; wv[0] = pk2(o[qs][d][4 * a] * inv, o[qs][d][4 * a + 1] * inv); wv[1] = pk2(o[qs][d][4 * a + 2] * inv, o[qs][d][4 * a + 3] * inv);
                *(u32x2*)(dst + 32 * d + 8 * a + 4 * h) = wv;
            }
    }
}

DI void tr_read8(unsigned a, s16x4 (&v)[8]) {
    asm volatile("ds_read_b64_tr_b16 %0, %8\n\tds_read_b64_tr_b16 %1, %8 offset:256\n\tds_read_b64_tr_b16 %2, %8 offset:1024\n\tds_read_b64_tr_b16 %3, %8 offset:1280\n\t"
                 "ds_read_b64_tr_b16 %4, %8 offset:2048\n\tds_read_b64_tr_b16 %5, %8 offset:2304\n\tds_read_b64_tr_b16 %6, %8 offset:3072\n\tds_read_b64_tr_b16 %7, %8 offset:3328\n\t"
                 "s_waitcnt lgkmcnt(0)"
                 : "=&v"(v[0]), "=&v"(v[1]), "=&v"(v[2]), "=&v"(v[3]), "=&v"(v[4]), "=&v"(v[5]), "=&v"(v[6]), "=&v"(v[7]) : "v"(a) : "memory");
}

DI void s5_wave_task(const Params& p, int layer, int wt, char* ldsw) {
    const int lane = tidx() & 63, r = lane & 31, h = lane >> 5;
    const int dir = wt & 1, g = (wt >> 1) & 31, pair = wt >> 6;
    const bf16_t* ub = (const bf16_t*)(p.ws + OFF_U);
    const int hp = (r >> 2) & 1, ia = 4 * (r >> 3) + (r & 3);
    const unsigned img = (unsigned)(size_t)ldsw;
    char* chunkbuf = ldsw + 8192;
    const int i16 = lane & 15, tq = i16 >> 2, tp = i16 & 3, blk = (lane >> 4) & 1;
    const unsigned trA = img + (8 * h + tq) * 64 + 8 * (4 * blk + tp);
    const float dsk = r < 16 ? p.in[I_SD][layer * 512 + g * 16 + r] : 0.f;
    bf16_t* yl = (bf16_t*)(p.ws + (dir ? OFF_YB : OFF_YF)) + ((size_t)(2 * pair + h) * 512 + g * 16 + (r & 15)) * SL;
    const int pb = (layer * 2 + dir) * 32 + g;
    const float dt = expf(p.in[I_SLDT][pb]);
    float abr[2], abi[2];
    bf16x8 bfrag[2][2], cfrag[2][2][2], dfrag;
    {
        u32x4 dw;
#pragma unroll
        for (int j = 0; j < 4; ++j) dw[j] = pk2((dir == 0 && r == 8 * h + 2 * j) ? dsk : 0.f, (dir == 0 && r == 8 * h + 2 * j + 1) ? dsk : 0.f);
        dfrag = __builtin_bit_cast(bf16x8, dw);
    }
#pragma unroll
    for (int st = 0; st < 2; ++st) {
        const int n = 32 * st + r;
        const float are = p.in[I_SARE][pb * 64 + n], aim = p.in[I_SAIM][pb * 64 + n];
        const float mag = expf(dt * are);
        abr[st] = mag * cosf(dt * aim); abi[st] = mag * sinf(dt * aim);
        const float den = are * are + aim * aim, nr = abr[st] - 1.0f;
        const float fre = (nr * are + abi[st] * aim) / den, fim = (abi[st] * are - nr * aim) / den;
        const float* bre = p.in[I_SBRE] + ((size_t)pb * 64 + n) * 16 + 8 * h;
        const float* bim = p.in[I_SBIM] + ((size_t)pb * 64 + n) * 16 + 8 * h;
        u32x4 wre, wim;
#pragma unroll
        for (int j = 0; j < 4; ++j) {
            const float br0 = bre[2 * j], bi0 = bim[2 * j], br1 = bre[2 * j + 1], bi1 = bim[2 * j + 1];
            wre[j] = pk2(fre * br0 - fim * bi0, fre * br1 - fim * bi1);
            wim[j] = pk2(fre * bi0 + fim * br0, fre * bi1 + fim * br1);
        }
        bfrag[st][0] = __builtin_bit_cast(bf16x8, wre); bfrag[st][1] = __builtin_bit_cast(bf16x8, wim);
#pragma unroll
        for (int s = 0; s < 2; ++s) {
            u32x4 cr = {0u, 0u, 0u, 0u}, ci = {0u, 0u, 0u, 0u};
            if (r < 16) {
                const float* cre = p.in[I_SCRE] + ((size_t)pb * 16 + r) * 64 + 32 * st + 16 * s + 8 * h;
                const float* cim = p.in[I_SCIM] + ((size_t)pb * 16 + r) * 64 + 32 * st + 16 * s + 8 * h;
#pragma unroll
                for (int j = 0; j < 4; ++j) { cr[j] = pk2(cre[2 * j], cre[2 * j + 1]); ci[j] = pk2(-cim[2 * j], -cim[2 * j + 1]); }
            }
            cfrag[st][s][0] = __builtin_bit_cast(bf16x8, cr); cfrag[st][s][1] = __builtin_bit_cast(bf16x8, ci);
        }
    }
    float sre[2] = {0.f, 0.f}, sim[2] = {0.f, 0.f};
    const bf16_t* gsrc[4]; int loff[4];
#pragma unroll
    for (int j = 0; j < 4; ++j) {
        const int c = lane + 64 * j, row = c >> 1, half = c & 1, ss = row >> 6, tau = row & 63;
        gsrc[j] = ub + ((size_t)(2 * pair + ss) * SL + (dir ? (SL - 1 - tau) : tau)) * INW + 768 + g * 16 + half * 8;
        loff[j] = row * 32 + half * 16;
    }
    const long cstep = dir ? -(long)64 * INW : (long)64 * INW;
    u32x4 crg[4];
#pragma unroll
    for (int j = 0; j < 4; ++j) crg[j] = *(const u32x4*)gsrc[j];
#pragma unroll
    for (int j = 0; j < 4; ++j) *(u32x4*)(chunkbuf + loff[j]) = crg[j];
    const int aoff = (hp * 64 + ia) * 32 + h * 16;
    for (int chunk = 0; chunk < SL / 64; ++chunk) {
        if (chunk + 1 < SL / 64) {
#pragma unroll
            for (int j = 0; j < 4; ++j) { gsrc[j] += cstep; crg[j] = *(const u32x4*)gsrc[j]; }
        }
        const char* cb = chunkbuf + (chunk & 1) * 4096;
#pragma unroll 1
        for (int tl = 0; tl < 4; ++tl) {
            const int s0 = chunk * 64 + tl * 16;
            const bf16x8 ua = *(const bf16x8*)(cb + aoff + tl * 512);
            f32x16 z;
#pragma unroll
            for (int i = 0; i < 16; ++i) z[i] = 0.f;
            f32x16 y0 = MFMA32(ua, dfrag, z);
            f32x16 y1 = z;
#pragma unroll
            for (int st = 0; st < 2; ++st) {
                f32x16 xr = MFMA32(ua, bfrag[st][0], z);
                f32x16 xi = MFMA32(ua, bfrag[st][1], z);
                float cr = sre[st], ci = sim[st];
#pragma unroll
                for (int i = 0; i < 16; ++i) {
                    const float nr = abr[st] * cr - abi[st] * ci + xr[i];
                    const float ni = abr[st] * ci + abi[st] * cr + xi[i];
                    cr = nr; ci = ni; xr[i] = nr; xi[i] = ni;
                }
                sre[st] = cr; sim[st] = ci;
#pragma unroll
                for (int a = 0; a < 4; ++a) {
                    u32x2 w0, w1; w0[0] = pk2(xr[4 * a], xr[4 * a + 1]); w0[1] = pk2(xr[4 * a + 2], xr[4 * a + 3]);
                    w1[0] = pk2(xi[4 * a], xi[4 * a + 1]); w1[1] = pk2(xi[4 * a + 2], xi[4 * a + 3]);
                    *(u32x2*)(ldsw + (st * 2 + 0) * 2048 + r * 64 + 8 * (2 * a + h)) = w0;
                    *(u32x2*)(ldsw + (st * 2 + 1) * 2048 + r * 64 + 8 * (2 * a + h)) = w1;
                }
            }
            asm volatile("s_waitcnt lgkmcnt(0)" ::: "memory");
            {
                s16x4 v[8];
                tr_read8(trA, v);
                y0 = MFMA32(__builtin_shufflevector(v[0], v[1], 0, 1, 2, 3, 4, 5, 6, 7), cfrag[0][0][0], y0);
                y0 = MFMA32(__builtin_shufflevector(v[2], v[3], 0, 1, 2, 3, 4, 5, 6, 7), cfrag[0][1][0], y0);
                y0 = MFMA32(__builtin_shufflevector(v[4], v[5], 0, 1, 2, 3, 4, 5, 6, 7), cfrag[0][0][1], y0);
                y0 = MFMA32(__builtin_shufflevector(v[6], v[7], 0, 1, 2, 3, 4, 5, 6, 7), cfrag[0][1][1], y0);
                s16x4 u[8];
                tr_read8(trA + 4096, u);
                y1 = MFMA32(__builtin_shufflevector(u[0], u[1], 0, 1, 2, 3, 4, 5, 6, 7), cfrag[1][0][0], y1);
                y1 = MFMA32(__builtin_shufflevector(u[2], u[3], 0, 1, 2, 3, 4, 5, 6, 7), cfrag[1][1][0], y1);
                y1 = MFMA32(__builtin_shufflevector(u[4], u[5], 0, 1, 2, 3, 4, 5, 6, 7), cfrag[1][0][1], y1);
                y1 = MFMA32(__builtin_shufflevector(u[6], u[7], 0, 1, 2, 3, 4, 5, 6, 7), cfrag[1][1][1], y1);
            }
            if (r < 16) {
                u32x4 o0, o1;
                if (dir == 0) {
#pragma unroll
                    for (int j = 0; j < 4; ++j) { o0[j] = pk2(y0[2 * j] + y1[2 * j], y0[2 * j + 1] + y1[2 * j + 1]); o1[j] = pk2(y0[8 + 2 * j] + y1[8 + 2 * j], y0[9 + 2 * j] + y1[9 + 2 * j]); }
                    *(u32x4*)(yl + s0) = o0; *(u32x4*)(yl + s0 + 8) = o1;
                } else {
#pragma unroll
                    for (int j = 0; j < 4; ++j) { o0[j] = pk2(y0[15 - 2 * j] + y1[15 - 2 * j], y0[14 - 2 * j] + y1[14 - 2 * j]); o1[j] = pk2(y0[7 - 2 * j] + y1[7 - 2 * j], y0[6 - 2 * j] + y1[6 - 2 * j]); }
                    *(u32x4*)(yl + (SL - 16 - s0)) = o0; *(u32x4*)(yl + (SL - 16 - s0) + 8) = o1;
                }
            }
        }
        if (chunk + 1 < SL / 64) {
#pragma unroll
            for (int j = 0; j < 4; ++j) *(u32x4*)(chunkbuf + ((chunk + 1) & 1) * 4096 + loff[j]) = crg[j];
        }
    }
}

DI void phase_mix(const Params& p, int layer, int qidx, char* lds, bool only_s5 = false) {
    __shared__ int s_task;
    int* qc = (int*)(p.ws + OFF_QCNT) + qidx;
    constexpr int N_S5 = (G / 2) * 32 * 2 / 4, N_DIFF = G * 4 * 2 * 16, N_RET = G * 4 * 16, N_GQA = G * 8 * 8;
    constexpr int NTOT = N_S5 + N_DIFF + N_RET + N_GQA;
    for (;;) {
        __syncthreads();
        if (tidx() == 0) s_task = atomicAdd(qc, 1);
        __syncthreads();
        int task = s_task;
        if (task >= (only_s5 ? N_S5 : NTOT)) break;
        if (task < N_S5) { const int wave = tidx() >> 6; s5_wave_task(p, layer, task * 4 + wave, lds + wave * 16384); }
        else if ((task -= N_S5) < N_DIFF) attn_task<128, 1>(p, task, lds);
        else if ((task -= N_DIFF) < N_RET) attn_task<128, 2>(p, task, lds);
        else attn_gqa2(p, task - N_RET, lds);
    }
}

DI float gelu_tanh(float v) { const float z2 = 1.5957691216057308f * (v + 0.044715f * v * v * v); return v * __builtin_amdgcn_rcpf(1.0f + __builtin_amdgcn_exp2f(-LOG2E * z2)); }

DI void glu_tile(const Params& p, int layer, int tm, int tn, char* lds) {
    const int tid = tidx(), lane = tid & 63, w = tid >> 6, wr = w >> 1, wc = w & 1, r16 = lane & 15, q4 = lane >> 4;
    const bf16_t* yf = (const bf16_t*)(p.ws + OFF_YF);
    const bf16_t* yb = (const bf16_t*)(p.ws + OFF_YB);
    const bf16_t* B = wts(p, layer) + WGLU + (size_t)tn * 128 * 512;
    const int seq = (tm * 128) >> 11, t0 = (tm * 128) & 2047;
    const int ach = tid & 63, aseg0 = tid >> 6;
    const bf16_t* fg = yf + ((size_t)seq * 512 + ach) * SL + t0;
    const bf16_t* bg2 = yb + ((size_t)seq * 512 + ach) * SL + t0;
    const int srow = tid >> 3, scol = tid & 7;
    const bf16_t* bg = B + (size_t)srow * 512 + scol * 8;
    const int soff = srow * ROWB + ((scol ^ ((srow >> 1) & 7)) << 4);
    u32x4 rf[4], rbk[4], rb[4];
    f32x4 acc[4][4]; zero_acc(acc);
    const int aoff = (wr * 64 + (lane & 15)) * ROWB;
    const int boff = GT_BYTES + (wc * 64 + (lane & 15)) * ROWB;
    const int sw = ((lane >> 4) ^ ((lane & 15) >> 1)) << 4;
    for (int kt = 0; kt < 8; ++kt) {
#pragma unroll
        for (int j = 0; j < 4; ++j) {
            rf[j] = *(const u32x4*)(fg + (size_t)kt * 64 * SL + (aseg0 + 4 * j) * 8);
            rbk[j] = *(const u32x4*)(bg2 + (size_t)kt * 64 * SL + (aseg0 + 4 * j) * 8);
            rb[j] = *(const u32x4*)(bg + (size_t)(32 * j) * 512 + kt * 64);
        }
#pragma unroll
        for (int j = 0; j < 4; ++j) {
            *(u32x4*)(lds + GT_BYTES + soff + 32 * j * ROWB) = rb[j];
            char* abase = lds + (aseg0 + 4 * j) * 8 * ROWB + (ach & 7) * 2;
#pragma unroll
            for (int e = 0; e < 4; ++e) {
                const float v0 = gelu_tanh(bflo(rf[j][e]) + bflo(rbk[j][e])), v1 = gelu_tanh(bfhi(rf[j][e]) + bfhi(rbk[j][e]));
                const unsigned pw = pk2(v0, v1);
                const int cs = (((ach >> 3) ^ ((4 * aseg0 + e) & 7)) << 4);
                *(bf16_t*)(abase + (2 * e) * ROWB + cs) = (bf16_t)(pw & 0xffffu);
                *(bf16_t*)(abase + (2 * e + 1) * ROWB + cs) = (bf16_t)(pw >> 16);
            }
        }
        __syncthreads();
        gemm_compute<false, 0>(lds, aoff, boff, sw, acc);
        __syncthreads();
    }
    bf16_t* ob = (bf16_t*)(p.ws + OFF_O) + (size_t)1 * TG * 512;
    const float* bgl = p.in[I_SBGLU] + layer * 512;
#pragma unroll
    for (int n = 0; n < 4; ++n) {
        const int ch = tn * 128 + wc * 64 + n * 16 + r16;
        const float bias = bgl[ch];
#pragma unroll
        for (int m = 0; m < 4; ++m) {
            const int tl = wr * 64 + m * 16 + q4 * 4;
            const u32x2 fw = *(const u32x2*)(yf + ((size_t)seq * 512 + ch) * SL + t0 + tl);
            const u32x2 bw = *(const u32x2*)(yb + ((size_t)seq * 512 + ch) * SL + t0 + tl);
            const float y0 = gelu_tanh(bflo(fw[0]) + bflo(bw[0])), y1 = gelu_tanh(bfhi(fw[0]) + bfhi(bw[0]));
            const float y2 = gelu_tanh(bflo(fw[1]) + bflo(bw[1])), y3 = gelu_tanh(bfhi(fw[1]) + bfhi(bw[1]));
            const unsigned w01 = pk2(y0 * sigmoidf_(acc[m][n][0] + bias), y1 * sigmoidf_(acc[m][n][1] + bias));
            const unsigned w23 = pk2(y2 * sigmoidf_(acc[m][n][2] + bias), y3 * sigmoidf_(acc[m][n][3] + bias));
            bf16_t* orow = ob + (size_t)(tm * 128 + tl) * 512 + ch;
            orow[0] = (bf16_t)(w01 & 0xffffu); orow[512] = (bf16_t)(w01 >> 16); orow[1024] = (bf16_t)(w23 & 0xffffu); orow[1536] = (bf16_t)(w23 >> 16);
        }
    }
}

DI void phase_glu(const Params& p, int layer, char* lds) {
    const int lane = tidx() & 63, w = tidx() >> 6;
    { TileIter it; ti_init(it, TG / 128, 4, 16, 4); int tm, tn; while (ti_next(it, tm, tn)) glu_tile(p, layer, tm, tn, lds); }
    const float lam = ((const float*)(p.ws + OFF_LAM))[layer], li = ((const float*)(p.ws + OFF_LAM))[4 + layer];
    const bf16_t* d0 = (const bf16_t*)(p.ws + OFF_DT); const bf16_t* d1 = d0 + (size_t)TG * 512;
    bf16_t* oc = (bf16_t*)(p.ws + OFF_O) + (size_t)2 * TG * 512;
    const f32x2 sg = *(const f32x2*)(p.in[I_DSUB] + layer * 128 + 2 * lane);
    const int gw = bidx() * 4 + w, nw = gdim() * 4;
    for (int it0 = gw; it0 < TG * 4; it0 += 8 * nw) {
        unsigned a[8], b[8];
#pragma unroll
        for (int j = 0; j < 8; ++j) {
            const int it = it0 + j * nw;
            const size_t off = (size_t)(it < TG * 4 ? it : gw) * 128 + 2 * lane;
            a[j] = *(const unsigned*)(d0 + off); b[j] = *(const unsigned*)(d1 + off);
        }
#pragma unroll
        for (int j = 0; j < 8; ++j) {
            const int it = it0 + j * nw;
            const float v0 = bflo(a[j]) - lam * bflo(b[j]), v1 = bfhi(a[j]) - lam * bfhi(b[j]);
            const float ss = wave_sum(v0 * v0 + v1 * v1);
            const float rs = rsqrtf(ss * (1.0f / 128.0f) + EPS) * (1.0f - li);
            if (it < TG * 4) *(unsigned*)(oc + (size_t)it * 128 + 2 * lane) = pk2(v0 * rs * sg[0], v1 * rs * sg[1]);
        }
    }
}

DI void phase_merge(const Params& p, int layer, char* lds) {
    const int lane = tidx() & 63, w = tidx() >> 6, wr = w >> 1, wc = w & 1, r16 = lane & 15, q4 = lane >> 4;
    const bf16_t* ob = (const bf16_t*)(p.ws + OFF_O);
    const bf16_t* gb = (const bf16_t*)(p.ws + OFF_GATE);
    const bf16_t* W = wts(p, layer) + WB;
    bf16_t* mb = (bf16_t*)(p.ws + OFF_M);
    TileIter it; ti_init(it, TG / 128, 8, 8, 8);
    int tm, tn;
    while (ti_next(it, tm, tn)) {
        f32x4 macc[4][4]; zero_acc(macc);
#pragma unroll 1
        for (int b = 0; b < 4; ++b) {
            f32x4 acc[4][4]; zero_acc(acc);
            gemm128<true, 0, false>(ob + ((size_t)b * TG + tm * 128) * 512, 512, W + ((size_t)b * 1024 + tn * 128) * 512, 512, 512, acc, lds);
#pragma unroll
            for (int m = 0; m < 4; ++m) {
                const int row = tm * 128 + wr * 64 + m * 16 + r16;
#pragma unroll
                for (int n = 0; n < 4; ++n) {
                    const int col = tn * 128 + wc * 64 + n * 16 + q4 * 4;
                    const u32x2 gw = *(const u32x2*)(gb + (size_t)row * 4096 + b * 1024 + col);
                    macc[m][n][0] += acc[m][n][0] * bflo(gw[0]); macc[m][n][1] += acc[m][n][1] * bfhi(gw[0]);
                    macc[m][n][2] += acc[m][n][2] * bflo(gw[1]); macc[m][n][3] += acc[m][n][3] * bfhi(gw[1]);
                }
            }
        }
#pragma unroll
        for (int m = 0; m < 4; ++m) {
            const int row = tm * 128 + wr * 64 + m * 16 + r16;
#pragma unroll
            for (int n = 0; n < 4; ++n) {
                const int col = tn * 128 + wc * 64 + n * 16 + q4 * 4;
                otile_put(lds, wr * 64 + m * 16 + r16, wc * 64 + n * 16 + q4 * 4, pk2(macc[m][n][0], macc[m][n][1]), pk2(macc[m][n][2], macc[m][n][3]));
            }
        }
        otile_flush(lds, mb + (size_t)(tm * 128) * DM + tn * 128, DM);
    }
}

DI void phase_resid(const Params& p, int grp, const bf16_t* A, int K, const bf16_t* Wt, bool first, char* lds) {
    const int lane = tidx() & 63, w = tidx() >> 6, wr = w >> 1, wc = w & 1, r16 = lane & 15, q4 = lane >> 4;
    TileIter it; ti_init(it, TG / 128, 8, 8, 8);
    int tm, tn, ntm = 0, ntn = 0;
    bool have = ti_next(it, tm, tn);
    GemmRegs g;
    if (have) gemm_prime(A + (size_t)tm * 128 * K, K, Wt + (size_t)tn * 128 * K, K, g);
    for (; have; tm = ntm, tn = ntn) {
        have = ti_next(it, ntm, ntn);
        const bf16_t* At = A + (size_t)tm * 128 * K; const bf16_t* Bt = Wt + (size_t)tn * 128 * K;
        const bf16_t* nAt = have ? A + (size_t)ntm * 128 * K : At; const bf16_t* nBt = have ? Wt + (size_t)ntn * 128 * K : Bt;
        f32x4 acc[4][4]; zero_acc(acc);
        gemm_stream<true>(At, Bt, nAt, nBt, K, K, K, g, acc, lds);
        {
            const int tid = tidx();
            f32x4 xv[12];
#define RES_LOAD(I0, N) { _Pragma("unroll") for (int i = 0; i < (N); ++i) { const int c = tid + 256 * ((I0) + i), rl = c >> 5, ch = c & 31, row = tm * 128 + rl; \
                const float* xi = first ? x_in_row(p, grp, row) + tn * 128 + ch * 4 : p.out + ((size_t)grp * TG + row) * DM + tn * 128 + ch * 4; xv[i] = *(const f32x4*)xi; } }
#define RES_STORE(I0, N) { _Pragma("unroll") for (int i = 0; i < (N); ++i) { const int c = tid + 256 * ((I0) + i), rl = c >> 5, ch = c & 31, row = tm * 128 + rl; \
                float* xo = p.out + ((size_t)grp * TG + row) * DM + tn * 128 + ch * 4; const f32x4 a = *(const f32x4*)(lds + rl * OROWF + ch * 16); *(f32x4*)xo = xv[i] + a; } }
            RES_LOAD(0, 12);
#pragma unroll
            for (int m = 0; m < 4; ++m)
#pragma unroll
                for (int n = 0; n < 4; ++n) *(f32x4*)(lds + (wr * 64 + m * 16 + r16) * OROWF + (wc * 64 + n * 16 + q4 * 4) * 4) = acc[m][n];
            __syncthreads();
            RES_STORE(0, 12);
            RES_LOAD(12, 4);
            RES_STORE(12, 4);
        }
        __syncthreads();
    }
}

DI void phase_ffn1(const Params& p, int layer, char* lds) {
    const int lane = tidx() & 63, w = tidx() >> 6, wr = w >> 1, wc = w & 1, r16 = lane & 15, q4 = lane >> 4;
    const bf16_t* hb = (const bf16_t*)(p.ws + OFF_H);
    const bf16_t* W = wts(p, layer) + WFI;
    bf16_t* fb = (bf16_t*)(p.ws + OFF_F);
    constexpr int NT = DFF / 64;
    TileIter it; ti_init(it, TG / 128, NT, 8, 4);
    int tm, tn, ntm = 0, ntn = 0;
    bool have = ti_next(it, tm, tn);
    GemmRegs g;
    if (have) gemm_prime(hb + (size_t)tm * 128 * DM, DM, W + (size_t)tn * 128 * DM, DM, g);
    for (; have; tm = ntm, tn = ntn) {
        have = ti_next(it, ntm, ntn);
        const bf16_t* At = hb + (size_t)tm * 128 * DM; const bf16_t* Bt = W + (size_t)tn * 128 * DM;
        const bf16_t* nAt = have ? hb + (size_t)ntm * 128 * DM : At; const bf16_t* nBt = have ? W + (size_t)ntn * 128 * DM : Bt;
        f32x4 acc[4][4]; zero_acc(acc);
        gemm_stream<true, 1>(At, Bt, nAt, nBt, DM, DM, DM, g, acc, lds);
#pragma unroll
        for (int m = 0; m < 4; ++m) {
            const int row = tm * 128 + wr * 64 + m * 16 + r16;
#pragma unroll
            for (int n = 0; n < 2; ++n) {
                const int col = tn * 64 + wc * 32 + n * 16 + q4 * 4;
                float f[4];
#pragma unroll
                for (int i = 0; i < 4; ++i) { const float gq = acc[m][n][i]; f[i] = gq * sigmoidf_(gq) * acc[m][n + 2][i]; }
                otile_put(lds, wr * 64 + m * 16 + r16, wc * 32 + n * 16 + q4 * 4, pk2(f[0], f[1]), pk2(f[2], f[3]));
            }
        }
        {
            const int tid = tidx();
            __syncthreads();
#pragma unroll
            for (int i = 0; i < 4; ++i) {
                const int c = tid + 256 * i, row = c >> 3, ch = c & 7;
                const u32x4 v = *(const u32x4*)(lds + row * OROW + ch * 16);
                *(u32x4*)(fb + (size_t)(tm * 128 + row) * DFF + tn * 64 + ch * 8) = v;
            }
            __syncthreads();
        }
    }
}

#define XB_TMO      128
#define XB_XCNT(j)  (256  + 64 * (j))
#define XB_XSUB(j)  (1280 + 64 * (j))
#define XB_XGEN(j)  (2304 + 64 * (j))
#define XB_TOP      3328
#define XB_TOPGEN   3392
#define XCD_BAR_WORDS 3456
#define XB_SPIN_CAP (1u << 18)
#define LAS __attribute__((address_space(3)))

__device__ __forceinline__ unsigned xb_ld(unsigned* p)              { return __hip_atomic_load(p, __ATOMIC_RELAXED, __HIP_MEMORY_SCOPE_AGENT); }
__device__ __forceinline__ unsigned xb_add(unsigned* p, unsigned v) { return __hip_atomic_fetch_add(p, v, __ATOMIC_RELAXED, __HIP_MEMORY_SCOPE_AGENT); }
__device__ __forceinline__ unsigned xb_xcc_id() { return (unsigned)__builtin_amdgcn_s_getreg((3 << 11) | 20) & 0xFu; }
#define XB_SPIN(cond, bar) do { unsigned _sp = 0; while (cond) { __builtin_amdgcn_s_sleep(1); \
    if ((++_sp & 255u) == 0u) { if (xb_ld(&(bar)[XB_TMO])) break; if (_sp > XB_SPIN_CAP) { atomicAdd(&(bar)[XB_TMO], 1u); break; } } } } while (0)

struct XcdBarrier {
    unsigned* bar; unsigned x;
    volatile LAS unsigned* st;
};

__device__ __forceinline__ XcdBarrier xcd_barrier_post(unsigned* bar, volatile LAS unsigned* st) {
    XcdBarrier b; b.bar = bar; b.x = xb_xcc_id(); b.st = st;
    if (threadIdx.x == 0) (void)xb_add(&bar[XB_XCNT(b.x)], 1u);
    return b;
}
__device__ __forceinline__ void xcd_barrier_complete(unsigned* bar, unsigned x, unsigned& nloc, unsigned& nx) {
    const unsigned G = gdim() * gridDim.y * gridDim.z;
    unsigned sum, cnt, mine, sp = 0u;
    for (;;) {
        sum = 0u; cnt = 0u; mine = 0u;
#pragma unroll
        for (unsigned j = 0; j < 16; ++j) { const unsigned c = xb_ld(&bar[XB_XCNT(j)]); sum += c; cnt += (c > 0u) ? 1u : 0u; mine = (j == x) ? c : mine; }
        if (sum == G) break;
        __builtin_amdgcn_s_sleep(1);
        if ((++sp & 255u) == 0u) { if (xb_ld(&bar[XB_TMO])) break; if (sp > XB_SPIN_CAP) { atomicAdd(&bar[XB_TMO], 1u); break; } }
    }
    nloc = mine > 0u ? mine : 1u; nx = cnt > 0u ? cnt : 1u;
}

__device__ __forceinline__ void xcd_barrier(const XcdBarrier& b) {
    asm volatile("s_waitcnt vmcnt(0)" ::: "memory");
    __syncthreads();
    if (threadIdx.x == 0) {
        unsigned* bar = b.bar;
        __builtin_amdgcn_s_waitcnt(0);
        unsigned nloc = b.st[0], nx = b.st[1];
        if (nloc == 0u) { xcd_barrier_complete(bar, b.x, nloc, nx); b.st[0] = nloc; b.st[1] = nx; }
        const unsigned old = xb_add(&bar[XB_XSUB(b.x)], 1u);
        const unsigned gen = old / nloc;
        if (old + 1u == (gen + 1u) * nloc) {
            __builtin_amdgcn_fence(__ATOMIC_RELEASE, "agent");
            asm volatile("s_waitcnt vmcnt(0)" ::: "memory");
            const unsigned og = xb_add(&bar[XB_TOP], 1u);
            const unsigned tg = og / nx;
            if (og + 1u == (tg + 1u) * nx) xb_add(&bar[XB_TOPGEN], 1u);
            else XB_SPIN(xb_ld(&bar[XB_TOPGEN]) == tg, bar);
            __builtin_amdgcn_fence(__ATOMIC_ACQUIRE, "agent");
            xb_add(&bar[XB_XGEN(b.x)], 1u);
            asm volatile("s_waitcnt vmcnt(0)" ::: "memory");
        } else {
            XB_SPIN(xb_ld(&bar[XB_XGEN(b.x)]) == gen, bar);
            __builtin_amdgcn_fence(__ATOMIC_ACQUIRE, "agent");
            asm volatile("s_waitcnt vmcnt(0)" ::: "memory");
        }
    }
    __syncthreads();
}


constexpr int PH_PER_GRP = 4 * 9 + 1;
constexpr int NPHASE = 1 + NGRP * PH_PER_GRP;

#ifndef PROBE_K
#define PROBE_K (-1)
#endif
DI void run_phase(const Params& p, int ph, char* lds, int rep = 0) {
    if (ph == 0) { phase_prologue(p, lds); return; }
    const int q = ph - 1, grp = q / PH_PER_GRP, r = q % PH_PER_GRP;
    if (r == 36) { phase_norm(p, grp, p.in[I_NFIN], 2); return; }
    const int layer = r / 9, k = r % 9;
    switch (k) {
        case 0: phase_norm(p, grp, p.in[I_NMIX] + layer * DM, layer == 0 ? 0 : 1); break;
        case 1: phase_in(p, layer, lds, rep == 1); break;
        case 2: phase_mix(p, layer, grp * 4 + layer + 20 * rep, lds, rep == 1); break;
        case 3: phase_glu(p, layer, lds); break;
        case 4: phase_merge(p, layer, lds); break;
        case 5: phase_resid(p, grp, (const bf16_t*)(p.ws + OFF_M), DM, wts(p, layer) + WO, layer == 0, lds); break;
        case 6: phase_norm(p, grp, p.in[I_NFFN] + layer * DM, 1); break;
        case 7: phase_ffn1(p, layer, lds); break;
        default: phase_resid(p, grp, (const bf16_t*)(p.ws + OFF_F), DFF, wts(p, layer) + WFO, false, lds); break;
    }
}

__global__ void __launch_bounds__(256, 2) mega(Params p, int only) {
    __shared__ __attribute__((aligned(16))) char lds[LDS_BYTES];
#if MULTI_LAUNCH
    if (only >= 0) { run_phase(p, only, lds); return; }
#endif
    cg::grid_group grid = cg::this_grid();
    __shared__ uint4 xb_words;
    if (threadIdx.x == 0) xb_words = make_uint4(0u, 0u, 0u, 0u);
    __syncthreads();
    XcdBarrier xb = xcd_barrier_post((unsigned*)(p.ws + OFF_BAR), (volatile LAS unsigned*)&xb_words);
    for (int ph = 0; ph < NPHASE; ++ph) {
        run_phase(p, ph, lds);
        if (ph + 1 < NPHASE) { if (ph == 0) grid.sync(); else xcd_barrier(xb); }
        if (PROBE_K == 100) xcd_barrier(xb);
        if (PROBE_K >= 0 && PROBE_K < 9 && ph > 0 && ((ph - 1) % PH_PER_GRP) < 36 && (((ph - 1) % PH_PER_GRP) % 9) == PROBE_K) { run_phase(p, ph, lds, 1); xcd_barrier(xb); }
    }
}

extern "C" void kernel_launch(void* const* d_in, const int* in_sizes, int n_in, void* d_out, int out_size, void* d_ws, size_t ws_size, hipStream_t stream) {
    (void)in_sizes; (void)n_in; (void)out_size;
    static int grid_blocks = 0;
    if (!grid_blocks) {
        int dev = 0, cus = 0, per_cu = 0;
        hipGetDevice(&dev);
        hipDeviceGetAttribute(&cus, hipDeviceAttributeMultiprocessorCount, dev);
        hipOccupancyMaxActiveBlocksPerMultiprocessor(&per_cu, mega, 256, 0);
        if (per_cu < 1) per_cu = 1;
        if (per_cu > 2) per_cu = 2;
        grid_blocks = cus * per_cu;
    }
    if (ws_size < WS_END) { fprintf(stderr, "workspace too small: %zu < %zu\n", ws_size, (size_t)WS_END); return; }
    Params p{};
    for (int i = 0; i < 26; ++i) p.in[i] = (const float*)d_in[i];
    p.out = (float*)d_out; p.ws = (char*)d_ws;
    hipMemsetAsync((char*)d_ws + OFF_BAR, 0, XCD_BAR_WORDS * sizeof(unsigned), stream);
#if MULTI_LAUNCH
    for (int ph = 0; ph < NPHASE; ++ph) mega<<<dim3(grid_blocks), dim3(256), 0, stream>>>(p, ph);
#else
    int only = -1;
    void* args[] = {&p, &only};
    hipError_t e = hipLaunchCooperativeKernel((void*)mega, dim3(grid_blocks), dim3(256), args, 0, stream);
    if (e != hipSuccess) fprintf(stderr, "cooperative launch failed: %s (grid %d)\n", hipGetErrorString(e), grid_blocks);
#endif
}
```
